# Optimizing an MI355X kernel written in HIP

```python
import math
import jax, jax.numpy as jnp
from jax import lax
import numpy as np

D_MODEL = 2048
BATCH = 1
SEQ = 8192
DEPTH = 1

CHUNK = 64
EPS = 1e-6
RW_HEADS = 16
RW_HEAD_DIM = 64
RW_WIDTH = RW_HEADS * RW_HEAD_DIM
RW_DECAY_RANK = 64
RW_ICL_RANK = 64
RW_GATE_RANK = 160
RW_GN_EPS = 64e-5
RW_SPLITS = (RW_WIDTH, RW_WIDTH, RW_WIDTH, RW_DECAY_RANK, RW_ICL_RANK, RW_GATE_RANK)
RW_IN = 3 * RW_WIDTH + RW_DECAY_RANK + RW_ICL_RANK + RW_GATE_RANK
SA_HEADS = 16
SA_HEAD_DIM = 64
SA_WIDTH = SA_HEADS * SA_HEAD_DIM
SA_SCALE = SA_HEAD_DIM ** -0.5
KV_RANK = 256
IDX_HEADS = 8
IDX_DIM = 64
IDX_SCALE = (IDX_HEADS * IDX_DIM) ** -0.5
TOPK_MAX = 256
Q_BLOCK = 128
REL_BUCKETS = 32
REL_MAX_DIST = 1024
N_BRANCHES = 2
IN_SPLITS = (RW_IN, SA_WIDTH, KV_RANK, IDX_HEADS * IDX_DIM, IDX_DIM, IDX_HEADS, N_BRANCHES * D_MODEL)
IN_TOTAL = RW_IN + SA_WIDTH + KV_RANK + IDX_HEADS * IDX_DIM + IDX_DIM + IDX_HEADS + N_BRANCHES * D_MODEL
PEER_HEADS = 8
PEER_KEYS = 128
PEER_EXPERTS = PEER_KEYS * PEER_KEYS
PEER_QDIM = 256
PEER_HALF = PEER_QDIM // 2
PEER_TOPK = 16
PEER_BLOCK = 128

kernel_name = 'hybrid_rwkv7_dsa_peer'


def _split(x, sizes):
    idx = []
    acc = 0
    for s in sizes[:-1]:
        acc += s
        idx.append(acc)
    return jnp.split(x, idx, axis=-1)


def _rmsnorm(x, g):
    x32 = x.astype(jnp.float32)
    y = x32 * lax.rsqrt(jnp.mean(x32 * x32, axis=-1, keepdims=True) + EPS)
    return (y * g.astype(jnp.float32)).astype(x.dtype)


def _rel_bucket(rel):
    nb = REL_BUCKETS // 2
    max_exact = nb // 2
    ret = (rel > 0).astype(jnp.int32) * nb
    n = jnp.abs(rel)
    large = max_exact + (jnp.log(jnp.maximum(n, 1).astype(jnp.float32) / max_exact)
                         / math.log(REL_MAX_DIST / max_exact) * (nb - max_exact)).astype(jnp.int32)
    large = jnp.minimum(large, nb - 1)
    return ret + jnp.where(n < max_exact, n, large)


def _rwkv7_time_mix(p, shift_mix, w0, w_decay_up, a0, w_icl_up, w_gate_up, k_k, k_a, r_k, ln_x_w, ln_x_b):
    B, T, _ = p.shape
    H, N = RW_HEADS, RW_HEAD_DIM
    f32 = jnp.float32
    prev = jnp.pad(p, ((0, 0), (1, 0), (0, 0)))[:, :T]
    z = p + (prev - p) * shift_mix
    r, k, v, zw, za, zg = _split(z, RW_SPLITS)
    w_log = -jax.nn.softplus(-(w0 + jnp.tanh(zw) @ w_decay_up).astype(f32)) - 0.5
    decay = jnp.exp(-jnp.exp(w_log))
    a = jax.nn.sigmoid((a0 + za @ w_icl_up).astype(f32))
    g = jax.nn.sigmoid(zg) @ w_gate_up
    kf = k.astype(f32)
    kk = (kf * k_k.astype(f32)).reshape(B, T, H, N)
    kk = kk / jnp.maximum(jnp.linalg.norm(kk, axis=-1, keepdims=True), 1e-12)
    k4 = (kf * (1.0 + (a - 1.0) * k_a.astype(f32))).reshape(B, T, H, N)
    r4 = r.astype(f32).reshape(B, T, H, N)
    v4 = v.astype(f32).reshape(B, T, H, N)
    a4 = a.reshape(B, T, H, N)
    w4 = decay.reshape(B, T, H, N)

    def step(S, inp):
        r_t, k_t, v_t, kk_t, a_t, w_t = inp
        sa = jnp.einsum('bhvk,bhk->bhv', S, -kk_t)
        S = (S * w_t[:, :, None, :] + sa[..., None] * (kk_t * a_t)[:, :, None, :]
             + v_t[..., None] * k_t[:, :, None, :])
        return S, jnp.einsum('bhvk,bhk->bhv', S, r_t)

    xs = tuple(jnp.moveaxis(t, 1, 0) for t in (r4, k4, v4, kk, a4, w4))
    _, ys = lax.scan(step, jnp.zeros((B, H, N, N), f32), xs)
    y = jnp.moveaxis(ys, 0, 1)
    mean = jnp.mean(y, axis=-1, keepdims=True)
    var = jnp.mean(jnp.square(y - mean), axis=-1, keepdims=True)
    y = ((y - mean) * lax.rsqrt(var + RW_GN_EPS)).reshape(B, T, RW_WIDTH)
    y = y * ln_x_w.astype(f32) + ln_x_b.astype(f32)
    bonus = jnp.sum(r4 * k4 * r_k.astype(f32), axis=-1, keepdims=True) * v4
    y = (y + bonus.reshape(B, T, RW_WIDTH)) * g.astype(f32)
    return y.astype(p.dtype)


def _dsa_attention(q, c_kv, iq, ik, iw, kv_norm_g, w_uk, w_uv, rel_bias):
    B, T, _ = q.shape
    topk = min(TOPK_MAX, T // 4)
    f32 = jnp.float32
    c = _rmsnorm(c_kv, kv_norm_g)
    q_lat = jnp.einsum('bthd,hrd->bthr', q.reshape(B, T, SA_HEADS, SA_HEAD_DIM), w_uk)
    iq = iq.reshape(B, T, IDX_HEADS, IDX_DIM)
    iw = iw * IDX_SCALE
    key_chunk = jnp.arange(T) // CHUNK

    def block(i):
        s0 = i * Q_BLOCK
        qi = lax.dynamic_slice_in_dim(iq, s0, Q_BLOCK, axis=1)
        wi = lax.dynamic_slice_in_dim(iw, s0, Q_BLOCK, axis=1)
        ql = lax.dynamic_slice_in_dim(q_lat, s0, Q_BLOCK, axis=1)
        tq = s0 + jnp.arange(Q_BLOCK)
        score = jnp.einsum('bqhs,bqh->bqs', jax.nn.relu(jnp.einsum('bqhd,bsd->bqhs', qi, ik)), wi).astype(f32)
        allowed = key_chunk[None, :] <= (tq // CHUNK)[:, None]
        score = jnp.where(allowed[None], score, -jnp.inf)
        top_s, idx = lax.top_k(score, topk)
        valid = jnp.isfinite(top_s)
        c_sel = jax.vmap(lambda cb, ib: cb[ib])(c, idx)
        logits = jnp.einsum('bqhr,bqkr->bqhk', ql, c_sel).astype(f32) * SA_SCALE
        bias = rel_bias[_rel_bucket(idx - tq[None, :, None])]
        logits = logits + jnp.transpose(bias, (0, 1, 3, 2)).astype(f32)
        logits = jnp.where(valid[:, :, None, :], logits, -jnp.inf)
        pr = jax.nn.softmax(logits, axis=-1).astype(c.dtype)
        o_lat = jnp.einsum('bqhk,bqkr->bqhr', pr, c_sel)
        o = jnp.einsum('bqhr,hrd->bqhd', o_lat, w_uv)
        return o.reshape(B, Q_BLOCK, SA_WIDTH)

    out = lax.map(block, jnp.arange(T // Q_BLOCK))
    return jnp.moveaxis(out, 0, 1).reshape(B, T, SA_WIDTH)


def _peer_ffn(h, w_query, sub_keys, expert_u, expert_v):
    B, T, D = h.shape
    q = (h @ w_query).reshape(B, T, PEER_HEADS, 2, PEER_HALF)
    s = jnp.einsum('bthcq,hcnq->bthcn', q, sub_keys).astype(jnp.float32)
    s1, i1 = lax.top_k(s[..., 0, :], PEER_TOPK)
    s2, i2 = lax.top_k(s[..., 1, :], PEER_TOPK)
    cand = (s1[..., :, None] + s2[..., None, :]).reshape(B, T, PEER_HEADS, PEER_TOPK * PEER_TOPK)
    cand_id = (i1[..., :, None] * PEER_KEYS + i2[..., None, :]).reshape(B, T, PEER_HEADS, PEER_TOPK * PEER_TOPK)
    top_s, pos = lax.top_k(cand, PEER_TOPK)
    eid = jnp.take_along_axis(cand_id, pos, axis=-1)
    gate = jax.nn.softmax(top_s, axis=-1).astype(h.dtype)
    nb = (B * T) // PEER_BLOCK
    hb = h.reshape(nb, PEER_BLOCK, D)
    eb = eid.reshape(nb, PEER_BLOCK, PEER_HEADS, PEER_TOPK)
    gb = gate.reshape(nb, PEER_BLOCK, PEER_HEADS, PEER_TOPK)

    def blk(args):
        hx, e, gt = args
        act = jax.nn.gelu(jnp.einsum('nd,nhkd->nhk', hx, expert_u[e]), approximate=False)
        return jnp.einsum('nhk,nhkd->nd', gt * act, expert_v[e])

    return lax.map(blk, (hb, eb, gb)).reshape(B, T, D)


def setup_inputs(seed: int = 0) -> dict:
    key = jax.random.key(seed)
    ks = iter(jax.random.split(key, 40))
    L, D = DEPTH, D_MODEL
    nrm = lambda shape, scale: jax.random.normal(next(ks), shape, jnp.float32) * scale
    uni = lambda shape, lo, hi: jax.random.uniform(next(ks), shape, jnp.float32, lo, hi)
    gain = lambda shape: 1.0 + nrm(shape, 0.02)
    return {
        'x': nrm((BATCH, SEQ, D), 1.0),
        'norm_mix_g': gain((L, D)),
        'w_in': nrm((L, D, IN_TOTAL), D ** -0.5),
        'shift_mix': uni((L, RW_IN), 0.0, 1.0),
        'w0': uni((L, RW_WIDTH), -4.0, 0.0),
        'w_decay_up': nrm((L, RW_DECAY_RANK, RW_WIDTH), 0.3 * RW_DECAY_RANK ** -0.5),
        'a0': nrm((L, RW_WIDTH), 0.3),
        'w_icl_up': nrm((L, RW_ICL_RANK, RW_WIDTH), RW_ICL_RANK ** -0.5),
        'w_gate_up': nrm((L, RW_GATE_RANK, RW_WIDTH), RW_GATE_RANK ** -0.5),
        'k_k': 0.85 + nrm((L, RW_WIDTH), 0.05),
        'k_a': 1.0 + nrm((L, RW_WIDTH), 0.05),
        'r_k': nrm((L, RW_HEADS, RW_HEAD_DIM), 0.1),
        'ln_x_w': gain((L, RW_WIDTH)),
        'ln_x_b': nrm((L, RW_WIDTH), 0.02),
        'kv_norm_g': gain((L, KV_RANK)),
        'w_uk': nrm((L, SA_HEADS, KV_RANK, SA_HEAD_DIM), KV_RANK ** -0.5),
        'w_uv': nrm((L, SA_HEADS, KV_RANK, SA_HEAD_DIM), KV_RANK ** -0.5),
        'rel_bias': nrm((REL_BUCKETS, SA_HEADS), 0.5),
        'w_branch_rwkv': nrm((L, RW_WIDTH, D), RW_WIDTH ** -0.5),
        'w_branch_dsa': nrm((L, SA_WIDTH, D), SA_WIDTH ** -0.5),
        'w_out': nrm((L, D, D), D ** -0.5),
        'norm_ffn_g': gain((L, D)),
        'w_peer_query': nrm((L, D, PEER_HEADS * PEER_QDIM), D ** -0.5),
        'peer_sub_keys': nrm((L, PEER_HEADS, 2, PEER_KEYS, PEER_HALF), PEER_HALF ** -0.5),
        'peer_u': nrm((L, PEER_EXPERTS, D), D ** -0.5),
        'peer_v': nrm((L, PEER_EXPERTS, D), 0.25),
        'norm_final_g': gain((D,)),
    }


def reference(x, norm_mix_g, w_in, shift_mix, w0, w_decay_up, a0, w_icl_up, w_gate_up, k_k, k_a, r_k,
              ln_x_w, ln_x_b, kv_norm_g, w_uk, w_uv, rel_bias, w_branch_rwkv, w_branch_dsa, w_out,
              norm_ffn_g, w_peer_query, peer_sub_keys, peer_u, peer_v, norm_final_g):
    h = x
    for l in range(DEPTH):
        xn = _rmsnorm(h, norm_mix_g[l])
        p_rw, q, c_kv, iq, ik, iw, gates = _split(xn @ w_in[l], IN_SPLITS)
        y_a = _rwkv7_time_mix(p_rw, shift_mix[l], w0[l], w_decay_up[l], a0[l], w_icl_up[l], w_gate_up[l],
                              k_k[l], k_a[l], r_k[l], ln_x_w[l], ln_x_b[l]) @ w_branch_rwkv[l]
        y_b = _dsa_attention(q, c_kv, iq, ik, iw, kv_norm_g[l], w_uk[l], w_uv[l], rel_bias) @ w_branch_dsa[l]
        g_a, g_b = jnp.split(jax.nn.sigmoid(gates), N_BRANCHES, axis=-1)
        h = h + (g_a * y_a + g_b * y_b) @ w_out[l]
        h = h + _peer_ffn(_rmsnorm(h, norm_ffn_g[l]), w_peer_query[l], peer_sub_keys[l], peer_u[l], peer_v[l])
    return _rmsnorm(h, norm_final_g)
```

```cpp
#include <hip/hip_runtime.h>
#include <stdint.h>
#include <stdio.h>

#ifndef MK_SPLIT
#define MK_SPLIT 0
#endif

#ifndef DBG_NOPEER
#define DBG_NOPEER 0
#endif
#ifndef DBG_NODSA
#define DBG_NODSA 0
#endif
typedef unsigned short bfr;
using bf16x8 = __attribute__((ext_vector_type(8))) short;
using bf16x4 = __attribute__((ext_vector_type(4))) short;
using f32x4  = __attribute__((ext_vector_type(4))) float;
using f32x2  = __attribute__((ext_vector_type(2))) float;
using f32x16 = __attribute__((ext_vector_type(16))) float;
using u32x4  = __attribute__((ext_vector_type(4))) unsigned;
using h16x2  = __attribute__((ext_vector_type(2))) _Float16;

constexpr int T = 8192, D = 2048, NIN = 9320, NINP = 9472;
constexpr int RW = 1024, NH = 16, HD = 64;
constexpr int C_R = 0, C_K = 1024, C_V = 2048, C_ZW = 3072, C_ZA = 3136, C_ZG = 3200, C_Q = 3360, C_CKV = 4384,
              C_IQ = 4640, C_IK = 5152, C_IW = 5216, C_GA = 5224, C_GB = 7272;
constexpr int KVR = 256, NUNIT = 128 * 16;
constexpr float EPS = 1e-6f;

constexpr size_t MiB = 1u << 20;
constexpr size_t WS_CTL = 0;
constexpr size_t CTL_ZERO = 65536;
constexpr size_t CTL_CNT = 16384;
constexpr size_t CTL_ROWSS = 32768;
constexpr size_t WS_WTA = 1 * MiB, WS_WTB = 5 * MiB, WS_WTOUT = 9 * MiB, WS_WTPQ = 17 * MiB;
constexpr size_t WS_WUK = 25 * MiB, WS_WUVT = 25 * MiB + 512 * 1024, WS_SUBK = 26 * MiB;
constexpr size_t WS_X = 27 * MiB;
constexpr size_t WS_XN = WS_X, WS_WTIN = WS_X + 32 * MiB;
constexpr size_t WS_PM = WS_X, WS_WY = WS_X + 16 * MiB, WS_GM = WS_X + 32 * MiB, WS_YLOC = WS_X + 48 * MiB;
constexpr size_t WS_MIX = WS_X;
constexpr size_t WS_P = 96 * MiB;
constexpr size_t WS_H = 96 * MiB, WS_HB = 160 * MiB, WS_QP = 192 * MiB;
constexpr size_t WS_GG = 244 * MiB, WS_BON = 260 * MiB, WS_CB = 276 * MiB;
constexpr size_t WS_QLAT = 280 * MiB, WS_OLAT = WS_QLAT;
constexpr size_t WS_KEYS = 344 * MiB;
constexpr size_t WS_PU = 490 * MiB, WS_PV = 312 * MiB;
constexpr size_t WS_PUS = WS_PU + 32 * MiB, WS_PVS = WS_PV + 32 * MiB;
constexpr size_t WS_ZT = 408 * MiB, WS_RWO = 424 * MiB, WS_DO = 440 * MiB, WS_TMPA = 456 * MiB;
constexpr size_t WS_IKC = 489 * MiB;
constexpr size_t WS_PART = 488 * MiB;
constexpr size_t WS_END = 508 * MiB;

constexpr int LDS_BYTES = 163840 - 1024;
constexpr int LDS_BARW = LDS_BYTES - 64;
constexpr int LDS_MISC = LDS_BYTES - 512;

typedef __bf16 bf16v2_t __attribute__((ext_vector_type(2)));
__device__ __forceinline__ bfr f2bf(float f) { const __bf16 r = (__bf16)f; return __builtin_bit_cast(bfr, r); }
__device__ __forceinline__ float bf2f(bfr b) { return __uint_as_float(((unsigned)b) << 16); }
__device__ __forceinline__ unsigned pack2(float a, float b) { const f32x2 v = {a, b}; const bf16v2_t r = __builtin_convertvector(v, bf16v2_t); return __builtin_bit_cast(unsigned, r); }
__device__ __forceinline__ float bflo(unsigned u) { return __uint_as_float(u << 16); }
__device__ __forceinline__ float bfhi(unsigned u) { return __uint_as_float(u & 0xFFFF0000u); }
__device__ __forceinline__ int my_tid() { int t = threadIdx.x; asm volatile("" : "+v"(t)); return t; }

template <int CTRL> __device__ __forceinline__ float dpp_f(float v) {
    return __int_as_float(__builtin_amdgcn_update_dpp(0, __float_as_int(v), CTRL, 0xF, 0xF, true));
}
#define DPP_XOR1 0xB1
#define DPP_XOR2 0x4E
__device__ __forceinline__ float wave_sum(float v) {
    v += dpp_f<DPP_XOR1>(v); v += dpp_f<DPP_XOR2>(v); v += dpp_f<0x141>(v); v += dpp_f<0x140>(v);
    v += __shfl_xor(v, 16); v += __shfl_xor(v, 32); return v;
}
__device__ __forceinline__ float wave_max(float v) {
    v = fmaxf(v, dpp_f<DPP_XOR1>(v)); v = fmaxf(v, dpp_f<DPP_XOR2>(v)); v = fmaxf(v, dpp_f<0x141>(v)); v = fmaxf(v, dpp_f<0x140>(v));
    v = fmaxf(v, __shfl_xor(v, 16)); v = fmaxf(v, __shfl_xor(v, 32)); return v;
}
__device__ __forceinline__ float frcp_(float x) { return __builtin_amdgcn_rcpf(x); }
__device__ __forceinline__ float sigmoidf_(float x) { return frcp_(1.f + __expf(-x)); }

#define XB_TMO      128
#define XB_XCNT(j)  (256  + 64 * (j))
#define XB_XSUB(j)  (1280 + 64 * (j))
#define XB_XGEN(j)  (2304 + 64 * (j))
#define XB_TOP      3328
#define XB_TOPGEN   3392
#define XCD_BAR_WORDS 3456
#define XB_SPIN_CAP (1u << 20)
#define LAS __attribute__((address_space(3)))

__device__ __forceinline__ unsigned xb_ld(unsigned* p)              { return __hip_atomic_load(p, __ATOMIC_RELAXED, __HIP_MEMORY_SCOPE_AGENT); }
__device__ __forceinline__ unsigned xb_add(unsigned* p, unsigned v) { return __hip_atomic_fetch_add(p, v, __ATOMIC_RELAXED, __HIP_MEMORY_SCOPE_AGENT); }
__device__ __forceinline__ unsigned xb_xcc_id() { return (unsigned)__builtin_amdgcn_s_getreg((3 << 11) | 20) & 0xFu; }
#define XB_SPIN(cond, bar) do { unsigned _sp = 0; while (cond) { __builtin_amdgcn_s_sleep(1); \
    if ((++_sp & 255u) == 0u) { if (xb_ld(&(bar)[XB_TMO])) break; if (_sp > XB_SPIN_CAP) { atomicAdd(&(bar)[XB_TMO], 1u); break; } } } } while (0)

struct XcdBarrier { unsigned* bar; unsigned x; volatile LAS unsigned* st; };

__device__ __forceinline__ XcdBarrier xcd_barrier_post(unsigned* bar, volatile LAS unsigned* st) {
    XcdBarrier b; b.bar = bar; b.x = xb_xcc_id(); b.st = st;
    if (threadIdx.x == 0) (void)xb_add(&bar[XB_XCNT(b.x)], 1u);
    return b;
}
__device__ __forceinline__ void xcd_barrier_complete(unsigned* bar, unsigned x, unsigned& nloc, unsigned& nx) {
    const unsigned G = gridDim.x * gridDim.y * gridDim.z;
    unsigned sum, cnt, mine, sp = 0u;
    for (;;) {
        sum = 0u; cnt = 0u; mine = 0u;
#pragma unroll
        for (unsigned j = 0; j < 16; ++j) { const unsigned c = xb_ld(&bar[XB_XCNT(j)]); sum += c; cnt += (c > 0u) ? 1u : 0u; mine = (j == x) ? c : mine; }
        if (sum == G) break;
        __builtin_amdgcn_s_sleep(1);
        if ((++sp & 255u) == 0u) { if (xb_ld(&bar[XB_TMO])) break; if (sp > XB_SPIN_CAP) { atomicAdd(&bar[XB_TMO], 1u); break; } }
    }
    nloc = mine > 0u ? mine : 1u; nx = cnt > 0u ? cnt : 1u;
}
__device__ __forceinline__ void xcd_barrier(const XcdBarrier& b) {
    asm volatile("s_waitcnt vmcnt(0)" ::: "memory");
    __syncthreads();
    if (threadIdx.x == 0) {
        unsigned* bar = b.bar;
        __builtin_amdgcn_s_waitcnt(0);
        unsigned nloc = b.st[0], nx = b.st[1];
        if (nloc == 0u) { xcd_barrier_complete(bar, b.x, nloc, nx); b.st[0] = nloc; b.st[1] = nx; }
        const unsigned old = xb_add(&bar[XB_XSUB(b.x)], 1u);
        const unsigned gen = old / nloc;
        if (old + 1u == (gen + 1u) * nloc) {
            __builtin_amdgcn_fence(__ATOMIC_RELEASE, "agent");
            asm volatile("s_waitcnt vmcnt(0)" ::: "memory");
            const unsigned og = xb_add(&bar[XB_TOP], 1u);
            const unsigned tg = og / nx;
            if (og + 1u == (tg + 1u) * nx) xb_add(&bar[XB_TOPGEN], 1u);
            else XB_SPIN(xb_ld(&bar[XB_TOPGEN]) == tg, bar);
            __builtin_amdgcn_fence(__ATOMIC_ACQUIRE, "agent");
            xb_add(&bar[XB_XGEN(b.x)], 1u);
            asm volatile("s_waitcnt vmcnt(0)" ::: "memory");
        } else {
            XB_SPIN(xb_ld(&bar[XB_XGEN(b.x)]) == gen, bar);
            __builtin_amdgcn_fence(__ATOMIC_ACQUIRE, "agent");
            asm volatile("s_waitcnt vmcnt(0)" ::: "memory");
        }
    }
    __syncthreads();
}

struct Args { const float* in[27]; float* out; unsigned char* ws; int ph_lo, ph_hi; };
enum { I_X = 0, I_NMG, I_WIN, I_SHIFT, I_W0, I_WDEC, I_A0, I_WICL, I_WGATE, I_KK, I_KA, I_RK, I_LNW, I_LNB, I_KVG, I_WUK, I_WUV,
       I_RELB, I_WBR, I_WBD, I_WOUT, I_NFG, I_WPQ, I_SUBK, I_PU, I_PV, I_NFIN };

constexpr int BM = 256, BK = 64, HALF = 128, HT = HALF * BK;
constexpr int EPI_LDW = 260;
__device__ __forceinline__ int lds_byte(int r, int c) {
    int st = (r >> 4) * 2 + (c >> 5), rr = r & 15, cc = c & 31, ob = rr * 64 + cc * 2;
    return st * 1024 + (ob ^ (((ob >> 9) & 1) << 5));
}
__device__ __forceinline__ void stage_rc(int b, int& R, int& C) {
    int st = b / 1024, sb = b % 1024, swz = sb ^ (((sb >> 9) & 1) << 5);
    R = (st >> 1) * 16 + swz / 64; C = (st & 1) * 32 + (swz % 64) / 2;
}

template <class Epi>
__device__ __forceinline__ void gemm_tile(const bfr* __restrict__ A, const bfr* __restrict__ Bt, const int K, const int brow, const int bcol,
                                          bfr* shm, Epi& epi) {
#define SA(b,h) (shm+((b)*2+(h))*HT)
#define SB(b,h) (shm+(4+(b)*2+(h))*HT)
#define STAGE_X(TT,P,BASE,br,kt) do{long _g=(long)(br)*K+(long)(kt)*BK; \
    for(int _i=0;_i<2;++_i){int _b=(TT)*16+_i*8192;int _r,_c;stage_rc(_b,_r,_c); \
      __builtin_amdgcn_global_load_lds((const unsigned*)(BASE+_g+(long)_r*K+_c), \
        (LAS unsigned*)((LAS char*)(P)+_b),16,0,0);}}while(0)
#define STAGE(P,BASE,br,kt) STAGE_X(tq,P,BASE,br,kt)
#define LDA(dst,b,h) for(int m=0;m<4;++m)for(int k=0;k<2;++k) \
    dst[m][k]=*reinterpret_cast<const bf16x8*>((char*)SA(b,h)+lds_byte(wr*64+m*16+fr,k*32+fq*8))
#define LDB(dst,b,h) for(int n=0;n<2;++n)for(int k=0;k<2;++k) \
    dst[n][k]=*reinterpret_cast<const bf16x8*>((char*)SB(b,h)+lds_byte(wc*32+n*16+fr,k*32+fq*8))
#define MMA(ai,bj,At_,Bt_) do{__builtin_amdgcn_s_setprio(1); \
    for(int m=0;m<4;++m)for(int n=0;n<2;++n)for(int k=0;k<2;++k) \
      acc[ai][bj][m][n]=__builtin_amdgcn_mfma_f32_16x16x32_bf16(At_[m][k],Bt_[n][k],acc[ai][bj][m][n],0,0,0); \
    __builtin_amdgcn_s_setprio(0);}while(0)
#define WAIT_V(n) asm volatile("s_waitcnt vmcnt(" #n ")":::"memory")
#define WAIT_L(n) asm volatile("s_waitcnt lgkmcnt(" #n ")":::"memory")
#define BAR __builtin_amdgcn_s_barrier()
#define SCHED __builtin_amdgcn_sched_barrier(0)
    const int tq = my_tid();
    int wid = tq >> 6, lane = tq & 63, wr = wid >> 2, wc = wid & 3, fr = lane & 15, fq = lane >> 4;
    f32x4 acc[2][2][4][2] = {};
    bf16x8 At[4][2], B0[2][2], B1[2][2];
    const int nt = K / BK;
    STAGE(SB(0,0),Bt,bcol,0); STAGE(SA(0,0),A,brow,0);
    STAGE(SB(0,1),Bt,bcol+HALF,0); STAGE(SA(0,1),A,brow+HALF,0);
    if(wr==1)BAR;
    WAIT_V(4); BAR;
    STAGE(SB(1,0),Bt,bcol,1); STAGE(SA(1,0),A,brow,1); STAGE(SB(1,1),Bt,bcol+HALF,1);
    WAIT_V(6); BAR;
    for(int t=0;t<nt-2;t+=2){
        LDB(B0,0,0); SCHED; LDA(At,0,0); STAGE(SA(1,1),A,brow+HALF,t+1);
        WAIT_L(8); BAR; WAIT_L(0); MMA(0,0,At,B0); BAR; SCHED;
        LDB(B1,0,1); STAGE(SB(0,0),Bt,bcol,t+2);
        BAR; WAIT_L(0); MMA(0,1,At,B1); BAR;
        LDA(At,0,1); STAGE(SA(0,0),A,brow,t+2);
        BAR; WAIT_L(0); MMA(1,0,At,B0); BAR; SCHED;
        STAGE(SB(0,1),Bt,bcol+HALF,t+2);
        WAIT_V(6); BAR; MMA(1,1,At,B1); BAR;
        LDB(B0,1,0); SCHED; LDA(At,1,0); STAGE(SA(0,1),A,brow+HALF,t+2);
        WAIT_L(8); BAR; WAIT_L(0); MMA(0,0,At,B0); BAR; SCHED;
        LDB(B1,1,1); STAGE(SB(1,0),Bt,bcol,t+3);
        BAR; WAIT_L(0); MMA(0,1,At,B1); BAR;
        LDA(At,1,1); STAGE(SA(1,0),A,brow,t+3);
        BAR; WAIT_L(0); MMA(1,0,At,B0); BAR; SCHED;
        STAGE(SB(1,1),Bt,bcol+HALF,t+3);
        WAIT_V(6); BAR; MMA(1,1,At,B1); BAR;
    }
    int tz=threadIdx.x; asm volatile("":"+v"(tz)); wid=tz>>6; lane=tz&63; wr=wid>>2; wc=wid&3; fr=lane&15; fq=lane>>4;
    { LDB(B0,0,0); WAIT_V(0); LDA(At,0,0); STAGE_X(tz,SA(1,1),A,brow+HALF,nt-1);
      BAR; WAIT_L(0); MMA(0,0,At,B0); BAR;
      LDB(B1,0,1); BAR; WAIT_L(0); MMA(0,1,At,B1); BAR;
      LDA(At,0,1); WAIT_V(4); BAR; WAIT_L(0); MMA(1,0,At,B0); MMA(1,1,At,B1); BAR; }
    { LDB(B0,1,0); LDA(At,1,0); WAIT_V(2); BAR; WAIT_L(0); MMA(0,0,At,B0); BAR;
      LDB(B1,1,1); WAIT_V(0); BAR; WAIT_L(0); MMA(0,1,At,B1); BAR;
      LDA(At,1,1); BAR; WAIT_L(0); MMA(1,0,At,B0); MMA(1,1,At,B1); BAR; }
    if(wr==0)BAR;
    {
        float* stg = (float*)shm;
#pragma unroll
        for (int ai = 0; ai < 2; ++ai) {
            __syncthreads();
#pragma unroll
            for (int bj = 0; bj < 2; ++bj)
#pragma unroll
                for (int m = 0; m < 4; ++m)
#pragma unroll
                    for (int n = 0; n < 2; ++n)
#pragma unroll
                        for (int j = 0; j < 4; ++j) stg[(wr * 64 + m * 16 + fq * 4 + j) * EPI_LDW + bj * HALF + wc * 32 + n * 16 + fr] = acc[ai][bj][m][n][j];
            __syncthreads();
#pragma unroll 2
            for (int it = 0; it < 8; ++it) {
                const int r = it * 16 + wid * 2 + (lane >> 5), c = (lane & 31) * 8;
                const float4 v0 = *reinterpret_cast<const float4*>(&stg[r * EPI_LDW + c]);
                const float4 v1 = *reinterpret_cast<const float4*>(&stg[r * EPI_LDW + c + 4]);
                const float v[8] = {v0.x, v0.y, v0.z, v0.w, v1.x, v1.y, v1.z, v1.w};
                epi.vec8(brow + ai * HALF + r, bcol + c, v);
            }
        }
    }
    __syncthreads();
#undef SA
#undef SB
#undef STAGE_X
#undef STAGE
#undef LDA
#undef LDB
#undef MMA
}

__device__ __forceinline__ void tile_rc(int wgid, const int nM, const int nN, int& brow, int& bcol) {
    const int nwg = nM * nN;
    { int q = nwg / 8, r = nwg % 8, xcd = wgid % 8, off = wgid / 8; wgid = (xcd < r ? xcd * (q + 1) : r * (q + 1) + (xcd - r) * q) + off; }
    const int nig = 8 * nN, gid = wgid / nig, fm = gid * 8, gsz = min(nM - fm, 8);
    const int pm = fm + ((wgid % nig) % gsz), pn = (wgid % nig) / gsz;
    brow = pm * BM; bcol = pn * BM;
}

__device__ __forceinline__ uint4 pack8(const float* v) { uint4 o; o.x = pack2(v[0], v[1]); o.y = pack2(v[2], v[3]); o.z = pack2(v[4], v[5]); o.w = pack2(v[6], v[7]); return o; }
__device__ __forceinline__ void unpack8(const uint4 u, float* v) { v[0] = bflo(u.x); v[1] = bfhi(u.x); v[2] = bflo(u.y); v[3] = bfhi(u.y); v[4] = bflo(u.z); v[5] = bfhi(u.z); v[6] = bflo(u.w); v[7] = bfhi(u.w); }
struct EpiP {
    bfr* P;
    __device__ __forceinline__ void vec8(int row, int col, const float* v) { *reinterpret_cast<uint4*>(&P[(size_t)row * NINP + col]) = pack8(v); }
};
struct EpiMix {
    bfr* outp; const bfr* addp; const bfr* gate;
    __device__ __forceinline__ void vec8(int row, int col, const float* v) {
        float g[8], r[8];
        unpack8(*reinterpret_cast<const uint4*>(&gate[(size_t)row * NINP + col]), g);
#pragma unroll
        for (int i = 0; i < 8; ++i) r[i] = sigmoidf_(g[i]) * v[i];
        if (addp) { float t[8]; unpack8(*reinterpret_cast<const uint4*>(&addp[(size_t)row * D + col]), t);
#pragma unroll
            for (int i = 0; i < 8; ++i) r[i] += t[i]; }
        *reinterpret_cast<uint4*>(&outp[(size_t)row * D + col]) = pack8(r);
    }
};
struct EpiH {
    bfr* hb; const float* x; float* part; int slot;
    __device__ __forceinline__ void vec8(int row, int col, const float* v) {
        const float4 x0 = *reinterpret_cast<const float4*>(&x[(size_t)row * D + col]), x1 = *reinterpret_cast<const float4*>(&x[(size_t)row * D + col + 4]);
        float h[8] = {x0.x + v[0], x0.y + v[1], x0.z + v[2], x0.w + v[3], x1.x + v[4], x1.y + v[5], x1.z + v[6], x1.w + v[7]};
        *reinterpret_cast<uint4*>(&hb[(size_t)row * D + col]) = pack8(h);
        float s = 0.f;
#pragma unroll
        for (int i = 0; i < 8; ++i) s += h[i] * h[i];
        s += dpp_f<DPP_XOR1>(s); s += dpp_f<DPP_XOR2>(s); s += dpp_f<0x141>(s); s += dpp_f<0x140>(s);
        s += __shfl_xor(s, 16);
        if ((threadIdx.x & 31) == 0) part[(size_t)row * 8 + slot] = s;
    }
};
struct EpiQ {
    bfr* qp; const float* rs; int brow;
    __device__ __forceinline__ void vec8(int row, int col, const float* v) {
        const float sc = rs[row - brow]; float r[8];
#pragma unroll
        for (int i = 0; i < 8; ++i) r[i] = v[i] * sc;
        *reinterpret_cast<uint4*>(&qp[(size_t)row * D + col]) = pack8(r);
    }
};
__device__ __forceinline__ float row_rstd(const float* part, int row) {
    float s = 0.f;
#pragma unroll
    for (int i = 0; i < 8; ++i) s += part[(size_t)row * 8 + i];
    return rsqrtf(s * (1.f / D) + EPS);
}

__device__ __forceinline__ void tr_tile(const float* __restrict__ src, bfr* __restrict__ dst, int K, int N, int k0, int n0, const float* kscale, float* lds) {
    const int tid = my_tid(), n = tid & 63, kk = tid >> 6;
#pragma unroll
    for (int j = 0; j < 8; ++j) { int k = kk + 8 * j, gn = n0 + n; float v = (gn < N) ? src[(size_t)(k0 + k) * N + gn] : 0.f; if (kscale) v *= kscale[k0 + k]; lds[k * 65 + n] = v; }
    __syncthreads();
    const int nn = tid >> 3, ks = tid & 7;
    uint4 o;
    o.x = pack2(lds[(ks * 8 + 0) * 65 + nn], lds[(ks * 8 + 1) * 65 + nn]); o.y = pack2(lds[(ks * 8 + 2) * 65 + nn], lds[(ks * 8 + 3) * 65 + nn]);
    o.z = pack2(lds[(ks * 8 + 4) * 65 + nn], lds[(ks * 8 + 5) * 65 + nn]); o.w = pack2(lds[(ks * 8 + 6) * 65 + nn], lds[(ks * 8 + 7) * 65 + nn]);
    *reinterpret_cast<uint4*>(&dst[(size_t)(n0 + nn) * K + k0 + ks * 8]) = o;
    __syncthreads();
}
struct StripRegs { float v[8][4]; };
__device__ __forceinline__ void strip_load(const float* __restrict__ src, int N, int k0, int n0, StripRegs& R) {
    const int tid = my_tid(), n = tid & 63, kk = tid >> 6;
#pragma unroll
    for (int j = 0; j < 8; ++j)
#pragma unroll
        for (int q = 0; q < 4; ++q) { const int gn = n0 + q * 64 + n; R.v[j][q] = (gn < N) ? src[(size_t)(k0 + kk + 8 * j) * N + gn] : 0.f; }
}
__device__ __forceinline__ void strip_store(const StripRegs& R, bfr* __restrict__ dst, int K, int k0, int n0, const float* kscale, float* lds) {
    const int tid = my_tid(), n = tid & 63, kk = tid >> 6;
#pragma unroll
    for (int j = 0; j < 8; ++j) {
        const float sc = kscale ? kscale[k0 + kk + 8 * j] : 1.f;
#pragma unroll
        for (int q = 0; q < 4; ++q) lds[(kk + 8 * j) * 257 + q * 64 + n] = R.v[j][q] * sc;
    }
    __syncthreads();
    const int nn = tid >> 1, hf = tid & 1;
#pragma unroll
    for (int c = 0; c < 4; ++c) {
        const int kb = hf * 32 + c * 8;
        uint4 o;
        o.x = pack2(lds[(kb + 0) * 257 + nn], lds[(kb + 1) * 257 + nn]); o.y = pack2(lds[(kb + 2) * 257 + nn], lds[(kb + 3) * 257 + nn]);
        o.z = pack2(lds[(kb + 4) * 257 + nn], lds[(kb + 5) * 257 + nn]); o.w = pack2(lds[(kb + 6) * 257 + nn], lds[(kb + 7) * 257 + nn]);
        *reinterpret_cast<uint4*>(&dst[(size_t)(n0 + nn) * K + k0 + kb]) = o;
    }
    __syncthreads();
}
__device__ __forceinline__ void tr_all(const float* src, bfr* dst, int K, int N, int Npad, const float* kscale, float* lds) {
    if ((Npad & 255) == 0) {
        const int nk = K / 64, ns = Npad / 256, tot = nk * ns;
        StripRegs RA, RB;
        int it = blockIdx.x;
        if (it < tot) strip_load(src, N, (it % nk) * 64, (it / nk) * 256, RA);
        while (it < tot) {
            const int itn = it + gridDim.x, it2 = itn + gridDim.x;
            if (itn < tot) strip_load(src, N, (itn % nk) * 64, (itn / nk) * 256, RB);
            strip_store(RA, dst, K, (it % nk) * 64, (it / nk) * 256, kscale, lds);
            if (itn >= tot) break;
            if (it2 < tot) strip_load(src, N, (it2 % nk) * 64, (it2 / nk) * 256, RA);
            strip_store(RB, dst, K, (itn % nk) * 64, (itn / nk) * 256, kscale, lds);
            it = it2;
        }
        return;
    }
    const int nk = K / 64, nn = Npad / 64;
    for (int it = blockIdx.x; it < nk * nn; it += gridDim.x) tr_tile(src, dst, K, N, (it % nk) * 64, (it / nk) * 64, kscale, lds);
}
__device__ __forceinline__ void cvt_all(const float* __restrict__ src, bfr* __restrict__ dst, size_t n) {
    const size_t n4 = n / 4;
    for (size_t i = (size_t)blockIdx.x * 512 + my_tid(); i < n4; i += (size_t)gridDim.x * 512) {
        float4 v = reinterpret_cast<const float4*>(src)[i];
        uint2 o; o.x = pack2(v.x, v.y); o.y = pack2(v.z, v.w);
        reinterpret_cast<uint2*>(dst)[i] = o;
    }
}

constexpr int PEER_ROWB = 1152;
__device__ __forceinline__ void cvt_fp4_rows(const float* __restrict__ src, unsigned char* __restrict__ dst, const int wrank, const int nwaves) {
    const int tid = my_tid(), lane = tid & 63;
    for (int row = wrank; row < 16384; row += nwaves) {
        float v[32]; float amax = 0.f;
#pragma unroll
        for (int q = 0; q < 8; ++q) {
            const float4 x = *reinterpret_cast<const float4*>(&src[(size_t)row * D + q * 256 + lane * 4]);
            v[q * 4] = x.x; v[q * 4 + 1] = x.y; v[q * 4 + 2] = x.z; v[q * 4 + 3] = x.w;
            amax = fmaxf(amax, fmaxf(fmaxf(fabsf(x.x), fabsf(x.y)), fmaxf(fabsf(x.z), fabsf(x.w))));
        }
        const bfr sb = f2bf(amax * (1.f / 6.f));
        const float sc = bf2f(sb), inv = sc > 0.f ? frcp_(sc) : 0.f;
        unsigned dw[4];
#pragma unroll
        for (int d = 0; d < 4; ++d) {
            unsigned p = 0;
            p = __builtin_amdgcn_cvt_scalef32_pk_fp4_f32(p, v[d * 8 + 0] * inv, v[d * 8 + 1] * inv, 1.0f, 0);
            p = __builtin_amdgcn_cvt_scalef32_pk_fp4_f32(p, v[d * 8 + 2] * inv, v[d * 8 + 3] * inv, 1.0f, 1);
            p = __builtin_amdgcn_cvt_scalef32_pk_fp4_f32(p, v[d * 8 + 4] * inv, v[d * 8 + 5] * inv, 1.0f, 2);
            p = __builtin_amdgcn_cvt_scalef32_pk_fp4_f32(p, v[d * 8 + 6] * inv, v[d * 8 + 7] * inv, 1.0f, 3);
            dw[d] = p;
        }
        uint4 o4; o4.x = dw[0]; o4.y = dw[1]; o4.z = dw[2]; o4.w = dw[3];
        *reinterpret_cast<uint4*>(dst + (size_t)row * PEER_ROWB + lane * 16) = o4;
        *reinterpret_cast<bfr*>(dst + (size_t)row * PEER_ROWB + 1024 + lane * 2) = sb;
    }
}

__device__ __forceinline__ unsigned pack8_i4(const float* v) {
    unsigned d = 0;
#pragma unroll
    for (int i = 0; i < 8; ++i) d |= ((unsigned)((int)v[i]) & 0xFu) << (4 * i);
    return d;
}
__device__ __forceinline__ void cvt_i4_rows(const float* __restrict__ src, unsigned char* __restrict__ dst, const int rank, const int nranks) {
    const int tid = my_tid(), lane = tid & 63, wv = tid >> 6;
    for (int row = rank * 8 + wv; row < 16384; row += nranks * 8) {
        float v[32]; float amax = 0.f;
#pragma unroll
        for (int q = 0; q < 8; ++q) {
            const float4 x = *reinterpret_cast<const float4*>(&src[(size_t)row * D + q * 256 + lane * 4]);
            v[q * 4] = x.x; v[q * 4 + 1] = x.y; v[q * 4 + 2] = x.z; v[q * 4 + 3] = x.w;
            amax = fmaxf(amax, fmaxf(fmaxf(fabsf(x.x), fabsf(x.y)), fmaxf(fabsf(x.z), fabsf(x.w))));
        }
        const bfr sb = f2bf(amax * (1.f / 7.f));
        const float sc = bf2f(sb), inv = sc > 0.f ? frcp_(sc) : 0.f;
#pragma unroll
        for (int i = 0; i < 32; ++i) v[i] = fminf(fmaxf(__builtin_rintf(v[i] * inv), -7.f), 7.f);
        uint4 o4; o4.x = pack8_i4(v); o4.y = pack8_i4(v + 8); o4.z = pack8_i4(v + 16); o4.w = pack8_i4(v + 24);
        *reinterpret_cast<uint4*>(dst + (size_t)row * PEER_ROWB + lane * 16) = o4;
        *reinterpret_cast<bfr*>(dst + (size_t)row * PEER_ROWB + 1024 + ((lane & 7) * 8 + (lane >> 3)) * 2) = sb;
    }
}
__device__ __forceinline__ int pm_index(int kp, int k) {
    const int kpt = kp >> 5, r = kp & 31, kt = k >> 5, kk = k & 31, s = kk >> 4, rem = kk & 15;
    const int j = ((rem >> 3) << 2) | (rem & 3), hf = (rem >> 2) & 1, lane = hf * 32 + r;
    return ((((kpt * 2 + kt) * 2 + s) * 64 + lane) * 8) + j;
}
__device__ __forceinline__ int acc_index(int row, int col) {
    const int rt = row >> 5, r = row & 31, ct = col >> 5, c = col & 31;
    const int g4 = r >> 3, comp = r & 3, hf = (r >> 2) & 1, lane = hf * 32 + c;
    return ((((rt * 2 + ct) * 4 + g4) * 64 + lane) * 4) + comp;
}

constexpr int RW_ACT_STRIDE = 296, RW_LD = 72, RW_SLOT = 9216, RW_WL_OFF = 110592, RW_TOT_OFF = 148480, RW_BASE_OFF = 152576, RW_PART_OFF = 156928;
__device__ __forceinline__ f32x16 tile_mm_acc(f32x16 acc, const bfr* A, const int arow0, const bfr* Bt, const int brow0, const int r, const int hf) {
#pragma unroll
    for (int ks = 0; ks < 4; ++ks)
        acc = __builtin_amdgcn_mfma_f32_32x32x16_bf16(*reinterpret_cast<const bf16x8*>(&A[(arow0 + r) * RW_LD + ks * 16 + hf * 8]),
                                                     *reinterpret_cast<const bf16x8*>(&Bt[(brow0 + r) * RW_LD + ks * 16 + hf * 8]), acc, 0, 0, 0);
    return acc;
}
__device__ __forceinline__ f32x16 tile_mm(const bfr* A, const int arow0, const bfr* Bt, const int brow0, const int r, const int hf) {
    f32x16 z;
#pragma unroll
    for (int g = 0; g < 16; ++g) z[g] = 0.f;
    return tile_mm_acc(z, A, arow0, Bt, brow0, r, hf);
}
__device__ __forceinline__ void store_t(bfr* dst, const int col0, const int row0, const f32x16 acc, const int r, const int hf) {
#pragma unroll
    for (int g4 = 0; g4 < 4; ++g4) { uint2 p; p.x = pack2(acc[g4 * 4], acc[g4 * 4 + 1]); p.y = pack2(acc[g4 * 4 + 2], acc[g4 * 4 + 3]);
        *reinterpret_cast<uint2*>(&dst[(col0 + r) * RW_LD + row0 + g4 * 8 + hf * 4]) = p; }
}
#define DPP_HMIRROR 0x141
#define DPP_MIRROR  0x140

__device__ __forceinline__ void rwkv_load_weights(const Args& a, const int h, unsigned char* lds) {
    bfr* WL = (bfr*)(lds + RW_WL_OFF);
    const int tid = my_tid();
    for (int idx = tid; idx < 288 * 64; idx += 512) {
        const int m = idx >> 6, d = idx & 63;
        const float v = (m < 64) ? a.in[I_WDEC][(size_t)m * RW + h * 64 + d] : (m < 128) ? a.in[I_WICL][(size_t)(m - 64) * RW + h * 64 + d] : a.in[I_WGATE][(size_t)(m - 128) * RW + h * 64 + d];
        WL[d * RW_ACT_STRIDE + m] = f2bf(v);
    }
    __syncthreads();
}

struct RwIn { unsigned cu[18], pu[18]; bfr r[2][5], k[2][5], v[2][5]; };
__device__ __forceinline__ void rwkv_fetch(const Args& a, const int c, const int h, RwIn& in) {
    const bfr* __restrict__ P = (const bfr*)(a.ws + WS_P);
    const int tid = my_tid(), lane = tid & 63, wv = tid >> 6, fr = lane & 15, fq = lane >> 4, t0 = c * 64;
    {
        const int i = tid >> 3, part = tid & 7, t = t0 + i;
        const bfr* pc = P + (size_t)t * NINP + C_ZW + part * 36;
        const bfr* pp = pc - NINP;
#pragma unroll
        for (int q = 0; q < 18; ++q) { in.cu[q] = *reinterpret_cast<const unsigned*>(pc + q * 2); in.pu[q] = (t > 0) ? *reinterpret_cast<const unsigned*>(pp + q * 2) : 0u; }
    }
    const int tt = wv >> 1, dh = wv & 1;
#pragma unroll
    for (int dt = 0; dt < 2; ++dt) {
        const int hd = h * 64 + dh * 32 + dt * 16 + fr;
        const int tp = t0 + tt * 16 + fq * 4 - 1;
        const bool hp = tp >= 0;
        in.r[dt][0] = hp ? P[(size_t)(hp ? tp : 0) * NINP + C_R + hd] : (bfr)0; in.k[dt][0] = hp ? P[(size_t)(hp ? tp : 0) * NINP + C_K + hd] : (bfr)0; in.v[dt][0] = hp ? P[(size_t)(hp ? tp : 0) * NINP + C_V + hd] : (bfr)0;
#pragma unroll
        for (int j = 0; j < 4; ++j) { const size_t ro = (size_t)(tp + 1 + j) * NINP; in.r[dt][j + 1] = P[ro + C_R + hd]; in.k[dt][j + 1] = P[ro + C_K + hd]; in.v[dt][j + 1] = P[ro + C_V + hd]; }
    }
}

__device__ __forceinline__ void rwkv_unit(const Args& a, const int c, const int h, unsigned char* lds, const RwIn& in, RwIn& nxt, const int cnext) {
    const float* __restrict__ smix = a.in[I_SHIFT];
    const int tid = my_tid(), lane = tid & 63, wv = tid >> 6, fr = lane & 15, fq = lane >> 4, t0 = c * 64, u = c * 16 + h;
#define SLOT(k) ((bfr*)(lds + (k) * RW_SLOT))
    bfr* ACT = (bfr*)lds; const bfr* WL = (const bfr*)(lds + RW_WL_OFF);
    float* TOT = (float*)(lds + RW_TOT_OFF); float* BASE = (float*)(lds + RW_BASE_OFF); float* PART = (float*)(lds + RW_PART_OFF);
    {
        const int i = tid >> 3, part = tid & 7;
#pragma unroll
        for (int q = 0; q < 18; ++q) {
            const int cc = part * 36 + q * 2;
            const unsigned cu = in.cu[q], pu = in.pu[q];
            const float2 mx = *reinterpret_cast<const float2*>(&smix[C_ZW + cc]);
            const float c0 = bflo(cu), c1 = bfhi(cu);
            float z0 = c0 + (bflo(pu) - c0) * mx.x, z1 = c1 + (bfhi(pu) - c1) * mx.y;
            if (cc < 64) { z0 = 1.f - 2.f * frcp_(1.f + __expf(2.f * z0)); z1 = 1.f - 2.f * frcp_(1.f + __expf(2.f * z1)); }
            else if (cc >= 128) { z0 = sigmoidf_(z0); z1 = sigmoidf_(z1); }
            *reinterpret_cast<unsigned*>(&ACT[i * RW_ACT_STRIDE + cc]) = pack2(z0, z1);
        }
    }
    const int tt = wv >> 1, dh = wv & 1;
    float zr[2][4], zk[2][4], zv[2][4];
#pragma unroll
    for (int dt = 0; dt < 2; ++dt) {
        const int hd = h * 64 + dh * 32 + dt * 16 + fr;
        const float mr = smix[C_R + hd], mk = smix[C_K + hd], mv = smix[C_V + hd];
        float pr = bf2f(in.r[dt][0]), pk = bf2f(in.k[dt][0]), pv = bf2f(in.v[dt][0]);
#pragma unroll
        for (int j = 0; j < 4; ++j) {
            const float cr = bf2f(in.r[dt][j + 1]), ck = bf2f(in.k[dt][j + 1]), cv = bf2f(in.v[dt][j + 1]);
            zr[dt][j] = cr + (pr - cr) * mr; zk[dt][j] = ck + (pk - ck) * mk; zv[dt][j] = cv + (pv - cv) * mv;
            pr = cr; pk = ck; pv = cv;
        }
    }
    __syncthreads();
    f32x4 xw[2], xa[2], xg[2];
#pragma unroll
    for (int dt = 0; dt < 2; ++dt) {
        xw[dt] = f32x4{0.f, 0.f, 0.f, 0.f}; xa[dt] = xw[dt]; xg[dt] = xw[dt];
        const bfr* arow = ACT + (tt * 16 + fr) * RW_ACT_STRIDE + fq * 8;
        const bfr* brow = WL + (dh * 32 + dt * 16 + fr) * RW_ACT_STRIDE + fq * 8;
#pragma unroll
        for (int ks = 0; ks < 2; ++ks) {
            xw[dt] = __builtin_amdgcn_mfma_f32_16x16x32_bf16(*reinterpret_cast<const bf16x8*>(arow + ks * 32), *reinterpret_cast<const bf16x8*>(brow + ks * 32), xw[dt], 0, 0, 0);
            xa[dt] = __builtin_amdgcn_mfma_f32_16x16x32_bf16(*reinterpret_cast<const bf16x8*>(arow + 64 + ks * 32), *reinterpret_cast<const bf16x8*>(brow + 64 + ks * 32), xa[dt], 0, 0, 0);
        }
#pragma unroll
        for (int ks = 0; ks < 5; ++ks)
            xg[dt] = __builtin_amdgcn_mfma_f32_16x16x32_bf16(*reinterpret_cast<const bf16x8*>(arow + 128 + ks * 32), *reinterpret_cast<const bf16x8*>(brow + 128 + ks * 32), xg[dt], 0, 0, 0);
    }
    float lw[2][4], av[2][4], kkr[2][4], k4[2][4], n2[4], cf[4];
#pragma unroll
    for (int j = 0; j < 4; ++j) { n2[j] = 0.f; cf[j] = 0.f; }
#pragma unroll
    for (int dt = 0; dt < 2; ++dt) {
        const int hd = h * 64 + dh * 32 + dt * 16 + fr;
        const float w0 = a.in[I_W0][hd], a0 = a.in[I_A0][hd], kkm = a.in[I_KK][hd], kam = a.in[I_KA][hd], rkm = a.in[I_RK][hd];
        float run = 0.f;
#pragma unroll
        for (int j = 0; j < 4; ++j) {
            run += -0.6065306597126334f * sigmoidf_(w0 + xw[dt][j]);
            lw[dt][j] = run;
            av[dt][j] = sigmoidf_(a0 + xa[dt][j]);
            kkr[dt][j] = zk[dt][j] * kkm;
            k4[dt][j] = zk[dt][j] * (1.f + (av[dt][j] - 1.f) * kam);
            n2[j] += kkr[dt][j] * kkr[dt][j];
            cf[j] += zr[dt][j] * k4[dt][j] * rkm;
        }
        TOT[(tt * 4 + fq) * 64 + dh * 32 + dt * 16 + fr] = run;
    }
#pragma unroll
    for (int j = 0; j < 4; ++j) {
        n2[j] += dpp_f<DPP_XOR1>(n2[j]); n2[j] += dpp_f<DPP_XOR2>(n2[j]); n2[j] += dpp_f<DPP_HMIRROR>(n2[j]); n2[j] += dpp_f<DPP_MIRROR>(n2[j]);
        cf[j] += dpp_f<DPP_XOR1>(cf[j]); cf[j] += dpp_f<DPP_XOR2>(cf[j]); cf[j] += dpp_f<DPP_HMIRROR>(cf[j]); cf[j] += dpp_f<DPP_MIRROR>(cf[j]);
        if (fr == 0) { PART[(wv * 16 + fq * 4 + j) * 2] = n2[j]; PART[(wv * 16 + fq * 4 + j) * 2 + 1] = cf[j]; }
    }
    __syncthreads();
    if (tid < 64) {
        float run = 0.f;
#pragma unroll
        for (int g = 0; g < 16; ++g) { const float tv = TOT[g * 64 + tid]; BASE[g * 64 + tid] = run; run += tv; }
        BASE[16 * 64 + tid] = run;
    }
    __syncthreads();
    {
        bfr* Gg = (bfr*)(a.ws + WS_GG); bfr* Bon = (bfr*)(a.ws + WS_BON);
        const int i0 = tt * 16 + fq * 4;
        float rn[4], cft[4];
#pragma unroll
        for (int j = 0; j < 4; ++j) {
            const float n2t = n2[j] + PART[((wv ^ 1) * 16 + fq * 4 + j) * 2]; cft[j] = cf[j] + PART[((wv ^ 1) * 16 + fq * 4 + j) * 2 + 1];
            rn[j] = __builtin_amdgcn_rsqf(fmaxf(n2t, 1e-24f));
        }
#pragma unroll
        for (int dt = 0; dt < 2; ++dt) {
            const int d = dh * 32 + dt * 16 + fr;
            const float base = BASE[(tt * 4 + fq) * 64 + d], clT = BASE[16 * 64 + d];
            float vAt[4], vBh[4], vKh[4];
#pragma unroll
            for (int j = 0; j < 4; ++j) {
                const float cl = base + lw[dt][j], clm1 = (j == 0) ? base : base + lw[dt][j - 1];
                const float gi = __expf(cl), gm1 = __expf(clm1), ig = __expf(-cl), gce = __expf(clT - cl);
                const float kk = kkr[dt][j] * rn[j], beta = kk * av[dt][j];
                vAt[j] = -kk * gm1; vBh[j] = beta * gce; vKh[j] = k4[dt][j] * gce;
                SLOT(0)[(i0 + j) * RW_LD + d] = f2bf(vAt[j]);
                SLOT(1)[(i0 + j) * RW_LD + d] = f2bf(beta * ig);
                SLOT(2)[(i0 + j) * RW_LD + d] = f2bf(k4[dt][j] * ig);
                SLOT(3)[(i0 + j) * RW_LD + d] = f2bf(zr[dt][j] * gi);
                const size_t o = (size_t)(t0 + i0 + j) * RW + h * 64 + d;
                Gg[o] = f2bf(xg[dt][j]); Bon[o] = f2bf(cft[j] * zv[dt][j]);
            }
            uint2 p;
            p.x = pack2(vAt[0], vAt[1]); p.y = pack2(vAt[2], vAt[3]); *reinterpret_cast<uint2*>(&SLOT(4)[d * RW_LD + i0]) = p;
            p.x = pack2(vBh[0], vBh[1]); p.y = pack2(vBh[2], vBh[3]); *reinterpret_cast<uint2*>(&SLOT(5)[d * RW_LD + i0]) = p;
            p.x = pack2(vKh[0], vKh[1]); p.y = pack2(vKh[2], vKh[3]); *reinterpret_cast<uint2*>(&SLOT(6)[d * RW_LD + i0]) = p;
            p.x = pack2(zv[dt][0], zv[dt][1]); p.y = pack2(zv[dt][2], zv[dt][3]); *reinterpret_cast<uint2*>(&SLOT(7)[d * RW_LD + i0]) = p;
        }
    }
    __syncthreads();
    if (cnext >= 0) rwkv_fetch(a, cnext, h, nxt);
    const int r = lane & 31, hf = lane >> 5;
    {
        const int prod = wv >> 1, sub = wv & 1;
        const bfr* Aop = (prod & 1) ? SLOT(2) : SLOT(1);
        const bfr* Bop = (prod >= 2) ? SLOT(3) : SLOT(0);
        bfr* Ld = SLOT(8 + prod);
        const bool incl = prod >= 2;
        for (int job = 0; job < (sub ? 2 : 1); ++job) {
            const int jt = sub ? job : 0, it = sub ? 1 : 0;
            f32x16 acc = tile_mm(Aop, jt * 32, Bop, it * 32, r, hf);
#pragma unroll
            for (int g4 = 0; g4 < 4; ++g4) {
                const int i = it * 32 + r, j0 = jt * 32 + g4 * 8 + hf * 4;
                float v[4];
#pragma unroll
                for (int q = 0; q < 4; ++q) { const int j = j0 + q; v[q] = (incl ? (j <= i) : (j < i)) ? acc[g4 * 4 + q] : 0.f; }
                uint2 p; p.x = pack2(v[0], v[1]); p.y = pack2(v[2], v[3]);
                *reinterpret_cast<uint2*>(&Ld[i * RW_LD + j0]) = p;
            }
        }
        if (!sub) {
#pragma unroll
            for (int g4 = 0; g4 < 4; ++g4) *reinterpret_cast<uint2*>(&Ld[r * RW_LD + 32 + g4 * 8 + hf * 4]) = make_uint2(0u, 0u);
        }
    }
    __syncthreads();
    if (wv == 0) {
        bfr* Tl = SLOT(0); bfr* TlT = SLOT(1); const bfr* Lab = SLOT(8);
        for (int q = 0; q < 9; ++q) { *reinterpret_cast<uint4*>((unsigned char*)Tl + (q * 64 + lane) * 16) = make_uint4(0u, 0u, 0u, 0u); *reinterpret_cast<uint4*>((unsigned char*)TlT + (q * 64 + lane) * 16) = make_uint4(0u, 0u, 0u, 0u); }
        {
            const int bq = lane >> 4, cc = lane & 15;
            float x[16];
#pragma unroll
            for (int rr = 0; rr < 16; ++rr) {
                float lrow[16];
                unpack8(*reinterpret_cast<const uint4*>(&Lab[(bq * 16 + rr) * RW_LD + bq * 16]), lrow);
                unpack8(*reinterpret_cast<const uint4*>(&Lab[(bq * 16 + rr) * RW_LD + bq * 16 + 8]), lrow + 8);
                float sacc = (rr == cc) ? 1.f : 0.f;
#pragma unroll
                for (int m = 0; m < rr; ++m) sacc += lrow[m] * x[m];
                x[rr] = sacc;
            }
#pragma unroll
            for (int rr = 0; rr < 16; ++rr) Tl[(bq * 16 + rr) * RW_LD + bq * 16 + cc] = f2bf(x[rr]);
            *reinterpret_cast<uint4*>(&TlT[(bq * 16 + cc) * RW_LD + bq * 16]) = pack8(x);
            *reinterpret_cast<uint4*>(&TlT[(bq * 16 + cc) * RW_LD + bq * 16 + 8]) = pack8(x + 8);
        }
        asm volatile("s_waitcnt lgkmcnt(0)" ::: "memory");
#pragma unroll
        for (int bi = 1; bi < 4; ++bi) {
#pragma unroll
            for (int bj = 0; bj < bi; ++bj) {
                f32x4 acc = {0.f, 0.f, 0.f, 0.f};
#pragma unroll
                for (int bm = bj; bm < bi; ++bm) {
                    const bf16x4 Af = *reinterpret_cast<const bf16x4*>(&Lab[(bi * 16 + fr) * RW_LD + bm * 16 + fq * 4]);
                    const bf16x4 Bf = *reinterpret_cast<const bf16x4*>(&TlT[(bj * 16 + fr) * RW_LD + bm * 16 + fq * 4]);
                    acc = __builtin_amdgcn_mfma_f32_16x16x16bf16_1k(Af, Bf, acc, 0, 0, 0);
                }
                bf16x4 Bacc; Bacc[0] = (short)f2bf(acc[0]); Bacc[1] = (short)f2bf(acc[1]); Bacc[2] = (short)f2bf(acc[2]); Bacc[3] = (short)f2bf(acc[3]);
                const bf16x4 Ad = *reinterpret_cast<const bf16x4*>(&Tl[(bi * 16 + fr) * RW_LD + bi * 16 + fq * 4]);
                const f32x4 tb = __builtin_amdgcn_mfma_f32_16x16x16bf16_1k(Ad, Bacc, f32x4{0.f, 0.f, 0.f, 0.f}, 0, 0, 0);
#pragma unroll
                for (int q = 0; q < 4; ++q) Tl[(bi * 16 + fq * 4 + q) * RW_LD + bj * 16 + fr] = f2bf(tb[q]);
                uint2 p; p.x = pack2(tb[0], tb[1]); p.y = pack2(tb[2], tb[3]);
                *reinterpret_cast<uint2*>(&TlT[(bj * 16 + fr) * RW_LD + bi * 16 + fq * 4]) = p;
            }
            asm volatile("s_waitcnt lgkmcnt(0)" ::: "memory");
        }
    } else if (wv >= 4) {
        const int it = (wv >> 1) & 1, vt = wv & 1;
        const f32x16 acc = tile_mm(SLOT(9), it * 32, SLOT(7), vt * 32, r, hf);
        store_t(SLOT(2), vt * 32, it * 32, acc, r, hf);
    }
    __syncthreads();
    {
        const int which = wv >> 2, it = (wv >> 1) & 1, ct = wv & 1;
        const f32x16 acc = tile_mm(SLOT(0), it * 32, which ? SLOT(2) : SLOT(4), ct * 32, r, hf);
        store_t(which ? SLOT(9) : SLOT(8), ct * 32, it * 32, acc, r, hf);
    }
    __syncthreads();
    if (wv < 4) {
        {
            const int dtl = wv >> 1, itl = wv & 1;
            f32x16 acc = tile_mm(SLOT(8), dtl * 32, SLOT(10), itl * 32, r, hf);
            bfr* WY = (bfr*)(a.ws + WS_WY) + (size_t)u * 4096;
            const int i = itl * 32 + r;
#pragma unroll
            for (int g4 = 0; g4 < 4; ++g4) {
                const int d0 = dtl * 32 + g4 * 8 + hf * 4;
                const uint2 rr2 = *reinterpret_cast<const uint2*>(&SLOT(3)[i * RW_LD + d0]);
                uint2 p; p.x = pack2(acc[g4 * 4] + bflo(rr2.x), acc[g4 * 4 + 1] + bfhi(rr2.x)); p.y = pack2(acc[g4 * 4 + 2] + bflo(rr2.y), acc[g4 * 4 + 3] + bfhi(rr2.y));
                *reinterpret_cast<uint2*>(&WY[i * 64 + d0]) = p;
            }
        }
        {
            const int it = wv >> 1, vt = wv & 1;
            f32x16 acc = tile_mm(SLOT(10), it * 32, SLOT(9), vt * 32, r, hf);
            acc = tile_mm_acc(acc, SLOT(11), it * 32, SLOT(7), vt * 32, r, hf);
            bfr* YL = (bfr*)(a.ws + WS_YLOC) + (size_t)u * 4096;
#pragma unroll
            for (int g4 = 0; g4 < 4; ++g4) { uint2 p; p.x = pack2(acc[g4 * 4], acc[g4 * 4 + 1]); p.y = pack2(acc[g4 * 4 + 2], acc[g4 * 4 + 3]);
                *reinterpret_cast<uint2*>(&YL[(((it * 2 + vt) * 4 + g4) * 64 + lane) * 4]) = p; }
        }
    } else {
        {
            const int kt = (wv >> 1) & 1, kpt = wv & 1;
            f32x16 acc = tile_mm(SLOT(8), kt * 32, SLOT(5), kpt * 32, r, hf);
            if (kt == kpt) {
                const float gc = __expf(BASE[16 * 64 + kt * 32 + r]);
#pragma unroll
                for (int g = 0; g < 16; ++g) if (((g & 3) + 8 * (g >> 2) + 4 * hf) == r) acc[g] += gc;
            }
            bfr* PM = (bfr*)(a.ws + WS_PM) + (size_t)u * 4096;
#pragma unroll
            for (int sgrp = 0; sgrp < 2; ++sgrp) {
                float v8[8];
#pragma unroll
                for (int q = 0; q < 8; ++q) v8[q] = acc[sgrp * 8 + q];
                *reinterpret_cast<uint4*>(&PM[(((kpt * 2 + kt) * 2 + sgrp) * 64 + lane) * 8]) = pack8(v8);
            }
        }
        {
            const int kpt = (wv >> 1) & 1, vt = wv & 1;
            f32x16 acc = tile_mm(SLOT(5), kpt * 32, SLOT(9), vt * 32, r, hf);
            acc = tile_mm_acc(acc, SLOT(6), kpt * 32, SLOT(7), vt * 32, r, hf);
            bfr* GM = (bfr*)(a.ws + WS_GM) + (size_t)u * 4096;
#pragma unroll
            for (int g4 = 0; g4 < 4; ++g4) { uint2 p; p.x = pack2(acc[g4 * 4], acc[g4 * 4 + 1]); p.y = pack2(acc[g4 * 4 + 2], acc[g4 * 4 + 3]);
                *reinterpret_cast<uint2*>(&GM[(((kpt * 2 + vt) * 4 + g4) * 64 + lane) * 4]) = p; }
        }
    }
    __syncthreads();
#undef SLOT
}

__device__ __forceinline__ void rwkv_chain(const Args& a, const int h, const int vh) {
    const int lane = my_tid() & 63, r = lane & 31, hf = lane >> 5;
    const bfr* PMb = (const bfr*)(a.ws + WS_PM); const bfr* GMb = (const bfr*)(a.ws + WS_GM); bfr* ZTb = (bfr*)(a.ws + WS_ZT);
    f32x16 Z[2];
#pragma unroll
    for (int g = 0; g < 16; ++g) { Z[0][g] = 0.f; Z[1][g] = 0.f; }
    bf16x8 Acur[8], Anxt[8]; uint2 Ccur[8], Cnxt[8];
    {
        const bfr* pm = PMb + (size_t)h * 4096; const bfr* gm = GMb + (size_t)h * 4096;
#pragma unroll
        for (int f = 0; f < 8; ++f) Acur[f] = *reinterpret_cast<const bf16x8*>(&pm[(f * 64 + lane) * 8]);
#pragma unroll
        for (int kpt = 0; kpt < 2; ++kpt)
#pragma unroll
            for (int g4 = 0; g4 < 4; ++g4) Ccur[kpt * 4 + g4] = *reinterpret_cast<const uint2*>(&gm[(((kpt * 2 + vh) * 4 + g4) * 64 + lane) * 4]);
    }
    for (int c = 0; c < 128; ++c) {
        const int u = c * 16 + h;
        if (c + 1 < 128) {
            const bfr* pm = PMb + (size_t)(u + 16) * 4096; const bfr* gm = GMb + (size_t)(u + 16) * 4096;
#pragma unroll
            for (int f = 0; f < 8; ++f) Anxt[f] = *reinterpret_cast<const bf16x8*>(&pm[(f * 64 + lane) * 8]);
#pragma unroll
            for (int kpt = 0; kpt < 2; ++kpt)
#pragma unroll
                for (int g4 = 0; g4 < 4; ++g4) Cnxt[kpt * 4 + g4] = *reinterpret_cast<const uint2*>(&gm[(((kpt * 2 + vh) * 4 + g4) * 64 + lane) * 4]);
        }
        bfr* zt = ZTb + (size_t)u * 4096 + (size_t)(vh * 32 + r) * 64;
        bf16x8 Bf[2][2];
#pragma unroll
        for (int kt = 0; kt < 2; ++kt) {
#pragma unroll
            for (int g4 = 0; g4 < 4; ++g4) {
                uint2 o; o.x = pack2(Z[kt][g4 * 4], Z[kt][g4 * 4 + 1]); o.y = pack2(Z[kt][g4 * 4 + 2], Z[kt][g4 * 4 + 3]);
                *reinterpret_cast<uint2*>(&zt[kt * 32 + g4 * 8 + hf * 4]) = o;
                const int s = g4 >> 1, e = (g4 & 1) * 4;
                Bf[kt][s][e] = (short)(o.x & 0xFFFF); Bf[kt][s][e + 1] = (short)(o.x >> 16); Bf[kt][s][e + 2] = (short)(o.y & 0xFFFF); Bf[kt][s][e + 3] = (short)(o.y >> 16);
            }
        }
        f32x16 Zn[2];
#pragma unroll
        for (int kpt = 0; kpt < 2; ++kpt)
#pragma unroll
            for (int g4 = 0; g4 < 4; ++g4) {
                const uint2 cc = Ccur[kpt * 4 + g4];
                Zn[kpt][g4 * 4] = bflo(cc.x); Zn[kpt][g4 * 4 + 1] = bfhi(cc.x); Zn[kpt][g4 * 4 + 2] = bflo(cc.y); Zn[kpt][g4 * 4 + 3] = bfhi(cc.y);
            }
#pragma unroll
        for (int kpt = 0; kpt < 2; ++kpt)
#pragma unroll
            for (int kt = 0; kt < 2; ++kt)
#pragma unroll
                for (int s = 0; s < 2; ++s)
                    Zn[kpt] = __builtin_amdgcn_mfma_f32_32x32x16_bf16(Acur[(kpt * 2 + kt) * 2 + s], Bf[kt][s], Zn[kpt], 0, 0, 0);
        Z[0] = Zn[0]; Z[1] = Zn[1];
#pragma unroll
        for (int f = 0; f < 8; ++f) { Acur[f] = Anxt[f]; Ccur[f] = Cnxt[f]; }
    }
}

__device__ __forceinline__ void rwkv_out_unit(const Args& a, const int u, float* Ls) {
    const int lane = my_tid() & 63, r = lane & 31, hf = lane >> 5, c = u >> 4, h = u & 15, t0 = c * 64;
    const bfr* WY = (const bfr*)(a.ws + WS_WY) + (size_t)u * 4096; const bfr* YL = (const bfr*)(a.ws + WS_YLOC) + (size_t)u * 4096;
    const bfr* ZT = (const bfr*)(a.ws + WS_ZT) + (size_t)u * 4096;
    f32x16 acc[2][2];
#pragma unroll
    for (int it = 0; it < 2; ++it)
#pragma unroll
        for (int vt = 0; vt < 2; ++vt)
#pragma unroll
            for (int g4 = 0; g4 < 4; ++g4) {
                const uint2 cc = *reinterpret_cast<const uint2*>(&YL[(((it * 2 + vt) * 4 + g4) * 64 + lane) * 4]);
                acc[it][vt][g4 * 4] = bflo(cc.x); acc[it][vt][g4 * 4 + 1] = bfhi(cc.x); acc[it][vt][g4 * 4 + 2] = bflo(cc.y); acc[it][vt][g4 * 4 + 3] = bfhi(cc.y);
            }
#pragma unroll
    for (int ks = 0; ks < 4; ++ks) {
        bf16x8 A[2], B[2];
#pragma unroll
        for (int it = 0; it < 2; ++it) A[it] = *reinterpret_cast<const bf16x8*>(&WY[(it * 32 + r) * 64 + ks * 16 + hf * 8]);
#pragma unroll
        for (int vt = 0; vt < 2; ++vt) B[vt] = *reinterpret_cast<const bf16x8*>(&ZT[(vt * 32 + r) * 64 + ks * 16 + hf * 8]);
#pragma unroll
        for (int it = 0; it < 2; ++it)
#pragma unroll
            for (int vt = 0; vt < 2; ++vt) acc[it][vt] = __builtin_amdgcn_mfma_f32_32x32x16_bf16(A[it], B[vt], acc[it][vt], 0, 0, 0);
    }
#pragma unroll
    for (int it = 0; it < 2; ++it)
#pragma unroll
        for (int vt = 0; vt < 2; ++vt)
#pragma unroll
            for (int g = 0; g < 16; ++g) Ls[(it * 32 + (g & 3) + 8 * (g >> 2) + 4 * hf) * 68 + vt * 32 + r] = acc[it][vt][g];
    asm volatile("s_waitcnt lgkmcnt(0)" ::: "memory");
    __builtin_amdgcn_wave_barrier();
    {
        float y[64]; float s1 = 0.f, s2 = 0.f;
#pragma unroll
        for (int q = 0; q < 16; ++q) {
            const float4 x = *reinterpret_cast<const float4*>(&Ls[lane * 68 + q * 4]);
            y[q * 4] = x.x; y[q * 4 + 1] = x.y; y[q * 4 + 2] = x.z; y[q * 4 + 3] = x.w;
            s1 += (x.x + x.y) + (x.z + x.w);
        }
        const float mean = s1 * (1.f / 64.f);
#pragma unroll
        for (int v = 0; v < 64; ++v) { const float d = y[v] - mean; s2 += d * d; }
        const float rstd = rsqrtf(s2 * (1.f / 64.f) + 64e-5f);
        const bfr* Gg = (const bfr*)(a.ws + WS_GG); const bfr* Bon = (const bfr*)(a.ws + WS_BON); bfr* RWO = (bfr*)(a.ws + WS_RWO);
        const size_t o = (size_t)(t0 + lane) * RW + h * 64;
        const float* lnw = a.in[I_LNW] + h * 64; const float* lnb = a.in[I_LNB] + h * 64;
#pragma unroll
        for (int q = 0; q < 8; ++q) {
            float gg[8], bb[8], rr[8];
            unpack8(*reinterpret_cast<const uint4*>(&Gg[o + q * 8]), gg);
            unpack8(*reinterpret_cast<const uint4*>(&Bon[o + q * 8]), bb);
#pragma unroll
            for (int e = 0; e < 8; ++e) rr[e] = ((y[q * 8 + e] - mean) * rstd * lnw[q * 8 + e] + lnb[q * 8 + e] + bb[e]) * gg[e];
            *reinterpret_cast<uint4*>(&RWO[o + q * 8]) = pack8(rr);
        }
    }
    asm volatile("s_waitcnt lgkmcnt(0)" ::: "memory");
    __builtin_amdgcn_wave_barrier();
}
#ifndef DUP_DSA
#define DUP_DSA 0
#endif
constexpr float IDX_SCALE = 0.04419417382415922f;
constexpr int CT_ROW = 544;
constexpr int CT_WAVE = 18432;
constexpr int DSA_RELB_OFF = 155648;
constexpr int DSA_HIST_OFF = 131072;
constexpr int DSA_SEL_OFF = 147456;

typedef __bf16 bf16p2_t __attribute__((ext_vector_type(2)));
__device__ __forceinline__ bf16x8 fp8x8_to_bf16(const uint2 w) {
    const u32x4 r = {__builtin_bit_cast(unsigned, __builtin_amdgcn_cvt_scalef32_pk_bf16_fp8(w.x, 1.0f, false)), __builtin_bit_cast(unsigned, __builtin_amdgcn_cvt_scalef32_pk_bf16_fp8(w.x, 1.0f, true)),
                     __builtin_bit_cast(unsigned, __builtin_amdgcn_cvt_scalef32_pk_bf16_fp8(w.y, 1.0f, false)), __builtin_bit_cast(unsigned, __builtin_amdgcn_cvt_scalef32_pk_bf16_fp8(w.y, 1.0f, true))};
    return __builtin_bit_cast(bf16x8, r);
}
__device__ __forceinline__ unsigned pack4_fp8(float a0, float a1, float a2, float a3) {
    int p = 0; p = __builtin_amdgcn_cvt_pk_fp8_f32(a0, a1, p, false); p = __builtin_amdgcn_cvt_pk_fp8_f32(a2, a3, p, true); return (unsigned)p;
}
__device__ __forceinline__ int rel_bucket(int rel) {
    const int n = rel < 0 ? -rel : rel;
    const int lg = 8 + (n >= 15) + (n >= 27) + (n >= 50) + (n >= 91) + (n >= 166) + (n >= 305) + (n >= 559);
    return (n < 8 ? n : lg) + (rel > 0 ? 16 : 0);
}
__device__ __forceinline__ unsigned fkey(float f) {
    if (f == 0.f) f = 0.f;
    const unsigned u = __float_as_uint(f);
    return (u & 0x80000000u) ? ~u : (u | 0x80000000u);
}

__device__ __forceinline__ void dsa_cnorm(const Args& a) {
    const bfr* P = (const bfr*)(a.ws + WS_P); unsigned char* CB8 = a.ws + WS_CB; bfr* IKC = (bfr*)(a.ws + WS_IKC);
    const int lane = my_tid() & 63, wv = my_tid() >> 6;
    const float4 g = reinterpret_cast<const float4*>(a.in[I_KVG])[lane];
    for (int t = blockIdx.x * 8 + wv; t < T; t += gridDim.x * 8) {
        const uint2 raw = *reinterpret_cast<const uint2*>(&P[(size_t)t * NINP + C_CKV + lane * 4]);
        const float v0 = bflo(raw.x), v1 = bfhi(raw.x), v2 = bflo(raw.y), v3 = bfhi(raw.y);
        const float ss = wave_sum(v0 * v0 + v1 * v1 + v2 * v2 + v3 * v3);
        const float rs = rsqrtf(ss * (1.f / 256.f) + EPS);
        int pk = 0;
        pk = __builtin_amdgcn_cvt_pk_fp8_f32(v0 * rs * g.x, v1 * rs * g.y, pk, false);
        pk = __builtin_amdgcn_cvt_pk_fp8_f32(v2 * rs * g.z, v3 * rs * g.w, pk, true);
        *reinterpret_cast<int*>(&CB8[(size_t)t * 256 + lane * 4]) = pk;
        if (lane < 16) *reinterpret_cast<uint2*>(&IKC[(size_t)t * 64 + lane * 4]) = *reinterpret_cast<const uint2*>(&P[(size_t)t * NINP + C_IK + lane * 4]);
    }
}
__device__ __forceinline__ void dsa_qlat(const Args& a) {
    const bfr* P = (const bfr*)(a.ws + WS_P); const bfr* WUK = (const bfr*)(a.ws + WS_WUK); unsigned char* QL8 = a.ws + WS_QLAT;
    const int lane = my_tid() & 63, wv = my_tid() >> 6, fr = lane & 15, fq = lane >> 4;
    for (int it = blockIdx.x * 8 + wv; it < (T / 64) * NH; it += gridDim.x * 8) {
        const int tg = it >> 4, h = it & 15, t0 = tg * 64;
        bf16x8 Bt[4][2];
#pragma unroll
        for (int tl = 0; tl < 4; ++tl)
#pragma unroll
            for (int ks = 0; ks < 2; ++ks) Bt[tl][ks] = *reinterpret_cast<const bf16x8*>(&P[(size_t)(t0 + tl * 16 + fr) * NINP + C_Q + h * 64 + ks * 32 + fq * 8]);
#pragma unroll 2
        for (int nt = 0; nt < 16; ++nt) {
            const bf16x8 A0 = *reinterpret_cast<const bf16x8*>(&WUK[(size_t)(h * 256 + nt * 16 + fr) * 64 + fq * 8]);
            const bf16x8 A1 = *reinterpret_cast<const bf16x8*>(&WUK[(size_t)(h * 256 + nt * 16 + fr) * 64 + 32 + fq * 8]);
#pragma unroll
            for (int tl = 0; tl < 4; ++tl) {
                f32x4 acc = {0.f, 0.f, 0.f, 0.f};
                acc = __builtin_amdgcn_mfma_f32_16x16x32_bf16(A0, Bt[tl][0], acc, 0, 0, 0);
                acc = __builtin_amdgcn_mfma_f32_16x16x32_bf16(A1, Bt[tl][1], acc, 0, 0, 0);
                *reinterpret_cast<unsigned*>(&QL8[((size_t)(t0 + tl * 16 + fr) * NH + h) * 256 + nt * 16 + fq * 4]) = pack4_fp8(acc[0], acc[1], acc[2], acc[3]);
            }
        }
    }
}
__device__ __forceinline__ void dsa_oproj(const Args& a) {
    const unsigned char* OL8 = a.ws + WS_OLAT; const bfr* WUVT = (const bfr*)(a.ws + WS_WUVT); bfr* DO = (bfr*)(a.ws + WS_DO);
    const int lane = my_tid() & 63, wv = my_tid() >> 6, fr = lane & 15, fq = lane >> 4;
    for (int it = blockIdx.x * 8 + wv; it < (T / 64) * NH; it += gridDim.x * 8) {
        const int tg = it >> 4, h = it & 15, t0 = tg * 64;
        f32x4 acc[4][4];
#pragma unroll
        for (int tl = 0; tl < 4; ++tl)
#pragma unroll
            for (int nt = 0; nt < 4; ++nt) acc[tl][nt] = f32x4{0.f, 0.f, 0.f, 0.f};
#pragma unroll 2
        for (int ks = 0; ks < 8; ++ks) {
            bf16x8 A[4];
#pragma unroll
            for (int nt = 0; nt < 4; ++nt) A[nt] = *reinterpret_cast<const bf16x8*>(&WUVT[(size_t)(h * 64 + nt * 16 + fr) * 256 + ks * 32 + fq * 8]);
#pragma unroll
            for (int tl = 0; tl < 4; ++tl) {
                const bf16x8 Bt = fp8x8_to_bf16(*reinterpret_cast<const uint2*>(&OL8[((size_t)(t0 + tl * 16 + fr) * NH + h) * 256 + ks * 32 + fq * 8]));
#pragma unroll
                for (int nt = 0; nt < 4; ++nt) acc[tl][nt] = __builtin_amdgcn_mfma_f32_16x16x32_bf16(A[nt], Bt, acc[tl][nt], 0, 0, 0);
            }
        }
#pragma unroll
        for (int tl = 0; tl < 4; ++tl)
#pragma unroll
            for (int nt = 0; nt < 4; ++nt) { uint2 o; o.x = pack2(acc[tl][nt][0], acc[tl][nt][1]); o.y = pack2(acc[tl][nt][2], acc[tl][nt][3]);
                *reinterpret_cast<uint2*>(&DO[(size_t)(t0 + tl * 16 + fr) * RW + h * 64 + nt * 16 + fq * 4]) = o; }
    }
}

__device__ __forceinline__ float bin_scale(const float sumw2) { const float sg = sqrtf(32.f * sumw2); return sg > 1e-20f ? 90.f / sg : 1.f; }
__device__ __forceinline__ int score_bin(const float sc, const float bsc) { const float f = floorf(sc * bsc) + 512.f; return (int)fminf(fmaxf(f, 0.f), 1023.f); }
__device__ __forceinline__ float key_score(const unsigned k) { return __uint_as_float((k & 0x80000000u) ? (k ^ 0x80000000u) : ~k); }
__device__ __forceinline__ void hist_scan(const unsigned* hist, const int nb, const unsigned need, unsigned* res, const int lane) {
    const int per = nb >> 6;
    unsigned s = 0;
    for (int i = 0; i < per; ++i) s += hist[lane * per + i];
    unsigned S = s;
#pragma unroll
    for (int o = 1; o < 64; o <<= 1) { const unsigned tt = __shfl_down(S, o); if (lane + o < 64) S += tt; }
    const unsigned long long m = __ballot(S >= need);
    const int ls = 63 - __clzll(m);
    if (lane == ls) {
        unsigned accv = S - s; int bin = lane * per; unsigned abv = accv;
        for (int bb = lane * per + per - 1; bb >= lane * per; --bb) { const unsigned cc = hist[bb]; if (accv + cc >= need) { bin = bb; abv = accv; break; } accv += cc; }
        res[0] = (unsigned)bin; res[1] = abv;
    }
}

__device__ __forceinline__ void dsa_select4(const Args& a, const int t0, const int qs, unsigned char* lds) {
    const bfr* P = (const bfr*)(a.ws + WS_P); const bfr* IKC = (const bfr*)(a.ws + WS_IKC);
    float* SC = (float*)lds; int* SEL = (int*)(lds + DSA_SEL_OFF); unsigned* MISC = (unsigned*)(lds + LDS_MISC);
    const int tid = my_tid(), lane = tid & 63, wv = tid >> 6, r = lane & 31, hf = lane >> 5;
    const int L = 64 * (t0 / 64 + 1);
    if (L <= 256) {
        for (int i = tid; i < 4 * 256; i += 512) SEL[(qs + (i >> 8)) * 256 + (i & 255)] = (i & 255) | (rel_bucket((i & 255) - (t0 + (i >> 8))) << 16);
        if (tid < 4) MISC[16 + qs + tid] = (unsigned)L;
        __syncthreads();
        return;
    }
    for (int i = tid; i < 4096; i += 512) ((unsigned*)(lds + DSA_HIST_OFF))[i] = 0u;
    __syncthreads();
    {
        const int qq = r >> 3, hh = r & 7;
        bf16x8 B[4];
#pragma unroll
        for (int ks = 0; ks < 4; ++ks) B[ks] = *reinterpret_cast<const bf16x8*>(&P[(size_t)(t0 + qq) * NINP + C_IQ + hh * 64 + ks * 16 + hf * 8]);
        const float wgt = bf2f(P[(size_t)(t0 + qq) * NINP + C_IW + hh]) * IDX_SCALE;
        float w2 = wgt * wgt; w2 += dpp_f<DPP_XOR1>(w2); w2 += dpp_f<DPP_XOR2>(w2); w2 += dpp_f<0x141>(w2);
        const float bsc = bin_scale(w2);
        if (hh == 0 && hf == 0) ((float*)MISC)[48 + qq] = bsc;
        const int ntile = L >> 5;
        for (int rp_ = 0; rp_ < ((DUP_DSA & 1) ? 2 : 1); ++rp_) {
        bf16x8 An[4];
        if (wv < ntile) {
#pragma unroll
            for (int ks = 0; ks < 4; ++ks) An[ks] = *reinterpret_cast<const bf16x8*>(&IKC[(size_t)(wv * 32 + r) * 64 + ks * 16 + hf * 8]);
        }
        for (int kt = wv; kt < ntile; kt += 8) {
            bf16x8 Ac[4];
#pragma unroll
            for (int ks = 0; ks < 4; ++ks) Ac[ks] = An[ks];
            if (kt + 8 < ntile) {
#pragma unroll
                for (int ks = 0; ks < 4; ++ks) An[ks] = *reinterpret_cast<const bf16x8*>(&IKC[(size_t)((kt + 8) * 32 + r) * 64 + ks * 16 + hf * 8]);
            }
            f32x16 acc;
#pragma unroll
            for (int g = 0; g < 16; ++g) acc[g] = 0.f;
#pragma unroll
            for (int ks = 0; ks < 4; ++ks) acc = __builtin_amdgcn_mfma_f32_32x32x16_bf16(Ac[ks], B[ks], acc, 0, 0, 0);
            float s1[8], s2[4], s3[2];
            const bool b0 = (hh & 1) != 0, b1 = (hh & 2) != 0, b2 = (hh & 4) != 0;
#pragma unroll
            for (int p = 0; p < 8; ++p) {
                const float x0 = fmaxf(acc[2 * p], 0.f) * wgt, x1 = fmaxf(acc[2 * p + 1], 0.f) * wgt;
                s1[p] = (b0 ? x1 : x0) + dpp_f<DPP_XOR1>(b0 ? x0 : x1);
            }
#pragma unroll
            for (int p = 0; p < 4; ++p) s2[p] = (b1 ? s1[2 * p + 1] : s1[2 * p]) + dpp_f<DPP_XOR2>(b1 ? s1[2 * p] : s1[2 * p + 1]);
#pragma unroll
            for (int p = 0; p < 2; ++p) s3[p] = (b2 ? s2[2 * p + 1] : s2[2 * p]) + __shfl_xor(b2 ? s2[2 * p] : s2[2 * p + 1], 4);
#pragma unroll
            for (int p = 0; p < 2; ++p) { const int g = 8 * p + hh; const unsigned fk = fkey(s3[p]); ((unsigned*)SC)[qq * 8192 + kt * 32 + (g & 3) + 8 * (g >> 2) + 4 * hf] = fk;
                if (rp_ == 0) atomicAdd((unsigned*)(lds + DSA_HIST_OFF) + qq * 1024 + score_bin(s3[p], bsc), 1u); }
        }
        }
    }
    __syncthreads();
    const int q = wv >> 1, l128 = (wv & 1) * 64 + lane;
    const unsigned* keys = (const unsigned*)(SC + q * 8192);
    unsigned* hist = (unsigned*)(lds + DSA_HIST_OFF) + q * 1024;
    unsigned* res = MISC + 32 + q * 4;
    for (int rp_ = 0; rp_ < ((DUP_DSA & 2) ? 2 : 1); ++rp_) {
    const float bsc = ((const float*)MISC)[48 + q];
    unsigned need = 256;
    if (rp_ > 0) {
        for (int i = l128; i < 1024; i += 128) hist[i] = 0u;
        __syncthreads();
        for (int idx = l128; idx < L; idx += 128) atomicAdd(&hist[score_bin(key_score(keys[idx]), bsc)], 1u);
        __syncthreads();
    }
    if ((wv & 1) == 0) hist_scan(hist, 1024, need, res, lane);
    __syncthreads();
    const int b0 = (int)res[0]; need -= res[1];
    __syncthreads();
    unsigned* cand = hist + 256;
    if (l128 == 0) { res[2] = 0u; res[3] = 0u; }
    if (tid == 0) MISC[52] = 0u;
    __syncthreads();
    for (int idx = l128; idx < L; idx += 128) {
        const unsigned k = keys[idx];
        if (score_bin(key_score(k), bsc) == b0) { const unsigned p = atomicAdd(&res[2], 1u); if (p < 768u) cand[p] = k; }
    }
    __syncthreads();
    const unsigned ncand = res[2];
    if (l128 == 0 && ncand > 768u) MISC[52] = 1u;
    __syncthreads();
    const bool fast = MISC[52] == 0u;
    unsigned prefix = 0;
    if (fast) {
        for (unsigned i = l128; i < ncand; i += 128) {
            const unsigned me = cand[i]; unsigned cgt = 0, ceq = 0;
            for (unsigned j = 0; j < ncand; ++j) { const unsigned o = cand[j]; cgt += (o > me) ? 1u : 0u; ceq += (o == me) ? 1u : 0u; }
            if (cgt < need && need <= cgt + ceq) { res[0] = me; res[1] = cgt; }
        }
        __syncthreads();
        prefix = res[0]; need -= res[1];
        __syncthreads();
    } else {
#pragma unroll 1
        for (int pass = 0; pass < 4; ++pass) {
            const int lo_shift = 24 - 8 * pass;
            for (int i = l128; i < 256; i += 128) hist[i] = 0u;
            __syncthreads();
            for (int idx = l128; idx < L; idx += 128) {
                const unsigned k = keys[idx];
                const bool ok = (score_bin(key_score(k), bsc) == b0) && (pass == 0 || (k >> (lo_shift + 8)) == prefix);
                if (ok) atomicAdd(&hist[(k >> lo_shift) & 255u], 1u);
            }
            __syncthreads();
            if ((wv & 1) == 0) hist_scan(hist, 256, need, res, lane);
            __syncthreads();
            prefix = (prefix << 8) | res[0]; need -= res[1];
            __syncthreads();
        }
    }
    const unsigned tkey = prefix;
    if ((wv & 1) == 0) {
        const unsigned ngt = 256u - need; unsigned rg = 0, rt = 0;
        const unsigned long long lt = (1ull << lane) - 1ull;
        for (int base = 0; base < L; base += 64) {
            const unsigned k = keys[base + lane];
            const bool gt = k > tkey, tie = k == tkey;
            const unsigned long long mg = __ballot(gt), mt = __ballot(tie);
            if (gt) { const unsigned p = rg + (unsigned)__popcll(mg & lt); if (p < 256u) SEL[(qs + q) * 256 + p] = base + lane; }
            if (tie) { const unsigned p = rt + (unsigned)__popcll(mt & lt); if (p < need) SEL[(qs + q) * 256 + ngt + p] = base + lane; }
            rg += (unsigned)__popcll(mg); rt += (unsigned)__popcll(mt);
        }
        if (lane == 0) MISC[16 + qs + q] = 256u;
    }
    __syncthreads();
    for (int i = l128; i < 256; i += 128) { const int e = SEL[(qs + q) * 256 + i]; SEL[(qs + q) * 256 + i] = e | (rel_bucket(e - (t0 + q)) << 16); }
    __syncthreads();
    }
}

__device__ __forceinline__ void dsa_attend(const Args& a, const int t, const int* sel, const int nsel, unsigned char* ct, const float* relb_l) {
    const unsigned char* CB8 = a.ws + WS_CB; const unsigned char* QL8 = a.ws + WS_QLAT; unsigned char* OL8 = a.ws + WS_OLAT;
    const int lane = my_tid() & 63, fr = lane & 15, fq = lane >> 4;
    bf16x8 Bq[8];
#pragma unroll
    for (int ks = 0; ks < 8; ++ks) Bq[ks] = fp8x8_to_bf16(*reinterpret_cast<const uint2*>(&QL8[((size_t)t * NH + fr) * 256 + ks * 32 + fq * 8]));
    f32x4 o[16];
#pragma unroll
    for (int mt = 0; mt < 16; ++mt) o[mt] = f32x4{0.f, 0.f, 0.f, 0.f};
    float mrun = -1e30f, lrun = 0.f;
    const unsigned tr_addr = (unsigned)(size_t)ct + (unsigned)((4 * fq + (fr >> 2)) * CT_ROW + (fr & 3) * 8);
    const int nblk = nsel >> 5;
    uint2 Ar[2][8];
#pragma unroll
    for (int tt = 0; tt < 2; ++tt) {
        const int kidx = sel[tt * 16 + fr] & 0xFFFF;
#pragma unroll
        for (int ks = 0; ks < 8; ++ks) Ar[tt][ks] = *reinterpret_cast<const uint2*>(&CB8[(size_t)kidx * 256 + ks * 32 + fq * 8]);
    }
    for (int kb = 0; kb < nblk; ++kb) {
        f32x4 st[2];
#pragma unroll
        for (int tt = 0; tt < 2; ++tt) {
            st[tt] = f32x4{0.f, 0.f, 0.f, 0.f};
#pragma unroll
            for (int ks = 0; ks < 8; ++ks) {
                const bf16x8 Af = fp8x8_to_bf16(Ar[tt][ks]);
                st[tt] = __builtin_amdgcn_mfma_f32_16x16x32_bf16(Af, Bq[ks], st[tt], 0, 0, 0);
                *reinterpret_cast<bf16x8*>(ct + (tt * 16 + fr) * CT_ROW + (ks * 32 + fq * 8) * 2) = Af;
            }
        }
        if (kb + 1 < nblk) {
#pragma unroll
            for (int tt = 0; tt < 2; ++tt) {
                const int kidx = sel[(kb + 1) * 32 + tt * 16 + fr] & 0xFFFF;
#pragma unroll
                for (int ks = 0; ks < 8; ++ks) Ar[tt][ks] = *reinterpret_cast<const uint2*>(&CB8[(size_t)kidx * 256 + ks * 32 + fq * 8]);
            }
        }
        float lg[8]; float bmax = -1e30f;
#pragma unroll
        for (int tt = 0; tt < 2; ++tt) {
            const int4 k4 = *reinterpret_cast<const int4*>(&sel[kb * 32 + tt * 16 + fq * 4]);
            const int kk4[4] = {k4.x, k4.y, k4.z, k4.w};
#pragma unroll
            for (int j = 0; j < 4; ++j) {
                const float v = st[tt][j] * 0.125f + relb_l[(kk4[j] >> 16) * 16 + fr];
                lg[tt * 4 + j] = v; bmax = fmaxf(bmax, v);
            }
        }
        bmax = fmaxf(bmax, __shfl_xor(bmax, 16)); bmax = fmaxf(bmax, __shfl_xor(bmax, 32));
        const bool resc = __any(bmax > mrun + 8.f);
        float alpha = 1.f;
        if (resc) { const float mnew = fmaxf(mrun, bmax); alpha = __expf(mrun - mnew); mrun = mnew; lrun *= alpha; }
        float psum = 0.f; bf16x8 Pf;
#pragma unroll
        for (int e = 0; e < 8; e += 2) {
            const float p0 = __expf(lg[e] - mrun), p1 = __expf(lg[e + 1] - mrun); psum += p0 + p1;
            const unsigned pk = pack2(p0, p1); Pf[e] = (short)(pk & 0xFFFF); Pf[e + 1] = (short)(pk >> 16);
        }
        lrun += psum;
        asm volatile("s_waitcnt lgkmcnt(0)" ::: "memory");
        __builtin_amdgcn_wave_barrier();
#pragma unroll
        for (int m4 = 0; m4 < 4; ++m4) {
            uint2 r0[4], r1[4];
            asm volatile("ds_read_b64_tr_b16 %0, %8 offset:%9\n\tds_read_b64_tr_b16 %1, %8 offset:%10\n\t"
                         "ds_read_b64_tr_b16 %2, %8 offset:%11\n\tds_read_b64_tr_b16 %3, %8 offset:%12\n\t"
                         "ds_read_b64_tr_b16 %4, %8 offset:%13\n\tds_read_b64_tr_b16 %5, %8 offset:%14\n\t"
                         "ds_read_b64_tr_b16 %6, %8 offset:%15\n\tds_read_b64_tr_b16 %7, %8 offset:%16\n\ts_waitcnt lgkmcnt(0)"
                         : "=&v"(r0[0]), "=&v"(r1[0]), "=&v"(r0[1]), "=&v"(r1[1]), "=&v"(r0[2]), "=&v"(r1[2]), "=&v"(r0[3]), "=&v"(r1[3])
                         : "v"(tr_addr), "n"(m4 * 128), "n"(m4 * 128 + 16 * CT_ROW), "n"(m4 * 128 + 32), "n"(m4 * 128 + 32 + 16 * CT_ROW),
                           "n"(m4 * 128 + 64), "n"(m4 * 128 + 64 + 16 * CT_ROW), "n"(m4 * 128 + 96), "n"(m4 * 128 + 96 + 16 * CT_ROW)
                         : "memory");
#pragma unroll
            for (int i = 0; i < 4; ++i) {
                const int mt = m4 * 4 + i;
                const u32x4 raw = {r0[i].x, r0[i].y, r1[i].x, r1[i].y};
                const bf16x8 Av = __builtin_bit_cast(bf16x8, raw);
                f32x4 oo = o[mt];
                if (resc) { oo[0] *= alpha; oo[1] *= alpha; oo[2] *= alpha; oo[3] *= alpha; }
                o[mt] = __builtin_amdgcn_mfma_f32_16x16x32_bf16(Av, Pf, oo, 0, 0, 0);
            }
        }
        asm volatile("s_waitcnt lgkmcnt(0)" ::: "memory");
        __builtin_amdgcn_wave_barrier();
    }
    lrun += __shfl_xor(lrun, 16); lrun += __shfl_xor(lrun, 32);
    const float inv = frcp_(lrun);
#pragma unroll
    for (int mt = 0; mt < 16; ++mt) {
        *reinterpret_cast<unsigned*>(&OL8[((size_t)t * NH + fr) * 256 + mt * 16 + fq * 4]) = pack4_fp8(o[mt][0] * inv, o[mt][1] * inv, o[mt][2] * inv, o[mt][3] * inv);
    }
}

constexpr int DSA_CCAP = 256;
__device__ __forceinline__ bool dsa_select8(const Args& a, const int t0, unsigned char* lds) {
    const bfr* P = (const bfr*)(a.ws + WS_P); const bfr* IKC = (const bfr*)(a.ws + WS_IKC);
    unsigned* KEYS = (unsigned*)(a.ws + WS_KEYS) + (size_t)blockIdx.x * (8 * 8192);
    unsigned short* BIN = (unsigned short*)lds; unsigned* H16 = (unsigned*)(lds + DSA_HIST_OFF);
    int* SEL = (int*)(lds + DSA_SEL_OFF); unsigned* MISC = (unsigned*)(lds + LDS_MISC);
    const int tid = my_tid(), lane = tid & 63, wv = tid >> 6, r = lane & 31, hf = lane >> 5;
    const int L = 64 * (t0 / 64 + 1);
    if (L <= 256) {
        for (int i = tid; i < 8 * 256; i += 512) SEL[i] = (i & 255) | (rel_bucket((i & 255) - (t0 + (i >> 8))) << 16);
        if (tid < 8) MISC[16 + tid] = (unsigned)L;
        __syncthreads();
        return true;
    }
    for (int i = tid; i < 4096; i += 512) H16[i] = 0u;
    if (tid == 0) MISC[60] = 0u;
    __syncthreads();
    {
        const int qq = r >> 3, hh = r & 7;
        bf16x8 B[2][4]; float wgt[2], bsc[2];
#pragma unroll
        for (int grp = 0; grp < 2; ++grp) {
#pragma unroll
            for (int ks = 0; ks < 4; ++ks) B[grp][ks] = *reinterpret_cast<const bf16x8*>(&P[(size_t)(t0 + grp * 4 + qq) * NINP + C_IQ + hh * 64 + ks * 16 + hf * 8]);
            wgt[grp] = bf2f(P[(size_t)(t0 + grp * 4 + qq) * NINP + C_IW + hh]) * IDX_SCALE;
            float w2 = wgt[grp] * wgt[grp]; w2 += dpp_f<DPP_XOR1>(w2); w2 += dpp_f<DPP_XOR2>(w2); w2 += dpp_f<0x141>(w2);
            bsc[grp] = bin_scale(w2);
            if (hh == 0 && hf == 0) ((float*)MISC)[48 + grp * 4 + qq] = bsc[grp];
        }
        const bool b0 = (hh & 1) != 0, b1 = (hh & 2) != 0, b2 = (hh & 4) != 0;
        const int ntile = L >> 5;
        bf16x8 An[4];
        if (wv < ntile) {
#pragma unroll
            for (int ks = 0; ks < 4; ++ks) An[ks] = *reinterpret_cast<const bf16x8*>(&IKC[(size_t)(wv * 32 + r) * 64 + ks * 16 + hf * 8]);
        }
        for (int kt = wv; kt < ntile; kt += 8) {
            bf16x8 Ac[4];
#pragma unroll
            for (int ks = 0; ks < 4; ++ks) Ac[ks] = An[ks];
            if (kt + 8 < ntile) {
#pragma unroll
                for (int ks = 0; ks < 4; ++ks) An[ks] = *reinterpret_cast<const bf16x8*>(&IKC[(size_t)((kt + 8) * 32 + r) * 64 + ks * 16 + hf * 8]);
            }
#pragma unroll
            for (int grp = 0; grp < 2; ++grp) {
                f32x16 acc;
#pragma unroll
                for (int g = 0; g < 16; ++g) acc[g] = 0.f;
#pragma unroll
                for (int ks = 0; ks < 4; ++ks) acc = __builtin_amdgcn_mfma_f32_32x32x16_bf16(Ac[ks], B[grp][ks], acc, 0, 0, 0);
                float s1[8], s2[4], s3[2];
#pragma unroll
                for (int p = 0; p < 8; ++p) {
                    const float x0 = fmaxf(acc[2 * p], 0.f) * wgt[grp], x1 = fmaxf(acc[2 * p + 1], 0.f) * wgt[grp];
                    s1[p] = (b0 ? x1 : x0) + dpp_f<DPP_XOR1>(b0 ? x0 : x1);
                }
#pragma unroll
                for (int p = 0; p < 4; ++p) s2[p] = (b1 ? s1[2 * p + 1] : s1[2 * p]) + dpp_f<DPP_XOR2>(b1 ? s1[2 * p] : s1[2 * p + 1]);
#pragma unroll
                for (int p = 0; p < 2; ++p) s3[p] = (b2 ? s2[2 * p + 1] : s2[2 * p]) + __shfl_xor(b2 ? s2[2 * p] : s2[2 * p + 1], 4);
#pragma unroll
                for (int p = 0; p < 2; ++p) {
                    const int g = 8 * p + hh, kidx = kt * 32 + (g & 3) + 8 * (g >> 2) + 4 * hf, q = grp * 4 + qq;
                    const int bin = score_bin(s3[p], bsc[grp]);
                    BIN[q * 8192 + kidx] = (unsigned short)bin;
                    atomicAdd(&H16[q * 512 + (bin >> 1)], (bin & 1) ? 0x10000u : 1u);
                    KEYS[q * 8192 + kidx] = fkey(s3[p]);
                }
            }
        }
    }
    asm volatile("s_waitcnt vmcnt(0)" ::: "memory");
    __syncthreads();
    {
        const int q = wv;
        const unsigned short* bins = BIN + q * 8192;
        unsigned* hrow = H16 + q * 512;
        unsigned cnt[16]; unsigned sown = 0;
#pragma unroll
        for (int i = 0; i < 8; ++i) { const unsigned w = hrow[lane * 8 + i]; cnt[2 * i] = w & 0xFFFFu; cnt[2 * i + 1] = w >> 16; sown += cnt[2 * i] + cnt[2 * i + 1]; }
        unsigned S = sown;
#pragma unroll
        for (int o = 1; o < 64; o <<= 1) { const unsigned tt = __shfl_down(S, o); if (lane + o < 64) S += tt; }
        const unsigned long long mfound = __ballot(S >= 256u);
        const int ls = 63 - __clzll(mfound);
        int b0l = 0; unsigned abovel = 0;
        {
            unsigned accv = S - sown; bool done = false;
#pragma unroll
            for (int bb = 15; bb >= 0; --bb) { if (!done) { if (accv + cnt[bb] >= 256u) { b0l = lane * 16 + bb; abovel = accv; done = true; } else accv += cnt[bb]; } }
        }
        const int b0 = __shfl(b0l, ls); const unsigned ngt = __shfl((int)abovel, ls); const unsigned need = 256u - ngt;
        __builtin_amdgcn_wave_barrier();
        int* CL = (int*)hrow; unsigned* CK = hrow + DSA_CCAP;
        const unsigned long long lt = (1ull << lane) - 1ull;
        unsigned rg = 0, rc = 0;
        for (int base = 0; base < (L >> 1); base += 64) {
            const bool valid = (base + lane) < (L >> 1);
            const unsigned w = valid ? reinterpret_cast<const unsigned*>(bins)[base + lane] : 0u;
            const int ba = (int)(w & 0xFFFFu), bb = (int)(w >> 16), ia = 2 * (base + lane), ib = ia + 1;
            const bool ga = valid && ba > b0, gb = valid && bb > b0, ca = valid && ba == b0, cb = valid && bb == b0;
            const unsigned long long mga = __ballot(ga), mgb = __ballot(gb), mca = __ballot(ca), mcb = __ballot(cb);
            const unsigned pg = rg + (unsigned)__popcll(mga & lt) + (unsigned)__popcll(mgb & lt);
            const unsigned pc = rc + (unsigned)__popcll(mca & lt) + (unsigned)__popcll(mcb & lt);
            if (ga && pg < 256u) SEL[q * 256 + pg] = ia;
            if (gb && pg + (ga ? 1u : 0u) < 256u) SEL[q * 256 + pg + (ga ? 1u : 0u)] = ib;
            if (ca && pc < (unsigned)DSA_CCAP) CL[pc] = ia;
            if (cb && pc + (ca ? 1u : 0u) < (unsigned)DSA_CCAP) CL[pc + (ca ? 1u : 0u)] = ib;
            rg += (unsigned)__popcll(mga) + (unsigned)__popcll(mgb); rc += (unsigned)__popcll(mca) + (unsigned)__popcll(mcb);
        }
        const unsigned ncand = rc;
        if (ncand > (unsigned)DSA_CCAP) { if (lane == 0) MISC[60] = 1u; }
        else {
            asm volatile("s_waitcnt lgkmcnt(0)" ::: "memory");
            for (unsigned i = lane; i < ncand; i += 64) CK[i] = __hip_atomic_load(&KEYS[q * 8192 + CL[i]], __ATOMIC_RELAXED, __HIP_MEMORY_SCOPE_AGENT);
            asm volatile("s_waitcnt vmcnt(0) lgkmcnt(0)" ::: "memory");
            __builtin_amdgcn_wave_barrier();
            for (unsigned i = lane; i < ncand; i += 64) {
                const unsigned me = CK[i]; unsigned rk = 0;
                for (unsigned j = 0; j < ncand; ++j) { const unsigned o = CK[j]; rk += (o > me || (o == me && j < i)) ? 1u : 0u; }
                if (rk < need) SEL[q * 256 + ngt + rk] = CL[i];
            }
            asm volatile("s_waitcnt lgkmcnt(0)" ::: "memory");
            __builtin_amdgcn_wave_barrier();
            for (int i = lane; i < 256; i += 64) { const int e = SEL[q * 256 + i]; SEL[q * 256 + i] = e | (rel_bucket(e - (t0 + q)) << 16); }
            if (lane == 0) MISC[16 + q] = 256u;
        }
    }
    __syncthreads();
    return MISC[60] == 0u;
}

__device__ __forceinline__ void dsa_unit(const Args& a, const int unit, unsigned char* lds) {
    const int t0 = unit * 8, wv = my_tid() >> 6;
    if (!dsa_select8(a, t0, lds)) {
        __syncthreads();
        dsa_select4(a, t0, 0, lds);
        dsa_select4(a, t0 + 4, 4, lds);
    }
    const int* SEL = (const int*)(lds + DSA_SEL_OFF); const unsigned* MISC = (const unsigned*)(lds + LDS_MISC);
    dsa_attend(a, t0 + wv, SEL + wv * 256, (int)MISC[16 + wv], lds + wv * CT_WAVE, (const float*)(lds + DSA_RELB_OFF));
    __syncthreads();
}
template <int J> __device__ __forceinline__ int xchg_i(int v) {
    if (J == 1) return __builtin_amdgcn_update_dpp(0, v, 0xB1, 0xF, 0xF, true);
    else if (J == 2) return __builtin_amdgcn_update_dpp(0, v, 0x4E, 0xF, 0xF, true);
    else if (J == 4) { int t = __builtin_amdgcn_update_dpp(v, v, 0x104, 0xF, 0x5, false);
                       return __builtin_amdgcn_update_dpp(t, v, 0x114, 0xF, 0xA, false); }
    else if (J == 8) return __builtin_amdgcn_update_dpp(0, v, 0x128, 0xF, 0xF, true);
    else return __shfl_xor(v, J);
}
template <int J> __device__ __forceinline__ float xchg_f(float v) { return __int_as_float(xchg_i<J>(__float_as_int(v))); }

__device__ __forceinline__ unsigned okey(float f) { const unsigned u = __float_as_uint(f); return (u & 0x80000000u) ? ~u : (u | 0x80000000u); }
template <int K, int J> __device__ __forceinline__ void bitonic_step(unsigned& k, const int lane) {
    const unsigned ok = (unsigned)xchg_i<J>((int)k);
    const bool desc = (K == 64) ? true : ((lane & K) == 0);
    const bool keepmax = ((lane & J) == 0) == desc;
    k = keepmax ? max(k, ok) : min(k, ok);
}
__device__ __forceinline__ void bitonic64(unsigned& k, const int lane) {
    bitonic_step<2, 1>(k, lane);
    bitonic_step<4, 2>(k, lane); bitonic_step<4, 1>(k, lane);
    bitonic_step<8, 4>(k, lane); bitonic_step<8, 2>(k, lane); bitonic_step<8, 1>(k, lane);
    bitonic_step<16, 8>(k, lane); bitonic_step<16, 4>(k, lane); bitonic_step<16, 2>(k, lane); bitonic_step<16, 1>(k, lane);
    bitonic_step<32, 16>(k, lane); bitonic_step<32, 8>(k, lane); bitonic_step<32, 4>(k, lane); bitonic_step<32, 2>(k, lane); bitonic_step<32, 1>(k, lane);
    bitonic_step<64, 32>(k, lane); bitonic_step<64, 16>(k, lane); bitonic_step<64, 8>(k, lane); bitonic_step<64, 4>(k, lane); bitonic_step<64, 2>(k, lane); bitonic_step<64, 1>(k, lane);
}
__device__ __forceinline__ void merge32(unsigned& k, const int lane) {
    bitonic_step<64, 16>(k, lane); bitonic_step<64, 8>(k, lane); bitonic_step<64, 4>(k, lane); bitonic_step<64, 2>(k, lane); bitonic_step<64, 1>(k, lane);
}
__device__ __forceinline__ void top16_of_128(const float* s, float& tv, int& ti, const int lane) {
    unsigned ka = (okey(s[lane]) & ~0x7Fu) | (unsigned)(127 - lane), kb = (okey(s[64 + lane]) & ~0x7Fu) | (unsigned)(63 - lane);
    bitonic64(ka, lane); bitonic64(kb, lane);
    const unsigned rb = (unsigned)__shfl((int)kb, 31 - lane);
    unsigned k = (lane < 16) ? ka : ((lane < 32) ? rb : 0u);
    merge32(k, lane);
    ti = 127 - (int)(k & 0x7Fu);
    tv = s[ti];
}

#ifndef DUP_PEER
#define DUP_PEER 0
#endif
constexpr int PEER_EID_OFF = 131072, PEER_GATE_OFF = 139264;
#ifndef PGB
#define PGB 8
#endif

__device__ __forceinline__ void peer_unit(const Args& a, const int unit, unsigned char* lds) {
    const bfr* QP = (const bfr*)(a.ws + WS_QP); const bfr* SUBK = (const bfr*)(a.ws + WS_SUBK);
    const unsigned char* PU4 = a.ws + WS_PU; const unsigned char* PV4 = a.ws + WS_PV;
    const bfr* HB = (const bfr*)(a.ws + WS_HB); const float* part = (const float*)(a.ws + WS_PART);
    float* S = (float*)lds; int* EID = (int*)(lds + PEER_EID_OFF); float* GATE = (float*)(lds + PEER_GATE_OFF);
    const int tid = my_tid(), lane = tid & 63, wv = tid >> 6, fr = lane & 15, fq = lane >> 4, t0 = unit * 16;
    for (int rp_ = 0; rp_ < ((DUP_PEER & 1) ? 2 : 1); ++rp_) {
    for (int hc = wv * 2; hc < wv * 2 + 2; ++hc) {
        bf16x8 A[4];
#pragma unroll
        for (int ks = 0; ks < 4; ++ks) A[ks] = *reinterpret_cast<const bf16x8*>(&QP[(size_t)(t0 + fr) * D + hc * 128 + ks * 32 + fq * 8]);
#pragma unroll 2
        for (int nt = 0; nt < 8; ++nt) {
            f32x4 acc = {0.f, 0.f, 0.f, 0.f};
#pragma unroll
            for (int ks = 0; ks < 4; ++ks) {
                const bf16x8 B = *reinterpret_cast<const bf16x8*>(&SUBK[(size_t)(hc * 128 + nt * 16 + fr) * 128 + ks * 32 + fq * 8]);
                acc = __builtin_amdgcn_mfma_f32_16x16x32_bf16(A[ks], B, acc, 0, 0, 0);
            }
#pragma unroll
            for (int j = 0; j < 4; ++j) S[((fq * 4 + j) * 16 + hc) * 128 + nt * 16 + fr] = acc[j];
        }
    }
    __syncthreads();
    for (int job = wv * 16; job < wv * 16 + 16; ++job) {
        const int tok = job >> 3, hh = job & 7;
        const float* s1 = S + (tok * 16 + hh * 2) * 128; const float* s2 = s1 + 128;
        float v1, v2; int i1, i2;
        top16_of_128(s1, v1, i1, lane);
        top16_of_128(s2, v2, i2, lane);
        int ci = -1, cj = 0;
        { int base = 0;
#pragma unroll
          for (int i = 0; i < 16; ++i) { const int cnt = 16 / (i + 1); if (lane >= base && lane < base + cnt) { ci = i; cj = lane - base; } base += cnt; } }
        const float a1 = __shfl(v1, ci < 0 ? 0 : ci), b1 = __shfl(v2, cj);
        unsigned ck = (ci >= 0) ? ((okey(a1 + b1) & ~0xFFu) | (unsigned)(255 - (ci * 16 + cj))) : 0u;
        bitonic64(ck, lane);
        const int cid = 255 - (int)(ck & 0xFFu);
        const int pi = (lane < 16) ? (cid >> 4) : 0, pj = (lane < 16) ? (cid & 15) : 0;
        const float cv = __shfl(v1, pi) + __shfl(v2, pj);
        const float mx = __shfl(cv, 0);
        float e = (lane < 16) ? __expf(cv - mx) : 0.f;
        float se = e;
#pragma unroll
        for (int o = 1; o < 16; o <<= 1) se += __shfl_xor(se, o);
        const int e1 = __shfl(i1, pi), e2 = __shfl(i2, pj);
        if (lane < 16) { EID[tok * 128 + hh * 16 + lane] = e1 * 128 + e2; GATE[tok * 128 + hh * 16 + lane] = e * frcp_(se); }
    }
    __syncthreads();
    }
    for (int rp_ = 0; rp_ < ((DUP_PEER & 2) ? 2 : 1); ++rp_)
    for (int tk = wv * 2; tk < wv * 2 + 2; ++tk) {
        const int t = t0 + tk;
        int ln = lane; asm volatile("" : "+v"(ln));
        const float rstd = row_rstd(part, t);
        float hsc; uint4 q1r[8], q2r[8];
        {
            float hf[32]; float am = 0.f;
#pragma unroll
            for (int q = 0; q < 8; ++q) {
                const uint2 xr = *reinterpret_cast<const uint2*>(&HB[(size_t)t * D + q * 256 + ln * 4]);
                const float4 g0 = *reinterpret_cast<const float4*>(&a.in[I_NFG][q * 256 + ln * 4]);
                hf[q * 4] = bflo(xr.x) * rstd * g0.x; hf[q * 4 + 1] = bfhi(xr.x) * rstd * g0.y; hf[q * 4 + 2] = bflo(xr.y) * rstd * g0.z; hf[q * 4 + 3] = bfhi(xr.y) * rstd * g0.w;
                am = fmaxf(am, fmaxf(fmaxf(fabsf(hf[q * 4]), fabsf(hf[q * 4 + 1])), fmaxf(fabsf(hf[q * 4 + 2]), fabsf(hf[q * 4 + 3]))));
            }
            am = wave_max(am);
            const float h1s = am * (1.f / 7.f), i1 = h1s > 0.f ? frcp_(h1s) : 0.f, i2 = 14.f * i1; hsc = h1s * (1.f / 14.f);
            float qv[32];
#pragma unroll
            for (int i = 0; i < 32; ++i) { qv[i] = fminf(fmaxf(__builtin_rintf(hf[i] * i1), -7.f), 7.f); hf[i] -= qv[i] * h1s; }
            uint4 p1; p1.x = pack8_i4(qv); p1.y = pack8_i4(qv + 8); p1.z = pack8_i4(qv + 16); p1.w = pack8_i4(qv + 24);
#pragma unroll
            for (int i = 0; i < 32; ++i) qv[i] = fminf(fmaxf(__builtin_rintf(hf[i] * i2), -7.f), 7.f);
            uint4 p2; p2.x = pack8_i4(qv); p2.y = pack8_i4(qv + 8); p2.z = pack8_i4(qv + 16); p2.w = pack8_i4(qv + 24);
            unsigned char* HQ = lds + wv * 2048;
            *reinterpret_cast<uint4*>(HQ + ln * 32) = p1; *reinterpret_cast<uint4*>(HQ + ln * 32 + 16) = p2;
            asm volatile("s_waitcnt lgkmcnt(0)" ::: "memory");
#pragma unroll
            for (int i = 0; i < 8; ++i) { const int b = i * 8 + (ln & 7); q1r[i] = *reinterpret_cast<const uint4*>(HQ + b * 32); q2r[i] = *reinterpret_cast<const uint4*>(HQ + b * 32 + 16); }
            asm volatile("s_waitcnt lgkmcnt(0)" ::: "memory");
        }
        float coef0, coef1;
        {
            const int grp = ln >> 3, j16 = (ln & 7) * 16;
            float md0 = 0.f, md1 = 0.f;
#define PEER_LOAD_U(W, SC, E0) { const int eid = EID[tk * 128 + (E0) + grp]; const unsigned char* rowp = PU4 + (size_t)eid * PEER_ROWB + j16; \
                SC = *reinterpret_cast<const uint4*>(rowp + 1024); \
                _Pragma("unroll") for (int i = 0; i < 8; ++i) W[i] = *reinterpret_cast<const uint4*>(rowp + i * 128); __builtin_amdgcn_sched_barrier(0); }
#define PEER_DOT_U(W, SC, E0) { float p = 0.f; const unsigned scw[4] = {SC.x, SC.y, SC.z, SC.w}; \
                _Pragma("unroll") for (int i = 0; i < 8; ++i) { \
                    int d1 = 0; \
                    d1 = __builtin_amdgcn_sdot8((int)W[i].x, (int)q1r[i].x, d1, false); d1 = __builtin_amdgcn_sdot8((int)W[i].y, (int)q1r[i].y, d1, false); \
                    d1 = __builtin_amdgcn_sdot8((int)W[i].z, (int)q1r[i].z, d1, false); d1 = __builtin_amdgcn_sdot8((int)W[i].w, (int)q1r[i].w, d1, false); \
                    int d2 = __mul24(d1, 14); \
                    d2 = __builtin_amdgcn_sdot8((int)W[i].x, (int)q2r[i].x, d2, false); d2 = __builtin_amdgcn_sdot8((int)W[i].y, (int)q2r[i].y, d2, false); \
                    d2 = __builtin_amdgcn_sdot8((int)W[i].z, (int)q2r[i].z, d2, false); d2 = __builtin_amdgcn_sdot8((int)W[i].w, (int)q2r[i].w, d2, false); \
                    const float rs = (i & 1) ? bfhi(scw[i >> 1]) : bflo(scw[i >> 1]); \
                    p = fmaf((float)d2, rs, p); } \
                p += dpp_f<DPP_XOR1>(p); p += dpp_f<DPP_XOR2>(p); p += dpp_f<0x141>(p); \
                const bool mine = (ln & 7) == ((((E0)) >> 3) & 7); \
                if (mine && (E0) < 64) md0 = p; if (mine && (E0) >= 64) md1 = p; __builtin_amdgcn_sched_barrier(0); }
            uint4 wA[8], wB[8]; uint4 sA, sB;
            PEER_LOAD_U(wA, sA, 0)
#pragma unroll 1
            for (int e0 = 0; e0 < 112; e0 += 16) {
                PEER_LOAD_U(wB, sB, e0 + 8)
                PEER_DOT_U(wA, sA, e0)
                PEER_LOAD_U(wA, sA, e0 + 16)
                PEER_DOT_U(wB, sB, e0 + 8)
            }
            PEER_LOAD_U(wB, sB, 120)
            PEER_DOT_U(wA, sA, 112)
            PEER_DOT_U(wB, sB, 120)
            const int pe = (ln & 7) * 8 + (ln >> 3);
            md0 *= hsc; md1 *= hsc;
            coef0 = 0.5f * md0 * (1.f + erff(md0 * 0.7071067811865476f)) * GATE[tk * 128 + pe];
            coef1 = 0.5f * md1 * (1.f + erff(md1 * 0.7071067811865476f)) * GATE[tk * 128 + 64 + pe];
        }
#define PEER_EL(e) ((((e) & 7) << 3) | ((e) >> 3))
        h16x2 ov2[16];
#pragma unroll
        for (int j = 0; j < 16; ++j) ov2[j] = h16x2{(_Float16)0.f, (_Float16)0.f};
        {
#define PEER_LOAD_V(W, SC, E0) _Pragma("unroll") for (int bq = 0; bq < 4; ++bq) { \
                const int eid = __builtin_amdgcn_readfirstlane(EID[tk * 128 + (E0) + bq]); const unsigned char* rowp = PV4 + (size_t)eid * PEER_ROWB; \
                SC[bq] = *reinterpret_cast<const bfr*>(rowp + 1024 + ln * 2); W[bq] = *reinterpret_cast<const uint4*>(rowp + ln * 16); } __builtin_amdgcn_sched_barrier(0);
#define PEER_AXPY_V(W, SC, E0) _Pragma("unroll") for (int bq = 0; bq < 4; ++bq) { \
                const float cfl = __int_as_float(__builtin_amdgcn_readlane(__float_as_int(((E0) < 64) ? coef0 : coef1), PEER_EL(((E0) + bq) & 63))); \
                const unsigned dw[4] = {W[bq].x, W[bq].y, W[bq].z, W[bq].w}; const _Float16 ch = (_Float16)(cfl * bf2f(SC[bq])); const h16x2 c2 = {ch, ch}; \
                _Pragma("unroll") for (int d = 0; d < 4; ++d) { \
                    ov2[d * 4 + 0] = c2 * __builtin_amdgcn_cvt_scalef32_pk_f16_fp4(dw[d], 1.0f, 0) + ov2[d * 4 + 0]; \
                    ov2[d * 4 + 1] = c2 * __builtin_amdgcn_cvt_scalef32_pk_f16_fp4(dw[d], 1.0f, 1) + ov2[d * 4 + 1]; \
                    ov2[d * 4 + 2] = c2 * __builtin_amdgcn_cvt_scalef32_pk_f16_fp4(dw[d], 1.0f, 2) + ov2[d * 4 + 2]; \
                    ov2[d * 4 + 3] = c2 * __builtin_amdgcn_cvt_scalef32_pk_f16_fp4(dw[d], 1.0f, 3) + ov2[d * 4 + 3]; } \
                __builtin_amdgcn_sched_barrier(0); }
            uint4 wA[4], wB[4]; bfr sA[4], sB[4];
            PEER_LOAD_V(wA, sA, 0)
#pragma unroll 1
            for (int e0 = 0; e0 < 120; e0 += 8) {
                PEER_LOAD_V(wB, sB, e0 + 4)
                PEER_AXPY_V(wA, sA, e0)
                PEER_LOAD_V(wA, sA, e0 + 8)
                PEER_AXPY_V(wB, sB, e0 + 4)
            }
            PEER_LOAD_V(wB, sB, 124)
            PEER_AXPY_V(wA, sA, 120)
            PEER_AXPY_V(wB, sB, 124)
        }
        float ss = 0.f;
        float hv[32];
        { int l2 = lane; asm volatile("" : "+v"(l2));
#pragma unroll
          for (int q = 0; q < 8; ++q) {
              const uint2 xr = *reinterpret_cast<const uint2*>(&HB[(size_t)t * D + q * 256 + l2 * 4]);
              float4 x0; x0.x = bflo(xr.x); x0.y = bfhi(xr.x); x0.z = bflo(xr.y); x0.w = bfhi(xr.y);
              hv[q * 4 + 0] = x0.x; hv[q * 4 + 1] = x0.y; hv[q * 4 + 2] = x0.z; hv[q * 4 + 3] = x0.w;
          } }
#pragma unroll
        for (int j = 0; j < 32; ++j) { hv[j] += (DBG_NOPEER ? 0.f : (float)ov2[j >> 1][j & 1]); ss += hv[j] * hv[j]; }
        ss = wave_sum(ss);
        const float r2 = rsqrtf(ss * (1.f / D) + EPS);
#pragma unroll
        for (int q = 0; q < 8; ++q) {
            const float4 g0 = *reinterpret_cast<const float4*>(&a.in[I_NFIN][q * 256 + ln * 4]);
            float4 o0;
            o0.x = hv[q * 4 + 0] * r2 * g0.x; o0.y = hv[q * 4 + 1] * r2 * g0.y; o0.z = hv[q * 4 + 2] * r2 * g0.z; o0.w = hv[q * 4 + 3] * r2 * g0.w;
            *reinterpret_cast<float4*>(&a.out[(size_t)t * D + q * 256 + ln * 4]) = o0;
        }
    }
    __syncthreads();
}
constexpr int NPHASE = 9;
__global__ void __launch_bounds__(512, 2) mk_fwd(Args a) {
    extern __shared__ __attribute__((aligned(16))) unsigned char lds[];
    volatile LAS unsigned* barw = (volatile LAS unsigned*)((LAS unsigned char*)lds + LDS_BARW);
    unsigned* MISC = (unsigned*)(lds + LDS_MISC);
    if (threadIdx.x < 4) barw[threadIdx.x] = 0u;
    __syncthreads();
    XcdBarrier bar; bar.bar = (unsigned*)(a.ws + WS_CTL); bar.x = 0; bar.st = barw;
#if !MK_SPLIT
    bar = xcd_barrier_post((unsigned*)(a.ws + WS_CTL), barw);
#endif
    const int lo = a.ph_lo, hi = a.ph_hi;
#ifndef PH_MASK
#define PH_MASK 0x1FF
#endif
#define IN(k) (((PH_MASK >> (k)) & 1) && lo <= (k) && (k) < hi)
#ifndef DUP_RW
#define DUP_RW 0
#endif
#ifndef DUP_CHAIN
#define DUP_CHAIN 0
#endif
#ifndef DUP_MASK
#define DUP_MASK 0
#endif
#define REP(k) for (int rep_ = 0; rep_ < (((DUP_MASK >> (k)) & 1) ? 2 : 1); ++rep_)
#define SEAM(k) do { if (IN(k) && IN((k) + 1)) xcd_barrier(bar); } while (0)
    unsigned char* ws = a.ws;
    const bfr* P = (const bfr*)(ws + WS_P);

    if (IN(0)) REP(0) {
        const int tid = my_tid(), wv = tid >> 6; (void)tid; (void)wv;
        {
            const float* x = a.in[I_X]; const float* g = a.in[I_NMG]; bfr* XN = (bfr*)(ws + WS_XN);
            const int lane = tid & 63;
            for (int row = blockIdx.x * 8 + wv; row < T; row += gridDim.x * 8) {
                float4 v[8]; float ss = 0.f;
#pragma unroll
                for (int j = 0; j < 8; ++j) { v[j] = reinterpret_cast<const float4*>(x + (size_t)row * D)[j * 64 + lane]; ss += v[j].x * v[j].x + v[j].y * v[j].y + v[j].z * v[j].z + v[j].w * v[j].w; }
                ss = wave_sum(ss);
                const float rs = rsqrtf(ss * (1.f / D) + EPS);
#pragma unroll
                for (int j = 0; j < 8; ++j) {
                    const float4 gg = reinterpret_cast<const float4*>(g)[j * 64 + lane];
                    uint2 o; o.x = pack2(v[j].x * rs * gg.x, v[j].y * rs * gg.y); o.y = pack2(v[j].z * rs * gg.z, v[j].w * rs * gg.w);
                    reinterpret_cast<uint2*>(XN + (size_t)row * D)[j * 64 + lane] = o;
                }
            }
        }
        float* tl = (float*)lds;
        tr_all(a.in[I_WIN], (bfr*)(ws + WS_WTIN), D, NIN, NINP, nullptr, tl);
        tr_all(a.in[I_WBR], (bfr*)(ws + WS_WTA), RW, D, D, nullptr, tl);
        tr_all(a.in[I_WBD], (bfr*)(ws + WS_WTB), RW, D, D, nullptr, tl);
        tr_all(a.in[I_WOUT], (bfr*)(ws + WS_WTOUT), D, D, D, nullptr, tl);
        tr_all(a.in[I_WPQ], (bfr*)(ws + WS_WTPQ), D, D, D, a.in[I_NFG], tl);
        for (int it = blockIdx.x; it < 16 * 4; it += gridDim.x) {
            const int h = it >> 2, k0 = (it & 3) * 64;
            tr_tile(a.in[I_WUV] + (size_t)h * 256 * 64, (bfr*)(ws + WS_WUVT) + (size_t)h * 64 * 256, 256, 64, k0, 0, nullptr, tl);
        }
        cvt_all(a.in[I_WUK], (bfr*)(ws + WS_WUK), (size_t)16 * 256 * 64);
        cvt_all(a.in[I_SUBK], (bfr*)(ws + WS_SUBK), (size_t)16 * 128 * 128);
    }
    SEAM(0);

    if (IN(1)) REP(1) {
        const int tid = my_tid(), wv = tid >> 6; (void)tid; (void)wv;
        EpiP E{(bfr*)(ws + WS_P)};
        const int nM = T / BM, nN = NINP / BM;
        for (int tile = blockIdx.x; tile < nM * nN; tile += gridDim.x) {
            int brow, bcol; tile_rc(tile, nM, nN, brow, bcol);
            gemm_tile((const bfr*)(ws + WS_XN), (const bfr*)(ws + WS_WTIN), D, brow, bcol, (bfr*)lds, E);
        }
        {
            const int rem = (nM * nN) % (int)gridDim.x, idle = (int)gridDim.x - rem;
            if (rem == 0) cvt_i4_rows(a.in[I_PU], ws + WS_PU, blockIdx.x, gridDim.x);
            else if ((int)blockIdx.x >= rem) cvt_i4_rows(a.in[I_PU], ws + WS_PU, (int)blockIdx.x - rem, idle);
        }
    }
    SEAM(1);

    if (IN(2)) REP(2) {
        const int tid = my_tid(), wv = tid >> 6; (void)tid; (void)wv;
        rwkv_load_weights(a, blockIdx.x & 15, lds);
        {
            const int h = blockIdx.x & 15, nun = (NUNIT - (int)blockIdx.x + (int)gridDim.x - 1) / (int)gridDim.x;
            RwIn inA, inB;
            if (nun > 0) rwkv_fetch(a, (int)blockIdx.x >> 4, h, inA);
            for (int k = 0; k < nun; k += 2) {
                const int c0 = ((int)blockIdx.x + k * (int)gridDim.x) >> 4, c1 = ((int)blockIdx.x + (k + 1) * (int)gridDim.x) >> 4, c2 = ((int)blockIdx.x + (k + 2) * (int)gridDim.x) >> 4;
                rwkv_unit(a, c0, h, lds, inA, inB, (k + 1 < nun) ? c1 : -1);
                if (k + 1 < nun) rwkv_unit(a, c1, h, lds, inB, inA, (k + 2 < nun) ? c2 : -1);
            }
        }
        dsa_cnorm(a);
        dsa_qlat(a);
    }
    SEAM(2);

    if (IN(3)) REP(3) {
        const int tid = my_tid(), wv = tid >> 6; (void)tid; (void)wv;
        if (blockIdx.x < 32) {
            if (wv == 0) rwkv_chain(a, blockIdx.x >> 1, blockIdx.x & 1);
            else cvt_fp4_rows(a.in[I_PV], ws + WS_PV, (int)blockIdx.x * 7 + (wv - 1), 32 * 7);
        }
        __syncthreads();
        for (int i = tid; i < 512; i += 512) ((float*)(lds + DSA_RELB_OFF))[i] = a.in[I_RELB][i];
        __syncthreads();
        unsigned* cnt = (unsigned*)(ws + WS_CTL + CTL_CNT) + rep_ * 64;
        for (;;) {
            if (tid == 0) MISC[0] = atomicAdd(cnt, 1u);
            __syncthreads();
            const unsigned n = MISC[0];
            __syncthreads();
            if (n >= T / 8) break;
            dsa_unit(a, (T / 8 - 1) - (int)n, lds);
        }
    }
    SEAM(3);

    if (IN(4)) REP(4) {
        const int tid = my_tid(), wv = tid >> 6; (void)tid; (void)wv;
        float* Ls = (float*)lds + wv * 4352;
        for (int u = blockIdx.x * 8 + wv; u < NUNIT; u += gridDim.x * 8) rwkv_out_unit(a, u, Ls);
        dsa_oproj(a);
    }
    SEAM(4);

    if (IN(5)) REP(5) {
        const int tid = my_tid(), wv = tid >> 6; (void)tid; (void)wv;
        const int nM = T / BM, nN = D / BM;
        for (int tile = blockIdx.x; tile < nM * nN; tile += gridDim.x) {
            int brow, bcol; tile_rc(tile, nM, nN, brow, bcol);
#pragma unroll 1
            for (int pass = 0; pass < 2; ++pass) {
                EpiMix E{(bfr*)(ws + (pass ? WS_MIX : WS_TMPA)), pass ? (const bfr*)(ws + WS_TMPA) : (const bfr*)nullptr, P + (pass ? C_GB : C_GA)};
                gemm_tile((const bfr*)(ws + (pass ? WS_DO : WS_RWO)), (const bfr*)(ws + (pass ? WS_WTB : WS_WTA)), RW, brow, bcol, (bfr*)lds, E);
                asm volatile("s_waitcnt vmcnt(0)" ::: "memory");
            }
        }
    }
    SEAM(5);

    if (IN(6)) REP(6) {
        const int tid = my_tid(), wv = tid >> 6; (void)tid; (void)wv;
        const int nM = T / BM, nN = D / BM;
        for (int tile = blockIdx.x; tile < nM * nN; tile += gridDim.x) {
            int brow, bcol; tile_rc(tile, nM, nN, brow, bcol);
            EpiH E{(bfr*)(ws + WS_HB), a.in[I_X], (float*)(ws + WS_PART), bcol >> 8};
            gemm_tile((const bfr*)(ws + WS_MIX), (const bfr*)(ws + WS_WTOUT), D, brow, bcol, (bfr*)lds, E);
        }
    }
    SEAM(6);

    if (IN(7)) REP(7) {
        const int tid = my_tid(), wv = tid >> 6; (void)tid; (void)wv;
        const int nM = T / BM, nN = D / BM;
        float* rs = (float*)(lds + 135168);
        for (int tile = blockIdx.x; tile < nM * nN; tile += gridDim.x) {
            int brow, bcol; tile_rc(tile, nM, nN, brow, bcol);
            if (tid < 256) rs[tid] = row_rstd((const float*)(ws + WS_PART), brow + tid);
            __syncthreads();
            EpiQ E{(bfr*)(ws + WS_QP), rs, brow};
            gemm_tile((const bfr*)(ws + WS_HB), (const bfr*)(ws + WS_WTPQ), D, brow, bcol, (bfr*)lds, E);
        }
    }
    SEAM(7);

    if (IN(8)) REP(8) {
        const int tid = my_tid(), wv = tid >> 6; (void)tid; (void)wv;
        for (int u = blockIdx.x; u < T / 16; u += gridDim.x) peer_unit(a, u, lds);
    }
#undef IN
#undef SEAM
}

extern "C" void kernel_launch(void* const* d_in, const int* in_sizes, int n_in, void* d_out, int out_size, void* d_ws, size_t ws_size, hipStream_t stream) {
    static int grid = 0;
    if (grid == 0) {
        if (n_in != 27 || out_size != T * D || ws_size < WS_END) { fprintf(stderr, "kernel_launch: unexpected shapes (n_in %d out %d ws %zu)\n", n_in, out_size, ws_size); grid = -1; return; }
        int dev = 0, cus = 0, per_cu = 0;
        if (hipGetDevice(&dev) != hipSuccess || hipDeviceGetAttribute(&cus, hipDeviceAttributeMultiprocessorCount, dev) != hipSuccess) { grid = -1; return; }
        if (hipFuncSetAttribute((const void*)mk_fwd, hipFuncAttributeMaxDynamicSharedMemorySize, LDS_BYTES) != hipSuccess) { fprintf(stderr, "kernel_launch: hipFuncSetAttribute failed\n"); grid = -1; return; }
        if (hipOccupancyMaxActiveBlocksPerMultiprocessor(&per_cu, (const void*)mk_fwd, 512, LDS_BYTES) != hipSuccess || per_cu < 1) { fprintf(stderr, "kernel_launch: occupancy query says %d\n", per_cu); (void)hipGetLastError(); grid = -1; return; }
        grid = cus;
    }
    if (grid < 0) return;
    if (hipMemsetAsync((char*)d_ws + WS_CTL, 0, CTL_ZERO, stream) != hipSuccess) return;
    Args a{};
    for (int i = 0; i < 27; ++i) a.in[i] = (const float*)d_in[i];
    a.out = (float*)d_out; a.ws = (unsigned char*)d_ws;
#if MK_SPLIT
    for (int ph = 0; ph < NPHASE; ++ph) { a.ph_lo = ph; a.ph_hi = ph + 1; hipLaunchKernelGGL(mk_fwd, dim3(grid), dim3(512), LDS_BYTES, stream, a); }
#elif defined(PROBE_PHASE)
    a.ph_lo = 0; a.ph_hi = PROBE_PHASE + 1;
    hipLaunchKernelGGL(mk_fwd, dim3(grid), dim3(512), LDS_BYTES, stream, a);
    (void)hipMemsetAsync((char*)d_ws + WS_CTL, 0, CTL_ZERO, stream);
    a.ph_lo = PROBE_PHASE; a.ph_hi = NPHASE;
    hipLaunchKernelGGL(mk_fwd, dim3(grid), dim3(512), LDS_BYTES, stream, a);
#else
    a.ph_lo = 0; a.ph_hi = NPHASE;
    hipLaunchKernelGGL(mk_fwd, dim3(grid), dim3(512), LDS_BYTES, stream, a);
#endif
}
```

```cpp
#include <hip/hip_runtime.h>
#include <stdint.h>
#include <stdio.h>

#ifndef MK_SPLIT
#define MK_SPLIT 0
#endif

#ifndef DBG_NOPEER
#define DBG_NOPEER 0
#endif
#ifndef DBG_NODSA
#define DBG_NODSA 0
#endif
typedef unsigned short bfr;
using bf16x8 = __attribute__((ext_vector_type(8))) short;
using bf16x4 = __attribute__((ext_vector_type(4))) short;
using f32x4  = __attribute__((ext_vector_type(4))) float;
using f32x2  = __attribute__((ext_vector_type(2))) float;
using f32x16 = __attribute__((ext_vector_type(16))) float;
using u32x4  = __attribute__((ext_vector_type(4))) unsigned;
using h16x2  = __attribute__((ext_vector_type(2))) _Float16;

constexpr int T = 8192, D = 2048, NIN = 9320, NINP = 9472;
constexpr int RW = 1024, NH = 16, HD = 64;
constexpr int C_R = 0, C_K = 1024, C_V = 2048, C_ZW = 3072, C_ZA = 3136, C_ZG = 3200, C_Q = 3360, C_CKV = 4384,
              C_IQ = 4640, C_IK = 5152, C_IW = 5216, C_GA = 5224, C_GB = 7272;
constexpr int KVR = 256, NUNIT = 128 * 16;
constexpr float EPS = 1e-6f;

constexpr size_t MiB = 1u << 20;
constexpr size_t WS_CTL = 0;
constexpr size_t CTL_ZERO = 65536;
constexpr size_t CTL_CNT = 16384;
constexpr size_t CTL_ROWSS = 32768;
constexpr size_t WS_WTA = 1 * MiB, WS_WTB = 5 * MiB, WS_WTOUT = 9 * MiB, WS_WTPQ = 17 * MiB;
constexpr size_t WS_WUK = 25 * MiB, WS_WUVT = 25 * MiB + 512 * 1024, WS_SUBK = 26 * MiB;
constexpr size_t WS_X = 27 * MiB;
constexpr size_t WS_XN = WS_X, WS_WTIN = WS_X + 32 * MiB;
constexpr size_t WS_PM = WS_X, WS_WY = WS_X + 16 * MiB, WS_GM = WS_X + 32 * MiB, WS_YLOC = WS_X + 48 * MiB;
constexpr size_t WS_MIX = WS_X;
constexpr size_t WS_P = 96 * MiB;
constexpr size_t WS_H = 96 * MiB, WS_HB = 160 * MiB, WS_QP = 192 * MiB;
constexpr size_t WS_GG = 244 * MiB, WS_BON = 260 * MiB, WS_CB = 276 * MiB;
constexpr size_t WS_QLAT = 280 * MiB, WS_OLAT = WS_QLAT;
constexpr size_t WS_KEYS = 344 * MiB;
constexpr size_t WS_PU = 490 * MiB, WS_PV = 312 * MiB;
constexpr size_t WS_PUS = WS_PU + 32 * MiB, WS_PVS = WS_PV + 32 * MiB;
constexpr size_t WS_ZT = 408 * MiB, WS_RWO = 424 * MiB, WS_DO = 440 * MiB, WS_TMPA = 456 * MiB;
constexpr size_t WS_IKC = 489 * MiB;
constexpr size_t WS_PART = 488 * MiB;
constexpr size_t WS_END = 508 * MiB;

constexpr int LDS_BYTES = 163840 - 1024;
constexpr int LDS_BARW = LDS_BYTES - 64;
constexpr int LDS_MISC = LDS_BYTES - 512;

typedef __bf16 bf16v2_t __attribute__((ext_vector_type(2)));
__device__ __forceinline__ bfr f2bf(float f) { const __bf16 r = (__bf16)f; return __builtin_bit_cast(bfr, r); }
__device__ __forceinline__ float bf2f(bfr b) { return __uint_as_float(((unsigned)b) << 16); }
__device__ __forceinline__ unsigned pack2(float a, float b) { const f32x2 v = {a, b}; const bf16v2_t r = __builtin_convertvector(v, bf16v2_t); return __builtin_bit_cast(unsigned, r); }
__device__ __forceinline__ float bflo(unsigned u) { return __uint_as_float(u << 16); }
__device__ __forceinline__ float bfhi(unsigned u) { return __uint_as_float(u & 0xFFFF0000u); }
__device__ __forceinline__ int my_tid() { int t = threadIdx.x; asm volatile("" : "+v"(t)); return t; }

template <int CTRL> __device__ __forceinline__ float dpp_f(float v) {
    return __int_as_float(__builtin_amdgcn_update_dpp(0, __float_as_int(v), CTRL, 0xF, 0xF, true));
}
#define DPP_XOR1 0xB1
#define DPP_XOR2 0x4E
__device__ __forceinline__ float wave_sum(float v) {
    v += dpp_f<DPP_XOR1>(v); v += dpp_f<DPP_XOR2>(v); v += dpp_f<0x141>(v); v += dpp_f<0x140>(v);
    v += __shfl_xor(v, 16); v += __shfl_xor(v, 32); return v;
}
__device__ __forceinline__ float frcp_(float x) { return __builtin_amdgcn_rcpf(x); }
__device__ __forceinline__ float sigmoidf_(float x) { return frcp_(1.f + __expf(-x)); }

#define XB_TMO      128
#define XB_XCNT(j)  (256  + 64 * (j))
#define XB_XSUB(j)  (1280 + 64 * (j))
#define XB_XGEN(j)  (2304 + 64 * (j))
#define XB_TOP      3328
#define XB_TOPGEN   3392
#define XCD_BAR_WORDS 3456
#define XB_SPIN_CAP (1u << 20)
#define LAS __attribute__((address_space(3)))

__device__ __forceinline__ unsigned xb_ld(unsigned* p)              { return __hip_atomic_load(p, __ATOMIC_RELAXED, __HIP_MEMORY_SCOPE_AGENT); }
__device__ __forceinline__ unsigned xb_add(unsigned* p, unsigned v) { return __hip_atomic_fetch_add(p, v, __ATOMIC_RELAXED, __HIP_MEMORY_SCOPE_AGENT); }
__device__ __forceinline__ unsigned xb_xcc_id() { return (unsigned)__builtin_amdgcn_s_getreg((3 << 11) | 20) & 0xFu; }
#define XB_SPIN(cond, bar) do { unsigned _sp = 0; while (cond) { __builtin_amdgcn_s_sleep(1); \
    if ((++_sp & 255u) == 0u) { if (xb_ld(&(bar)[XB_TMO])) break; if (_sp > XB_SPIN_CAP) { atomicAdd(&(bar)[XB_TMO], 1u); break; } } } } while (0)

struct XcdBarrier { unsigned* bar; unsigned x; volatile LAS unsigned* st; };

__device__ __forceinline__ XcdBarrier xcd_barrier_post(unsigned* bar, volatile LAS unsigned* st) {
    XcdBarrier b; b.bar = bar; b.x = xb_xcc_id(); b.st = st;
    if (threadIdx.x == 0) (void)xb_add(&bar[XB_XCNT(b.x)], 1u);
    return b;
}
__device__ __forceinline__ void xcd_barrier_complete(unsigned* bar, unsigned x, unsigned& nloc, unsigned& nx) {
    const unsigned G = gridDim.x * gridDim.y * gridDim.z;
    unsigned sum, cnt, mine, sp = 0u;
    for (;;) {
        sum = 0u; cnt = 0u; mine = 0u;
#pragma unroll
        for (unsigned j = 0; j < 16; ++j) { const unsigned c = xb_ld(&bar[XB_XCNT(j)]); sum += c; cnt += (c > 0u) ? 1u : 0u; mine = (j == x) ? c : mine; }
        if (sum == G) break;
        __builtin_amdgcn_s_sleep(1);
        if ((++sp & 255u) == 0u) { if (xb_ld(&bar[XB_TMO])) break; if (sp > XB_SPIN_CAP) { atomicAdd(&bar[XB_TMO], 1u); break; } }
    }
    nloc = mine > 0u ? mine : 1u; nx = cnt > 0u ? cnt : 1u;
}
__device__ __forceinline__ void xcd_barrier(const XcdBarrier& b) {
    asm volatile("s_waitcnt vmcnt(0)" ::: "memory");
    __syncthreads();
    if (threadIdx.x == 0) {
        unsigned* bar = b.bar;
        __builtin_amdgcn_s_waitcnt(0);
        unsigned nloc = b.st[0], nx = b.st[1];
        if (nloc == 0u) { xcd_barrier_complete(bar, b.x, nloc, nx); b.st[0] = nloc; b.st[1] = nx; }
        const unsigned old = xb_add(&bar[XB_XSUB(b.x)], 1u);
        const unsigned gen = old / nloc;
        if (old + 1u == (gen + 1u) * nloc) {
            __builtin_amdgcn_fence(__ATOMIC_RELEASE, "agent");
            asm volatile("s_waitcnt vmcnt(0)" ::: "memory");
            const unsigned og = xb_add(&bar[XB_TOP], 1u);
            const unsigned tg = og / nx;
            if (og + 1u == (tg + 1u) * nx) xb_add(&bar[XB_TOPGEN], 1u);
            else XB_SPIN(xb_ld(&bar[XB_TOPGEN]) == tg, bar);
            __builtin_amdgcn_fence(__ATOMIC_ACQUIRE, "agent");
            xb_add(&bar[XB_XGEN(b.x)], 1u);
            asm volatile("s_waitcnt vmcnt(0)" ::: "memory");
        } else {
            XB_SPIN(xb_ld(&bar[XB_XGEN(b.x)]) == gen, bar);
            __builtin_amdgcn_fence(__ATOMIC_ACQUIRE, "agent");
            asm volatile("s_waitcnt vmcnt(0)" ::: "memory");
        }
    }
    __syncthreads();
}

struct Args { const float* in[27]; float* out; unsigned char* ws; int ph_lo, ph_hi; };
enum { I_X = 0, I_NMG, I_WIN, I_SHIFT, I_W0, I_WDEC, I_A0, I_WICL, I_WGATE, I_KK, I_KA, I_RK, I_LNW, I_LNB, I_KVG, I_WUK, I_WUV,
       I_RELB, I_WBR, I_WBD, I_WOUT, I_NFG, I_WPQ, I_SUBK, I_PU, I_PV, I_NFIN };

constexpr int BM = 256, BK = 64, HALF = 128, HT = HALF * BK;
constexpr int EPI_LDW = 260;
__device__ __forceinline__ int lds_byte(int r, int c) {
    int st = (r >> 4) * 2 + (c >> 5), rr = r & 15, cc = c & 31, ob = rr * 64 + cc * 2;
    return st * 1024 + (ob ^ (((ob >> 9) & 1) << 5));
}
__device__ __forceinline__ void stage_rc(int b, int& R, int& C) {
    int st = b / 1024, sb = b % 1024, swz = sb ^ (((sb >> 9) & 1) << 5);
    R = (st >> 1) * 16 + swz / 64; C = (st & 1) * 32 + (swz % 64) / 2;
}

template <class Epi>
__device__ __forceinline__ void gemm_tile(const bfr* __restrict__ A, const bfr* __restrict__ Bt, const int K, const int brow, const int bcol,
                                          bfr* shm, Epi& epi) {
#define SA(b,h) (shm+((b)*2+(h))*HT)
#define SB(b,h) (shm+(4+(b)*2+(h))*HT)
#define STAGE_X(TT,P,BASE,br,kt) do{long _g=(long)(br)*K+(long)(kt)*BK; \
    for(int _i=0;_i<2;++_i){int _b=(TT)*16+_i*8192;int _r,_c;stage_rc(_b,_r,_c); \
      __builtin_amdgcn_global_load_lds((const unsigned*)(BASE+_g+(long)_r*K+_c), \
        (LAS unsigned*)((LAS char*)(P)+_b),16,0,0);}}while(0)
#define STAGE(P,BASE,br,kt) STAGE_X(tq,P,BASE,br,kt)
#define LDA(dst,b,h) for(int m=0;m<4;++m)for(int k=0;k<2;++k) \
    dst[m][k]=*reinterpret_cast<const bf16x8*>((char*)SA(b,h)+lds_byte(wr*64+m*16+fr,k*32+fq*8))
#define LDB(dst,b,h) for(int n=0;n<2;++n)for(int k=0;k<2;++k) \
    dst[n][k]=*reinterpret_cast<const bf16x8*>((char*)SB(b,h)+lds_byte(wc*32+n*16+fr,k*32+fq*8))
#define MMA(ai,bj,At_,Bt_) do{__builtin_amdgcn_s_setprio(1); \
    for(int m=0;m<4;++m)for(int n=0;n<2;++n)for(int k=0;k<2;++k) \
      acc[ai][bj][m][n]=__builtin_amdgcn_mfma_f32_16x16x32_bf16(At_[m][k],Bt_[n][k],acc[ai][bj][m][n],0,0,0); \
    __builtin_amdgcn_s_setprio(0);}while(0)
#define WAIT_V(n) asm volatile("s_waitcnt vmcnt(" #n ")":::"memory")
#define WAIT_L(n) asm volatile("s_waitcnt lgkmcnt(" #n ")":::"memory")
#define BAR __builtin_amdgcn_s_barrier()
#define SCHED __builtin_amdgcn_sched_barrier(0)
    const int tq = my_tid();
    int wid = tq >> 6, lane = tq & 63, wr = wid >> 2, wc = wid & 3, fr = lane & 15, fq = lane >> 4;
    f32x4 acc[2][2][4][2] = {};
    bf16x8 At[4][2], B0[2][2], B1[2][2];
    const int nt = K / BK;
    STAGE(SB(0,0),Bt,bcol,0); STAGE(SA(0,0),A,brow,0);
    STAGE(SB(0,1),Bt,bcol+HALF,0); STAGE(SA(0,1),A,brow+HALF,0);
    if(wr==1)BAR;
    WAIT_V(4); BAR;
    STAGE(SB(1,0),Bt,bcol,1); STAGE(SA(1,0),A,brow,1); STAGE(SB(1,1),Bt,bcol+HALF,1);
    WAIT_V(6); BAR;
    for(int t=0;t<nt-2;t+=2){
        LDB(B0,0,0); SCHED; LDA(At,0,0); STAGE(SA(1,1),A,brow+HALF,t+1);
        WAIT_L(8); BAR; WAIT_L(0); MMA(0,0,At,B0); BAR; SCHED;
        LDB(B1,0,1); STAGE(SB(0,0),Bt,bcol,t+2);
        BAR; WAIT_L(0); MMA(0,1,At,B1); BAR;
        LDA(At,0,1); STAGE(SA(0,0),A,brow,t+2);
        BAR; WAIT_L(0); MMA(1,0,At,B0); BAR; SCHED;
        STAGE(SB(0,1),Bt,bcol+HALF,t+2);
        WAIT_V(6); BAR; MMA(1,1,At,B1); BAR;
        LDB(B0,1,0); SCHED; LDA(At,1,0); STAGE(SA(0,1),A,brow+HALF,t+2);
        WAIT_L(8); BAR; WAIT_L(0); MMA(0,0,At,B0); BAR; SCHED;
        LDB(B1,1,1); STAGE(SB(1,0),Bt,bcol,t+3);
        BAR; WAIT_L(0); MMA(0,1,At,B1); BAR;
        LDA(At,1,1); STAGE(SA(1,0),A,brow,t+3);
        BAR; WAIT_L(0); MMA(1,0,At,B0); BAR; SCHED;
        STAGE(SB(1,1),Bt,bcol+HALF,t+3);
        WAIT_V(6); BAR; MMA(1,1,At,B1); BAR;
    }
    int tz=threadIdx.x; asm volatile("":"+v"(tz)); wid=tz>>6; lane=tz&63; wr=wid>>2; wc=wid&3; fr=lane&15; fq=lane>>4;
    { LDB(B0,0,0); WAIT_V(0); LDA(At,0,0); STAGE_X(tz,SA(1,1),A,brow+HALF,nt-1);
      BAR; WAIT_L(0); MMA(0,0,At,B0); BAR;
      LDB(B1,0,1); BAR; WAIT_L(0); MMA(0,1,At,B1); BAR;
      LDA(At,0,1); WAIT_V(4); BAR; WAIT_L(0); MMA(1,0,At,B0); MMA(1,1,At,B1); BAR; }
    { LDB(B0,1,0); LDA(At,1,0); WAIT_V(2); BAR; WAIT_L(0); MMA(0,0,At,B0); BAR;
      LDB(B1,1,1); WAIT_V(0); BAR; WAIT_L(0); MMA(0,1,At,B1); BAR;
      LDA(At,1,1); BAR; WAIT_L(0); MMA(1,0,At,B0); MMA(1,1,At,B1); BAR; }
    if(wr==0)BAR;
    {
        float* stg = (float*)shm;
#pragma unroll
        for (int ai = 0; ai < 2; ++ai) {
            __syncthreads();
#pragma unroll
            for (int bj = 0; bj < 2; ++bj)
#pragma unroll
                for (int m = 0; m < 4; ++m)
#pragma unroll
                    for (int n = 0; n < 2; ++n)
#pragma unroll
                        for (int j = 0; j < 4; ++j) stg[(wr * 64 + m * 16 + fq * 4 + j) * EPI_LDW + bj * HALF + wc * 32 + n * 16 + fr] = acc[ai][bj][m][n][j];
            __syncthreads();
#pragma unroll 2
            for (int it = 0; it < 8; ++it) {
                const int r = it * 16 + wid * 2 + (lane >> 5), c = (lane & 31) * 8;
                const float4 v0 = *reinterpret_cast<const float4*>(&stg[r * EPI_LDW + c]);
                const float4 v1 = *reinterpret_cast<const float4*>(&stg[r * EPI_LDW + c + 4]);
                const float v[8] = {v0.x, v0.y, v0.z, v0.w, v1.x, v1.y, v1.z, v1.w};
                epi.vec8(brow + ai * HALF + r, bcol + c, v);
            }
        }
    }
    __syncthreads();
#undef SA
#undef SB
#undef STAGE_X
#undef STAGE
#undef LDA
#undef LDB
#undef MMA
}

__device__ __forceinline__ void tile_rc(int wgid, const int nM, const int nN, int& brow, int& bcol) {
    const int nwg = nM * nN;
    { int q = nwg / 8, r = nwg % 8, xcd = wgid % 8, off = wgid / 8; wgid = (xcd < r ? xcd * (q + 1) : r * (q + 1) + (xcd - r) * q) + off; }
    const int nig = 8 * nN, gid = wgid / nig, fm = gid * 8, gsz = min(nM - fm, 8);
    const int pm = fm + ((wgid % nig) % gsz), pn = (wgid % nig) / gsz;
    brow = pm * BM; bcol = pn * BM;
}

__device__ __forceinline__ uint4 pack8(const float* v) { uint4 o; o.x = pack2(v[0], v[1]); o.y = pack2(v[2], v[3]); o.z = pack2(v[4], v[5]); o.w = pack2(v[6], v[7]); return o; }
__device__ __forceinline__ void unpack8(const uint4 u, float* v) { v[0] = bflo(u.x); v[1] = bfhi(u.x); v[2] = bflo(u.y); v[3] = bfhi(u.y); v[4] = bflo(u.z); v[5] = bfhi(u.z); v[6] = bflo(u.w); v[7] = bfhi(u.w); }
struct EpiP {
    bfr* P;
    __device__ __forceinline__ void vec8(int row, int col, const float* v) { *reinterpret_cast<uint4*>(&P[(size_t)row * NINP + col]) = pack8(v); }
};
struct EpiMix {
    bfr* outp; const bfr* addp; const bfr* gate;
    __device__ __forceinline__ void vec8(int row, int col, const float* v) {
        float g[8], r[8];
        unpack8(*reinterpret_cast<const uint4*>(&gate[(size_t)row * NINP + col]), g);
#pragma unroll
        for (int i = 0; i < 8; ++i) r[i] = sigmoidf_(g[i]) * v[i];
        if (addp) { float t[8]; unpack8(*reinterpret_cast<const uint4*>(&addp[(size_t)row * D + col]), t);
#pragma unroll
            for (int i = 0; i < 8; ++i) r[i] += t[i]; }
        *reinterpret_cast<uint4*>(&outp[(size_t)row * D + col]) = pack8(r);
    }
};
struct EpiH {
    bfr* hb; const float* x; float* part; int slot;
    __device__ __forceinline__ void vec8(int row, int col, const float* v) {
        const float4 x0 = *reinterpret_cast<const float4*>(&x[(size_t)row * D + col]), x1 = *reinterpret_cast<const float4*>(&x[(size_t)row * D + col + 4]);
        float h[8] = {x0.x + v[0], x0.y + v[1], x0.z + v[2], x0.w + v[3], x1.x + v[4], x1.y + v[5], x1.z + v[6], x1.w + v[7]};
        *reinterpret_cast<uint4*>(&hb[(size_t)row * D + col]) = pack8(h);
        float s = 0.f;
#pragma unroll
        for (int i = 0; i < 8; ++i) s += h[i] * h[i];
        s += dpp_f<DPP_XOR1>(s); s += dpp_f<DPP_XOR2>(s); s += dpp_f<0x141>(s); s += dpp_f<0x140>(s);
        s += __shfl_xor(s, 16);
        if ((threadIdx.x & 31) == 0) part[(size_t)row * 8 + slot] = s;
    }
};
struct EpiQ {
    bfr* qp; const float* rs; int brow;
    __device__ __forceinline__ void vec8(int row, int col, const float* v) {
        const float sc = rs[row - brow]; float r[8];
#pragma unroll
        for (int i = 0; i < 8; ++i) r[i] = v[i] * sc;
        *reinterpret_cast<uint4*>(&qp[(size_t)row * D + col]) = pack8(r);
    }
};
__device__ __forceinline__ float row_rstd(const float* part, int row) {
    float s = 0.f;
#pragma unroll
    for (int i = 0; i < 8; ++i) s += part[(size_t)row * 8 + i];
    return rsqrtf(s * (1.f / D) + EPS);
}

__device__ __forceinline__ void tr_tile(const float* __restrict__ src, bfr* __restrict__ dst, int K, int N, int k0, int n0, const float* kscale, float* lds) {
    const int tid = my_tid(), n = tid & 63, kk = tid >> 6;
#pragma unroll
    for (int j = 0; j < 8; ++j) { int k = kk + 8 * j, gn = n0 + n; float v = (gn < N) ? src[(size_t)(k0 + k) * N + gn] : 0.f; if (kscale) v *= kscale[k0 + k]; lds[k * 65 + n] = v; }
    __syncthreads();
    const int nn = tid >> 3, ks = tid & 7;
    uint4 o;
    o.x = pack2(lds[(ks * 8 + 0) * 65 + nn], lds[(ks * 8 + 1) * 65 + nn]); o.y = pack2(lds[(ks * 8 + 2) * 65 + nn], lds[(ks * 8 + 3) * 65 + nn]);
    o.z = pack2(lds[(ks * 8 + 4) * 65 + nn], lds[(ks * 8 + 5) * 65 + nn]); o.w = pack2(lds[(ks * 8 + 6) * 65 + nn], lds[(ks * 8 + 7) * 65 + nn]);
    *reinterpret_cast<uint4*>(&dst[(size_t)(n0 + nn) * K + k0 + ks * 8]) = o;
    __syncthreads();
}
struct StripRegs { float v[8][4]; };
__device__ __forceinline__ void strip_load(const float* __restrict__ src, int N, int k0, int n0, StripRegs& R) {
    const int tid = my_tid(), n = tid & 63, kk = tid >> 6;
#pragma unroll
    for (int j = 0; j < 8; ++j)
#pragma unroll
        for (int q = 0; q < 4; ++q) { const int gn = n0 + q * 64 + n; R.v[j][q] = (gn < N) ? src[(size_t)(k0 + kk + 8 * j) * N + gn] : 0.f; }
}
__device__ __forceinline__ void strip_store(const StripRegs& R, bfr* __restrict__ dst, int K, int k0, int n0, const float* kscale, float* lds) {
    const int tid = my_tid(), n = tid & 63, kk = tid >> 6;
#pragma unroll
    for (int j = 0; j < 8; ++j) {
        const float sc = kscale ? kscale[k0 + kk + 8 * j] : 1.f;
#pragma unroll
        for (int q = 0; q < 4; ++q) lds[(kk + 8 * j) * 257 + q * 64 + n] = R.v[j][q] * sc;
    }
    __syncthreads();
    const int nn = tid >> 1, hf = tid & 1;
#pragma unroll
    for (int c = 0; c < 4; ++c) {
        const int kb = hf * 32 + c * 8;
        uint4 o;
        o.x = pack2(lds[(kb + 0) * 257 + nn], lds[(kb + 1) * 257 + nn]); o.y = pack2(lds[(kb + 2) * 257 + nn], lds[(kb + 3) * 257 + nn]);
        o.z = pack2(lds[(kb + 4) * 257 + nn], lds[(kb + 5) * 257 + nn]); o.w = pack2(lds[(kb + 6) * 257 + nn], lds[(kb + 7) * 257 + nn]);
        *reinterpret_cast<uint4*>(&dst[(size_t)(n0 + nn) * K + k0 + kb]) = o;
    }
    __syncthreads();
}
__device__ __forceinline__ void tr_all(const float* src, bfr* dst, int K, int N, int Npad, const float* kscale, float* lds) {
    if ((Npad & 255) == 0) {
        const int nk = K / 64, ns = Npad / 256, tot = nk * ns;
        StripRegs RA, RB;
        int it = blockIdx.x;
        if (it < tot) strip_load(src, N, (it % nk) * 64, (it / nk) * 256, RA);
        while (it < tot) {
            const int itn = it + gridDim.x, it2 = itn + gridDim.x;
            if (itn < tot) strip_load(src, N, (itn % nk) * 64, (itn / nk) * 256, RB);
            strip_store(RA, dst, K, (it % nk) * 64, (it / nk) * 256, kscale, lds);
            if (itn >= tot) break;
            if (it2 < tot) strip_load(src, N, (it2 % nk) * 64, (it2 / nk) * 256, RA);
            strip_store(RB, dst, K, (itn % nk) * 64, (itn / nk) * 256, kscale, lds);
            it = it2;
        }
        return;
    }
    const int nk = K / 64, nn = Npad / 64;
    for (int it = blockIdx.x; it < nk * nn; it += gridDim.x) tr_tile(src, dst, K, N, (it % nk) * 64, (it / nk) * 64, kscale, lds);
}
__device__ __forceinline__ void cvt_all(const float* __restrict__ src, bfr* __restrict__ dst, size_t n) {
    const size_t n4 = n / 4;
    for (size_t i = (size_t)blockIdx.x * 512 + my_tid(); i < n4; i += (size_t)gridDim.x * 512) {
        float4 v = reinterpret_cast<const float4*>(src)[i];
        uint2 o; o.x = pack2(v.x, v.y); o.y = pack2(v.z, v.w);
        reinterpret_cast<uint2*>(dst)[i] = o;
    }
}

constexpr int PEER_ROWB = 1152;
__device__ __forceinline__ void cvt_fp4_rows(const float* __restrict__ src, unsigned char* __restrict__ dst, const int wrank, const int nwaves) {
    const int tid = my_tid(), lane = tid & 63;
    for (int row = wrank; row < 16384; row += nwaves) {
        float v[32]; float amax = 0.f;
#pragma unroll
        for (int q = 0; q < 8; ++q) {
            const float4 x = *reinterpret_cast<const float4*>(&src[(size_t)row * D + q * 256 + lane * 4]);
            v[q * 4] = x.x; v[q * 4 + 1] = x.y; v[q * 4 + 2] = x.z; v[q * 4 + 3] = x.w;
            amax = fmaxf(amax, fmaxf(fmaxf(fabsf(x.x), fabsf(x.y)), fmaxf(fabsf(x.z), fabsf(x.w))));
        }
        const bfr sb = f2bf(amax * (1.f / 6.f));
        const float sc = bf2f(sb), inv = sc > 0.f ? frcp_(sc) : 0.f;
        unsigned dw[4];
#pragma unroll
        for (int d = 0; d < 4; ++d) {
            unsigned p = 0;
            p = __builtin_amdgcn_cvt_scalef32_pk_fp4_f32(p, v[d * 8 + 0] * inv, v[d * 8 + 1] * inv, 1.0f, 0);
            p = __builtin_amdgcn_cvt_scalef32_pk_fp4_f32(p, v[d * 8 + 2] * inv, v[d * 8 + 3] * inv, 1.0f, 1);
            p = __builtin_amdgcn_cvt_scalef32_pk_fp4_f32(p, v[d * 8 + 4] * inv, v[d * 8 + 5] * inv, 1.0f, 2);
            p = __builtin_amdgcn_cvt_scalef32_pk_fp4_f32(p, v[d * 8 + 6] * inv, v[d * 8 + 7] * inv, 1.0f, 3);
            dw[d] = p;
        }
        uint4 o4; o4.x = dw[0]; o4.y = dw[1]; o4.z = dw[2]; o4.w = dw[3];
        *reinterpret_cast<uint4*>(dst + (size_t)row * PEER_ROWB + lane * 16) = o4;
        *reinterpret_cast<bfr*>(dst + (size_t)row * PEER_ROWB + 1024 + lane * 2) = sb;
    }
}

__device__ __forceinline__ unsigned pack8_i4(const float* v) {
    unsigned d = 0;
#pragma unroll
    for (int i = 0; i < 8; ++i) d |= ((unsigned)((int)v[i]) & 0xFu) << (4 * i);
    return d;
}
__device__ __forceinline__ void cvt_i4_rows(const float* __restrict__ src, unsigned char* __restrict__ dst, const int rank, const int nranks) {
    const int tid = my_tid(), lane = tid & 63, wv = tid >> 6;
    for (int row = rank * 8 + wv; row < 16384; row += nranks * 8) {
        float v[32]; float amax = 0.f;
#pragma unroll
        for (int q = 0; q < 8; ++q) {
            const float4 x = *reinterpret_cast<const float4*>(&src[(size_t)row * D + q * 256 + lane * 4]);
            v[q * 4] = x.x; v[q * 4 + 1] = x.y; v[q * 4 + 2] = x.z; v[q * 4 + 3] = x.w;
            amax = fmaxf(amax, fmaxf(fmaxf(fabsf(x.x), fabsf(x.y)), fmaxf(fabsf(x.z), fabsf(x.w))));
        }
        const bfr sb = f2bf(amax * (1.f / 7.f));
        const float sc = bf2f(sb), inv = sc > 0.f ? frcp_(sc) : 0.f;
#pragma unroll
        for (int i = 0; i < 32; ++i) v[i] = fminf(fmaxf(__builtin_rintf(v[i] * inv), -7.f), 7.f);
        uint4 o4; o4.x = pack8_i4(v); o4.y = pack8_i4(v + 8); o4.z = pack8_i4(v + 16); o4.w = pack8_i4(v + 24);
        *reinterpret_cast<uint4*>(dst + (size_t)row * PEER_ROWB + lane * 16) = o4;
        *reinterpret_cast<bfr*>(dst + (size_t)row * PEER_ROWB + 1024 + lane * 2) = sb;
    }
}
__device__ __forceinline__ int pm_index(int kp, int k) {
    const int kpt = kp >> 5, r = kp & 31, kt = k >> 5, kk = k & 31, s = kk >> 4, rem = kk & 15;
    const int j = ((rem >> 3) << 2) | (rem & 3), hf = (rem >> 2) & 1, lane = hf * 32 + r;
    return ((((kpt * 2 + kt) * 2 + s) * 64 + lane) * 8) + j;
}
__device__ __forceinline__ int acc_index(int row, int col) {
    const int rt = row >> 5, r = row & 31, ct = col >> 5, c = col & 31;
    const int g4 = r >> 3, comp = r & 3, hf = (r >> 2) & 1, lane = hf * 32 + c;
    return ((((rt * 2 + ct) * 4 + g4) * 64 + lane) * 4) + comp;
}

constexpr int RW_ACT_STRIDE = 296, RW_LD = 72, RW_SLOT = 9216, RW_WL_OFF = 110592, RW_TOT_OFF = 148480, RW_BASE_OFF = 152576, RW_PART_OFF = 156928;
__device__ __forceinline__ f32x16 tile_mm_acc(f32x16 acc, const bfr* A, const int arow0, const bfr* Bt, const int brow0, const int r, const int hf) {
#pragma unroll
    for (int ks = 0; ks < 4; ++ks)
        acc = __builtin_amdgcn_mfma_f32_32x32x16_bf16(*reinterpret_cast<const bf16x8*>(&A[(arow0 + r) * RW_LD + ks * 16 + hf * 8]),
                                                     *reinterpret_cast<const bf16x8*>(&Bt[(brow0 + r) * RW_LD + ks * 16 + hf * 8]), acc, 0, 0, 0);
    return acc;
}
__device__ __forceinline__ f32x16 tile_mm(const bfr* A, const int arow0, const bfr* Bt, const int brow0, const int r, const int hf) {
    f32x16 z;
#pragma unroll
    for (int g = 0; g < 16; ++g) z[g] = 0.f;
    return tile_mm_acc(z, A, arow0, Bt, brow0, r, hf);
}
__device__ __forceinline__ void store_t(bfr* dst, const int col0, const int row0, const f32x16 acc, const int r, const int hf) {
#pragma unroll
    for (int g4 = 0; g4 < 4; ++g4) { uint2 p; p.x = pack2(acc[g4 * 4], acc[g4 * 4 + 1]); p.y = pack2(acc[g4 * 4 + 2], acc[g4 * 4 + 3]);
        *reinterpret_cast<uint2*>(&dst[(col0 + r) * RW_LD + row0 + g4 * 8 + hf * 4]) = p; }
}
#define DPP_HMIRROR 0x141
#define DPP_MIRROR  0x140

__device__ __forceinline__ void rwkv_load_weights(const Args& a, const int h, unsigned char* lds) {
    bfr* WL = (bfr*)(lds + RW_WL_OFF);
    const int tid = my_tid();
    for (int idx = tid; idx < 288 * 64; idx += 512) {
        const int m = idx >> 6, d = idx & 63;
        const float v = (m < 64) ? a.in[I_WDEC][(size_t)m * RW + h * 64 + d] : (m < 128) ? a.in[I_WICL][(size_t)(m - 64) * RW + h * 64 + d] : a.in[I_WGATE][(size_t)(m - 128) * RW + h * 64 + d];
        WL[d * RW_ACT_STRIDE + m] = f2bf(v);
    }
    __syncthreads();
}

struct RwIn { unsigned cu[18], pu[18]; bfr r[2][5], k[2][5], v[2][5]; };
__device__ __forceinline__ void rwkv_fetch(const Args& a, const int c, const int h, RwIn& in) {
    const bfr* __restrict__ P = (const bfr*)(a.ws + WS_P);
    const int tid = my_tid(), lane = tid & 63, wv = tid >> 6, fr = lane & 15, fq = lane >> 4, t0 = c * 64;
    {
        const int i = tid >> 3, part = tid & 7, t = t0 + i;
        const bfr* pc = P + (size_t)t * NINP + C_ZW + part * 36;
        const bfr* pp = pc - NINP;
#pragma unroll
        for (int q = 0; q < 18; ++q) { in.cu[q] = *reinterpret_cast<const unsigned*>(pc + q * 2); in.pu[q] = (t > 0) ? *reinterpret_cast<const unsigned*>(pp + q * 2) : 0u; }
    }
    const int tt = wv >> 1, dh = wv & 1;
#pragma unroll
    for (int dt = 0; dt < 2; ++dt) {
        const int hd = h * 64 + dh * 32 + dt * 16 + fr;
        const int tp = t0 + tt * 16 + fq * 4 - 1;
        const bool hp = tp >= 0;
        in.r[dt][0] = hp ? P[(size_t)(hp ? tp : 0) * NINP + C_R + hd] : (bfr)0; in.k[dt][0] = hp ? P[(size_t)(hp ? tp : 0) * NINP + C_K + hd] : (bfr)0; in.v[dt][0] = hp ? P[(size_t)(hp ? tp : 0) * NINP + C_V + hd] : (bfr)0;
#pragma unroll
        for (int j = 0; j < 4; ++j) { const size_t ro = (size_t)(tp + 1 + j) * NINP; in.r[dt][j + 1] = P[ro + C_R + hd]; in.k[dt][j + 1] = P[ro + C_K + hd]; in.v[dt][j + 1] = P[ro + C_V + hd]; }
    }
}

__device__ __forceinline__ void rwkv_unit(const Args& a, const int c, const int h, unsigned char* lds, const RwIn& in, RwIn& nxt, const int cnext) {
    const float* __restrict__ smix = a.in[I_SHIFT];
    const int tid = my_tid(), lane = tid & 63, wv = tid >> 6, fr = lane & 15, fq = lane >> 4, t0 = c * 64, u = c * 16 + h;
#define SLOT(k) ((bfr*)(lds + (k) * RW_SLOT))
    bfr* ACT = (bfr*)lds; const bfr* WL = (const bfr*)(lds + RW_WL_OFF);
    float* TOT = (float*)(lds + RW_TOT_OFF); float* BASE = (float*)(lds + RW_BASE_OFF); float* PART = (float*)(lds + RW_PART_OFF);
    {
        const int i = tid >> 3, part = tid & 7;
#pragma unroll
        for (int q = 0; q < 18; ++q) {
            const int cc = part * 36 + q * 2;
            const unsigned cu = in.cu[q], pu = in.pu[q];
            const float2 mx = *reinterpret_cast<const float2*>(&smix[C_ZW + cc]);
            const float c0 = bflo(cu), c1 = bfhi(cu);
            float z0 = c0 + (bflo(pu) - c0) * mx.x, z1 = c1 + (bfhi(pu) - c1) * mx.y;
            if (cc < 64) { z0 = 1.f - 2.f * frcp_(1.f + __expf(2.f * z0)); z1 = 1.f - 2.f * frcp_(1.f + __expf(2.f * z1)); }
            else if (cc >= 128) { z0 = sigmoidf_(z0); z1 = sigmoidf_(z1); }
            *reinterpret_cast<unsigned*>(&ACT[i * RW_ACT_STRIDE + cc]) = pack2(z0, z1);
        }
    }
    const int tt = wv >> 1, dh = wv & 1;
    float zr[2][4], zk[2][4], zv[2][4];
#pragma unroll
    for (int dt = 0; dt < 2; ++dt) {
        const int hd = h * 64 + dh * 32 + dt * 16 + fr;
        const float mr = smix[C_R + hd], mk = smix[C_K + hd], mv = smix[C_V + hd];
        float pr = bf2f(in.r[dt][0]), pk = bf2f(in.k[dt][0]), pv = bf2f(in.v[dt][0]);
#pragma unroll
        for (int j = 0; j < 4; ++j) {
            const float cr = bf2f(in.r[dt][j + 1]), ck = bf2f(in.k[dt][j + 1]), cv = bf2f(in.v[dt][j + 1]);
            zr[dt][j] = cr + (pr - cr) * mr; zk[dt][j] = ck + (pk - ck) * mk; zv[dt][j] = cv + (pv - cv) * mv;
            pr = cr; pk = ck; pv = cv;
        }
    }
    __syncthreads();
    f32x4 xw[2], xa[2], xg[2];
#pragma unroll
    for (int dt = 0; dt < 2; ++dt) {
        xw[dt] = f32x4{0.f, 0.f, 0.f, 0.f}; xa[dt] = xw[dt]; xg[dt] = xw[dt];
        const bfr* arow = ACT + (tt * 16 + fr) * RW_ACT_STRIDE + fq * 8;
        const bfr* brow = WL + (dh * 32 + dt * 16 + fr) * RW_ACT_STRIDE + fq * 8;
#pragma unroll
        for (int ks = 0; ks < 2; ++ks) {
            xw[dt] = __builtin_amdgcn_mfma_f32_16x16x32_bf16(*reinterpret_cast<const bf16x8*>(arow + ks * 32), *reinterpret_cast<const bf16x8*>(brow + ks * 32), xw[dt], 0, 0, 0);
            xa[dt] = __builtin_amdgcn_mfma_f32_16x16x32_bf16(*reinterpret_cast<const bf16x8*>(arow + 64 + ks * 32), *reinterpret_cast<const bf16x8*>(brow + 64 + ks * 32), xa[dt], 0, 0, 0);
        }
#pragma unroll
        for (int ks = 0; ks < 5; ++ks)
            xg[dt] = __builtin_amdgcn_mfma_f32_16x16x32_bf16(*reinterpret_cast<const bf16x8*>(arow + 128 + ks * 32), *reinterpret_cast<const bf16x8*>(brow + 128 + ks * 32), xg[dt], 0, 0, 0);
    }
    float lw[2][4], av[2][4], kkr[2][4], k4[2][4], n2[4], cf[4];
#pragma unroll
    for (int j = 0; j < 4; ++j) { n2[j] = 0.f; cf[j] = 0.f; }
#pragma unroll
    for (int dt = 0; dt < 2; ++dt) {
        const int hd = h * 64 + dh * 32 + dt * 16 + fr;
        const float w0 = a.in[I_W0][hd], a0 = a.in[I_A0][hd], kkm = a.in[I_KK][hd], kam = a.in[I_KA][hd], rkm = a.in[I_RK][hd];
        float run = 0.f;
#pragma unroll
        for (int j = 0; j < 4; ++j) {
            run += -0.6065306597126334f * sigmoidf_(w0 + xw[dt][j]);
            lw[dt][j] = run;
            av[dt][j] = sigmoidf_(a0 + xa[dt][j]);
            kkr[dt][j] = zk[dt][j] * kkm;
            k4[dt][j] = zk[dt][j] * (1.f + (av[dt][j] - 1.f) * kam);
            n2[j] += kkr[dt][j] * kkr[dt][j];
            cf[j] += zr[dt][j] * k4[dt][j] * rkm;
        }
        TOT[(tt * 4 + fq) * 64 + dh * 32 + dt * 16 + fr] = run;
    }
#pragma unroll
    for (int j = 0; j < 4; ++j) {
        n2[j] += dpp_f<DPP_XOR1>(n2[j]); n2[j] += dpp_f<DPP_XOR2>(n2[j]); n2[j] += dpp_f<DPP_HMIRROR>(n2[j]); n2[j] += dpp_f<DPP_MIRROR>(n2[j]);
        cf[j] += dpp_f<DPP_XOR1>(cf[j]); cf[j] += dpp_f<DPP_XOR2>(cf[j]); cf[j] += dpp_f<DPP_HMIRROR>(cf[j]); cf[j] += dpp_f<DPP_MIRROR>(cf[j]);
        if (fr == 0) { PART[(wv * 16 + fq * 4 + j) * 2] = n2[j]; PART[(wv * 16 + fq * 4 + j) * 2 + 1] = cf[j]; }
    }
    __syncthreads();
    if (tid < 64) {
        float run = 0.f;
#pragma unroll
        for (int g = 0; g < 16; ++g) { const float tv = TOT[g * 64 + tid]; BASE[g * 64 + tid] = run; run += tv; }
        BASE[16 * 64 + tid] = run;
    }
    __syncthreads();
    {
        bfr* Gg = (bfr*)(a.ws + WS_GG); bfr* Bon = (bfr*)(a.ws + WS_BON);
        const int i0 = tt * 16 + fq * 4;
        float rn[4], cft[4];
#pragma unroll
        for (int j = 0; j < 4; ++j) {
            const float n2t = n2[j] + PART[((wv ^ 1) * 16 + fq * 4 + j) * 2]; cft[j] = cf[j] + PART[((wv ^ 1) * 16 + fq * 4 + j) * 2 + 1];
            rn[j] = __builtin_amdgcn_rsqf(fmaxf(n2t, 1e-24f));
        }
#pragma unroll
        for (int dt = 0; dt < 2; ++dt) {
            const int d = dh * 32 + dt * 16 + fr;
            const float base = BASE[(tt * 4 + fq) * 64 + d], clT = BASE[16 * 64 + d];
            float vAt[4], vBh[4], vKh[4];
#pragma unroll
            for (int j = 0; j < 4; ++j) {
                const float cl = base + lw[dt][j], clm1 = (j == 0) ? base : base + lw[dt][j - 1];
                const float gi = __expf(cl), gm1 = __expf(clm1), ig = __expf(-cl), gce = __expf(clT - cl);
                const float kk = kkr[dt][j] * rn[j], beta = kk * av[dt][j];
                vAt[j] = -kk * gm1; vBh[j] = beta * gce; vKh[j] = k4[dt][j] * gce;
                SLOT(0)[(i0 + j) * RW_LD + d] = f2bf(vAt[j]);
                SLOT(1)[(i0 + j) * RW_LD + d] = f2bf(beta * ig);
                SLOT(2)[(i0 + j) * RW_LD + d] = f2bf(k4[dt][j] * ig);
                SLOT(3)[(i0 + j) * RW_LD + d] = f2bf(zr[dt][j] * gi);
                const size_t o = (size_t)(t0 + i0 + j) * RW + h * 64 + d;
                Gg[o] = f2bf(xg[dt][j]); Bon[o] = f2bf(cft[j] * zv[dt][j]);
            }
            uint2 p;
            p.x = pack2(vAt[0], vAt[1]); p.y = pack2(vAt[2], vAt[3]); *reinterpret_cast<uint2*>(&SLOT(4)[d * RW_LD + i0]) = p;
            p.x = pack2(vBh[0], vBh[1]); p.y = pack2(vBh[2], vBh[3]); *reinterpret_cast<uint2*>(&SLOT(5)[d * RW_LD + i0]) = p;
            p.x = pack2(vKh[0], vKh[1]); p.y = pack2(vKh[2], vKh[3]); *reinterpret_cast<uint2*>(&SLOT(6)[d * RW_LD + i0]) = p;
            p.x = pack2(zv[dt][0], zv[dt][1]); p.y = pack2(zv[dt][2], zv[dt][3]); *reinterpret_cast<uint2*>(&SLOT(7)[d * RW_LD + i0]) = p;
        }
    }
    __syncthreads();
    if (cnext >= 0) rwkv_fetch(a, cnext, h, nxt);
    const int r = lane & 31, hf = lane >> 5;
    {
        const int prod = wv >> 1, sub = wv & 1;
        const bfr* Aop = (prod & 1) ? SLOT(2) : SLOT(1);
        const bfr* Bop = (prod >= 2) ? SLOT(3) : SLOT(0);
        bfr* Ld = SLOT(8 + prod);
        const bool incl = prod >= 2;
        for (int job = 0; job < (sub ? 2 : 1); ++job) {
            const int jt = sub ? job : 0, it = sub ? 1 : 0;
            f32x16 acc = tile_mm(Aop, jt * 32, Bop, it * 32, r, hf);
#pragma unroll
            for (int g4 = 0; g4 < 4; ++g4) {
                const int i = it * 32 + r, j0 = jt * 32 + g4 * 8 + hf * 4;
                float v[4];
#pragma unroll
                for (int q = 0; q < 4; ++q) { const int j = j0 + q; v[q] = (incl ? (j <= i) : (j < i)) ? acc[g4 * 4 + q] : 0.f; }
                uint2 p; p.x = pack2(v[0], v[1]); p.y = pack2(v[2], v[3]);
                *reinterpret_cast<uint2*>(&Ld[i * RW_LD + j0]) = p;
            }
        }
        if (!sub) {
#pragma unroll
            for (int g4 = 0; g4 < 4; ++g4) *reinterpret_cast<uint2*>(&Ld[r * RW_LD + 32 + g4 * 8 + hf * 4]) = make_uint2(0u, 0u);
        }
    }
    __syncthreads();
    if (wv == 0) {
        bfr* Tl = SLOT(0); bfr* TlT = SLOT(1); const bfr* Lab = SLOT(8);
        for (int q = 0; q < 9; ++q) { *reinterpret_cast<uint4*>((unsigned char*)Tl + (q * 64 + lane) * 16) = make_uint4(0u, 0u, 0u, 0u); *reinterpret_cast<uint4*>((unsigned char*)TlT + (q * 64 + lane) * 16) = make_uint4(0u, 0u, 0u, 0u); }
        {
            const int bq = lane >> 4, cc = lane & 15;
            float x[16];
#pragma unroll
            for (int rr = 0; rr < 16; ++rr) {
                float lrow[16];
                unpack8(*reinterpret_cast<const uint4*>(&Lab[(bq * 16 + rr) * RW_LD + bq * 16]), lrow);
                unpack8(*reinterpret_cast<const uint4*>(&Lab[(bq * 16 + rr) * RW_LD + bq * 16 + 8]), lrow + 8);
                float sacc = (rr == cc) ? 1.f : 0.f;
#pragma unroll
                for (int m = 0; m < rr; ++m) sacc += lrow[m] * x[m];
                x[rr] = sacc;
            }
#pragma unroll
            for (int rr = 0; rr < 16; ++rr) Tl[(bq * 16 + rr) * RW_LD + bq * 16 + cc] = f2bf(x[rr]);
            *reinterpret_cast<uint4*>(&TlT[(bq * 16 + cc) * RW_LD + bq * 16]) = pack8(x);
            *reinterpret_cast<uint4*>(&TlT[(bq * 16 + cc) * RW_LD + bq * 16 + 8]) = pack8(x + 8);
        }
        asm volatile("s_waitcnt lgkmcnt(0)" ::: "memory");
#pragma unroll
        for (int bi = 1; bi < 4; ++bi) {
#pragma unroll
            for (int bj = 0; bj < bi; ++bj) {
                f32x4 acc = {0.f, 0.f, 0.f, 0.f};
#pragma unroll
                for (int bm = bj; bm < bi; ++bm) {
                    const bf16x4 Af = *reinterpret_cast<const bf16x4*>(&Lab[(bi * 16 + fr) * RW_LD + bm * 16 + fq * 4]);
                    const bf16x4 Bf = *reinterpret_cast<const bf16x4*>(&TlT[(bj * 16 + fr) * RW_LD + bm * 16 + fq * 4]);
                    acc = __builtin_amdgcn_mfma_f32_16x16x16bf16_1k(Af, Bf, acc, 0, 0, 0);
                }
                bf16x4 Bacc; Bacc[0] = (short)f2bf(acc[0]); Bacc[1] = (short)f2bf(acc[1]); Bacc[2] = (short)f2bf(acc[2]); Bacc[3] = (short)f2bf(acc[3]);
                const bf16x4 Ad = *reinterpret_cast<const bf16x4*>(&Tl[(bi * 16 + fr) * RW_LD + bi * 16 + fq * 4]);
                const f32x4 tb = __builtin_amdgcn_mfma_f32_16x16x16bf16_1k(Ad, Bacc, f32x4{0.f, 0.f, 0.f, 0.f}, 0, 0, 0);
#pragma unroll
                for (int q = 0; q < 4; ++q) Tl[(bi * 16 + fq * 4 + q) * RW_LD + bj * 16 + fr] = f2bf(tb[q]);
                uint2 p; p.x = pack2(tb[0], tb[1]); p.y = pack2(tb[2], tb[3]);
                *reinterpret_cast<uint2*>(&TlT[(bj * 16 + fr) * RW_LD + bi * 16 + fq * 4]) = p;
            }
            asm volatile("s_waitcnt lgkmcnt(0)" ::: "memory");
        }
    } else if (wv >= 4) {
        const int it = (wv >> 1) & 1, vt = wv & 1;
        const f32x16 acc = tile_mm(SLOT(9), it * 32, SLOT(7), vt * 32, r, hf);
        store_t(SLOT(2), vt * 32, it * 32, acc, r, hf);
    }
    __syncthreads();
    {
        const int which = wv >> 2, it = (wv >> 1) & 1, ct = wv & 1;
        const f32x16 acc = tile_mm(SLOT(0), it * 32, which ? SLOT(2) : SLOT(4), ct * 32, r, hf);
        store_t(which ? SLOT(9) : SLOT(8), ct * 32, it * 32, acc, r, hf);
    }
    __syncthreads();
    if (wv < 4) {
        {
            const int dtl = wv >> 1, itl = wv & 1;
            f32x16 acc = tile_mm(SLOT(8), dtl * 32, SLOT(10), itl * 32, r, hf);
            bfr* WY = (bfr*)(a.ws + WS_WY) + (size_t)u * 4096;
            const int i = itl * 32 + r;
#pragma unroll
            for (int g4 = 0; g4 < 4; ++g4) {
                const int d0 = dtl * 32 + g4 * 8 + hf * 4;
                const uint2 rr2 = *reinterpret_cast<const uint2*>(&SLOT(3)[i * RW_LD + d0]);
                uint2 p; p.x = pack2(acc[g4 * 4] + bflo(rr2.x), acc[g4 * 4 + 1] + bfhi(rr2.x)); p.y = pack2(acc[g4 * 4 + 2] + bflo(rr2.y), acc[g4 * 4 + 3] + bfhi(rr2.y));
                *reinterpret_cast<uint2*>(&WY[i * 64 + d0]) = p;
            }
        }
        {
            const int it = wv >> 1, vt = wv & 1;
            f32x16 acc = tile_mm(SLOT(10), it * 32, SLOT(9), vt * 32, r, hf);
            acc = tile_mm_acc(acc, SLOT(11), it * 32, SLOT(7), vt * 32, r, hf);
            bfr* YL = (bfr*)(a.ws + WS_YLOC) + (size_t)u * 4096;
#pragma unroll
            for (int g4 = 0; g4 < 4; ++g4) { uint2 p; p.x = pack2(acc[g4 * 4], acc[g4 * 4 + 1]); p.y = pack2(acc[g4 * 4 + 2], acc[g4 * 4 + 3]);
                *reinterpret_cast<uint2*>(&YL[(((it * 2 + vt) * 4 + g4) * 64 + lane) * 4]) = p; }
        }
    } else {
        {
            const int kt = (wv >> 1) & 1, kpt = wv & 1;
            f32x16 acc = tile_mm(SLOT(8), kt * 32, SLOT(5), kpt * 32, r, hf);
            if (kt == kpt) {
                const float gc = __expf(BASE[16 * 64 + kt * 32 + r]);
#pragma unroll
                for (int g = 0; g < 16; ++g) if (((g & 3) + 8 * (g >> 2) + 4 * hf) == r) acc[g] += gc;
            }
            bfr* PM = (bfr*)(a.ws + WS_PM) + (size_t)u * 4096;
#pragma unroll
            for (int sgrp = 0; sgrp < 2; ++sgrp) {
                float v8[8];
#pragma unroll
                for (int q = 0; q < 8; ++q) v8[q] = acc[sgrp * 8 + q];
                *reinterpret_cast<uint4*>(&PM[(((kpt * 2 + kt) * 2 + sgrp) * 64 + lane) * 8]) = pack8(v8);
            }
        }
        {
            const int kpt = (wv >> 1) & 1, vt = wv & 1;
            f32x16 acc = tile_mm(SLOT(5), kpt * 32, SLOT(9), vt * 32, r, hf);
            acc = tile_mm_acc(acc, SLOT(6), kpt * 32, SLOT(7), vt * 32, r, hf);
            bfr* GM = (bfr*)(a.ws + WS_GM) + (size_t)u * 4096;
#pragma unroll
            for (int g4 = 0; g4 < 4; ++g4) { uint2 p; p.x = pack2(acc[g4 * 4], acc[g4 * 4 + 1]); p.y = pack2(acc[g4 * 4 + 2], acc[g4 * 4 + 3]);
                *reinterpret_cast<uint2*>(&GM[(((kpt * 2 + vt) * 4 + g4) * 64 + lane) * 4]) = p; }
        }
    }
    __syncthreads();
#undef SLOT
}

__device__ __forceinline__ void rwkv_chain(const Args& a, const int h, const int vh) {
    const int lane = my_tid() & 63, r = lane & 31, hf = lane >> 5;
    const bfr* PMb = (const bfr*)(a.ws + WS_PM); const bfr* GMb = (const bfr*)(a.ws + WS_GM); bfr* ZTb = (bfr*)(a.ws + WS_ZT);
    f32x16 Z[2];
#pragma unroll
    for (int g = 0; g < 16; ++g) { Z[0][g] = 0.f; Z[1][g] = 0.f; }
    bf16x8 Acur[8], Anxt[8]; uint2 Ccur[8], Cnxt[8];
    {
        const bfr* pm = PMb + (size_t)h * 4096; const bfr* gm = GMb + (size_t)h * 4096;
#pragma unroll
        for (int f = 0; f < 8; ++f) Acur[f] = *reinterpret_cast<const bf16x8*>(&pm[(f * 64 + lane) * 8]);
#pragma unroll
        for (int kpt = 0; kpt < 2; ++kpt)
#pragma unroll
            for (int g4 = 0; g4 < 4; ++g4) Ccur[kpt * 4 + g4] = *reinterpret_cast<const uint2*>(&gm[(((kpt * 2 + vh) * 4 + g4) * 64 + lane) * 4]);
    }
    for (int c = 0; c < 128; ++c) {
        const int u = c * 16 + h;
        if (c + 1 < 128) {
            const bfr* pm = PMb + (size_t)(u + 16) * 4096; const bfr* gm = GMb + (size_t)(u + 16) * 4096;
#pragma unroll
            for (int f = 0; f < 8; ++f) Anxt[f] = *reinterpret_cast<const bf16x8*>(&pm[(f * 64 + lane) * 8]);
#pragma unroll
            for (int kpt = 0; kpt < 2; ++kpt)
#pragma unroll
                for (int g4 = 0; g4 < 4; ++g4) Cnxt[kpt * 4 + g4] = *reinterpret_cast<const uint2*>(&gm[(((kpt * 2 + vh) * 4 + g4) * 64 + lane) * 4]);
        }
        bfr* zt = ZTb + (size_t)u * 4096 + (size_t)(vh * 32 + r) * 64;
        bf16x8 Bf[2][2];
#pragma unroll
        for (int kt = 0; kt < 2; ++kt) {
#pragma unroll
            for (int g4 = 0; g4 < 4; ++g4) {
                uint2 o; o.x = pack2(Z[kt][g4 * 4], Z[kt][g4 * 4 + 1]); o.y = pack2(Z[kt][g4 * 4 + 2], Z[kt][g4 * 4 + 3]);
                *reinterpret_cast<uint2*>(&zt[kt * 32 + g4 * 8 + hf * 4]) = o;
                const int s = g4 >> 1, e = (g4 & 1) * 4;
                Bf[kt][s][e] = (short)(o.x & 0xFFFF); Bf[kt][s][e + 1] = (short)(o.x >> 16); Bf[kt][s][e + 2] = (short)(o.y & 0xFFFF); Bf[kt][s][e + 3] = (short)(o.y >> 16);
            }
        }
        f32x16 Zn[2];
#pragma unroll
        for (int kpt = 0; kpt < 2; ++kpt)
#pragma unroll
            for (int g4 = 0; g4 < 4; ++g4) {
                const uint2 cc = Ccur[kpt * 4 + g4];
                Zn[kpt][g4 * 4] = bflo(cc.x); Zn[kpt][g4 * 4 + 1] = bfhi(cc.x); Zn[kpt][g4 * 4 + 2] = bflo(cc.y); Zn[kpt][g4 * 4 + 3] = bfhi(cc.y);
            }
#pragma unroll
        for (int kpt = 0; kpt < 2; ++kpt)
#pragma unroll
            for (int kt = 0; kt < 2; ++kt)
#pragma unroll
                for (int s = 0; s < 2; ++s)
                    Zn[kpt] = __builtin_amdgcn_mfma_f32_32x32x16_bf16(Acur[(kpt * 2 + kt) * 2 + s], Bf[kt][s], Zn[kpt], 0, 0, 0);
        Z[0] = Zn[0]; Z[1] = Zn[1];
#pragma unroll
        for (int f = 0; f < 8; ++f) { Acur[f] = Anxt[f]; Ccur[f] = Cnxt[f]; }
    }
}

__device__ __forceinline__ void rwkv_out_unit(const Args& a, const int u, float* Ls) {
    const int lane = my_tid() & 63, r = lane & 31, hf = lane >> 5, c = u >> 4, h = u & 15, t0 = c * 64;
    const bfr* WY = (const bfr*)(a.ws + WS_WY) + (size_t)u * 4096; const bfr* YL = (const bfr*)(a.ws + WS_YLOC) + (size_t)u * 4096;
    const bfr* ZT = (const bfr*)(a.ws + WS_ZT) + (size_t)u * 4096;
    f32x16 acc[2][2];
#pragma unroll
    for (int it = 0; it < 2; ++it)
#pragma unroll
        for (int vt = 0; vt < 2; ++vt)
#pragma unroll
            for (int g4 = 0; g4 < 4; ++g4) {
                const uint2 cc = *reinterpret_cast<const uint2*>(&YL[(((it * 2 + vt) * 4 + g4) * 64 + lane) * 4]);
                acc[it][vt][g4 * 4] = bflo(cc.x); acc[it][vt][g4 * 4 + 1] = bfhi(cc.x); acc[it][vt][g4 * 4 + 2] = bflo(cc.y); acc[it][vt][g4 * 4 + 3] = bfhi(cc.y);
            }
#pragma unroll
    for (int ks = 0; ks < 4; ++ks) {
        bf16x8 A[2], B[2];
#pragma unroll
        for (int it = 0; it < 2; ++it) A[it] = *reinterpret_cast<const bf16x8*>(&WY[(it * 32 + r) * 64 + ks * 16 + hf * 8]);
#pragma unroll
        for (int vt = 0; vt < 2; ++vt) B[vt] = *reinterpret_cast<const bf16x8*>(&ZT[(vt * 32 + r) * 64 + ks * 16 + hf * 8]);
#pragma unroll
        for (int it = 0; it < 2; ++it)
#pragma unroll
            for (int vt = 0; vt < 2; ++vt) acc[it][vt] = __builtin_amdgcn_mfma_f32_32x32x16_bf16(A[it], B[vt], acc[it][vt], 0, 0, 0);
    }
#pragma unroll
    for (int it = 0; it < 2; ++it)
#pragma unroll
        for (int vt = 0; vt < 2; ++vt)
#pragma unroll
            for (int g = 0; g < 16; ++g) Ls[(it * 32 + (g & 3) + 8 * (g >> 2) + 4 * hf) * 68 + vt * 32 + r] = acc[it][vt][g];
    asm volatile("s_waitcnt lgkmcnt(0)" ::: "memory");
    __builtin_amdgcn_wave_barrier();
    {
        float y[64]; float s1 = 0.f, s2 = 0.f;
#pragma unroll
        for (int q = 0; q < 16; ++q) {
            const float4 x = *reinterpret_cast<const float4*>(&Ls[lane * 68 + q * 4]);
            y[q * 4] = x.x; y[q * 4 + 1] = x.y; y[q * 4 + 2] = x.z; y[q * 4 + 3] = x.w;
            s1 += (x.x + x.y) + (x.z + x.w);
        }
        const float mean = s1 * (1.f / 64.f);
#pragma unroll
        for (int v = 0; v < 64; ++v) { const float d = y[v] - mean; s2 += d * d; }
        const float rstd = rsqrtf(s2 * (1.f / 64.f) + 64e-5f);
        const bfr* Gg = (const bfr*)(a.ws + WS_GG); const bfr* Bon = (const bfr*)(a.ws + WS_BON); bfr* RWO = (bfr*)(a.ws + WS_RWO);
        const size_t o = (size_t)(t0 + lane) * RW + h * 64;
        const float* lnw = a.in[I_LNW] + h * 64; const float* lnb = a.in[I_LNB] + h * 64;
#pragma unroll
        for (int q = 0; q < 8; ++q) {
            float gg[8], bb[8], rr[8];
            unpack8(*reinterpret_cast<const uint4*>(&Gg[o + q * 8]), gg);
            unpack8(*reinterpret_cast<const uint4*>(&Bon[o + q * 8]), bb);
#pragma unroll
            for (int e = 0; e < 8; ++e) rr[e] = ((y[q * 8 + e] - mean) * rstd * lnw[q * 8 + e] + lnb[q * 8 + e] + bb[e]) * gg[e];
            *reinterpret_cast<uint4*>(&RWO[o + q * 8]) = pack8(rr);
        }
    }
    asm volatile("s_waitcnt lgkmcnt(0)" ::: "memory");
    __builtin_amdgcn_wave_barrier();
}
#ifndef DUP_DSA
#define DUP_DSA 0
#endif
constexpr float IDX_SCALE = 0.04419417382415922f;
constexpr int CT_ROW = 544;
constexpr int CT_WAVE = 18432;
constexpr int DSA_RELB_OFF = 155648;
constexpr int DSA_HIST_OFF = 131072;
constexpr int DSA_SEL_OFF = 147456;

typedef __bf16 bf16p2_t __attribute__((ext_vector_type(2)));
__device__ __forceinline__ bf16x8 fp8x8_to_bf16(const uint2 w) {
    const u32x4 r = {__builtin_bit_cast(unsigned, __builtin_amdgcn_cvt_scalef32_pk_bf16_fp8(w.x, 1.0f, false)), __builtin_bit_cast(unsigned, __builtin_amdgcn_cvt_scalef32_pk_bf16_fp8(w.x, 1.0f, true)),
                     __builtin_bit_cast(unsigned, __builtin_amdgcn_cvt_scalef32_pk_bf16_fp8(w.y, 1.0f, false)), __builtin_bit_cast(unsigned, __builtin_amdgcn_cvt_scalef32_pk_bf16_fp8(w.y, 1.0f, true))};
    return __builtin_bit_cast(bf16x8, r);
}
__device__ __forceinline__ unsigned pack4_fp8(float a0, float a1, float a2, float a3) {
    int p = 0; p = __builtin_amdgcn_cvt_pk_fp8_f32(a0, a1, p, false); p = __builtin_amdgcn_cvt_pk_fp8_f32(a2, a3, p, true); return (unsigned)p;
}
__device__ __forceinline__ int rel_bucket(int rel) {
    const int n = rel < 0 ? -rel : rel;
    const int lg = 8 + (n >= 15) + (n >= 27) + (n >= 50) + (n >= 91) + (n >= 166) + (n >= 305) + (n >= 559);
    return (n < 8 ? n : lg) + (rel > 0 ? 16 : 0);
}
__device__ __forceinline__ unsigned fkey(float f) {
    if (f == 0.f) f = 0.f;
    const unsigned u = __float_as_uint(f);
    return (u & 0x80000000u) ? ~u : (u | 0x80000000u);
}

__device__ __forceinline__ void dsa_cnorm(const Args& a) {
    const bfr* P = (const bfr*)(a.ws + WS_P); unsigned char* CB8 = a.ws + WS_CB; bfr* IKC = (bfr*)(a.ws + WS_IKC);
    const int lane = my_tid() & 63, wv = my_tid() >> 6;
    const float4 g = reinterpret_cast<const float4*>(a.in[I_KVG])[lane];
    for (int t = blockIdx.x * 8 + wv; t < T; t += gridDim.x * 8) {
        const uint2 raw = *reinterpret_cast<const uint2*>(&P[(size_t)t * NINP + C_CKV + lane * 4]);
        const float v0 = bflo(raw.x), v1 = bfhi(raw.x), v2 = bflo(raw.y), v3 = bfhi(raw.y);
        const float ss = wave_sum(v0 * v0 + v1 * v1 + v2 * v2 + v3 * v3);
        const float rs = rsqrtf(ss * (1.f / 256.f) + EPS);
        int pk = 0;
        pk = __builtin_amdgcn_cvt_pk_fp8_f32(v0 * rs * g.x, v1 * rs * g.y, pk, false);
        pk = __builtin_amdgcn_cvt_pk_fp8_f32(v2 * rs * g.z, v3 * rs * g.w, pk, true);
        *reinterpret_cast<int*>(&CB8[(size_t)t * 256 + lane * 4]) = pk;
        if (lane < 16) *reinterpret_cast<uint2*>(&IKC[(size_t)t * 64 + lane * 4]) = *reinterpret_cast<const uint2*>(&P[(size_t)t * NINP + C_IK + lane * 4]);
    }
}
__device__ __forceinline__ void dsa_qlat(const Args& a) {
    const bfr* P = (const bfr*)(a.ws + WS_P); const bfr* WUK = (const bfr*)(a.ws + WS_WUK); unsigned char* QL8 = a.ws + WS_QLAT;
    const int lane = my_tid() & 63, wv = my_tid() >> 6, fr = lane & 15, fq = lane >> 4;
    for (int it = blockIdx.x * 8 + wv; it < (T / 64) * NH; it += gridDim.x * 8) {
        const int tg = it >> 4, h = it & 15, t0 = tg * 64;
        bf16x8 Bt[4][2];
#pragma unroll
        for (int tl = 0; tl < 4; ++tl)
#pragma unroll
            for (int ks = 0; ks < 2; ++ks) Bt[tl][ks] = *reinterpret_cast<const bf16x8*>(&P[(size_t)(t0 + tl * 16 + fr) * NINP + C_Q + h * 64 + ks * 32 + fq * 8]);
#pragma unroll 2
        for (int nt = 0; nt < 16; ++nt) {
            const bf16x8 A0 = *reinterpret_cast<const bf16x8*>(&WUK[(size_t)(h * 256 + nt * 16 + fr) * 64 + fq * 8]);
            const bf16x8 A1 = *reinterpret_cast<const bf16x8*>(&WUK[(size_t)(h * 256 + nt * 16 + fr) * 64 + 32 + fq * 8]);
#pragma unroll
            for (int tl = 0; tl < 4; ++tl) {
                f32x4 acc = {0.f, 0.f, 0.f, 0.f};
                acc = __builtin_amdgcn_mfma_f32_16x16x32_bf16(A0, Bt[tl][0], acc, 0, 0, 0);
                acc = __builtin_amdgcn_mfma_f32_16x16x32_bf16(A1, Bt[tl][1], acc, 0, 0, 0);
                *reinterpret_cast<unsigned*>(&QL8[((size_t)(t0 + tl * 16 + fr) * NH + h) * 256 + nt * 16 + fq * 4]) = pack4_fp8(acc[0], acc[1], acc[2], acc[3]);
            }
        }
    }
}
__device__ __forceinline__ void dsa_oproj(const Args& a) {
    const unsigned char* OL8 = a.ws + WS_OLAT; const bfr* WUVT = (const bfr*)(a.ws + WS_WUVT); bfr* DO = (bfr*)(a.ws + WS_DO);
    const int lane = my_tid() & 63, wv = my_tid() >> 6, fr = lane & 15, fq = lane >> 4;
    for (int it = blockIdx.x * 8 + wv; it < (T / 64) * NH; it += gridDim.x * 8) {
        const int tg = it >> 4, h = it & 15, t0 = tg * 64;
        f32x4 acc[4][4];
#pragma unroll
        for (int tl = 0; tl < 4; ++tl)
#pragma unroll
            for (int nt = 0; nt < 4; ++nt) acc[tl][nt] = f32x4{0.f, 0.f, 0.f, 0.f};
#pragma unroll 2
        for (int ks = 0; ks < 8; ++ks) {
            bf16x8 A[4];
#pragma unroll
            for (int nt = 0; nt < 4; ++nt) A[nt] = *reinterpret_cast<const bf16x8*>(&WUVT[(size_t)(h * 64 + nt * 16 + fr) * 256 + ks * 32 + fq * 8]);
#pragma unroll
            for (int tl = 0; tl < 4; ++tl) {
                const bf16x8 Bt = fp8x8_to_bf16(*reinterpret_cast<const uint2*>(&OL8[((size_t)(t0 + tl * 16 + fr) * NH + h) * 256 + ks * 32 + fq * 8]));
#pragma unroll
                for (int nt = 0; nt < 4; ++nt) acc[tl][nt] = __builtin_amdgcn_mfma_f32_16x16x32_bf16(A[nt], Bt, acc[tl][nt], 0, 0, 0);
            }
        }
#pragma unroll
        for (int tl = 0; tl < 4; ++tl)
#pragma unroll
            for (int nt = 0; nt < 4; ++nt) { uint2 o; o.x = pack2(acc[tl][nt][0], acc[tl][nt][1]); o.y = pack2(acc[tl][nt][2], acc[tl][nt][3]);
                *reinterpret_cast<uint2*>(&DO[(size_t)(t0 + tl * 16 + fr) * RW + h * 64 + nt * 16 + fq * 4]) = o; }
    }
}

__device__ __forceinline__ float bin_scale(const float sumw2) { const float sg = sqrtf(32.f * sumw2); return sg > 1e-20f ? 90.f / sg : 1.f; }
__device__ __forceinline__ int score_bin(const float sc, const float bsc) { const float f = floorf(sc * bsc) + 512.f; return (int)fminf(fmaxf(f, 0.f), 1023.f); }
__device__ __forceinline__ float key_score(const unsigned k) { return __uint_as_float((k & 0x80000000u) ? (k ^ 0x80000000u) : ~k); }
__device__ __forceinline__ void hist_scan(const unsigned* hist, const int nb, const unsigned need, unsigned* res, const int lane) {
    const int per = nb >> 6;
    unsigned s = 0;
    for (int i = 0; i < per; ++i) s += hist[lane * per + i];
    unsigned S = s;
#pragma unroll
    for (int o = 1; o < 64; o <<= 1) { const unsigned tt = __shfl_down(S, o); if (lane + o < 64) S += tt; }
    const unsigned long long m = __ballot(S >= need);
    const int ls = 63 - __clzll(m);
    if (lane == ls) {
        unsigned accv = S - s; int bin = lane * per; unsigned abv = accv;
        for (int bb = lane * per + per - 1; bb >= lane * per; --bb) { const unsigned cc = hist[bb]; if (accv + cc >= need) { bin = bb; abv = accv; break; } accv += cc; }
        res[0] = (unsigned)bin; res[1] = abv;
    }
}

__device__ __forceinline__ void dsa_select4(const Args& a, const int t0, const int qs, unsigned char* lds) {
    const bfr* P = (const bfr*)(a.ws + WS_P); const bfr* IKC = (const bfr*)(a.ws + WS_IKC);
    float* SC = (float*)lds; int* SEL = (int*)(lds + DSA_SEL_OFF); unsigned* MISC = (unsigned*)(lds + LDS_MISC);
    const int tid = my_tid(), lane = tid & 63, wv = tid >> 6, r = lane & 31, hf = lane >> 5;
    const int L = 64 * (t0 / 64 + 1);
    if (L <= 256) {
        for (int i = tid; i < 4 * 256; i += 512) SEL[(qs + (i >> 8)) * 256 + (i & 255)] = (i & 255) | (rel_bucket((i & 255) - (t0 + (i >> 8))) << 16);
        if (tid < 4) MISC[16 + qs + tid] = (unsigned)L;
        __syncthreads();
        return;
    }
    for (int i = tid; i < 4096; i += 512) ((unsigned*)(lds + DSA_HIST_OFF))[i] = 0u;
    __syncthreads();
    {
        const int qq = r >> 3, hh = r & 7;
        bf16x8 B[4];
#pragma unroll
        for (int ks = 0; ks < 4; ++ks) B[ks] = *reinterpret_cast<const bf16x8*>(&P[(size_t)(t0 + qq) * NINP + C_IQ + hh * 64 + ks * 16 + hf * 8]);
        const float wgt = bf2f(P[(size_t)(t0 + qq) * NINP + C_IW + hh]) * IDX_SCALE;
        float w2 = wgt * wgt; w2 += dpp_f<DPP_XOR1>(w2); w2 += dpp_f<DPP_XOR2>(w2); w2 += dpp_f<0x141>(w2);
        const float bsc = bin_scale(w2);
        if (hh == 0 && hf == 0) ((float*)MISC)[48 + qq] = bsc;
        const int ntile = L >> 5;
        for (int rp_ = 0; rp_ < ((DUP_DSA & 1) ? 2 : 1); ++rp_) {
        bf16x8 An[4];
        if (wv < ntile) {
#pragma unroll
            for (int ks = 0; ks < 4; ++ks) An[ks] = *reinterpret_cast<const bf16x8*>(&IKC[(size_t)(wv * 32 + r) * 64 + ks * 16 + hf * 8]);
        }
        for (int kt = wv; kt < ntile; kt += 8) {
            bf16x8 Ac[4];
#pragma unroll
            for (int ks = 0; ks < 4; ++ks) Ac[ks] = An[ks];
            if (kt + 8 < ntile) {
#pragma unroll
                for (int ks = 0; ks < 4; ++ks) An[ks] = *reinterpret_cast<const bf16x8*>(&IKC[(size_t)((kt + 8) * 32 + r) * 64 + ks * 16 + hf * 8]);
            }
            f32x16 acc;
#pragma unroll
            for (int g = 0; g < 16; ++g) acc[g] = 0.f;
#pragma unroll
            for (int ks = 0; ks < 4; ++ks) acc = __builtin_amdgcn_mfma_f32_32x32x16_bf16(Ac[ks], B[ks], acc, 0, 0, 0);
            float s1[8], s2[4], s3[2];
            const bool b0 = (hh & 1) != 0, b1 = (hh & 2) != 0, b2 = (hh & 4) != 0;
#pragma unroll
            for (int p = 0; p < 8; ++p) {
                const float x0 = fmaxf(acc[2 * p], 0.f) * wgt, x1 = fmaxf(acc[2 * p + 1], 0.f) * wgt;
                s1[p] = (b0 ? x1 : x0) + dpp_f<DPP_XOR1>(b0 ? x0 : x1);
            }
#pragma unroll
            for (int p = 0; p < 4; ++p) s2[p] = (b1 ? s1[2 * p + 1] : s1[2 * p]) + dpp_f<DPP_XOR2>(b1 ? s1[2 * p] : s1[2 * p + 1]);
#pragma unroll
            for (int p = 0; p < 2; ++p) s3[p] = (b2 ? s2[2 * p + 1] : s2[2 * p]) + __shfl_xor(b2 ? s2[2 * p] : s2[2 * p + 1], 4);
#pragma unroll
            for (int p = 0; p < 2; ++p) { const int g = 8 * p + hh; const unsigned fk = fkey(s3[p]); ((unsigned*)SC)[qq * 8192 + kt * 32 + (g & 3) + 8 * (g >> 2) + 4 * hf] = fk;
                if (rp_ == 0) atomicAdd((unsigned*)(lds + DSA_HIST_OFF) + qq * 1024 + score_bin(s3[p], bsc), 1u); }
        }
        }
    }
    __syncthreads();
    const int q = wv >> 1, l128 = (wv & 1) * 64 + lane;
    const unsigned* keys = (const unsigned*)(SC + q * 8192);
    unsigned* hist = (unsigned*)(lds + DSA_HIST_OFF) + q * 1024;
    unsigned* res = MISC + 32 + q * 4;
    for (int rp_ = 0; rp_ < ((DUP_DSA & 2) ? 2 : 1); ++rp_) {
    const float bsc = ((const float*)MISC)[48 + q];
    unsigned need = 256;
    if (rp_ > 0) {
        for (int i = l128; i < 1024; i += 128) hist[i] = 0u;
        __syncthreads();
        for (int idx = l128; idx < L; idx += 128) atomicAdd(&hist[score_bin(key_score(keys[idx]), bsc)], 1u);
        __syncthreads();
    }
    if ((wv & 1) == 0) hist_scan(hist, 1024, need, res, lane);
    __syncthreads();
    const int b0 = (int)res[0]; need -= res[1];
    __syncthreads();
    unsigned* cand = hist + 256;
    if (l128 == 0) { res[2] = 0u; res[3] = 0u; }
    if (tid == 0) MISC[52] = 0u;
    __syncthreads();
    for (int idx = l128; idx < L; idx += 128) {
        const unsigned k = keys[idx];
        if (score_bin(key_score(k), bsc) == b0) { const unsigned p = atomicAdd(&res[2], 1u); if (p < 768u) cand[p] = k; }
    }
    __syncthreads();
    const unsigned ncand = res[2];
    if (l128 == 0 && ncand > 768u) MISC[52] = 1u;
    __syncthreads();
    const bool fast = MISC[52] == 0u;
    unsigned prefix = 0;
    if (fast) {
        for (unsigned i = l128; i < ncand; i += 128) {
            const unsigned me = cand[i]; unsigned cgt = 0, ceq = 0;
            for (unsigned j = 0; j < ncand; ++j) { const unsigned o = cand[j]; cgt += (o > me) ? 1u : 0u; ceq += (o == me) ? 1u : 0u; }
            if (cgt < need && need <= cgt + ceq) { res[0] = me; res[1] = cgt; }
        }
        __syncthreads();
        prefix = res[0]; need -= res[1];
        __syncthreads();
    } else {
#pragma unroll 1
        for (int pass = 0; pass < 4; ++pass) {
            const int lo_shift = 24 - 8 * pass;
            for (int i = l128; i < 256; i += 128) hist[i] = 0u;
            __syncthreads();
            for (int idx = l128; idx < L; idx += 128) {
                const unsigned k = keys[idx];
                const bool ok = (score_bin(key_score(k), bsc) == b0) && (pass == 0 || (k >> (lo_shift + 8)) == prefix);
                if (ok) atomicAdd(&hist[(k >> lo_shift) & 255u], 1u);
            }
            __syncthreads();
            if ((wv & 1) == 0) hist_scan(hist, 256, need, res, lane);
            __syncthreads();
            prefix = (prefix << 8) | res[0]; need -= res[1];
            __syncthreads();
        }
    }
    const unsigned tkey = prefix;
    if ((wv & 1) == 0) {
        const unsigned ngt = 256u - need; unsigned rg = 0, rt = 0;
        const unsigned long long lt = (1ull << lane) - 1ull;
        for (int base = 0; base < L; base += 64) {
            const unsigned k = keys[base + lane];
            const bool gt = k > tkey, tie = k == tkey;
            const unsigned long long mg = __ballot(gt), mt = __ballot(tie);
            if (gt) { const unsigned p = rg + (unsigned)__popcll(mg & lt); if (p < 256u) SEL[(qs + q) * 256 + p] = base + lane; }
            if (tie) { const unsigned p = rt + (unsigned)__popcll(mt & lt); if (p < need) SEL[(qs + q) * 256 + ngt + p] = base + lane; }
            rg += (unsigned)__popcll(mg); rt += (unsigned)__popcll(mt);
        }
        if (lane == 0) MISC[16 + qs + q] = 256u;
    }
    __syncthreads();
    for (int i = l128; i < 256; i += 128) { const int e = SEL[(qs + q) * 256 + i]; SEL[(qs + q) * 256 + i] = e | (rel_bucket(e - (t0 + q)) << 16); }
    __syncthreads();
    }
}

__device__ __forceinline__ void dsa_attend(const Args& a, const int t, const int* sel, const int nsel, unsigned char* ct, const float* relb_l) {
    const unsigned char* CB8 = a.ws + WS_CB; const unsigned char* QL8 = a.ws + WS_QLAT; unsigned char* OL8 = a.ws + WS_OLAT;
    const int lane = my_tid() & 63, fr = lane & 15, fq = lane >> 4;
    bf16x8 Bq[8];
#pragma unroll
    for (int ks = 0; ks < 8; ++ks) Bq[ks] = fp8x8_to_bf16(*reinterpret_cast<const uint2*>(&QL8[((size_t)t * NH + fr) * 256 + ks * 32 + fq * 8]));
    f32x4 o[16];
#pragma unroll
    for (int mt = 0; mt < 16; ++mt) o[mt] = f32x4{0.f, 0.f, 0.f, 0.f};
    float mrun = -1e30f, lrun = 0.f;
    const unsigned tr_addr = (unsigned)(size_t)ct + (unsigned)((4 * fq + (fr >> 2)) * CT_ROW + (fr & 3) * 8);
    const int nblk = nsel >> 5;
    uint2 Ar[2][8];
#pragma unroll
    for (int tt = 0; tt < 2; ++tt) {
        const int kidx = sel[tt * 16 + fr] & 0xFFFF;
#pragma unroll
        for (int ks = 0; ks < 8; ++ks) Ar[tt][ks] = *reinterpret_cast<const uint2*>(&CB8[(size_t)kidx * 256 + ks * 32 + fq * 8]);
    }
    for (int kb = 0; kb < nblk; ++kb) {
        f32x4 st[2];
#pragma unroll
        for (int tt = 0; tt < 2; ++tt) {
            st[tt] = f32x4{0.f, 0.f, 0.f, 0.f};
#pragma unroll
            for (int ks = 0; ks < 8; ++ks) {
                const bf16x8 Af = fp8x8_to_bf16(Ar[tt][ks]);
                st[tt] = __builtin_amdgcn_mfma_f32_16x16x32_bf16(Af, Bq[ks], st[tt], 0, 0, 0);
                *reinterpret_cast<bf16x8*>(ct + (tt * 16 + fr) * CT_ROW + (ks * 32 + fq * 8) * 2) = Af;
            }
        }
        if (kb + 1 < nblk) {
#pragma unroll
            for (int tt = 0; tt < 2; ++tt) {
                const int kidx = sel[(kb + 1) * 32 + tt * 16 + fr] & 0xFFFF;
#pragma unroll
                for (int ks = 0; ks < 8; ++ks) Ar[tt][ks] = *reinterpret_cast<const uint2*>(&CB8[(size_t)kidx * 256 + ks * 32 + fq * 8]);
            }
        }
        float lg[8]; float bmax = -1e30f;
#pragma unroll
        for (int tt = 0; tt < 2; ++tt) {
            const int4 k4 = *reinterpret_cast<const int4*>(&sel[kb * 32 + tt * 16 + fq * 4]);
            const int kk4[4] = {k4.x, k4.y, k4.z, k4.w};
#pragma unroll
            for (int j = 0; j < 4; ++j) {
                const float v = st[tt][j] * 0.125f + relb_l[(kk4[j] >> 16) * 16 + fr];
                lg[tt * 4 + j] = v; bmax = fmaxf(bmax, v);
            }
        }
        bmax = fmaxf(bmax, __shfl_xor(bmax, 16)); bmax = fmaxf(bmax, __shfl_xor(bmax, 32));
        const bool resc = __any(bmax > mrun + 8.f);
        float alpha = 1.f;
        if (resc) { const float mnew = fmaxf(mrun, bmax); alpha = __expf(mrun - mnew); mrun = mnew; lrun *= alpha; }
        float psum = 0.f; bf16x8 Pf;
#pragma unroll
        for (int e = 0; e < 8; e += 2) {
            const float p0 = __expf(lg[e] - mrun), p1 = __expf(lg[e + 1] - mrun); psum += p0 + p1;
            const unsigned pk = pack2(p0, p1); Pf[e] = (short)(pk & 0xFFFF); Pf[e + 1] = (short)(pk >> 16);
        }
        lrun += psum;
        asm volatile("s_waitcnt lgkmcnt(0)" ::: "memory");
        __builtin_amdgcn_wave_barrier();
#pragma unroll
        for (int m4 = 0; m4 < 4; ++m4) {
            uint2 r0[4], r1[4];
            asm volatile("ds_read_b64_tr_b16 %0, %8 offset:%9\n\tds_read_b64_tr_b16 %1, %8 offset:%10\n\t"
                         "ds_read_b64_tr_b16 %2, %8 offset:%11\n\tds_read_b64_tr_b16 %3, %8 offset:%12\n\t"
                         "ds_read_b64_tr_b16 %4, %8 offset:%13\n\tds_read_b64_tr_b16 %5, %8 offset:%14\n\t"
                         "ds_read_b64_tr_b16 %6, %8 offset:%15\n\tds_read_b64_tr_b16 %7, %8 offset:%16\n\ts_waitcnt lgkmcnt(0)"
                         : "=&v"(r0[0]), "=&v"(r1[0]), "=&v"(r0[1]), "=&v"(r1[1]), "=&v"(r0[2]), "=&v"(r1[2]), "=&v"(r0[3]), "=&v"(r1[3])
                         : "v"(tr_addr), "n"(m4 * 128), "n"(m4 * 128 + 16 * CT_ROW), "n"(m4 * 128 + 32), "n"(m4 * 128 + 32 + 16 * CT_ROW),
                           "n"(m4 * 128 + 64), "n"(m4 * 128 + 64 + 16 * CT_ROW), "n"(m4 * 128 + 96), "n"(m4 * 128 + 96 + 16 * CT_ROW)
                         : "memory");
#pragma unroll
            for (int i = 0; i < 4; ++i) {
                const int mt = m4 * 4 + i;
                const u32x4 raw = {r0[i].x, r0[i].y, r1[i].x, r1[i].y};
                const bf16x8 Av = __builtin_bit_cast(bf16x8, raw);
                f32x4 oo = o[mt];
                if (resc) { oo[0] *= alpha; oo[1] *= alpha; oo[2] *= alpha; oo[3] *= alpha; }
                o[mt] = __builtin_amdgcn_mfma_f32_16x16x32_bf16(Av, Pf, oo, 0, 0, 0);
            }
        }
        asm volatile("s_waitcnt lgkmcnt(0)" ::: "memory");
        __builtin_amdgcn_wave_barrier();
    }
    lrun += __shfl_xor(lrun, 16); lrun += __shfl_xor(lrun, 32);
    const float inv = frcp_(lrun);
#pragma unroll
    for (int mt = 0; mt < 16; ++mt) {
        *reinterpret_cast<unsigned*>(&OL8[((size_t)t * NH + fr) * 256 + mt * 16 + fq * 4]) = pack4_fp8(o[mt][0] * inv, o[mt][1] * inv, o[mt][2] * inv, o[mt][3] * inv);
    }
}

constexpr int DSA_CCAP = 256;
__device__ __forceinline__ bool dsa_select8(const Args& a, const int t0, unsigned char* lds) {
    const bfr* P = (const bfr*)(a.ws + WS_P); const bfr* IKC = (const bfr*)(a.ws + WS_IKC);
    unsigned* KEYS = (unsigned*)(a.ws + WS_KEYS) + (size_t)blockIdx.x * (8 * 8192);
    unsigned short* BIN = (unsigned short*)lds; unsigned* H16 = (unsigned*)(lds + DSA_HIST_OFF);
    int* SEL = (int*)(lds + DSA_SEL_OFF); unsigned* MISC = (unsigned*)(lds + LDS_MISC);
    const int tid = my_tid(), lane = tid & 63, wv = tid >> 6, r = lane & 31, hf = lane >> 5;
    const int L = 64 * (t0 / 64 + 1);
    if (L <= 256) {
        for (int i = tid; i < 8 * 256; i += 512) SEL[i] = (i & 255) | (rel_bucket((i & 255) - (t0 + (i >> 8))) << 16);
        if (tid < 8) MISC[16 + tid] = (unsigned)L;
        __syncthreads();
        return true;
    }
    for (int i = tid; i < 4096; i += 512) H16[i] = 0u;
    if (tid == 0) MISC[60] = 0u;
    __syncthreads();
    {
        const int qq = r >> 3, hh = r & 7;
        bf16x8 B[2][4]; float wgt[2], bsc[2];
#pragma unroll
        for (int grp = 0; grp < 2; ++grp) {
#pragma unroll
            for (int ks = 0; ks < 4; ++ks) B[grp][ks] = *reinterpret_cast<const bf16x8*>(&P[(size_t)(t0 + grp * 4 + qq) * NINP + C_IQ + hh * 64 + ks * 16 + hf * 8]);
            wgt[grp] = bf2f(P[(size_t)(t0 + grp * 4 + qq) * NINP + C_IW + hh]) * IDX_SCALE;
            float w2 = wgt[grp] * wgt[grp]; w2 += dpp_f<DPP_XOR1>(w2); w2 += dpp_f<DPP_XOR2>(w2); w2 += dpp_f<0x141>(w2);
            bsc[grp] = bin_scale(w2);
            if (hh == 0 && hf == 0) ((float*)MISC)[48 + grp * 4 + qq] = bsc[grp];
        }
        const bool b0 = (hh & 1) != 0, b1 = (hh & 2) != 0, b2 = (hh & 4) != 0;
        const int ntile = L >> 5;
        bf16x8 An[4];
        if (wv < ntile) {
#pragma unroll
            for (int ks = 0; ks < 4; ++ks) An[ks] = *reinterpret_cast<const bf16x8*>(&IKC[(size_t)(wv * 32 + r) * 64 + ks * 16 + hf * 8]);
        }
        for (int kt = wv; kt < ntile; kt += 8) {
            bf16x8 Ac[4];
#pragma unroll
            for (int ks = 0; ks < 4; ++ks) Ac[ks] = An[ks];
            if (kt + 8 < ntile) {
#pragma unroll
                for (int ks = 0; ks < 4; ++ks) An[ks] = *reinterpret_cast<const bf16x8*>(&IKC[(size_t)((kt + 8) * 32 + r) * 64 + ks * 16 + hf * 8]);
            }
#pragma unroll
            for (int grp = 0; grp < 2; ++grp) {
                f32x16 acc;
#pragma unroll
                for (int g = 0; g < 16; ++g) acc[g] = 0.f;
#pragma unroll
                for (int ks = 0; ks < 4; ++ks) acc = __builtin_amdgcn_mfma_f32_32x32x16_bf16(Ac[ks], B[grp][ks], acc, 0, 0, 0);
                float s1[8], s2[4], s3[2];
#pragma unroll
                for (int p = 0; p < 8; ++p) {
                    const float x0 = fmaxf(acc[2 * p], 0.f) * wgt[grp], x1 = fmaxf(acc[2 * p + 1], 0.f) * wgt[grp];
                    s1[p] = (b0 ? x1 : x0) + dpp_f<DPP_XOR1>(b0 ? x0 : x1);
                }
#pragma unroll
                for (int p = 0; p < 4; ++p) s2[p] = (b1 ? s1[2 * p + 1] : s1[2 * p]) + dpp_f<DPP_XOR2>(b1 ? s1[2 * p] : s1[2 * p + 1]);
#pragma unroll
                for (int p = 0; p < 2; ++p) s3[p] = (b2 ? s2[2 * p + 1] : s2[2 * p]) + __shfl_xor(b2 ? s2[2 * p] : s2[2 * p + 1], 4);
#pragma unroll
                for (int p = 0; p < 2; ++p) {
                    const int g = 8 * p + hh, kidx = kt * 32 + (g & 3) + 8 * (g >> 2) + 4 * hf, q = grp * 4 + qq;
                    const int bin = score_bin(s3[p], bsc[grp]);
                    BIN[q * 8192 + kidx] = (unsigned short)bin;
                    atomicAdd(&H16[q * 512 + (bin >> 1)], (bin & 1) ? 0x10000u : 1u);
                    KEYS[q * 8192 + kidx] = fkey(s3[p]);
                }
            }
        }
    }
    asm volatile("s_waitcnt vmcnt(0)" ::: "memory");
    __syncthreads();
    {
        const int q = wv;
        const unsigned short* bins = BIN + q * 8192;
        unsigned* hrow = H16 + q * 512;
        unsigned cnt[16]; unsigned sown = 0;
#pragma unroll
        for (int i = 0; i < 8; ++i) { const unsigned w = hrow[lane * 8 + i]; cnt[2 * i] = w & 0xFFFFu; cnt[2 * i + 1] = w >> 16; sown += cnt[2 * i] + cnt[2 * i + 1]; }
        unsigned S = sown;
#pragma unroll
        for (int o = 1; o < 64; o <<= 1) { const unsigned tt = __shfl_down(S, o); if (lane + o < 64) S += tt; }
        const unsigned long long mfound = __ballot(S >= 256u);
        const int ls = 63 - __clzll(mfound);
        int b0l = 0; unsigned abovel = 0;
        {
            unsigned accv = S - sown; bool done = false;
#pragma unroll
            for (int bb = 15; bb >= 0; --bb) { if (!done) { if (accv + cnt[bb] >= 256u) { b0l = lane * 16 + bb; abovel = accv; done = true; } else accv += cnt[bb]; } }
        }
        const int b0 = __shfl(b0l, ls); const unsigned ngt = __shfl((int)abovel, ls); const unsigned need = 256u - ngt;
        __builtin_amdgcn_wave_barrier();
        int* CL = (int*)hrow; unsigned* CK = hrow + DSA_CCAP;
        const unsigned long long lt = (1ull << lane) - 1ull;
        unsigned rg = 0, rc = 0;
        for (int base = 0; base < (L >> 1); base += 64) {
            const bool valid = (base + lane) < (L >> 1);
            const unsigned w = valid ? reinterpret_cast<const unsigned*>(bins)[base + lane] : 0u;
            const int ba = (int)(w & 0xFFFFu), bb = (int)(w >> 16), ia = 2 * (base + lane), ib = ia + 1;
            const bool ga = valid && ba > b0, gb = valid && bb > b0, ca = valid && ba == b0, cb = valid && bb == b0;
            const unsigned long long mga = __ballot(ga), mgb = __ballot(gb), mca = __ballot(ca), mcb = __ballot(cb);
            const unsigned pg = rg + (unsigned)__popcll(mga & lt) + (unsigned)__popcll(mgb & lt);
            const unsigned pc = rc + (unsigned)__popcll(mca & lt) + (unsigned)__popcll(mcb & lt);
            if (ga && pg < 256u) SEL[q * 256 + pg] = ia;
            if (gb && pg + (ga ? 1u : 0u) < 256u) SEL[q * 256 + pg + (ga ? 1u : 0u)] = ib;
            if (ca && pc < (unsigned)DSA_CCAP) CL[pc] = ia;
            if (cb && pc + (ca ? 1u : 0u) < (unsigned)DSA_CCAP) CL[pc + (ca ? 1u : 0u)] = ib;
            rg += (unsigned)__popcll(mga) + (unsigned)__popcll(mgb); rc += (unsigned)__popcll(mca) + (unsigned)__popcll(mcb);
        }
        const unsigned ncand = rc;
        if (ncand > (unsigned)DSA_CCAP) { if (lane == 0) MISC[60] = 1u; }
        else {
            asm volatile("s_waitcnt lgkmcnt(0)" ::: "memory");
            for (unsigned i = lane; i < ncand; i += 64) CK[i] = __hip_atomic_load(&KEYS[q * 8192 + CL[i]], __ATOMIC_RELAXED, __HIP_MEMORY_SCOPE_AGENT);
            asm volatile("s_waitcnt vmcnt(0) lgkmcnt(0)" ::: "memory");
            __builtin_amdgcn_wave_barrier();
            for (unsigned i = lane; i < ncand; i += 64) {
                const unsigned me = CK[i]; unsigned rk = 0;
                for (unsigned j = 0; j < ncand; ++j) { const unsigned o = CK[j]; rk += (o > me || (o == me && j < i)) ? 1u : 0u; }
                if (rk < need) SEL[q * 256 + ngt + rk] = CL[i];
            }
            asm volatile("s_waitcnt lgkmcnt(0)" ::: "memory");
            __builtin_amdgcn_wave_barrier();
            for (int i = lane; i < 256; i += 64) { const int e = SEL[q * 256 + i]; SEL[q * 256 + i] = e | (rel_bucket(e - (t0 + q)) << 16); }
            if (lane == 0) MISC[16 + q] = 256u;
        }
    }
    __syncthreads();
    return MISC[60] == 0u;
}

__device__ __forceinline__ void dsa_unit(const Args& a, const int unit, unsigned char* lds) {
    const int t0 = unit * 8, wv = my_tid() >> 6;
    if (!dsa_select8(a, t0, lds)) {
        __syncthreads();
        dsa_select4(a, t0, 0, lds);
        dsa_select4(a, t0 + 4, 4, lds);
    }
    const int* SEL = (const int*)(lds + DSA_SEL_OFF); const unsigned* MISC = (const unsigned*)(lds + LDS_MISC);
    dsa_attend(a, t0 + wv, SEL + wv * 256, (int)MISC[16 + wv], lds + wv * CT_WAVE, (const float*)(lds + DSA_RELB_OFF));
    __syncthreads();
}
template <int J> __device__ __forceinline__ int xchg_i(int v) {
    if (J == 1) return __builtin_amdgcn_update_dpp(0, v, 0xB1, 0xF, 0xF, true);
    else if (J == 2) return __builtin_amdgcn_update_dpp(0, v, 0x4E, 0xF, 0xF, true);
    else if (J == 4) { int t = __builtin_amdgcn_update_dpp(v, v, 0x104, 0xF, 0x5, false);
                       return __builtin_amdgcn_update_dpp(t, v, 0x114, 0xF, 0xA, false); }
    else if (J == 8) return __builtin_amdgcn_update_dpp(0, v, 0x128, 0xF, 0xF, true);
    else return __shfl_xor(v, J);
}
template <int J> __device__ __forceinline__ float xchg_f(float v) { return __int_as_float(xchg_i<J>(__float_as_int(v))); }

__device__ __forceinline__ unsigned okey(float f) { const unsigned u = __float_as_uint(f); return (u & 0x80000000u) ? ~u : (u | 0x80000000u); }
template <int K, int J> __device__ __forceinline__ void bitonic_step(unsigned& k, const int lane) {
    const unsigned ok = (unsigned)xchg_i<J>((int)k);
    const bool desc = (K == 64) ? true : ((lane & K) == 0);
    const bool keepmax = ((lane & J) == 0) == desc;
    k = keepmax ? max(k, ok) : min(k, ok);
}
__device__ __forceinline__ void bitonic64(unsigned& k, const int lane) {
    bitonic_step<2, 1>(k, lane);
    bitonic_step<4, 2>(k, lane); bitonic_step<4, 1>(k, lane);
    bitonic_step<8, 4>(k, lane); bitonic_step<8, 2>(k, lane); bitonic_step<8, 1>(k, lane);
    bitonic_step<16, 8>(k, lane); bitonic_step<16, 4>(k, lane); bitonic_step<16, 2>(k, lane); bitonic_step<16, 1>(k, lane);
    bitonic_step<32, 16>(k, lane); bitonic_step<32, 8>(k, lane); bitonic_step<32, 4>(k, lane); bitonic_step<32, 2>(k, lane); bitonic_step<32, 1>(k, lane);
    bitonic_step<64, 32>(k, lane); bitonic_step<64, 16>(k, lane); bitonic_step<64, 8>(k, lane); bitonic_step<64, 4>(k, lane); bitonic_step<64, 2>(k, lane); bitonic_step<64, 1>(k, lane);
}
__device__ __forceinline__ void merge32(unsigned& k, const int lane) {
    bitonic_step<64, 16>(k, lane); bitonic_step<64, 8>(k, lane); bitonic_step<64, 4>(k, lane); bitonic_step<64, 2>(k, lane); bitonic_step<64, 1>(k, lane);
}
__device__ __forceinline__ void top16_of_128(const float* s, float& tv, int& ti, const int lane) {
    unsigned ka = (okey(s[lane]) & ~0x7Fu) | (unsigned)(127 - lane), kb = (okey(s[64 + lane]) & ~0x7Fu) | (unsigned)(63 - lane);
    bitonic64(ka, lane); bitonic64(kb, lane);
    const unsigned rb = (unsigned)__shfl((int)kb, 31 - lane);
    unsigned k = (lane < 16) ? ka : ((lane < 32) ? rb : 0u);
    merge32(k, lane);
    ti = 127 - (int)(k & 0x7Fu);
    tv = s[ti];
}

#ifndef DUP_PEER
#define DUP_PEER 0
#endif
constexpr int PEER_EID_OFF = 131072, PEER_GATE_OFF = 139264;
#ifndef PGB
#define PGB 8
#endif

__device__ __forceinline__ void peer_unit(const Args& a, const int unit, unsigned char* lds) {
    const bfr* QP = (const bfr*)(a.ws + WS_QP); const bfr* SUBK = (const bfr*)(a.ws + WS_SUBK);
    const unsigned char* PU4 = a.ws + WS_PU; const unsigned char* PV4 = a.ws + WS_PV;
    const bfr* HB = (const bfr*)(a.ws + WS_HB); const float* part = (const float*)(a.ws + WS_PART);
    float* S = (float*)lds; int* EID = (int*)(lds + PEER_EID_OFF); float* GATE = (float*)(lds + PEER_GATE_OFF);
    const int tid = my_tid(), lane = tid & 63, wv = tid >> 6, fr = lane & 15, fq = lane >> 4, t0 = unit * 16;
    for (int rp_ = 0; rp_ < ((DUP_PEER & 1) ? 2 : 1); ++rp_) {
    for (int hc = wv * 2; hc < wv * 2 + 2; ++hc) {
        bf16x8 A[4];
#pragma unroll
        for (int ks = 0; ks < 4; ++ks) A[ks] = *reinterpret_cast<const bf16x8*>(&QP[(size_t)(t0 + fr) * D + hc * 128 + ks * 32 + fq * 8]);
#pragma unroll 2
        for (int nt = 0; nt < 8; ++nt) {
            f32x4 acc = {0.f, 0.f, 0.f, 0.f};
#pragma unroll
            for (int ks = 0; ks < 4; ++ks) {
                const bf16x8 B = *reinterpret_cast<const bf16x8*>(&SUBK[(size_t)(hc * 128 + nt * 16 + fr) * 128 + ks * 32 + fq * 8]);
                acc = __builtin_amdgcn_mfma_f32_16x16x32_bf16(A[ks], B, acc, 0, 0, 0);
            }
#pragma unroll
            for (int j = 0; j < 4; ++j) S[((fq * 4 + j) * 16 + hc) * 128 + nt * 16 + fr] = acc[j];
        }
    }
    __syncthreads();
    for (int job = wv * 16; job < wv * 16 + 16; ++job) {
        const int tok = job >> 3, hh = job & 7;
        const float* s1 = S + (tok * 16 + hh * 2) * 128; const float* s2 = s1 + 128;
        float v1, v2; int i1, i2;
        top16_of_128(s1, v1, i1, lane);
        top16_of_128(s2, v2, i2, lane);
        int ci = -1, cj = 0;
        { int base = 0;
#pragma unroll
          for (int i = 0; i < 16; ++i) { const int cnt = 16 / (i + 1); if (lane >= base && lane < base + cnt) { ci = i; cj = lane - base; } base += cnt; } }
        const float a1 = __shfl(v1, ci < 0 ? 0 : ci), b1 = __shfl(v2, cj);
        unsigned ck = (ci >= 0) ? ((okey(a1 + b1) & ~0xFFu) | (unsigned)(255 - (ci * 16 + cj))) : 0u;
        bitonic64(ck, lane);
        const int cid = 255 - (int)(ck & 0xFFu);
        const int pi = (lane < 16) ? (cid >> 4) : 0, pj = (lane < 16) ? (cid & 15) : 0;
        const float cv = __shfl(v1, pi) + __shfl(v2, pj);
        const float mx = __shfl(cv, 0);
        float e = (lane < 16) ? __expf(cv - mx) : 0.f;
        float se = e;
#pragma unroll
        for (int o = 1; o < 16; o <<= 1) se += __shfl_xor(se, o);
        const int e1 = __shfl(i1, pi), e2 = __shfl(i2, pj);
        if (lane < 16) { EID[tok * 128 + hh * 16 + lane] = e1 * 128 + e2; GATE[tok * 128 + hh * 16 + lane] = e * frcp_(se); }
    }
    __syncthreads();
    }
    for (int rp_ = 0; rp_ < ((DUP_PEER & 2) ? 2 : 1); ++rp_)
    for (int tk = wv * 2; tk < wv * 2 + 2; ++tk) {
        const int t = t0 + tk;
        int ln = lane; asm volatile("" : "+v"(ln));
        const float rstd = row_rstd(part, t);
        unsigned q1[4], q2[4]; float h1s, h2s;
        {
            float hf[32]; float am = 0.f;
#pragma unroll
            for (int q = 0; q < 8; ++q) {
                const uint2 xr = *reinterpret_cast<const uint2*>(&HB[(size_t)t * D + q * 256 + ln * 4]);
                const float4 g0 = *reinterpret_cast<const float4*>(&a.in[I_NFG][q * 256 + ln * 4]);
                hf[q * 4] = bflo(xr.x) * rstd * g0.x; hf[q * 4 + 1] = bfhi(xr.x) * rstd * g0.y; hf[q * 4 + 2] = bflo(xr.y) * rstd * g0.z; hf[q * 4 + 3] = bfhi(xr.y) * rstd * g0.w;
                am = fmaxf(am, fmaxf(fmaxf(fabsf(hf[q * 4]), fabsf(hf[q * 4 + 1])), fmaxf(fabsf(hf[q * 4 + 2]), fabsf(hf[q * 4 + 3]))));
            }
            h1s = am * (1.f / 7.f); const float i1 = h1s > 0.f ? frcp_(h1s) : 0.f;
            float qv[32]; float am2 = 0.f;
#pragma unroll
            for (int i = 0; i < 32; ++i) { qv[i] = fminf(fmaxf(__builtin_rintf(hf[i] * i1), -7.f), 7.f); hf[i] -= qv[i] * h1s; am2 = fmaxf(am2, fabsf(hf[i])); }
            q1[0] = pack8_i4(qv); q1[1] = pack8_i4(qv + 8); q1[2] = pack8_i4(qv + 16); q1[3] = pack8_i4(qv + 24);
            h2s = am2 * (1.f / 7.f); const float i2 = h2s > 0.f ? frcp_(h2s) : 0.f;
#pragma unroll
            for (int i = 0; i < 32; ++i) qv[i] = fminf(fmaxf(__builtin_rintf(hf[i] * i2), -7.f), 7.f);
            q2[0] = pack8_i4(qv); q2[1] = pack8_i4(qv + 8); q2[2] = pack8_i4(qv + 16); q2[3] = pack8_i4(qv + 24);
        }
        float coef0 = 0.f, coef1 = 0.f;
#pragma unroll 1
        for (int half = 0; half < 2; ++half) {
            float mydot = 0.f;
#define PEER_LOAD_U(W, SC, E0) _Pragma("unroll") for (int bq = 0; bq < 4; ++bq) { \
                const int eid = EID[tk * 128 + half * 64 + (E0) + bq]; const unsigned char* rowp = PU4 + (size_t)eid * PEER_ROWB; \
                SC[bq] = *reinterpret_cast<const bfr*>(rowp + 1024 + ln * 2); W[bq] = *reinterpret_cast<const uint4*>(rowp + ln * 16); } __builtin_amdgcn_sched_barrier(0);
#define PEER_DOT_U(W, SC, E0) _Pragma("unroll") for (int bq = 0; bq < 4; ++bq) { \
                int a1 = 0, a2 = 0; \
                a1 = __builtin_amdgcn_sdot8((int)W[bq].x, (int)q1[0], a1, false); a2 = __builtin_amdgcn_sdot8((int)W[bq].x, (int)q2[0], a2, false); \
                a1 = __builtin_amdgcn_sdot8((int)W[bq].y, (int)q1[1], a1, false); a2 = __builtin_amdgcn_sdot8((int)W[bq].y, (int)q2[1], a2, false); \
                a1 = __builtin_amdgcn_sdot8((int)W[bq].z, (int)q1[2], a1, false); a2 = __builtin_amdgcn_sdot8((int)W[bq].z, (int)q2[2], a2, false); \
                a1 = __builtin_amdgcn_sdot8((int)W[bq].w, (int)q1[3], a1, false); a2 = __builtin_amdgcn_sdot8((int)W[bq].w, (int)q2[3], a2, false); \
                float p = ((float)a1 * h1s + (float)a2 * h2s) * bf2f(SC[bq]); \
                p = wave_sum(p); if (lane == (E0) + bq) mydot = p; __builtin_amdgcn_sched_barrier(0); }
            {
                uint4 wA[4], wB[4]; bfr sA[4], sB[4];
                PEER_LOAD_U(wA, sA, 0)
#pragma unroll 1
                for (int e0 = 0; e0 < 56; e0 += 8) {
                    PEER_LOAD_U(wB, sB, e0 + 4)
                    PEER_DOT_U(wA, sA, e0)
                    PEER_LOAD_U(wA, sA, e0 + 8)
                    PEER_DOT_U(wB, sB, e0 + 4)
                }
                PEER_LOAD_U(wB, sB, 60)
                PEER_DOT_U(wA, sA, 56)
                PEER_DOT_U(wB, sB, 60)
            }
            const float gl = 0.5f * mydot * (1.f + erff(mydot * 0.7071067811865476f));
            const float cfv = gl * GATE[tk * 128 + half * 64 + lane];
            if (half == 0) coef0 = cfv; else coef1 = cfv;
        }
        h16x2 ov2[16];
#pragma unroll
        for (int j = 0; j < 16; ++j) ov2[j] = h16x2{(_Float16)0.f, (_Float16)0.f};
        {
#define PEER_LOAD_V(W, SC, E0) _Pragma("unroll") for (int bq = 0; bq < 4; ++bq) { \
                const int eid = __builtin_amdgcn_readfirstlane(EID[tk * 128 + (E0) + bq]); const unsigned char* rowp = PV4 + (size_t)eid * PEER_ROWB; \
                SC[bq] = *reinterpret_cast<const bfr*>(rowp + 1024 + ln * 2); W[bq] = *reinterpret_cast<const uint4*>(rowp + ln * 16); } __builtin_amdgcn_sched_barrier(0);
#define PEER_AXPY_V(W, SC, E0) _Pragma("unroll") for (int bq = 0; bq < 4; ++bq) { \
                const float cfl = __int_as_float(__builtin_amdgcn_readlane(__float_as_int(((E0) < 64) ? coef0 : coef1), ((E0) + bq) & 63)); \
                const unsigned dw[4] = {W[bq].x, W[bq].y, W[bq].z, W[bq].w}; const _Float16 ch = (_Float16)(cfl * bf2f(SC[bq])); const h16x2 c2 = {ch, ch}; \
                _Pragma("unroll") for (int d = 0; d < 4; ++d) { \
                    ov2[d * 4 + 0] = c2 * __builtin_amdgcn_cvt_scalef32_pk_f16_fp4(dw[d], 1.0f, 0) + ov2[d * 4 + 0]; \
                    ov2[d * 4 + 1] = c2 * __builtin_amdgcn_cvt_scalef32_pk_f16_fp4(dw[d], 1.0f, 1) + ov2[d * 4 + 1]; \
                    ov2[d * 4 + 2] = c2 * __builtin_amdgcn_cvt_scalef32_pk_f16_fp4(dw[d], 1.0f, 2) + ov2[d * 4 + 2]; \
                    ov2[d * 4 + 3] = c2 * __builtin_amdgcn_cvt_scalef32_pk_f16_fp4(dw[d], 1.0f, 3) + ov2[d * 4 + 3]; } \
                __builtin_amdgcn_sched_barrier(0); }
            uint4 wA[4], wB[4]; bfr sA[4], sB[4];
            PEER_LOAD_V(wA, sA, 0)
#pragma unroll 1
            for (int e0 = 0; e0 < 120; e0 += 8) {
                PEER_LOAD_V(wB, sB, e0 + 4)
                PEER_AXPY_V(wA, sA, e0)
                PEER_LOAD_V(wA, sA, e0 + 8)
                PEER_AXPY_V(wB, sB, e0 + 4)
            }
            PEER_LOAD_V(wB, sB, 124)
            PEER_AXPY_V(wA, sA, 120)
            PEER_AXPY_V(wB, sB, 124)
        }
        float ss = 0.f;
        float hv[32];
        { int l2 = lane; asm volatile("" : "+v"(l2));
#pragma unroll
          for (int q = 0; q < 8; ++q) {
              const uint2 xr = *reinterpret_cast<const uint2*>(&HB[(size_t)t * D + q * 256 + l2 * 4]);
              float4 x0; x0.x = bflo(xr.x); x0.y = bfhi(xr.x); x0.z = bflo(xr.y); x0.w = bfhi(xr.y);
              hv[q * 4 + 0] = x0.x; hv[q * 4 + 1] = x0.y; hv[q * 4 + 2] = x0.z; hv[q * 4 + 3] = x0.w;
          } }
#pragma unroll
        for (int j = 0; j < 32; ++j) { hv[j] += (DBG_NOPEER ? 0.f : (float)ov2[j >> 1][j & 1]); ss += hv[j] * hv[j]; }
        ss = wave_sum(ss);
        const float r2 = rsqrtf(ss * (1.f / D) + EPS);
#pragma unroll
        for (int q = 0; q < 8; ++q) {
            const float4 g0 = *reinterpret_cast<const float4*>(&a.in[I_NFIN][q * 256 + ln * 4]);
            float4 o0;
            o0.x = hv[q * 4 + 0] * r2 * g0.x; o0.y = hv[q * 4 + 1] * r2 * g0.y; o0.z = hv[q * 4 + 2] * r2 * g0.z; o0.w = hv[q * 4 + 3] * r2 * g0.w;
            *reinterpret_cast<float4*>(&a.out[(size_t)t * D + q * 256 + ln * 4]) = o0;
        }
    }
    __syncthreads();
}
constexpr int NPHASE = 9;
__global__ void __launch_bounds__(512, 2) mk_fwd(Args a) {
    extern __shared__ __attribute__((aligned(16))) unsigned char lds[];
    volatile LAS unsigned* barw = (volatile LAS unsigned*)((LAS unsigned char*)lds + LDS_BARW);
    unsigned* MISC = (unsigned*)(lds + LDS_MISC);
    if (threadIdx.x < 4) barw[threadIdx.x] = 0u;
    __syncthreads();
    XcdBarrier bar; bar.bar = (unsigned*)(a.ws + WS_CTL); bar.x = 0; bar.st = barw;
#if !MK_SPLIT
    bar = xcd_barrier_post((unsigned*)(a.ws + WS_CTL), barw);
#endif
    const int lo = a.ph_lo, hi = a.ph_hi;
#ifndef PH_MASK
#define PH_MASK 0x1FF
#endif
#define IN(k) (((PH_MASK >> (k)) & 1) && lo <= (k) && (k) < hi)
#ifndef DUP_RW
#define DUP_RW 0
#endif
#ifndef DUP_CHAIN
#define DUP_CHAIN 0
#endif
#ifndef DUP_MASK
#define DUP_MASK 0
#endif
#define REP(k) for (int rep_ = 0; rep_ < (((DUP_MASK >> (k)) & 1) ? 2 : 1); ++rep_)
#define SEAM(k) do { if (IN(k) && IN((k) + 1)) xcd_barrier(bar); } while (0)
    unsigned char* ws = a.ws;
    const bfr* P = (const bfr*)(ws + WS_P);

    if (IN(0)) REP(0) {
        const int tid = my_tid(), wv = tid >> 6; (void)tid; (void)wv;
        {
            const float* x = a.in[I_X]; const float* g = a.in[I_NMG]; bfr* XN = (bfr*)(ws + WS_XN);
            const int lane = tid & 63;
            for (int row = blockIdx.x * 8 + wv; row < T; row += gridDim.x * 8) {
                float4 v[8]; float ss = 0.f;
#pragma unroll
                for (int j = 0; j < 8; ++j) { v[j] = reinterpret_cast<const float4*>(x + (size_t)row * D)[j * 64 + lane]; ss += v[j].x * v[j].x + v[j].y * v[j].y + v[j].z * v[j].z + v[j].w * v[j].w; }
                ss = wave_sum(ss);
                const float rs = rsqrtf(ss * (1.f / D) + EPS);
#pragma unroll
                for (int j = 0; j < 8; ++j) {
                    const float4 gg = reinterpret_cast<const float4*>(g)[j * 64 + lane];
                    uint2 o; o.x = pack2(v[j].x * rs * gg.x, v[j].y * rs * gg.y); o.y = pack2(v[j].z * rs * gg.z, v[j].w * rs * gg.w);
                    reinterpret_cast<uint2*>(XN + (size_t)row * D)[j * 64 + lane] = o;
                }
            }
        }
        float* tl = (float*)lds;
        tr_all(a.in[I_WIN], (bfr*)(ws + WS_WTIN), D, NIN, NINP, nullptr, tl);
        tr_all(a.in[I_WBR], (bfr*)(ws + WS_WTA), RW, D, D, nullptr, tl);
        tr_all(a.in[I_WBD], (bfr*)(ws + WS_WTB), RW, D, D, nullptr, tl);
        tr_all(a.in[I_WOUT], (bfr*)(ws + WS_WTOUT), D, D, D, nullptr, tl);
        tr_all(a.in[I_WPQ], (bfr*)(ws + WS_WTPQ), D, D, D, a.in[I_NFG], tl);
        for (int it = blockIdx.x; it < 16 * 4; it += gridDim.x) {
            const int h = it >> 2, k0 = (it & 3) * 64;
            tr_tile(a.in[I_WUV] + (size_t)h * 256 * 64, (bfr*)(ws + WS_WUVT) + (size_t)h * 64 * 256, 256, 64, k0, 0, nullptr, tl);
        }
        cvt_all(a.in[I_WUK], (bfr*)(ws + WS_WUK), (size_t)16 * 256 * 64);
        cvt_all(a.in[I_SUBK], (bfr*)(ws + WS_SUBK), (size_t)16 * 128 * 128);
    }
    SEAM(0);

    if (IN(1)) REP(1) {
        const int tid = my_tid(), wv = tid >> 6; (void)tid; (void)wv;
        EpiP E{(bfr*)(ws + WS_P)};
        const int nM = T / BM, nN = NINP / BM;
        for (int tile = blockIdx.x; tile < nM * nN; tile += gridDim.x) {
            int brow, bcol; tile_rc(tile, nM, nN, brow, bcol);
            gemm_tile((const bfr*)(ws + WS_XN), (const bfr*)(ws + WS_WTIN), D, brow, bcol, (bfr*)lds, E);
        }
        {
            const int rem = (nM * nN) % (int)gridDim.x, idle = (int)gridDim.x - rem;
            if (rem == 0) cvt_i4_rows(a.in[I_PU], ws + WS_PU, blockIdx.x, gridDim.x);
            else if ((int)blockIdx.x >= rem) cvt_i4_rows(a.in[I_PU], ws + WS_PU, (int)blockIdx.x - rem, idle);
        }
    }
    SEAM(1);

    if (IN(2)) REP(2) {
        const int tid = my_tid(), wv = tid >> 6; (void)tid; (void)wv;
        rwkv_load_weights(a, blockIdx.x & 15, lds);
        {
            const int h = blockIdx.x & 15, nun = (NUNIT - (int)blockIdx.x + (int)gridDim.x - 1) / (int)gridDim.x;
            RwIn inA, inB;
            if (nun > 0) rwkv_fetch(a, (int)blockIdx.x >> 4, h, inA);
            for (int k = 0; k < nun; k += 2) {
                const int c0 = ((int)blockIdx.x + k * (int)gridDim.x) >> 4, c1 = ((int)blockIdx.x + (k + 1) * (int)gridDim.x) >> 4, c2 = ((int)blockIdx.x + (k + 2) * (int)gridDim.x) >> 4;
                rwkv_unit(a, c0, h, lds, inA, inB, (k + 1 < nun) ? c1 : -1);
                if (k + 1 < nun) rwkv_unit(a, c1, h, lds, inB, inA, (k + 2 < nun) ? c2 : -1);
            }
        }
        dsa_cnorm(a);
        dsa_qlat(a);
    }
    SEAM(2);

    if (IN(3)) REP(3) {
        const int tid = my_tid(), wv = tid >> 6; (void)tid; (void)wv;
        if (blockIdx.x < 32) {
            if (wv == 0) rwkv_chain(a, blockIdx.x >> 1, blockIdx.x & 1);
            else cvt_fp4_rows(a.in[I_PV], ws + WS_PV, (int)blockIdx.x * 7 + (wv - 1), 32 * 7);
        }
        __syncthreads();
        for (int i = tid; i < 512; i += 512) ((float*)(lds + DSA_RELB_OFF))[i] = a.in[I_RELB][i];
        __syncthreads();
        unsigned* cnt = (unsigned*)(ws + WS_CTL + CTL_CNT) + rep_ * 64;
        for (;;) {
            if (tid == 0) MISC[0] = atomicAdd(cnt, 1u);
            __syncthreads();
            const unsigned n = MISC[0];
            __syncthreads();
            if (n >= T / 8) break;
            dsa_unit(a, (T / 8 - 1) - (int)n, lds);
        }
    }
    SEAM(3);

    if (IN(4)) REP(4) {
        const int tid = my_tid(), wv = tid >> 6; (void)tid; (void)wv;
        float* Ls = (float*)lds + wv * 4352;
        for (int u = blockIdx.x * 8 + wv; u < NUNIT; u += gridDim.x * 8) rwkv_out_unit(a, u, Ls);
        dsa_oproj(a);
    }
    SEAM(4);

    if (IN(5)) REP(5) {
        const int tid = my_tid(), wv = tid >> 6; (void)tid; (void)wv;
        const int nM = T / BM, nN = D / BM;
        for (int tile = blockIdx.x; tile < nM * nN; tile += gridDim.x) {
            int brow, bcol; tile_rc(tile, nM, nN, brow, bcol);
#pragma unroll 1
            for (int pass = 0; pass < 2; ++pass) {
                EpiMix E{(bfr*)(ws + (pass ? WS_MIX : WS_TMPA)), pass ? (const bfr*)(ws + WS_TMPA) : (const bfr*)nullptr, P + (pass ? C_GB : C_GA)};
                gemm_tile((const bfr*)(ws + (pass ? WS_DO : WS_RWO)), (const bfr*)(ws + (pass ? WS_WTB : WS_WTA)), RW, brow, bcol, (bfr*)lds, E);
                asm volatile("s_waitcnt vmcnt(0)" ::: "memory");
            }
        }
    }
    SEAM(5);

    if (IN(6)) REP(6) {
        const int tid = my_tid(), wv = tid >> 6; (void)tid; (void)wv;
        const int nM = T / BM, nN = D / BM;
        for (int tile = blockIdx.x; tile < nM * nN; tile += gridDim.x) {
            int brow, bcol; tile_rc(tile, nM, nN, brow, bcol);
            EpiH E{(bfr*)(ws + WS_HB), a.in[I_X], (float*)(ws + WS_PART), bcol >> 8};
            gemm_tile((const bfr*)(ws + WS_MIX), (const bfr*)(ws + WS_WTOUT), D, brow, bcol, (bfr*)lds, E);
        }
    }
    SEAM(6);

    if (IN(7)) REP(7) {
        const int tid = my_tid(), wv = tid >> 6; (void)tid; (void)wv;
        const int nM = T / BM, nN = D / BM;
        float* rs = (float*)(lds + 135168);
        for (int tile = blockIdx.x; tile < nM * nN; tile += gridDim.x) {
            int brow, bcol; tile_rc(tile, nM, nN, brow, bcol);
            if (tid < 256) rs[tid] = row_rstd((const float*)(ws + WS_PART), brow + tid);
            __syncthreads();
            EpiQ E{(bfr*)(ws + WS_QP), rs, brow};
            gemm_tile((const bfr*)(ws + WS_HB), (const bfr*)(ws + WS_WTPQ), D, brow, bcol, (bfr*)lds, E);
        }
    }
    SEAM(7);

    if (IN(8)) REP(8) {
        const int tid = my_tid(), wv = tid >> 6; (void)tid; (void)wv;
        for (int u = blockIdx.x; u < T / 16; u += gridDim.x) peer_unit(a, u, lds);
    }
#undef IN
#undef SEAM
}

extern "C" void kernel_launch(void* const* d_in, const int* in_sizes, int n_in, void* d_out, int out_size, void* d_ws, size_t ws_size, hipStream_t stream) {
    static int grid = 0;
    if (grid == 0) {
        if (n_in != 27 || out_size != T * D || ws_size < WS_END) { fprintf(stderr, "kernel_launch: unexpected shapes (n_in %d out %d ws %zu)\n", n_in, out_size, ws_size); grid = -1; return; }
        int dev = 0, cus = 0, per_cu = 0;
        if (hipGetDevice(&dev) != hipSuccess || hipDeviceGetAttribute(&cus, hipDeviceAttributeMultiprocessorCount, dev) != hipSuccess) { grid = -1; return; }
        if (hipFuncSetAttribute((const void*)mk_fwd, hipFuncAttributeMaxDynamicSharedMemorySize, LDS_BYTES) != hipSuccess) { fprintf(stderr, "kernel_launch: hipFuncSetAttribute failed\n"); grid = -1; return; }
        if (hipOccupancyMaxActiveBlocksPerMultiprocessor(&per_cu, (const void*)mk_fwd, 512, LDS_BYTES) != hipSuccess || per_cu < 1) { fprintf(stderr, "kernel_launch: occupancy query says %d\n", per_cu); (void)hipGetLastError(); grid = -1; return; }
        grid = cus;
    }
    if (grid < 0) return;
    if (hipMemsetAsync((char*)d_ws + WS_CTL, 0, CTL_ZERO, stream) != hipSuccess) return;
    Args a{};
    for (int i = 0; i < 27; ++i) a.in[i] = (const float*)d_in[i];
    a.out = (float*)d_out; a.ws = (unsigned char*)d_ws;
#if MK_SPLIT
    for (int ph = 0; ph < NPHASE; ++ph) { a.ph_lo = ph; a.ph_hi = ph + 1; hipLaunchKernelGGL(mk_fwd, dim3(grid), dim3(512), LDS_BYTES, stream, a); }
#elif defined(PROBE_PHASE)
    a.ph_lo = 0; a.ph_hi = PROBE_PHASE + 1;
    hipLaunchKernelGGL(mk_fwd, dim3(grid), dim3(512), LDS_BYTES, stream, a);
    (void)hipMemsetAsync((char*)d_ws + WS_CTL, 0, CTL_ZERO, stream);
    a.ph_lo = PROBE_PHASE; a.ph_hi = NPHASE;
    hipLaunchKernelGGL(mk_fwd, dim3(grid), dim3(512), LDS_BYTES, stream, a);
#else
    a.ph_lo = 0; a.ph_hi = NPHASE;
    hipLaunchKernelGGL(mk_fwd, dim3(grid), dim3(512), LDS_BYTES, stream, a);
#endif
}
```

```cpp
#include <hip/hip_runtime.h>
#include <stdint.h>
#include <stdio.h>

#ifndef MK_SPLIT
#define MK_SPLIT 0
#endif

#ifndef DBG_NOPEER
#define DBG_NOPEER 0
#endif
#ifndef DBG_NODSA
#define DBG_NODSA 0
#endif
typedef unsigned short bfr;
using bf16x8 = __attribute__((ext_vector_type(8))) short;
using bf16x4 = __attribute__((ext_vector_type(4))) short;
using f32x4  = __attribute__((ext_vector_type(4))) float;
using f32x2  = __attribute__((ext_vector_type(2))) float;
using f32x16 = __attribute__((ext_vector_type(16))) float;
using u32x4  = __attribute__((ext_vector_type(4))) unsigned;
using h16x2  = __attribute__((ext_vector_type(2))) _Float16;

constexpr int T = 8192, D = 2048, NIN = 9320, NINP = 9472;
constexpr int RW = 1024, NH = 16, HD = 64;
constexpr int C_R = 0, C_K = 1024, C_V = 2048, C_ZW = 3072, C_ZA = 3136, C_ZG = 3200, C_Q = 3360, C_CKV = 4384,
              C_IQ = 4640, C_IK = 5152, C_IW = 5216, C_GA = 5224, C_GB = 7272;
constexpr int KVR = 256, NUNIT = 128 * 16;
constexpr float EPS = 1e-6f;

constexpr size_t MiB = 1u << 20;
constexpr size_t WS_CTL = 0;
constexpr size_t CTL_ZERO = 65536;
constexpr size_t CTL_CNT = 16384;
constexpr size_t CTL_ROWSS = 32768;
constexpr size_t WS_WTA = 1 * MiB, WS_WTB = 5 * MiB, WS_WTOUT = 9 * MiB, WS_WTPQ = 17 * MiB;
constexpr size_t WS_WUK = 25 * MiB, WS_WUVT = 25 * MiB + 512 * 1024, WS_SUBK = 26 * MiB;
constexpr size_t WS_X = 27 * MiB;
constexpr size_t WS_XN = WS_X, WS_WTIN = WS_X + 32 * MiB;
constexpr size_t WS_PM = WS_X, WS_WY = WS_X + 16 * MiB, WS_GM = WS_X + 32 * MiB, WS_YLOC = WS_X + 48 * MiB;
constexpr size_t WS_MIX = WS_X;
constexpr size_t WS_P = 96 * MiB;
constexpr size_t WS_H = 96 * MiB, WS_HB = 160 * MiB, WS_QP = 192 * MiB;
constexpr size_t WS_GG = 244 * MiB, WS_BON = 260 * MiB, WS_CB = 276 * MiB;
constexpr size_t WS_QLAT = 280 * MiB, WS_OLAT = WS_QLAT;
constexpr size_t WS_KEYS = 344 * MiB;
constexpr size_t WS_PU = 490 * MiB, WS_PV = 312 * MiB;
constexpr size_t WS_PUS = WS_PU + 32 * MiB, WS_PVS = WS_PV + 32 * MiB;
constexpr size_t WS_ZT = 408 * MiB, WS_RWO = 424 * MiB, WS_DO = 440 * MiB, WS_TMPA = 456 * MiB;
constexpr size_t WS_IKC = 489 * MiB;
constexpr size_t WS_PART = 488 * MiB;
constexpr size_t WS_END = 508 * MiB;

constexpr int LDS_BYTES = 163840 - 1024;
constexpr int LDS_BARW = LDS_BYTES - 64;
constexpr int LDS_MISC = LDS_BYTES - 512;

typedef __bf16 bf16v2_t __attribute__((ext_vector_type(2)));
__device__ __forceinline__ bfr f2bf(float f) { const __bf16 r = (__bf16)f; return __builtin_bit_cast(bfr, r); }
__device__ __forceinline__ float bf2f(bfr b) { return __uint_as_float(((unsigned)b) << 16); }
__device__ __forceinline__ unsigned pack2(float a, float b) { const f32x2 v = {a, b}; const bf16v2_t r = __builtin_convertvector(v, bf16v2_t); return __builtin_bit_cast(unsigned, r); }
__device__ __forceinline__ float bflo(unsigned u) { return __uint_as_float(u << 16); }
__device__ __forceinline__ float bfhi(unsigned u) { return __uint_as_float(u & 0xFFFF0000u); }
__device__ __forceinline__ int my_tid() { int t = threadIdx.x; asm volatile("" : "+v"(t)); return t; }

template <int CTRL> __device__ __forceinline__ float dpp_f(float v) {
    return __int_as_float(__builtin_amdgcn_update_dpp(0, __float_as_int(v), CTRL, 0xF, 0xF, true));
}
#define DPP_XOR1 0xB1
#define DPP_XOR2 0x4E
__device__ __forceinline__ float wave_sum(float v) {
    v += dpp_f<DPP_XOR1>(v); v += dpp_f<DPP_XOR2>(v); v += dpp_f<0x141>(v); v += dpp_f<0x140>(v);
    v += __shfl_xor(v, 16); v += __shfl_xor(v, 32); return v;
}
__device__ __forceinline__ float frcp_(float x) { return __builtin_amdgcn_rcpf(x); }
__device__ __forceinline__ float sigmoidf_(float x) { return frcp_(1.f + __expf(-x)); }

#define XB_TMO      128
#define XB_XCNT(j)  (256  + 64 * (j))
#define XB_XSUB(j)  (1280 + 64 * (j))
#define XB_XGEN(j)  (2304 + 64 * (j))
#define XB_TOP      3328
#define XB_TOPGEN   3392
#define XCD_BAR_WORDS 3456
#define XB_SPIN_CAP (1u << 20)
#define LAS __attribute__((address_space(3)))

__device__ __forceinline__ unsigned xb_ld(unsigned* p)              { return __hip_atomic_load(p, __ATOMIC_RELAXED, __HIP_MEMORY_SCOPE_AGENT); }
__device__ __forceinline__ unsigned xb_add(unsigned* p, unsigned v) { return __hip_atomic_fetch_add(p, v, __ATOMIC_RELAXED, __HIP_MEMORY_SCOPE_AGENT); }
__device__ __forceinline__ unsigned xb_xcc_id() { return (unsigned)__builtin_amdgcn_s_getreg((3 << 11) | 20) & 0xFu; }
#define XB_SPIN(cond, bar) do { unsigned _sp = 0; while (cond) { __builtin_amdgcn_s_sleep(1); \
    if ((++_sp & 255u) == 0u) { if (xb_ld(&(bar)[XB_TMO])) break; if (_sp > XB_SPIN_CAP) { atomicAdd(&(bar)[XB_TMO], 1u); break; } } } } while (0)

struct XcdBarrier { unsigned* bar; unsigned x; volatile LAS unsigned* st; };

__device__ __forceinline__ XcdBarrier xcd_barrier_post(unsigned* bar, volatile LAS unsigned* st) {
    XcdBarrier b; b.bar = bar; b.x = xb_xcc_id(); b.st = st;
    if (threadIdx.x == 0) (void)xb_add(&bar[XB_XCNT(b.x)], 1u);
    return b;
}
__device__ __forceinline__ void xcd_barrier_complete(unsigned* bar, unsigned x, unsigned& nloc, unsigned& nx) {
    const unsigned G = gridDim.x * gridDim.y * gridDim.z;
    unsigned sum, cnt, mine, sp = 0u;
    for (;;) {
        sum = 0u; cnt = 0u; mine = 0u;
#pragma unroll
        for (unsigned j = 0; j < 16; ++j) { const unsigned c = xb_ld(&bar[XB_XCNT(j)]); sum += c; cnt += (c > 0u) ? 1u : 0u; mine = (j == x) ? c : mine; }
        if (sum == G) break;
        __builtin_amdgcn_s_sleep(1);
        if ((++sp & 255u) == 0u) { if (xb_ld(&bar[XB_TMO])) break; if (sp > XB_SPIN_CAP) { atomicAdd(&bar[XB_TMO], 1u); break; } }
    }
    nloc = mine > 0u ? mine : 1u; nx = cnt > 0u ? cnt : 1u;
}
__device__ __forceinline__ void xcd_barrier(const XcdBarrier& b) {
    asm volatile("s_waitcnt vmcnt(0)" ::: "memory");
    __syncthreads();
    if (threadIdx.x == 0) {
        unsigned* bar = b.bar;
        __builtin_amdgcn_s_waitcnt(0);
        unsigned nloc = b.st[0], nx = b.st[1];
        if (nloc == 0u) { xcd_barrier_complete(bar, b.x, nloc, nx); b.st[0] = nloc; b.st[1] = nx; }
        const unsigned old = xb_add(&bar[XB_XSUB(b.x)], 1u);
        const unsigned gen = old / nloc;
        if (old + 1u == (gen + 1u) * nloc) {
            __builtin_amdgcn_fence(__ATOMIC_RELEASE, "agent");
            asm volatile("s_waitcnt vmcnt(0)" ::: "memory");
            const unsigned og = xb_add(&bar[XB_TOP], 1u);
            const unsigned tg = og / nx;
            if (og + 1u == (tg + 1u) * nx) xb_add(&bar[XB_TOPGEN], 1u);
            else XB_SPIN(xb_ld(&bar[XB_TOPGEN]) == tg, bar);
            __builtin_amdgcn_fence(__ATOMIC_ACQUIRE, "agent");
            xb_add(&bar[XB_XGEN(b.x)], 1u);
            asm volatile("s_waitcnt vmcnt(0)" ::: "memory");
        } else {
            XB_SPIN(xb_ld(&bar[XB_XGEN(b.x)]) == gen, bar);
            __builtin_amdgcn_fence(__ATOMIC_ACQUIRE, "agent");
            asm volatile("s_waitcnt vmcnt(0)" ::: "memory");
        }
    }
    __syncthreads();
}

struct Args { const float* in[27]; float* out; unsigned char* ws; int ph_lo, ph_hi; };
enum { I_X = 0, I_NMG, I_WIN, I_SHIFT, I_W0, I_WDEC, I_A0, I_WICL, I_WGATE, I_KK, I_KA, I_RK, I_LNW, I_LNB, I_KVG, I_WUK, I_WUV,
       I_RELB, I_WBR, I_WBD, I_WOUT, I_NFG, I_WPQ, I_SUBK, I_PU, I_PV, I_NFIN };

constexpr int BM = 256, BK = 64, HALF = 128, HT = HALF * BK;
constexpr int EPI_LDW = 260;
__device__ __forceinline__ int lds_byte(int r, int c) {
    int st = (r >> 4) * 2 + (c >> 5), rr = r & 15, cc = c & 31, ob = rr * 64 + cc * 2;
    return st * 1024 + (ob ^ (((ob >> 9) & 1) << 5));
}
__device__ __forceinline__ void stage_rc(int b, int& R, int& C) {
    int st = b / 1024, sb = b % 1024, swz = sb ^ (((sb >> 9) & 1) << 5);
    R = (st >> 1) * 16 + swz / 64; C = (st & 1) * 32 + (swz % 64) / 2;
}

template <class Epi>
__device__ __forceinline__ void gemm_tile(const bfr* __restrict__ A, const bfr* __restrict__ Bt, const int K, const int brow, const int bcol,
                                          bfr* shm, Epi& epi) {
#define SA(b,h) (shm+((b)*2+(h))*HT)
#define SB(b,h) (shm+(4+(b)*2+(h))*HT)
#define STAGE_X(TT,P,BASE,br,kt) do{long _g=(long)(br)*K+(long)(kt)*BK; \
    for(int _i=0;_i<2;++_i){int _b=(TT)*16+_i*8192;int _r,_c;stage_rc(_b,_r,_c); \
      __builtin_amdgcn_global_load_lds((const unsigned*)(BASE+_g+(long)_r*K+_c), \
        (LAS unsigned*)((LAS char*)(P)+_b),16,0,0);}}while(0)
#define STAGE(P,BASE,br,kt) STAGE_X(tq,P,BASE,br,kt)
#define LDA(dst,b,h) for(int m=0;m<4;++m)for(int k=0;k<2;++k) \
    dst[m][k]=*reinterpret_cast<const bf16x8*>((char*)SA(b,h)+lds_byte(wr*64+m*16+fr,k*32+fq*8))
#define LDB(dst,b,h) for(int n=0;n<2;++n)for(int k=0;k<2;++k) \
    dst[n][k]=*reinterpret_cast<const bf16x8*>((char*)SB(b,h)+lds_byte(wc*32+n*16+fr,k*32+fq*8))
#define MMA(ai,bj,At_,Bt_) do{__builtin_amdgcn_s_setprio(1); \
    for(int m=0;m<4;++m)for(int n=0;n<2;++n)for(int k=0;k<2;++k) \
      acc[ai][bj][m][n]=__builtin_amdgcn_mfma_f32_16x16x32_bf16(At_[m][k],Bt_[n][k],acc[ai][bj][m][n],0,0,0); \
    __builtin_amdgcn_s_setprio(0);}while(0)
#define WAIT_V(n) asm volatile("s_waitcnt vmcnt(" #n ")":::"memory")
#define WAIT_L(n) asm volatile("s_waitcnt lgkmcnt(" #n ")":::"memory")
#define BAR __builtin_amdgcn_s_barrier()
#define SCHED __builtin_amdgcn_sched_barrier(0)
    const int tq = my_tid();
    int wid = tq >> 6, lane = tq & 63, wr = wid >> 2, wc = wid & 3, fr = lane & 15, fq = lane >> 4;
    f32x4 acc[2][2][4][2] = {};
    bf16x8 At[4][2], B0[2][2], B1[2][2];
    const int nt = K / BK;
    STAGE(SB(0,0),Bt,bcol,0); STAGE(SA(0,0),A,brow,0);
    STAGE(SB(0,1),Bt,bcol+HALF,0); STAGE(SA(0,1),A,brow+HALF,0);
    if(wr==1)BAR;
    WAIT_V(4); BAR;
    STAGE(SB(1,0),Bt,bcol,1); STAGE(SA(1,0),A,brow,1); STAGE(SB(1,1),Bt,bcol+HALF,1);
    WAIT_V(6); BAR;
    for(int t=0;t<nt-2;t+=2){
        LDB(B0,0,0); SCHED; LDA(At,0,0); STAGE(SA(1,1),A,brow+HALF,t+1);
        WAIT_L(8); BAR; WAIT_L(0); MMA(0,0,At,B0); BAR; SCHED;
        LDB(B1,0,1); STAGE(SB(0,0),Bt,bcol,t+2);
        BAR; WAIT_L(0); MMA(0,1,At,B1); BAR;
        LDA(At,0,1); STAGE(SA(0,0),A,brow,t+2);
        BAR; WAIT_L(0); MMA(1,0,At,B0); BAR; SCHED;
        STAGE(SB(0,1),Bt,bcol+HALF,t+2);
        WAIT_V(6); BAR; MMA(1,1,At,B1); BAR;
        LDB(B0,1,0); SCHED; LDA(At,1,0); STAGE(SA(0,1),A,brow+HALF,t+2);
        WAIT_L(8); BAR; WAIT_L(0); MMA(0,0,At,B0); BAR; SCHED;
        LDB(B1,1,1); STAGE(SB(1,0),Bt,bcol,t+3);
        BAR; WAIT_L(0); MMA(0,1,At,B1); BAR;
        LDA(At,1,1); STAGE(SA(1,0),A,brow,t+3);
        BAR; WAIT_L(0); MMA(1,0,At,B0); BAR; SCHED;
        STAGE(SB(1,1),Bt,bcol+HALF,t+3);
        WAIT_V(6); BAR; MMA(1,1,At,B1); BAR;
    }
    int tz=threadIdx.x; asm volatile("":"+v"(tz)); wid=tz>>6; lane=tz&63; wr=wid>>2; wc=wid&3; fr=lane&15; fq=lane>>4;
    { LDB(B0,0,0); WAIT_V(0); LDA(At,0,0); STAGE_X(tz,SA(1,1),A,brow+HALF,nt-1);
      BAR; WAIT_L(0); MMA(0,0,At,B0); BAR;
      LDB(B1,0,1); BAR; WAIT_L(0); MMA(0,1,At,B1); BAR;
      LDA(At,0,1); WAIT_V(4); BAR; WAIT_L(0); MMA(1,0,At,B0); MMA(1,1,At,B1); BAR; }
    { LDB(B0,1,0); LDA(At,1,0); WAIT_V(2); BAR; WAIT_L(0); MMA(0,0,At,B0); BAR;
      LDB(B1,1,1); WAIT_V(0); BAR; WAIT_L(0); MMA(0,1,At,B1); BAR;
      LDA(At,1,1); BAR; WAIT_L(0); MMA(1,0,At,B0); MMA(1,1,At,B1); BAR; }
    if(wr==0)BAR;
    {
        float* stg = (float*)shm;
#pragma unroll
        for (int ai = 0; ai < 2; ++ai) {
            __syncthreads();
#pragma unroll
            for (int bj = 0; bj < 2; ++bj)
#pragma unroll
                for (int m = 0; m < 4; ++m)
#pragma unroll
                    for (int n = 0; n < 2; ++n)
#pragma unroll
                        for (int j = 0; j < 4; ++j) stg[(wr * 64 + m * 16 + fq * 4 + j) * EPI_LDW + bj * HALF + wc * 32 + n * 16 + fr] = acc[ai][bj][m][n][j];
            __syncthreads();
#pragma unroll 2
            for (int it = 0; it < 8; ++it) {
                const int r = it * 16 + wid * 2 + (lane >> 5), c = (lane & 31) * 8;
                const float4 v0 = *reinterpret_cast<const float4*>(&stg[r * EPI_LDW + c]);
                const float4 v1 = *reinterpret_cast<const float4*>(&stg[r * EPI_LDW + c + 4]);
                const float v[8] = {v0.x, v0.y, v0.z, v0.w, v1.x, v1.y, v1.z, v1.w};
                epi.vec8(brow + ai * HALF + r, bcol + c, v);
            }
        }
    }
    __syncthreads();
#undef SA
#undef SB
#undef STAGE_X
#undef STAGE
#undef LDA
#undef LDB
#undef MMA
}

__device__ __forceinline__ void tile_rc(int wgid, const int nM, const int nN, int& brow, int& bcol) {
    const int nwg = nM * nN;
    { int q = nwg / 8, r = nwg % 8, xcd = wgid % 8, off = wgid / 8; wgid = (xcd < r ? xcd * (q + 1) : r * (q + 1) + (xcd - r) * q) + off; }
    const int nig = 8 * nN, gid = wgid / nig, fm = gid * 8, gsz = min(nM - fm, 8);
    const int pm = fm + ((wgid % nig) % gsz), pn = (wgid % nig) / gsz;
    brow = pm * BM; bcol = pn * BM;
}

__device__ __forceinline__ uint4 pack8(const float* v) { uint4 o; o.x = pack2(v[0], v[1]); o.y = pack2(v[2], v[3]); o.z = pack2(v[4], v[5]); o.w = pack2(v[6], v[7]); return o; }
__device__ __forceinline__ void unpack8(const uint4 u, float* v) { v[0] = bflo(u.x); v[1] = bfhi(u.x); v[2] = bflo(u.y); v[3] = bfhi(u.y); v[4] = bflo(u.z); v[5] = bfhi(u.z); v[6] = bflo(u.w); v[7] = bfhi(u.w); }
struct EpiP {
    bfr* P;
    __device__ __forceinline__ void vec8(int row, int col, const float* v) { *reinterpret_cast<uint4*>(&P[(size_t)row * NINP + col]) = pack8(v); }
};
struct EpiMix {
    bfr* outp; const bfr* addp; const bfr* gate;
    __device__ __forceinline__ void vec8(int row, int col, const float* v) {
        float g[8], r[8];
        unpack8(*reinterpret_cast<const uint4*>(&gate[(size_t)row * NINP + col]), g);
#pragma unroll
        for (int i = 0; i < 8; ++i) r[i] = sigmoidf_(g[i]) * v[i];
        if (addp) { float t[8]; unpack8(*reinterpret_cast<const uint4*>(&addp[(size_t)row * D + col]), t);
#pragma unroll
            for (int i = 0; i < 8; ++i) r[i] += t[i]; }
        *reinterpret_cast<uint4*>(&outp[(size_t)row * D + col]) = pack8(r);
    }
};
struct EpiH {
    bfr* hb; const float* x; float* part; int slot;
    __device__ __forceinline__ void vec8(int row, int col, const float* v) {
        const float4 x0 = *reinterpret_cast<const float4*>(&x[(size_t)row * D + col]), x1 = *reinterpret_cast<const float4*>(&x[(size_t)row * D + col + 4]);
        float h[8] = {x0.x + v[0], x0.y + v[1], x0.z + v[2], x0.w + v[3], x1.x + v[4], x1.y + v[5], x1.z + v[6], x1.w + v[7]};
        *reinterpret_cast<uint4*>(&hb[(size_t)row * D + col]) = pack8(h);
        float s = 0.f;
#pragma unroll
        for (int i = 0; i < 8; ++i) s += h[i] * h[i];
        s += dpp_f<DPP_XOR1>(s); s += dpp_f<DPP_XOR2>(s); s += dpp_f<0x141>(s); s += dpp_f<0x140>(s);
        s += __shfl_xor(s, 16);
        if ((threadIdx.x & 31) == 0) part[(size_t)row * 8 + slot] = s;
    }
};
struct EpiQ {
    bfr* qp; const float* rs; int brow;
    __device__ __forceinline__ void vec8(int row, int col, const float* v) {
        const float sc = rs[row - brow]; float r[8];
#pragma unroll
        for (int i = 0; i < 8; ++i) r[i] = v[i] * sc;
        *reinterpret_cast<uint4*>(&qp[(size_t)row * D + col]) = pack8(r);
    }
};
__device__ __forceinline__ float row_rstd(const float* part, int row) {
    float s = 0.f;
#pragma unroll
    for (int i = 0; i < 8; ++i) s += part[(size_t)row * 8 + i];
    return rsqrtf(s * (1.f / D) + EPS);
}

__device__ __forceinline__ void tr_tile(const float* __restrict__ src, bfr* __restrict__ dst, int K, int N, int k0, int n0, const float* kscale, float* lds) {
    const int tid = my_tid(), n = tid & 63, kk = tid >> 6;
#pragma unroll
    for (int j = 0; j < 8; ++j) { int k = kk + 8 * j, gn = n0 + n; float v = (gn < N) ? src[(size_t)(k0 + k) * N + gn] : 0.f; if (kscale) v *= kscale[k0 + k]; lds[k * 65 + n] = v; }
    __syncthreads();
    const int nn = tid >> 3, ks = tid & 7;
    uint4 o;
    o.x = pack2(lds[(ks * 8 + 0) * 65 + nn], lds[(ks * 8 + 1) * 65 + nn]); o.y = pack2(lds[(ks * 8 + 2) * 65 + nn], lds[(ks * 8 + 3) * 65 + nn]);
    o.z = pack2(lds[(ks * 8 + 4) * 65 + nn], lds[(ks * 8 + 5) * 65 + nn]); o.w = pack2(lds[(ks * 8 + 6) * 65 + nn], lds[(ks * 8 + 7) * 65 + nn]);
    *reinterpret_cast<uint4*>(&dst[(size_t)(n0 + nn) * K + k0 + ks * 8]) = o;
    __syncthreads();
}
struct StripRegs { float v[8][4]; };
__device__ __forceinline__ void strip_load(const float* __restrict__ src, int N, int k0, int n0, StripRegs& R) {
    const int tid = my_tid(), n = tid & 63, kk = tid >> 6;
#pragma unroll
    for (int j = 0; j < 8; ++j)
#pragma unroll
        for (int q = 0; q < 4; ++q) { const int gn = n0 + q * 64 + n; R.v[j][q] = (gn < N) ? src[(size_t)(k0 + kk + 8 * j) * N + gn] : 0.f; }
}
__device__ __forceinline__ void strip_store(const StripRegs& R, bfr* __restrict__ dst, int K, int k0, int n0, const float* kscale, float* lds) {
    const int tid = my_tid(), n = tid & 63, kk = tid >> 6;
#pragma unroll
    for (int j = 0; j < 8; ++j) {
        const float sc = kscale ? kscale[k0 + kk + 8 * j] : 1.f;
#pragma unroll
        for (int q = 0; q < 4; ++q) lds[(kk + 8 * j) * 257 + q * 64 + n] = R.v[j][q] * sc;
    }
    __syncthreads();
    const int nn = tid >> 1, hf = tid & 1;
#pragma unroll
    for (int c = 0; c < 4; ++c) {
        const int kb = hf * 32 + c * 8;
        uint4 o;
        o.x = pack2(lds[(kb + 0) * 257 + nn], lds[(kb + 1) * 257 + nn]); o.y = pack2(lds[(kb + 2) * 257 + nn], lds[(kb + 3) * 257 + nn]);
        o.z = pack2(lds[(kb + 4) * 257 + nn], lds[(kb + 5) * 257 + nn]); o.w = pack2(lds[(kb + 6) * 257 + nn], lds[(kb + 7) * 257 + nn]);
        *reinterpret_cast<uint4*>(&dst[(size_t)(n0 + nn) * K + k0 + kb]) = o;
    }
    __syncthreads();
}
__device__ __forceinline__ void tr_all(const float* src, bfr* dst, int K, int N, int Npad, const float* kscale, float* lds) {
    if ((Npad & 255) == 0) {
        const int nk = K / 64, ns = Npad / 256, tot = nk * ns;
        StripRegs RA, RB;
        int it = blockIdx.x;
        if (it < tot) strip_load(src, N, (it % nk) * 64, (it / nk) * 256, RA);
        while (it < tot) {
            const int itn = it + gridDim.x, it2 = itn + gridDim.x;
            if (itn < tot) strip_load(src, N, (itn % nk) * 64, (itn / nk) * 256, RB);
            strip_store(RA, dst, K, (it % nk) * 64, (it / nk) * 256, kscale, lds);
            if (itn >= tot) break;
            if (it2 < tot) strip_load(src, N, (it2 % nk) * 64, (it2 / nk) * 256, RA);
            strip_store(RB, dst, K, (itn % nk) * 64, (itn / nk) * 256, kscale, lds);
            it = it2;
        }
        return;
    }
    const int nk = K / 64, nn = Npad / 64;
    for (int it = blockIdx.x; it < nk * nn; it += gridDim.x) tr_tile(src, dst, K, N, (it % nk) * 64, (it / nk) * 64, kscale, lds);
}
__device__ __forceinline__ void cvt_all(const float* __restrict__ src, bfr* __restrict__ dst, size_t n) {
    const size_t n4 = n / 4;
    for (size_t i = (size_t)blockIdx.x * 512 + my_tid(); i < n4; i += (size_t)gridDim.x * 512) {
        float4 v = reinterpret_cast<const float4*>(src)[i];
        uint2 o; o.x = pack2(v.x, v.y); o.y = pack2(v.z, v.w);
        reinterpret_cast<uint2*>(dst)[i] = o;
    }
}

constexpr int PEER_ROWB = 1152;
__device__ __forceinline__ void cvt_fp4_rows(const float* __restrict__ src, unsigned char* __restrict__ dst, const int wrank, const int nwaves) {
    const int tid = my_tid(), lane = tid & 63;
    for (int row = wrank; row < 16384; row += nwaves) {
        float v[32]; float amax = 0.f;
#pragma unroll
        for (int q = 0; q < 8; ++q) {
            const float4 x = *reinterpret_cast<const float4*>(&src[(size_t)row * D + q * 256 + lane * 4]);
            v[q * 4] = x.x; v[q * 4 + 1] = x.y; v[q * 4 + 2] = x.z; v[q * 4 + 3] = x.w;
            amax = fmaxf(amax, fmaxf(fmaxf(fabsf(x.x), fabsf(x.y)), fmaxf(fabsf(x.z), fabsf(x.w))));
        }
        const bfr sb = f2bf(amax * (1.f / 6.f));
        const float sc = bf2f(sb), inv = sc > 0.f ? frcp_(sc) : 0.f;
        unsigned dw[4];
#pragma unroll
        for (int d = 0; d < 4; ++d) {
            unsigned p = 0;
            p = __builtin_amdgcn_cvt_scalef32_pk_fp4_f32(p, v[d * 8 + 0] * inv, v[d * 8 + 1] * inv, 1.0f, 0);
            p = __builtin_amdgcn_cvt_scalef32_pk_fp4_f32(p, v[d * 8 + 2] * inv, v[d * 8 + 3] * inv, 1.0f, 1);
            p = __builtin_amdgcn_cvt_scalef32_pk_fp4_f32(p, v[d * 8 + 4] * inv, v[d * 8 + 5] * inv, 1.0f, 2);
            p = __builtin_amdgcn_cvt_scalef32_pk_fp4_f32(p, v[d * 8 + 6] * inv, v[d * 8 + 7] * inv, 1.0f, 3);
            dw[d] = p;
        }
        uint4 o4; o4.x = dw[0]; o4.y = dw[1]; o4.z = dw[2]; o4.w = dw[3];
        *reinterpret_cast<uint4*>(dst + (size_t)row * PEER_ROWB + lane * 16) = o4;
        *reinterpret_cast<bfr*>(dst + (size_t)row * PEER_ROWB + 1024 + lane * 2) = sb;
    }
}

__device__ __forceinline__ unsigned pack8_i4(const float* v) {
    unsigned d = 0;
#pragma unroll
    for (int i = 0; i < 8; ++i) d |= ((unsigned)((int)v[i]) & 0xFu) << (4 * i);
    return d;
}
__device__ __forceinline__ void cvt_i4_rows(const float* __restrict__ src, unsigned char* __restrict__ dst, const int rank, const int nranks) {
    const int tid = my_tid(), lane = tid & 63, wv = tid >> 6;
    for (int row = rank * 8 + wv; row < 16384; row += nranks * 8) {
        float v[32]; float amax = 0.f;
#pragma unroll
        for (int q = 0; q < 8; ++q) {
            const float4 x = *reinterpret_cast<const float4*>(&src[(size_t)row * D + q * 256 + lane * 4]);
            v[q * 4] = x.x; v[q * 4 + 1] = x.y; v[q * 4 + 2] = x.z; v[q * 4 + 3] = x.w;
            amax = fmaxf(amax, fmaxf(fmaxf(fabsf(x.x), fabsf(x.y)), fmaxf(fabsf(x.z), fabsf(x.w))));
        }
        const bfr sb = f2bf(amax * (1.f / 7.f));
        const float sc = bf2f(sb), inv = sc > 0.f ? frcp_(sc) : 0.f;
#pragma unroll
        for (int i = 0; i < 32; ++i) v[i] = fminf(fmaxf(__builtin_rintf(v[i] * inv), -7.f), 7.f);
        uint4 o4; o4.x = pack8_i4(v); o4.y = pack8_i4(v + 8); o4.z = pack8_i4(v + 16); o4.w = pack8_i4(v + 24);
        *reinterpret_cast<uint4*>(dst + (size_t)row * PEER_ROWB + lane * 16) = o4;
        *reinterpret_cast<bfr*>(dst + (size_t)row * PEER_ROWB + 1024 + lane * 2) = sb;
    }
}
__device__ __forceinline__ int pm_index(int kp, int k) {
    const int kpt = kp >> 5, r = kp & 31, kt = k >> 5, kk = k & 31, s = kk >> 4, rem = kk & 15;
    const int j = ((rem >> 3) << 2) | (rem & 3), hf = (rem >> 2) & 1, lane = hf * 32 + r;
    return ((((kpt * 2 + kt) * 2 + s) * 64 + lane) * 8) + j;
}
__device__ __forceinline__ int acc_index(int row, int col) {
    const int rt = row >> 5, r = row & 31, ct = col >> 5, c = col & 31;
    const int g4 = r >> 3, comp = r & 3, hf = (r >> 2) & 1, lane = hf * 32 + c;
    return ((((rt * 2 + ct) * 4 + g4) * 64 + lane) * 4) + comp;
}

constexpr int RW_ACT_STRIDE = 296, RW_LD = 72, RW_SLOT = 9216, RW_WL_OFF = 110592, RW_TOT_OFF = 148480, RW_BASE_OFF = 152576, RW_PART_OFF = 156928;
__device__ __forceinline__ f32x16 tile_mm_acc(f32x16 acc, const bfr* A, const int arow0, const bfr* Bt, const int brow0, const int r, const int hf) {
#pragma unroll
    for (int ks = 0; ks < 4; ++ks)
        acc = __builtin_amdgcn_mfma_f32_32x32x16_bf16(*reinterpret_cast<const bf16x8*>(&A[(arow0 + r) * RW_LD + ks * 16 + hf * 8]),
                                                     *reinterpret_cast<const bf16x8*>(&Bt[(brow0 + r) * RW_LD + ks * 16 + hf * 8]), acc, 0, 0, 0);
    return acc;
}
__device__ __forceinline__ f32x16 tile_mm(const bfr* A, const int arow0, const bfr* Bt, const int brow0, const int r, const int hf) {
    f32x16 z;
#pragma unroll
    for (int g = 0; g < 16; ++g) z[g] = 0.f;
    return tile_mm_acc(z, A, arow0, Bt, brow0, r, hf);
}
__device__ __forceinline__ void store_t(bfr* dst, const int col0, const int row0, const f32x16 acc, const int r, const int hf) {
#pragma unroll
    for (int g4 = 0; g4 < 4; ++g4) { uint2 p; p.x = pack2(acc[g4 * 4], acc[g4 * 4 + 1]); p.y = pack2(acc[g4 * 4 + 2], acc[g4 * 4 + 3]);
        *reinterpret_cast<uint2*>(&dst[(col0 + r) * RW_LD + row0 + g4 * 8 + hf * 4]) = p; }
}
#define DPP_HMIRROR 0x141
#define DPP_MIRROR  0x140

__device__ __forceinline__ void rwkv_load_weights(const Args& a, const int h, unsigned char* lds) {
    bfr* WL = (bfr*)(lds + RW_WL_OFF);
    const int tid = my_tid();
    for (int idx = tid; idx < 288 * 64; idx += 512) {
        const int m = idx >> 6, d = idx & 63;
        const float v = (m < 64) ? a.in[I_WDEC][(size_t)m * RW + h * 64 + d] : (m < 128) ? a.in[I_WICL][(size_t)(m - 64) * RW + h * 64 + d] : a.in[I_WGATE][(size_t)(m - 128) * RW + h * 64 + d];
        WL[d * RW_ACT_STRIDE + m] = f2bf(v);
    }
    __syncthreads();
}

struct RwIn { unsigned cu[18], pu[18]; bfr r[2][5], k[2][5], v[2][5]; };
__device__ __forceinline__ void rwkv_fetch(const Args& a, const int c, const int h, RwIn& in) {
    const bfr* __restrict__ P = (const bfr*)(a.ws + WS_P);
    const int tid = my_tid(), lane = tid & 63, wv = tid >> 6, fr = lane & 15, fq = lane >> 4, t0 = c * 64;
    {
        const int i = tid >> 3, part = tid & 7, t = t0 + i;
        const bfr* pc = P + (size_t)t * NINP + C_ZW + part * 36;
        const bfr* pp = pc - NINP;
#pragma unroll
        for (int q = 0; q < 18; ++q) { in.cu[q] = *reinterpret_cast<const unsigned*>(pc + q * 2); in.pu[q] = (t > 0) ? *reinterpret_cast<const unsigned*>(pp + q * 2) : 0u; }
    }
    const int tt = wv >> 1, dh = wv & 1;
#pragma unroll
    for (int dt = 0; dt < 2; ++dt) {
        const int hd = h * 64 + dh * 32 + dt * 16 + fr;
        const int tp = t0 + tt * 16 + fq * 4 - 1;
        const bool hp = tp >= 0;
        in.r[dt][0] = hp ? P[(size_t)(hp ? tp : 0) * NINP + C_R + hd] : (bfr)0; in.k[dt][0] = hp ? P[(size_t)(hp ? tp : 0) * NINP + C_K + hd] : (bfr)0; in.v[dt][0] = hp ? P[(size_t)(hp ? tp : 0) * NINP + C_V + hd] : (bfr)0;
#pragma unroll
        for (int j = 0; j < 4; ++j) { const size_t ro = (size_t)(tp + 1 + j) * NINP; in.r[dt][j + 1] = P[ro + C_R + hd]; in.k[dt][j + 1] = P[ro + C_K + hd]; in.v[dt][j + 1] = P[ro + C_V + hd]; }
    }
}

__device__ __forceinline__ void rwkv_unit(const Args& a, const int c, const int h, unsigned char* lds, const RwIn& in, RwIn& nxt, const int cnext) {
    const float* __restrict__ smix = a.in[I_SHIFT];
    const int tid = my_tid(), lane = tid & 63, wv = tid >> 6, fr = lane & 15, fq = lane >> 4, t0 = c * 64, u = c * 16 + h;
#define SLOT(k) ((bfr*)(lds + (k) * RW_SLOT))
    bfr* ACT = (bfr*)lds; const bfr* WL = (const bfr*)(lds + RW_WL_OFF);
    float* TOT = (float*)(lds + RW_TOT_OFF); float* BASE = (float*)(lds + RW_BASE_OFF); float* PART = (float*)(lds + RW_PART_OFF);
    {
        const int i = tid >> 3, part = tid & 7;
#pragma unroll
        for (int q = 0; q < 18; ++q) {
            const int cc = part * 36 + q * 2;
            const unsigned cu = in.cu[q], pu = in.pu[q];
            const float2 mx = *reinterpret_cast<const float2*>(&smix[C_ZW + cc]);
            const float c0 = bflo(cu), c1 = bfhi(cu);
            float z0 = c0 + (bflo(pu) - c0) * mx.x, z1 = c1 + (bfhi(pu) - c1) * mx.y;
            if (cc < 64) { z0 = 1.f - 2.f * frcp_(1.f + __expf(2.f * z0)); z1 = 1.f - 2.f * frcp_(1.f + __expf(2.f * z1)); }
            else if (cc >= 128) { z0 = sigmoidf_(z0); z1 = sigmoidf_(z1); }
            *reinterpret_cast<unsigned*>(&ACT[i * RW_ACT_STRIDE + cc]) = pack2(z0, z1);
        }
    }
    const int tt = wv >> 1, dh = wv & 1;
    float zr[2][4], zk[2][4], zv[2][4];
#pragma unroll
    for (int dt = 0; dt < 2; ++dt) {
        const int hd = h * 64 + dh * 32 + dt * 16 + fr;
        const float mr = smix[C_R + hd], mk = smix[C_K + hd], mv = smix[C_V + hd];
        float pr = bf2f(in.r[dt][0]), pk = bf2f(in.k[dt][0]), pv = bf2f(in.v[dt][0]);
#pragma unroll
        for (int j = 0; j < 4; ++j) {
            const float cr = bf2f(in.r[dt][j + 1]), ck = bf2f(in.k[dt][j + 1]), cv = bf2f(in.v[dt][j + 1]);
            zr[dt][j] = cr + (pr - cr) * mr; zk[dt][j] = ck + (pk - ck) * mk; zv[dt][j] = cv + (pv - cv) * mv;
            pr = cr; pk = ck; pv = cv;
        }
    }
    __syncthreads();
    f32x4 xw[2], xa[2], xg[2];
#pragma unroll
    for (int dt = 0; dt < 2; ++dt) {
        xw[dt] = f32x4{0.f, 0.f, 0.f, 0.f}; xa[dt] = xw[dt]; xg[dt] = xw[dt];
        const bfr* arow = ACT + (tt * 16 + fr) * RW_ACT_STRIDE + fq * 8;
        const bfr* brow = WL + (dh * 32 + dt * 16 + fr) * RW_ACT_STRIDE + fq * 8;
#pragma unroll
        for (int ks = 0; ks < 2; ++ks) {
            xw[dt] = __builtin_amdgcn_mfma_f32_16x16x32_bf16(*reinterpret_cast<const bf16x8*>(arow + ks * 32), *reinterpret_cast<const bf16x8*>(brow + ks * 32), xw[dt], 0, 0, 0);
            xa[dt] = __builtin_amdgcn_mfma_f32_16x16x32_bf16(*reinterpret_cast<const bf16x8*>(arow + 64 + ks * 32), *reinterpret_cast<const bf16x8*>(brow + 64 + ks * 32), xa[dt], 0, 0, 0);
        }
#pragma unroll
        for (int ks = 0; ks < 5; ++ks)
            xg[dt] = __builtin_amdgcn_mfma_f32_16x16x32_bf16(*reinterpret_cast<const bf16x8*>(arow + 128 + ks * 32), *reinterpret_cast<const bf16x8*>(brow + 128 + ks * 32), xg[dt], 0, 0, 0);
    }
    float lw[2][4], av[2][4], kkr[2][4], k4[2][4], n2[4], cf[4];
#pragma unroll
    for (int j = 0; j < 4; ++j) { n2[j] = 0.f; cf[j] = 0.f; }
#pragma unroll
    for (int dt = 0; dt < 2; ++dt) {
        const int hd = h * 64 + dh * 32 + dt * 16 + fr;
        const float w0 = a.in[I_W0][hd], a0 = a.in[I_A0][hd], kkm = a.in[I_KK][hd], kam = a.in[I_KA][hd], rkm = a.in[I_RK][hd];
        float run = 0.f;
#pragma unroll
        for (int j = 0; j < 4; ++j) {
            run += -0.6065306597126334f * sigmoidf_(w0 + xw[dt][j]);
            lw[dt][j] = run;
            av[dt][j] = sigmoidf_(a0 + xa[dt][j]);
            kkr[dt][j] = zk[dt][j] * kkm;
            k4[dt][j] = zk[dt][j] * (1.f + (av[dt][j] - 1.f) * kam);
            n2[j] += kkr[dt][j] * kkr[dt][j];
            cf[j] += zr[dt][j] * k4[dt][j] * rkm;
        }
        TOT[(tt * 4 + fq) * 64 + dh * 32 + dt * 16 + fr] = run;
    }
#pragma unroll
    for (int j = 0; j < 4; ++j) {
        n2[j] += dpp_f<DPP_XOR1>(n2[j]); n2[j] += dpp_f<DPP_XOR2>(n2[j]); n2[j] += dpp_f<DPP_HMIRROR>(n2[j]); n2[j] += dpp_f<DPP_MIRROR>(n2[j]);
        cf[j] += dpp_f<DPP_XOR1>(cf[j]); cf[j] += dpp_f<DPP_XOR2>(cf[j]); cf[j] += dpp_f<DPP_HMIRROR>(cf[j]); cf[j] += dpp_f<DPP_MIRROR>(cf[j]);
        if (fr == 0) { PART[(wv * 16 + fq * 4 + j) * 2] = n2[j]; PART[(wv * 16 + fq * 4 + j) * 2 + 1] = cf[j]; }
    }
    __syncthreads();
    if (tid < 64) {
        float run = 0.f;
#pragma unroll
        for (int g = 0; g < 16; ++g) { const float tv = TOT[g * 64 + tid]; BASE[g * 64 + tid] = run; run += tv; }
        BASE[16 * 64 + tid] = run;
    }
    __syncthreads();
    {
        bfr* Gg = (bfr*)(a.ws + WS_GG); bfr* Bon = (bfr*)(a.ws + WS_BON);
        const int i0 = tt * 16 + fq * 4;
        float rn[4], cft[4];
#pragma unroll
        for (int j = 0; j < 4; ++j) {
            const float n2t = n2[j] + PART[((wv ^ 1) * 16 + fq * 4 + j) * 2]; cft[j] = cf[j] + PART[((wv ^ 1) * 16 + fq * 4 + j) * 2 + 1];
            rn[j] = __builtin_amdgcn_rsqf(fmaxf(n2t, 1e-24f));
        }
#pragma unroll
        for (int dt = 0; dt < 2; ++dt) {
            const int d = dh * 32 + dt * 16 + fr;
            const float base = BASE[(tt * 4 + fq) * 64 + d], clT = BASE[16 * 64 + d];
            float vAt[4], vBh[4], vKh[4];
#pragma unroll
            for (int j = 0; j < 4; ++j) {
                const float cl = base + lw[dt][j], clm1 = (j == 0) ? base : base + lw[dt][j - 1];
                const float gi = __expf(cl), gm1 = __expf(clm1), ig = __expf(-cl), gce = __expf(clT - cl);
                const float kk = kkr[dt][j] * rn[j], beta = kk * av[dt][j];
                vAt[j] = -kk * gm1; vBh[j] = beta * gce; vKh[j] = k4[dt][j] * gce;
                SLOT(0)[(i0 + j) * RW_LD + d] = f2bf(vAt[j]);
                SLOT(1)[(i0 + j) * RW_LD + d] = f2bf(beta * ig);
                SLOT(2)[(i0 + j) * RW_LD + d] = f2bf(k4[dt][j] * ig);
                SLOT(3)[(i0 + j) * RW_LD + d] = f2bf(zr[dt][j] * gi);
                const size_t o = (size_t)(t0 + i0 + j) * RW + h * 64 + d;
                Gg[o] = f2bf(xg[dt][j]); Bon[o] = f2bf(cft[j] * zv[dt][j]);
            }
            uint2 p;
            p.x = pack2(vAt[0], vAt[1]); p.y = pack2(vAt[2], vAt[3]); *reinterpret_cast<uint2*>(&SLOT(4)[d * RW_LD + i0]) = p;
            p.x = pack2(vBh[0], vBh[1]); p.y = pack2(vBh[2], vBh[3]); *reinterpret_cast<uint2*>(&SLOT(5)[d * RW_LD + i0]) = p;
            p.x = pack2(vKh[0], vKh[1]); p.y = pack2(vKh[2], vKh[3]); *reinterpret_cast<uint2*>(&SLOT(6)[d * RW_LD + i0]) = p;
            p.x = pack2(zv[dt][0], zv[dt][1]); p.y = pack2(zv[dt][2], zv[dt][3]); *reinterpret_cast<uint2*>(&SLOT(7)[d * RW_LD + i0]) = p;
        }
    }
    __syncthreads();
    if (cnext >= 0) rwkv_fetch(a, cnext, h, nxt);
    const int r = lane & 31, hf = lane >> 5;
    {
        const int prod = wv >> 1, sub = wv & 1;
        const bfr* Aop = (prod & 1) ? SLOT(2) : SLOT(1);
        const bfr* Bop = (prod >= 2) ? SLOT(3) : SLOT(0);
        bfr* Ld = SLOT(8 + prod);
        const bool incl = prod >= 2;
        for (int job = 0; job < (sub ? 2 : 1); ++job) {
            const int jt = sub ? job : 0, it = sub ? 1 : 0;
            f32x16 acc = tile_mm(Aop, jt * 32, Bop, it * 32, r, hf);
#pragma unroll
            for (int g4 = 0; g4 < 4; ++g4) {
                const int i = it * 32 + r, j0 = jt * 32 + g4 * 8 + hf * 4;
                float v[4];
#pragma unroll
                for (int q = 0; q < 4; ++q) { const int j = j0 + q; v[q] = (incl ? (j <= i) : (j < i)) ? acc[g4 * 4 + q] : 0.f; }
                uint2 p; p.x = pack2(v[0], v[1]); p.y = pack2(v[2], v[3]);
                *reinterpret_cast<uint2*>(&Ld[i * RW_LD + j0]) = p;
            }
        }
        if (!sub) {
#pragma unroll
            for (int g4 = 0; g4 < 4; ++g4) *reinterpret_cast<uint2*>(&Ld[r * RW_LD + 32 + g4 * 8 + hf * 4]) = make_uint2(0u, 0u);
        }
    }
    __syncthreads();
    if (wv == 0) {
        bfr* Tl = SLOT(0); bfr* TlT = SLOT(1); const bfr* Lab = SLOT(8);
        for (int q = 0; q < 9; ++q) { *reinterpret_cast<uint4*>((unsigned char*)Tl + (q * 64 + lane) * 16) = make_uint4(0u, 0u, 0u, 0u); *reinterpret_cast<uint4*>((unsigned char*)TlT + (q * 64 + lane) * 16) = make_uint4(0u, 0u, 0u, 0u); }
        {
            const int bq = lane >> 4, cc = lane & 15;
            float x[16];
#pragma unroll
            for (int rr = 0; rr < 16; ++rr) {
                float lrow[16];
                unpack8(*reinterpret_cast<const uint4*>(&Lab[(bq * 16 + rr) * RW_LD + bq * 16]), lrow);
                unpack8(*reinterpret_cast<const uint4*>(&Lab[(bq * 16 + rr) * RW_LD + bq * 16 + 8]), lrow + 8);
                float sacc = (rr == cc) ? 1.f : 0.f;
#pragma unroll
                for (int m = 0; m < rr; ++m) sacc += lrow[m] * x[m];
                x[rr] = sacc;
            }
#pragma unroll
            for (int rr = 0; rr < 16; ++rr) Tl[(bq * 16 + rr) * RW_LD + bq * 16 + cc] = f2bf(x[rr]);
            *reinterpret_cast<uint4*>(&TlT[(bq * 16 + cc) * RW_LD + bq * 16]) = pack8(x);
            *reinterpret_cast<uint4*>(&TlT[(bq * 16 + cc) * RW_LD + bq * 16 + 8]) = pack8(x + 8);
        }
        asm volatile("s_waitcnt lgkmcnt(0)" ::: "memory");
#pragma unroll
        for (int bi = 1; bi < 4; ++bi) {
#pragma unroll
            for (int bj = 0; bj < bi; ++bj) {
                f32x4 acc = {0.f, 0.f, 0.f, 0.f};
#pragma unroll
                for (int bm = bj; bm < bi; ++bm) {
                    const bf16x4 Af = *reinterpret_cast<const bf16x4*>(&Lab[(bi * 16 + fr) * RW_LD + bm * 16 + fq * 4]);
                    const bf16x4 Bf = *reinterpret_cast<const bf16x4*>(&TlT[(bj * 16 + fr) * RW_LD + bm * 16 + fq * 4]);
                    acc = __builtin_amdgcn_mfma_f32_16x16x16bf16_1k(Af, Bf, acc, 0, 0, 0);
                }
                bf16x4 Bacc; Bacc[0] = (short)f2bf(acc[0]); Bacc[1] = (short)f2bf(acc[1]); Bacc[2] = (short)f2bf(acc[2]); Bacc[3] = (short)f2bf(acc[3]);
                const bf16x4 Ad = *reinterpret_cast<const bf16x4*>(&Tl[(bi * 16 + fr) * RW_LD + bi * 16 + fq * 4]);
                const f32x4 tb = __builtin_amdgcn_mfma_f32_16x16x16bf16_1k(Ad, Bacc, f32x4{0.f, 0.f, 0.f, 0.f}, 0, 0, 0);
#pragma unroll
                for (int q = 0; q < 4; ++q) Tl[(bi * 16 + fq * 4 + q) * RW_LD + bj * 16 + fr] = f2bf(tb[q]);
                uint2 p; p.x = pack2(tb[0], tb[1]); p.y = pack2(tb[2], tb[3]);
                *reinterpret_cast<uint2*>(&TlT[(bj * 16 + fr) * RW_LD + bi * 16 + fq * 4]) = p;
            }
            asm volatile("s_waitcnt lgkmcnt(0)" ::: "memory");
        }
    } else if (wv >= 4) {
        const int it = (wv >> 1) & 1, vt = wv & 1;
        const f32x16 acc = tile_mm(SLOT(9), it * 32, SLOT(7), vt * 32, r, hf);
        store_t(SLOT(2), vt * 32, it * 32, acc, r, hf);
    }
    __syncthreads();
    {
        const int which = wv >> 2, it = (wv >> 1) & 1, ct = wv & 1;
        const f32x16 acc = tile_mm(SLOT(0), it * 32, which ? SLOT(2) : SLOT(4), ct * 32, r, hf);
        store_t(which ? SLOT(9) : SLOT(8), ct * 32, it * 32, acc, r, hf);
    }
    __syncthreads();
    if (wv < 4) {
        {
            const int dtl = wv >> 1, itl = wv & 1;
            f32x16 acc = tile_mm(SLOT(8), dtl * 32, SLOT(10), itl * 32, r, hf);
            bfr* WY = (bfr*)(a.ws + WS_WY) + (size_t)u * 4096;
            const int i = itl * 32 + r;
#pragma unroll
            for (int g4 = 0; g4 < 4; ++g4) {
                const int d0 = dtl * 32 + g4 * 8 + hf * 4;
                const uint2 rr2 = *reinterpret_cast<const uint2*>(&SLOT(3)[i * RW_LD + d0]);
                uint2 p; p.x = pack2(acc[g4 * 4] + bflo(rr2.x), acc[g4 * 4 + 1] + bfhi(rr2.x)); p.y = pack2(acc[g4 * 4 + 2] + bflo(rr2.y), acc[g4 * 4 + 3] + bfhi(rr2.y));
                *reinterpret_cast<uint2*>(&WY[i * 64 + d0]) = p;
            }
        }
        {
            const int it = wv >> 1, vt = wv & 1;
            f32x16 acc = tile_mm(SLOT(10), it * 32, SLOT(9), vt * 32, r, hf);
            acc = tile_mm_acc(acc, SLOT(11), it * 32, SLOT(7), vt * 32, r, hf);
            bfr* YL = (bfr*)(a.ws + WS_YLOC) + (size_t)u * 4096;
#pragma unroll
            for (int g4 = 0; g4 < 4; ++g4) { uint2 p; p.x = pack2(acc[g4 * 4], acc[g4 * 4 + 1]); p.y = pack2(acc[g4 * 4 + 2], acc[g4 * 4 + 3]);
                *reinterpret_cast<uint2*>(&YL[(((it * 2 + vt) * 4 + g4) * 64 + lane) * 4]) = p; }
        }
    } else {
        {
            const int kt = (wv >> 1) & 1, kpt = wv & 1;
            f32x16 acc = tile_mm(SLOT(8), kt * 32, SLOT(5), kpt * 32, r, hf);
            if (kt == kpt) {
                const float gc = __expf(BASE[16 * 64 + kt * 32 + r]);
#pragma unroll
                for (int g = 0; g < 16; ++g) if (((g & 3) + 8 * (g >> 2) + 4 * hf) == r) acc[g] += gc;
            }
            bfr* PM = (bfr*)(a.ws + WS_PM) + (size_t)u * 4096;
#pragma unroll
            for (int sgrp = 0; sgrp < 2; ++sgrp) {
                float v8[8];
#pragma unroll
                for (int q = 0; q < 8; ++q) v8[q] = acc[sgrp * 8 + q];
                *reinterpret_cast<uint4*>(&PM[(((kpt * 2 + kt) * 2 + sgrp) * 64 + lane) * 8]) = pack8(v8);
            }
        }
        {
            const int kpt = (wv >> 1) & 1, vt = wv & 1;
            f32x16 acc = tile_mm(SLOT(5), kpt * 32, SLOT(9), vt * 32, r, hf);
            acc = tile_mm_acc(acc, SLOT(6), kpt * 32, SLOT(7), vt * 32, r, hf);
            bfr* GM = (bfr*)(a.ws + WS_GM) + (size_t)u * 4096;
#pragma unroll
            for (int g4 = 0; g4 < 4; ++g4) { uint2 p; p.x = pack2(acc[g4 * 4], acc[g4 * 4 + 1]); p.y = pack2(acc[g4 * 4 + 2], acc[g4 * 4 + 3]);
                *reinterpret_cast<uint2*>(&GM[(((kpt * 2 + vt) * 4 + g4) * 64 + lane) * 4]) = p; }
        }
    }
    __syncthreads();
#undef SLOT
}

__device__ __forceinline__ void rwkv_chain(const Args& a, const int h, const int vh) {
    const int lane = my_tid() & 63, r = lane & 31, hf = lane >> 5;
    const bfr* PMb = (const bfr*)(a.ws + WS_PM); const bfr* GMb = (const bfr*)(a.ws + WS_GM); bfr* ZTb = (bfr*)(a.ws + WS_ZT);
    f32x16 Z[2];
#pragma unroll
    for (int g = 0; g < 16; ++g) { Z[0][g] = 0.f; Z[1][g] = 0.f; }
    bf16x8 Acur[8], Anxt[8]; uint2 Ccur[8], Cnxt[8];
    {
        const bfr* pm = PMb + (size_t)h * 4096; const bfr* gm = GMb + (size_t)h * 4096;
#pragma unroll
        for (int f = 0; f < 8; ++f) Acur[f] = *reinterpret_cast<const bf16x8*>(&pm[(f * 64 + lane) * 8]);
#pragma unroll
        for (int kpt = 0; kpt < 2; ++kpt)
#pragma unroll
            for (int g4 = 0; g4 < 4; ++g4) Ccur[kpt * 4 + g4] = *reinterpret_cast<const uint2*>(&gm[(((kpt * 2 + vh) * 4 + g4) * 64 + lane) * 4]);
    }
    for (int c = 0; c < 128; ++c) {
        const int u = c * 16 + h;
        if (c + 1 < 128) {
            const bfr* pm = PMb + (size_t)(u + 16) * 4096; const bfr* gm = GMb + (size_t)(u + 16) * 4096;
#pragma unroll
            for (int f = 0; f < 8; ++f) Anxt[f] = *reinterpret_cast<const bf16x8*>(&pm[(f * 64 + lane) * 8]);
#pragma unroll
            for (int kpt = 0; kpt < 2; ++kpt)
#pragma unroll
                for (int g4 = 0; g4 < 4; ++g4) Cnxt[kpt * 4 + g4] = *reinterpret_cast<const uint2*>(&gm[(((kpt * 2 + vh) * 4 + g4) * 64 + lane) * 4]);
        }
        bfr* zt = ZTb + (size_t)u * 4096 + (size_t)(vh * 32 + r) * 64;
        bf16x8 Bf[2][2];
#pragma unroll
        for (int kt = 0; kt < 2; ++kt) {
#pragma unroll
            for (int g4 = 0; g4 < 4; ++g4) {
                uint2 o; o.x = pack2(Z[kt][g4 * 4], Z[kt][g4 * 4 + 1]); o.y = pack2(Z[kt][g4 * 4 + 2], Z[kt][g4 * 4 + 3]);
                *reinterpret_cast<uint2*>(&zt[kt * 32 + g4 * 8 + hf * 4]) = o;
                const int s = g4 >> 1, e = (g4 & 1) * 4;
                Bf[kt][s][e] = (short)(o.x & 0xFFFF); Bf[kt][s][e + 1] = (short)(o.x >> 16); Bf[kt][s][e + 2] = (short)(o.y & 0xFFFF); Bf[kt][s][e + 3] = (short)(o.y >> 16);
            }
        }
        f32x16 Zn[2];
#pragma unroll
        for (int kpt = 0; kpt < 2; ++kpt)
#pragma unroll
            for (int g4 = 0; g4 < 4; ++g4) {
                const uint2 cc = Ccur[kpt * 4 + g4];
                Zn[kpt][g4 * 4] = bflo(cc.x); Zn[kpt][g4 * 4 + 1] = bfhi(cc.x); Zn[kpt][g4 * 4 + 2] = bflo(cc.y); Zn[kpt][g4 * 4 + 3] = bfhi(cc.y);
            }
#pragma unroll
        for (int kpt = 0; kpt < 2; ++kpt)
#pragma unroll
            for (int kt = 0; kt < 2; ++kt)
#pragma unroll
                for (int s = 0; s < 2; ++s)
                    Zn[kpt] = __builtin_amdgcn_mfma_f32_32x32x16_bf16(Acur[(kpt * 2 + kt) * 2 + s], Bf[kt][s], Zn[kpt], 0, 0, 0);
        Z[0] = Zn[0]; Z[1] = Zn[1];
#pragma unroll
        for (int f = 0; f < 8; ++f) { Acur[f] = Anxt[f]; Ccur[f] = Cnxt[f]; }
    }
}

__device__ __forceinline__ void rwkv_out_unit(const Args& a, const int u, float* Ls) {
    const int lane = my_tid() & 63, r = lane & 31, hf = lane >> 5, c = u >> 4, h = u & 15, t0 = c * 64;
    const bfr* WY = (const bfr*)(a.ws + WS_WY) + (size_t)u * 4096; const bfr* YL = (const bfr*)(a.ws + WS_YLOC) + (size_t)u * 4096;
    const bfr* ZT = (const bfr*)(a.ws + WS_ZT) + (size_t)u * 4096;
    f32x16 acc[2][2];
#pragma unroll
    for (int it = 0; it < 2; ++it)
#pragma unroll
        for (int vt = 0; vt < 2; ++vt)
#pragma unroll
            for (int g4 = 0; g4 < 4; ++g4) {
                const uint2 cc = *reinterpret_cast<const uint2*>(&YL[(((it * 2 + vt) * 4 + g4) * 64 + lane) * 4]);
                acc[it][vt][g4 * 4] = bflo(cc.x); acc[it][vt][g4 * 4 + 1] = bfhi(cc.x); acc[it][vt][g4 * 4 + 2] = bflo(cc.y); acc[it][vt][g4 * 4 + 3] = bfhi(cc.y);
            }
#pragma unroll
    for (int ks = 0; ks < 4; ++ks) {
        bf16x8 A[2], B[2];
#pragma unroll
        for (int it = 0; it < 2; ++it) A[it] = *reinterpret_cast<const bf16x8*>(&WY[(it * 32 + r) * 64 + ks * 16 + hf * 8]);
#pragma unroll
        for (int vt = 0; vt < 2; ++vt) B[vt] = *reinterpret_cast<const bf16x8*>(&ZT[(vt * 32 + r) * 64 + ks * 16 + hf * 8]);
#pragma unroll
        for (int it = 0; it < 2; ++it)
#pragma unroll
            for (int vt = 0; vt < 2; ++vt) acc[it][vt] = __builtin_amdgcn_mfma_f32_32x32x16_bf16(A[it], B[vt], acc[it][vt], 0, 0, 0);
    }
#pragma unroll
    for (int it = 0; it < 2; ++it)
#pragma unroll
        for (int vt = 0; vt < 2; ++vt)
#pragma unroll
            for (int g = 0; g < 16; ++g) Ls[(it * 32 + (g & 3) + 8 * (g >> 2) + 4 * hf) * 68 + vt * 32 + r] = acc[it][vt][g];
    asm volatile("s_waitcnt lgkmcnt(0)" ::: "memory");
    __builtin_amdgcn_wave_barrier();
    {
        float y[64]; float s1 = 0.f, s2 = 0.f;
#pragma unroll
        for (int q = 0; q < 16; ++q) {
            const float4 x = *reinterpret_cast<const float4*>(&Ls[lane * 68 + q * 4]);
            y[q * 4] = x.x; y[q * 4 + 1] = x.y; y[q * 4 + 2] = x.z; y[q * 4 + 3] = x.w;
            s1 += (x.x + x.y) + (x.z + x.w);
        }
        const float mean = s1 * (1.f / 64.f);
#pragma unroll
        for (int v = 0; v < 64; ++v) { const float d = y[v] - mean; s2 += d * d; }
        const float rstd = rsqrtf(s2 * (1.f / 64.f) + 64e-5f);
        const bfr* Gg = (const bfr*)(a.ws + WS_GG); const bfr* Bon = (const bfr*)(a.ws + WS_BON); bfr* RWO = (bfr*)(a.ws + WS_RWO);
        const size_t o = (size_t)(t0 + lane) * RW + h * 64;
        const float* lnw = a.in[I_LNW] + h * 64; const float* lnb = a.in[I_LNB] + h * 64;
#pragma unroll
        for (int q = 0; q < 8; ++q) {
            float gg[8], bb[8], rr[8];
            unpack8(*reinterpret_cast<const uint4*>(&Gg[o + q * 8]), gg);
            unpack8(*reinterpret_cast<const uint4*>(&Bon[o + q * 8]), bb);
#pragma unroll
            for (int e = 0; e < 8; ++e) rr[e] = ((y[q * 8 + e] - mean) * rstd * lnw[q * 8 + e] + lnb[q * 8 + e] + bb[e]) * gg[e];
            *reinterpret_cast<uint4*>(&RWO[o + q * 8]) = pack8(rr);
        }
    }
    asm volatile("s_waitcnt lgkmcnt(0)" ::: "memory");
    __builtin_amdgcn_wave_barrier();
}
#ifndef DUP_DSA
#define DUP_DSA 0
#endif
constexpr float IDX_SCALE = 0.04419417382415922f;
constexpr int CT_ROW = 544;
constexpr int CT_WAVE = 18432;
constexpr int DSA_RELB_OFF = 155648;
constexpr int DSA_HIST_OFF = 131072;
constexpr int DSA_SEL_OFF = 147456;

typedef __bf16 bf16p2_t __attribute__((ext_vector_type(2)));
__device__ __forceinline__ bf16x8 fp8x8_to_bf16(const uint2 w) {
    const u32x4 r = {__builtin_bit_cast(unsigned, __builtin_amdgcn_cvt_scalef32_pk_bf16_fp8(w.x, 1.0f, false)), __builtin_bit_cast(unsigned, __builtin_amdgcn_cvt_scalef32_pk_bf16_fp8(w.x, 1.0f, true)),
                     __builtin_bit_cast(unsigned, __builtin_amdgcn_cvt_scalef32_pk_bf16_fp8(w.y, 1.0f, false)), __builtin_bit_cast(unsigned, __builtin_amdgcn_cvt_scalef32_pk_bf16_fp8(w.y, 1.0f, true))};
    return __builtin_bit_cast(bf16x8, r);
}
__device__ __forceinline__ unsigned pack4_fp8(float a0, float a1, float a2, float a3) {
    int p = 0; p = __builtin_amdgcn_cvt_pk_fp8_f32(a0, a1, p, false); p = __builtin_amdgcn_cvt_pk_fp8_f32(a2, a3, p, true); return (unsigned)p;
}
__device__ __forceinline__ int rel_bucket(int rel) {
    const int n = rel < 0 ? -rel : rel;
    const int lg = 8 + (n >= 15) + (n >= 27) + (n >= 50) + (n >= 91) + (n >= 166) + (n >= 305) + (n >= 559);
    return (n < 8 ? n : lg) + (rel > 0 ? 16 : 0);
}
__device__ __forceinline__ unsigned fkey(float f) {
    if (f == 0.f) f = 0.f;
    const unsigned u = __float_as_uint(f);
    return (u & 0x80000000u) ? ~u : (u | 0x80000000u);
}

__device__ __forceinline__ void dsa_cnorm(const Args& a) {
    const bfr* P = (const bfr*)(a.ws + WS_P); unsigned char* CB8 = a.ws + WS_CB; bfr* IKC = (bfr*)(a.ws + WS_IKC);
    const int lane = my_tid() & 63, wv = my_tid() >> 6;
    const float4 g = reinterpret_cast<const float4*>(a.in[I_KVG])[lane];
    for (int t = blockIdx.x * 8 + wv; t < T; t += gridDim.x * 8) {
        const uint2 raw = *reinterpret_cast<const uint2*>(&P[(size_t)t * NINP + C_CKV + lane * 4]);
        const float v0 = bflo(raw.x), v1 = bfhi(raw.x), v2 = bflo(raw.y), v3 = bfhi(raw.y);
        const float ss = wave_sum(v0 * v0 + v1 * v1 + v2 * v2 + v3 * v3);
        const float rs = rsqrtf(ss * (1.f / 256.f) + EPS);
        int pk = 0;
        pk = __builtin_amdgcn_cvt_pk_fp8_f32(v0 * rs * g.x, v1 * rs * g.y, pk, false);
        pk = __builtin_amdgcn_cvt_pk_fp8_f32(v2 * rs * g.z, v3 * rs * g.w, pk, true);
        *reinterpret_cast<int*>(&CB8[(size_t)t * 256 + lane * 4]) = pk;
        if (lane < 16) *reinterpret_cast<uint2*>(&IKC[(size_t)t * 64 + lane * 4]) = *reinterpret_cast<const uint2*>(&P[(size_t)t * NINP + C_IK + lane * 4]);
    }
}
__device__ __forceinline__ void dsa_qlat(const Args& a) {
    const bfr* P = (const bfr*)(a.ws + WS_P); const bfr* WUK = (const bfr*)(a.ws + WS_WUK); unsigned char* QL8 = a.ws + WS_QLAT;
    const int lane = my_tid() & 63, wv = my_tid() >> 6, fr = lane & 15, fq = lane >> 4;
    for (int it = blockIdx.x * 8 + wv; it < (T / 64) * NH; it += gridDim.x * 8) {
        const int tg = it >> 4, h = it & 15, t0 = tg * 64;
        bf16x8 Bt[4][2];
#pragma unroll
        for (int tl = 0; tl < 4; ++tl)
#pragma unroll
            for (int ks = 0; ks < 2; ++ks) Bt[tl][ks] = *reinterpret_cast<const bf16x8*>(&P[(size_t)(t0 + tl * 16 + fr) * NINP + C_Q + h * 64 + ks * 32 + fq * 8]);
#pragma unroll 2
        for (int nt = 0; nt < 16; ++nt) {
            const bf16x8 A0 = *reinterpret_cast<const bf16x8*>(&WUK[(size_t)(h * 256 + nt * 16 + fr) * 64 + fq * 8]);
            const bf16x8 A1 = *reinterpret_cast<const bf16x8*>(&WUK[(size_t)(h * 256 + nt * 16 + fr) * 64 + 32 + fq * 8]);
#pragma unroll
            for (int tl = 0; tl < 4; ++tl) {
                f32x4 acc = {0.f, 0.f, 0.f, 0.f};
                acc = __builtin_amdgcn_mfma_f32_16x16x32_bf16(A0, Bt[tl][0], acc, 0, 0, 0);
                acc = __builtin_amdgcn_mfma_f32_16x16x32_bf16(A1, Bt[tl][1], acc, 0, 0, 0);
                *reinterpret_cast<unsigned*>(&QL8[((size_t)(t0 + tl * 16 + fr) * NH + h) * 256 + nt * 16 + fq * 4]) = pack4_fp8(acc[0], acc[1], acc[2], acc[3]);
            }
        }
    }
}
__device__ __forceinline__ void dsa_oproj(const Args& a) {
    const unsigned char* OL8 = a.ws + WS_OLAT; const bfr* WUVT = (const bfr*)(a.ws + WS_WUVT); bfr* DO = (bfr*)(a.ws + WS_DO);
    const int lane = my_tid() & 63, wv = my_tid() >> 6, fr = lane & 15, fq = lane >> 4;
    for (int it = blockIdx.x * 8 + wv; it < (T / 64) * NH; it += gridDim.x * 8) {
        const int tg = it >> 4, h = it & 15, t0 = tg * 64;
        f32x4 acc[4][4];
#pragma unroll
        for (int tl = 0; tl < 4; ++tl)
#pragma unroll
            for (int nt = 0; nt < 4; ++nt) acc[tl][nt] = f32x4{0.f, 0.f, 0.f, 0.f};
#pragma unroll 2
        for (int ks = 0; ks < 8; ++ks) {
            bf16x8 A[4];
#pragma unroll
            for (int nt = 0; nt < 4; ++nt) A[nt] = *reinterpret_cast<const bf16x8*>(&WUVT[(size_t)(h * 64 + nt * 16 + fr) * 256 + ks * 32 + fq * 8]);
#pragma unroll
            for (int tl = 0; tl < 4; ++tl) {
                const bf16x8 Bt = fp8x8_to_bf16(*reinterpret_cast<const uint2*>(&OL8[((size_t)(t0 + tl * 16 + fr) * NH + h) * 256 + ks * 32 + fq * 8]));
#pragma unroll
                for (int nt = 0; nt < 4; ++nt) acc[tl][nt] = __builtin_amdgcn_mfma_f32_16x16x32_bf16(A[nt], Bt, acc[tl][nt], 0, 0, 0);
            }
        }
#pragma unroll
        for (int tl = 0; tl < 4; ++tl)
#pragma unroll
            for (int nt = 0; nt < 4; ++nt) { uint2 o; o.x = pack2(acc[tl][nt][0], acc[tl][nt][1]); o.y = pack2(acc[tl][nt][2], acc[tl][nt][3]);
                *reinterpret_cast<uint2*>(&DO[(size_t)(t0 + tl * 16 + fr) * RW + h * 64 + nt * 16 + fq * 4]) = o; }
    }
}

__device__ __forceinline__ float bin_scale(const float sumw2) { const float sg = sqrtf(32.f * sumw2); return sg > 1e-20f ? 90.f / sg : 1.f; }
__device__ __forceinline__ int score_bin(const float sc, const float bsc) { const float f = floorf(sc * bsc) + 512.f; return (int)fminf(fmaxf(f, 0.f), 1023.f); }
__device__ __forceinline__ float key_score(const unsigned k) { return __uint_as_float((k & 0x80000000u) ? (k ^ 0x80000000u) : ~k); }
__device__ __forceinline__ void hist_scan(const unsigned* hist, const int nb, const unsigned need, unsigned* res, const int lane) {
    const int per = nb >> 6;
    unsigned s = 0;
    for (int i = 0; i < per; ++i) s += hist[lane * per + i];
    unsigned S = s;
#pragma unroll
    for (int o = 1; o < 64; o <<= 1) { const unsigned tt = __shfl_down(S, o); if (lane + o < 64) S += tt; }
    const unsigned long long m = __ballot(S >= need);
    const int ls = 63 - __clzll(m);
    if (lane == ls) {
        unsigned accv = S - s; int bin = lane * per; unsigned abv = accv;
        for (int bb = lane * per + per - 1; bb >= lane * per; --bb) { const unsigned cc = hist[bb]; if (accv + cc >= need) { bin = bb; abv = accv; break; } accv += cc; }
        res[0] = (unsigned)bin; res[1] = abv;
    }
}

__device__ __forceinline__ void dsa_select4(const Args& a, const int t0, const int qs, unsigned char* lds) {
    const bfr* P = (const bfr*)(a.ws + WS_P); const bfr* IKC = (const bfr*)(a.ws + WS_IKC);
    float* SC = (float*)lds; int* SEL = (int*)(lds + DSA_SEL_OFF); unsigned* MISC = (unsigned*)(lds + LDS_MISC);
    const int tid = my_tid(), lane = tid & 63, wv = tid >> 6, r = lane & 31, hf = lane >> 5;
    const int L = 64 * (t0 / 64 + 1);
    if (L <= 256) {
        for (int i = tid; i < 4 * 256; i += 512) SEL[(qs + (i >> 8)) * 256 + (i & 255)] = (i & 255) | (rel_bucket((i & 255) - (t0 + (i >> 8))) << 16);
        if (tid < 4) MISC[16 + qs + tid] = (unsigned)L;
        __syncthreads();
        return;
    }
    for (int i = tid; i < 4096; i += 512) ((unsigned*)(lds + DSA_HIST_OFF))[i] = 0u;
    __syncthreads();
    {
        const int qq = r >> 3, hh = r & 7;
        bf16x8 B[4];
#pragma unroll
        for (int ks = 0; ks < 4; ++ks) B[ks] = *reinterpret_cast<const bf16x8*>(&P[(size_t)(t0 + qq) * NINP + C_IQ + hh * 64 + ks * 16 + hf * 8]);
        const float wgt = bf2f(P[(size_t)(t0 + qq) * NINP + C_IW + hh]) * IDX_SCALE;
        float w2 = wgt * wgt; w2 += dpp_f<DPP_XOR1>(w2); w2 += dpp_f<DPP_XOR2>(w2); w2 += dpp_f<0x141>(w2);
        const float bsc = bin_scale(w2);
        if (hh == 0 && hf == 0) ((float*)MISC)[48 + qq] = bsc;
        const int ntile = L >> 5;
        for (int rp_ = 0; rp_ < ((DUP_DSA & 1) ? 2 : 1); ++rp_) {
        bf16x8 An[4];
        if (wv < ntile) {
#pragma unroll
            for (int ks = 0; ks < 4; ++ks) An[ks] = *reinterpret_cast<const bf16x8*>(&IKC[(size_t)(wv * 32 + r) * 64 + ks * 16 + hf * 8]);
        }
        for (int kt = wv; kt < ntile; kt += 8) {
            bf16x8 Ac[4];
#pragma unroll
            for (int ks = 0; ks < 4; ++ks) Ac[ks] = An[ks];
            if (kt + 8 < ntile) {
#pragma unroll
                for (int ks = 0; ks < 4; ++ks) An[ks] = *reinterpret_cast<const bf16x8*>(&IKC[(size_t)((kt + 8) * 32 + r) * 64 + ks * 16 + hf * 8]);
            }
            f32x16 acc;
#pragma unroll
            for (int g = 0; g < 16; ++g) acc[g] = 0.f;
#pragma unroll
            for (int ks = 0; ks < 4; ++ks) acc = __builtin_amdgcn_mfma_f32_32x32x16_bf16(Ac[ks], B[ks], acc, 0, 0, 0);
            float s1[8], s2[4], s3[2];
            const bool b0 = (hh & 1) != 0, b1 = (hh & 2) != 0, b2 = (hh & 4) != 0;
#pragma unroll
            for (int p = 0; p < 8; ++p) {
                const float x0 = fmaxf(acc[2 * p], 0.f) * wgt, x1 = fmaxf(acc[2 * p + 1], 0.f) * wgt;
                s1[p] = (b0 ? x1 : x0) + dpp_f<DPP_XOR1>(b0 ? x0 : x1);
            }
#pragma unroll
            for (int p = 0; p < 4; ++p) s2[p] = (b1 ? s1[2 * p + 1] : s1[2 * p]) + dpp_f<DPP_XOR2>(b1 ? s1[2 * p] : s1[2 * p + 1]);
#pragma unroll
            for (int p = 0; p < 2; ++p) s3[p] = (b2 ? s2[2 * p + 1] : s2[2 * p]) + __shfl_xor(b2 ? s2[2 * p] : s2[2 * p + 1], 4);
#pragma unroll
            for (int p = 0; p < 2; ++p) { const int g = 8 * p + hh; const unsigned fk = fkey(s3[p]); ((unsigned*)SC)[qq * 8192 + kt * 32 + (g & 3) + 8 * (g >> 2) + 4 * hf] = fk;
                if (rp_ == 0) atomicAdd((unsigned*)(lds + DSA_HIST_OFF) + qq * 1024 + score_bin(s3[p], bsc), 1u); }
        }
        }
    }
    __syncthreads();
    const int q = wv >> 1, l128 = (wv & 1) * 64 + lane;
    const unsigned* keys = (const unsigned*)(SC + q * 8192);
    unsigned* hist = (unsigned*)(lds + DSA_HIST_OFF) + q * 1024;
    unsigned* res = MISC + 32 + q * 4;
    for (int rp_ = 0; rp_ < ((DUP_DSA & 2) ? 2 : 1); ++rp_) {
    const float bsc = ((const float*)MISC)[48 + q];
    unsigned need = 256;
    if (rp_ > 0) {
        for (int i = l128; i < 1024; i += 128) hist[i] = 0u;
        __syncthreads();
        for (int idx = l128; idx < L; idx += 128) atomicAdd(&hist[score_bin(key_score(keys[idx]), bsc)], 1u);
        __syncthreads();
    }
    if ((wv & 1) == 0) hist_scan(hist, 1024, need, res, lane);
    __syncthreads();
    const int b0 = (int)res[0]; need -= res[1];
    __syncthreads();
    unsigned* cand = hist + 256;
    if (l128 == 0) { res[2] = 0u; res[3] = 0u; }
    if (tid == 0) MISC[52] = 0u;
    __syncthreads();
    for (int idx = l128; idx < L; idx += 128) {
        const unsigned k = keys[idx];
        if (score_bin(key_score(k), bsc) == b0) { const unsigned p = atomicAdd(&res[2], 1u); if (p < 768u) cand[p] = k; }
    }
    __syncthreads();
    const unsigned ncand = res[2];
    if (l128 == 0 && ncand > 768u) MISC[52] = 1u;
    __syncthreads();
    const bool fast = MISC[52] == 0u;
    unsigned prefix = 0;
    if (fast) {
        for (unsigned i = l128; i < ncand; i += 128) {
            const unsigned me = cand[i]; unsigned cgt = 0, ceq = 0;
            for (unsigned j = 0; j < ncand; ++j) { const unsigned o = cand[j]; cgt += (o > me) ? 1u : 0u; ceq += (o == me) ? 1u : 0u; }
            if (cgt < need && need <= cgt + ceq) { res[0] = me; res[1] = cgt; }
        }
        __syncthreads();
        prefix = res[0]; need -= res[1];
        __syncthreads();
    } else {
#pragma unroll 1
        for (int pass = 0; pass < 4; ++pass) {
            const int lo_shift = 24 - 8 * pass;
            for (int i = l128; i < 256; i += 128) hist[i] = 0u;
            __syncthreads();
            for (int idx = l128; idx < L; idx += 128) {
                const unsigned k = keys[idx];
                const bool ok = (score_bin(key_score(k), bsc) == b0) && (pass == 0 || (k >> (lo_shift + 8)) == prefix);
                if (ok) atomicAdd(&hist[(k >> lo_shift) & 255u], 1u);
            }
            __syncthreads();
            if ((wv & 1) == 0) hist_scan(hist, 256, need, res, lane);
            __syncthreads();
            prefix = (prefix << 8) | res[0]; need -= res[1];
            __syncthreads();
        }
    }
    const unsigned tkey = prefix;
    if ((wv & 1) == 0) {
        const unsigned ngt = 256u - need; unsigned rg = 0, rt = 0;
        const unsigned long long lt = (1ull << lane) - 1ull;
        for (int base = 0; base < L; base += 64) {
            const unsigned k = keys[base + lane];
            const bool gt = k > tkey, tie = k == tkey;
            const unsigned long long mg = __ballot(gt), mt = __ballot(tie);
            if (gt) { const unsigned p = rg + (unsigned)__popcll(mg & lt); if (p < 256u) SEL[(qs + q) * 256 + p] = base + lane; }
            if (tie) { const unsigned p = rt + (unsigned)__popcll(mt & lt); if (p < need) SEL[(qs + q) * 256 + ngt + p] = base + lane; }
            rg += (unsigned)__popcll(mg); rt += (unsigned)__popcll(mt);
        }
        if (lane == 0) MISC[16 + qs + q] = 256u;
    }
    __syncthreads();
    for (int i = l128; i < 256; i += 128) { const int e = SEL[(qs + q) * 256 + i]; SEL[(qs + q) * 256 + i] = e | (rel_bucket(e - (t0 + q)) << 16); }
    __syncthreads();
    }
}

__device__ __forceinline__ void dsa_attend(const Args& a, const int t, const int* sel, const int nsel, unsigned char* ct, const float* relb_l) {
    const unsigned char* CB8 = a.ws + WS_CB; const unsigned char* QL8 = a.ws + WS_QLAT; unsigned char* OL8 = a.ws + WS_OLAT;
    const int lane = my_tid() & 63, fr = lane & 15, fq = lane >> 4;
    bf16x8 Bq[8];
#pragma unroll
    for (int ks = 0; ks < 8; ++ks) Bq[ks] = fp8x8_to_bf16(*reinterpret_cast<const uint2*>(&QL8[((size_t)t * NH + fr) * 256 + ks * 32 + fq * 8]));
    f32x4 o[16];
#pragma unroll
    for (int mt = 0; mt < 16; ++mt) o[mt] = f32x4{0.f, 0.f, 0.f, 0.f};
    float mrun = -1e30f, lrun = 0.f;
    const unsigned tr_addr = (unsigned)(size_t)ct + (unsigned)((4 * fq + (fr >> 2)) * CT_ROW + (fr & 3) * 8);
    const int nblk = nsel >> 5;
    uint2 Ar[2][8];
#pragma unroll
    for (int tt = 0; tt < 2; ++tt) {
        const int kidx = sel[tt * 16 + fr] & 0xFFFF;
#pragma unroll
        for (int ks = 0; ks < 8; ++ks) Ar[tt][ks] = *reinterpret_cast<const uint2*>(&CB8[(size_t)kidx * 256 + ks * 32 + fq * 8]);
    }
    for (int kb = 0; kb < nblk; ++kb) {
        f32x4 st[2];
#pragma unroll
        for (int tt = 0; tt < 2; ++tt) {
            st[tt] = f32x4{0.f, 0.f, 0.f, 0.f};
#pragma unroll
            for (int ks = 0; ks < 8; ++ks) {
                const bf16x8 Af = fp8x8_to_bf16(Ar[tt][ks]);
                st[tt] = __builtin_amdgcn_mfma_f32_16x16x32_bf16(Af, Bq[ks], st[tt], 0, 0, 0);
                *reinterpret_cast<bf16x8*>(ct + (tt * 16 + fr) * CT_ROW + (ks * 32 + fq * 8) * 2) = Af;
            }
        }
        if (kb + 1 < nblk) {
#pragma unroll
            for (int tt = 0; tt < 2; ++tt) {
                const int kidx = sel[(kb + 1) * 32 + tt * 16 + fr] & 0xFFFF;
#pragma unroll
                for (int ks = 0; ks < 8; ++ks) Ar[tt][ks] = *reinterpret_cast<const uint2*>(&CB8[(size_t)kidx * 256 + ks * 32 + fq * 8]);
            }
        }
        float lg[8]; float bmax = -1e30f;
#pragma unroll
        for (int tt = 0; tt < 2; ++tt) {
            const int4 k4 = *reinterpret_cast<const int4*>(&sel[kb * 32 + tt * 16 + fq * 4]);
            const int kk4[4] = {k4.x, k4.y, k4.z, k4.w};
#pragma unroll
            for (int j = 0; j < 4; ++j) {
                const float v = st[tt][j] * 0.125f + relb_l[(kk4[j] >> 16) * 16 + fr];
                lg[tt * 4 + j] = v; bmax = fmaxf(bmax, v);
            }
        }
        bmax = fmaxf(bmax, __shfl_xor(bmax, 16)); bmax = fmaxf(bmax, __shfl_xor(bmax, 32));
        const bool resc = __any(bmax > mrun + 8.f);
        float alpha = 1.f;
        if (resc) { const float mnew = fmaxf(mrun, bmax); alpha = __expf(mrun - mnew); mrun = mnew; lrun *= alpha; }
        float psum = 0.f; bf16x8 Pf;
#pragma unroll
        for (int e = 0; e < 8; e += 2) {
            const float p0 = __expf(lg[e] - mrun), p1 = __expf(lg[e + 1] - mrun); psum += p0 + p1;
            const unsigned pk = pack2(p0, p1); Pf[e] = (short)(pk & 0xFFFF); Pf[e + 1] = (short)(pk >> 16);
        }
        lrun += psum;
        asm volatile("s_waitcnt lgkmcnt(0)" ::: "memory");
        __builtin_amdgcn_wave_barrier();
#pragma unroll
        for (int m4 = 0; m4 < 4; ++m4) {
            uint2 r0[4], r1[4];
            asm volatile("ds_read_b64_tr_b16 %0, %8 offset:%9\n\tds_read_b64_tr_b16 %1, %8 offset:%10\n\t"
                         "ds_read_b64_tr_b16 %2, %8 offset:%11\n\tds_read_b64_tr_b16 %3, %8 offset:%12\n\t"
                         "ds_read_b64_tr_b16 %4, %8 offset:%13\n\tds_read_b64_tr_b16 %5, %8 offset:%14\n\t"
                         "ds_read_b64_tr_b16 %6, %8 offset:%15\n\tds_read_b64_tr_b16 %7, %8 offset:%16\n\ts_waitcnt lgkmcnt(0)"
                         : "=&v"(r0[0]), "=&v"(r1[0]), "=&v"(r0[1]), "=&v"(r1[1]), "=&v"(r0[2]), "=&v"(r1[2]), "=&v"(r0[3]), "=&v"(r1[3])
                         : "v"(tr_addr), "n"(m4 * 128), "n"(m4 * 128 + 16 * CT_ROW), "n"(m4 * 128 + 32), "n"(m4 * 128 + 32 + 16 * CT_ROW),
                           "n"(m4 * 128 + 64), "n"(m4 * 128 + 64 + 16 * CT_ROW), "n"(m4 * 128 + 96), "n"(m4 * 128 + 96 + 16 * CT_ROW)
                         : "memory");
#pragma unroll
            for (int i = 0; i < 4; ++i) {
                const int mt = m4 * 4 + i;
                const u32x4 raw = {r0[i].x, r0[i].y, r1[i].x, r1[i].y};
                const bf16x8 Av = __builtin_bit_cast(bf16x8, raw);
                f32x4 oo = o[mt];
                if (resc) { oo[0] *= alpha; oo[1] *= alpha; oo[2] *= alpha; oo[3] *= alpha; }
                o[mt] = __builtin_amdgcn_mfma_f32_16x16x32_bf16(Av, Pf, oo, 0, 0, 0);
            }
        }
        asm volatile("s_waitcnt lgkmcnt(0)" ::: "memory");
        __builtin_amdgcn_wave_barrier();
    }
    lrun += __shfl_xor(lrun, 16); lrun += __shfl_xor(lrun, 32);
    const float inv = frcp_(lrun);
#pragma unroll
    for (int mt = 0; mt < 16; ++mt) {
        *reinterpret_cast<unsigned*>(&OL8[((size_t)t * NH + fr) * 256 + mt * 16 + fq * 4]) = pack4_fp8(o[mt][0] * inv, o[mt][1] * inv, o[mt][2] * inv, o[mt][3] * inv);
    }
}

constexpr int DSA_CCAP = 256;
__device__ __forceinline__ bool dsa_select8(const Args& a, const int t0, unsigned char* lds) {
    const bfr* P = (const bfr*)(a.ws + WS_P); const bfr* IKC = (const bfr*)(a.ws + WS_IKC);
    unsigned* KEYS = (unsigned*)(a.ws + WS_KEYS) + (size_t)blockIdx.x * (8 * 8192);
    unsigned short* BIN = (unsigned short*)lds; unsigned* H16 = (unsigned*)(lds + DSA_HIST_OFF);
    int* SEL = (int*)(lds + DSA_SEL_OFF); unsigned* MISC = (unsigned*)(lds + LDS_MISC);
    const int tid = my_tid(), lane = tid & 63, wv = tid >> 6, r = lane & 31, hf = lane >> 5;
    const int L = 64 * (t0 / 64 + 1);
    if (L <= 256) {
        for (int i = tid; i < 8 * 256; i += 512) SEL[i] = (i & 255) | (rel_bucket((i & 255) - (t0 + (i >> 8))) << 16);
        if (tid < 8) MISC[16 + tid] = (unsigned)L;
        __syncthreads();
        return true;
    }
    for (int i = tid; i < 4096; i += 512) H16[i] = 0u;
    if (tid == 0) MISC[60] = 0u;
    __syncthreads();
    {
        const int qq = r >> 3, hh = r & 7;
        bf16x8 B[2][4]; float wgt[2], bsc[2];
#pragma unroll
        for (int grp = 0; grp < 2; ++grp) {
#pragma unroll
            for (int ks = 0; ks < 4; ++ks) B[grp][ks] = *reinterpret_cast<const bf16x8*>(&P[(size_t)(t0 + grp * 4 + qq) * NINP + C_IQ + hh * 64 + ks * 16 + hf * 8]);
            wgt[grp] = bf2f(P[(size_t)(t0 + grp * 4 + qq) * NINP + C_IW + hh]) * IDX_SCALE;
            float w2 = wgt[grp] * wgt[grp]; w2 += dpp_f<DPP_XOR1>(w2); w2 += dpp_f<DPP_XOR2>(w2); w2 += dpp_f<0x141>(w2);
            bsc[grp] = bin_scale(w2);
            if (hh == 0 && hf == 0) ((float*)MISC)[48 + grp * 4 + qq] = bsc[grp];
        }
        const bool b0 = (hh & 1) != 0, b1 = (hh & 2) != 0, b2 = (hh & 4) != 0;
        const int ntile = L >> 5;
        bf16x8 An[4];
        if (wv < ntile) {
#pragma unroll
            for (int ks = 0; ks < 4; ++ks) An[ks] = *reinterpret_cast<const bf16x8*>(&IKC[(size_t)(wv * 32 + r) * 64 + ks * 16 + hf * 8]);
        }
        for (int kt = wv; kt < ntile; kt += 8) {
            bf16x8 Ac[4];
#pragma unroll
            for (int ks = 0; ks < 4; ++ks) Ac[ks] = An[ks];
            if (kt + 8 < ntile) {
#pragma unroll
                for (int ks = 0; ks < 4; ++ks) An[ks] = *reinterpret_cast<const bf16x8*>(&IKC[(size_t)((kt + 8) * 32 + r) * 64 + ks * 16 + hf * 8]);
            }
#pragma unroll
            for (int grp = 0; grp < 2; ++grp) {
                f32x16 acc;
#pragma unroll
                for (int g = 0; g < 16; ++g) acc[g] = 0.f;
#pragma unroll
                for (int ks = 0; ks < 4; ++ks) acc = __builtin_amdgcn_mfma_f32_32x32x16_bf16(Ac[ks], B[grp][ks], acc, 0, 0, 0);
                float s1[8], s2[4], s3[2];
#pragma unroll
                for (int p = 0; p < 8; ++p) {
                    const float x0 = fmaxf(acc[2 * p], 0.f) * wgt[grp], x1 = fmaxf(acc[2 * p + 1], 0.f) * wgt[grp];
                    s1[p] = (b0 ? x1 : x0) + dpp_f<DPP_XOR1>(b0 ? x0 : x1);
                }
#pragma unroll
                for (int p = 0; p < 4; ++p) s2[p] = (b1 ? s1[2 * p + 1] : s1[2 * p]) + dpp_f<DPP_XOR2>(b1 ? s1[2 * p] : s1[2 * p + 1]);
#pragma unroll
                for (int p = 0; p < 2; ++p) s3[p] = (b2 ? s2[2 * p + 1] : s2[2 * p]) + __shfl_xor(b2 ? s2[2 * p] : s2[2 * p + 1], 4);
#pragma unroll
                for (int p = 0; p < 2; ++p) {
                    const int g = 8 * p + hh, kidx = kt * 32 + (g & 3) + 8 * (g >> 2) + 4 * hf, q = grp * 4 + qq;
                    const int bin = score_bin(s3[p], bsc[grp]);
                    BIN[q * 8192 + kidx] = (unsigned short)bin;
                    atomicAdd(&H16[q * 512 + (bin >> 1)], (bin & 1) ? 0x10000u : 1u);
                    KEYS[q * 8192 + kidx] = fkey(s3[p]);
                }
            }
        }
    }
    asm volatile("s_waitcnt vmcnt(0)" ::: "memory");
    __syncthreads();
    {
        const int q = wv;
        const unsigned short* bins = BIN + q * 8192;
        unsigned* hrow = H16 + q * 512;
        unsigned cnt[16]; unsigned sown = 0;
#pragma unroll
        for (int i = 0; i < 8; ++i) { const unsigned w = hrow[lane * 8 + i]; cnt[2 * i] = w & 0xFFFFu; cnt[2 * i + 1] = w >> 16; sown += cnt[2 * i] + cnt[2 * i + 1]; }
        unsigned S = sown;
#pragma unroll
        for (int o = 1; o < 64; o <<= 1) { const unsigned tt = __shfl_down(S, o); if (lane + o < 64) S += tt; }
        const unsigned long long mfound = __ballot(S >= 256u);
        const int ls = 63 - __clzll(mfound);
        int b0l = 0; unsigned abovel = 0;
        {
            unsigned accv = S - sown; bool done = false;
#pragma unroll
            for (int bb = 15; bb >= 0; --bb) { if (!done) { if (accv + cnt[bb] >= 256u) { b0l = lane * 16 + bb; abovel = accv; done = true; } else accv += cnt[bb]; } }
        }
        const int b0 = __shfl(b0l, ls); const unsigned ngt = __shfl((int)abovel, ls); const unsigned need = 256u - ngt;
        __builtin_amdgcn_wave_barrier();
        int* CL = (int*)hrow; unsigned* CK = hrow + DSA_CCAP;
        const unsigned long long lt = (1ull << lane) - 1ull;
        unsigned rg = 0, rc = 0;
        for (int base = 0; base < (L >> 1); base += 64) {
            const bool valid = (base + lane) < (L >> 1);
            const unsigned w = valid ? reinterpret_cast<const unsigned*>(bins)[base + lane] : 0u;
            const int ba = (int)(w & 0xFFFFu), bb = (int)(w >> 16), ia = 2 * (base + lane), ib = ia + 1;
            const bool ga = valid && ba > b0, gb = valid && bb > b0, ca = valid && ba == b0, cb = valid && bb == b0;
            const unsigned long long mga = __ballot(ga), mgb = __ballot(gb), mca = __ballot(ca), mcb = __ballot(cb);
            const unsigned pg = rg + (unsigned)__popcll(mga & lt) + (unsigned)__popcll(mgb & lt);
            const unsigned pc = rc + (unsigned)__popcll(mca & lt) + (unsigned)__popcll(mcb & lt);
            if (ga && pg < 256u) SEL[q * 256 + pg] = ia;
            if (gb && pg + (ga ? 1u : 0u) < 256u) SEL[q * 256 + pg + (ga ? 1u : 0u)] = ib;
            if (ca && pc < (unsigned)DSA_CCAP) CL[pc] = ia;
            if (cb && pc + (ca ? 1u : 0u) < (unsigned)DSA_CCAP) CL[pc + (ca ? 1u : 0u)] = ib;
            rg += (unsigned)__popcll(mga) + (unsigned)__popcll(mgb); rc += (unsigned)__popcll(mca) + (unsigned)__popcll(mcb);
        }
        const unsigned ncand = rc;
        if (ncand > (unsigned)DSA_CCAP) { if (lane == 0) MISC[60] = 1u; }
        else {
            asm volatile("s_waitcnt lgkmcnt(0)" ::: "memory");
            for (unsigned i = lane; i < ncand; i += 64) CK[i] = __hip_atomic_load(&KEYS[q * 8192 + CL[i]], __ATOMIC_RELAXED, __HIP_MEMORY_SCOPE_AGENT);
            asm volatile("s_waitcnt vmcnt(0) lgkmcnt(0)" ::: "memory");
            __builtin_amdgcn_wave_barrier();
            for (unsigned i = lane; i < ncand; i += 64) {
                const unsigned me = CK[i]; unsigned rk = 0;
                for (unsigned j = 0; j < ncand; ++j) { const unsigned o = CK[j]; rk += (o > me || (o == me && j < i)) ? 1u : 0u; }
                if (rk < need) SEL[q * 256 + ngt + rk] = CL[i];
            }
            asm volatile("s_waitcnt lgkmcnt(0)" ::: "memory");
            __builtin_amdgcn_wave_barrier();
            for (int i = lane; i < 256; i += 64) { const int e = SEL[q * 256 + i]; SEL[q * 256 + i] = e | (rel_bucket(e - (t0 + q)) << 16); }
            if (lane == 0) MISC[16 + q] = 256u;
        }
    }
    __syncthreads();
    return MISC[60] == 0u;
}

__device__ __forceinline__ void dsa_unit(const Args& a, const int unit, unsigned char* lds) {
    const int t0 = unit * 8, wv = my_tid() >> 6;
    if (!dsa_select8(a, t0, lds)) {
        __syncthreads();
        dsa_select4(a, t0, 0, lds);
        dsa_select4(a, t0 + 4, 4, lds);
    }
    const int* SEL = (const int*)(lds + DSA_SEL_OFF); const unsigned* MISC = (const unsigned*)(lds + LDS_MISC);
    dsa_attend(a, t0 + wv, SEL + wv * 256, (int)MISC[16 + wv], lds + wv * CT_WAVE, (const float*)(lds + DSA_RELB_OFF));
    __syncthreads();
}
template <int J> __device__ __forceinline__ int xchg_i(int v) {
    if (J == 1) return __builtin_amdgcn_update_dpp(0, v, 0xB1, 0xF, 0xF, true);
    else if (J == 2) return __builtin_amdgcn_update_dpp(0, v, 0x4E, 0xF, 0xF, true);
    else if (J == 4) { int t = __builtin_amdgcn_update_dpp(v, v, 0x104, 0xF, 0x5, false);
                       return __builtin_amdgcn_update_dpp(t, v, 0x114, 0xF, 0xA, false); }
    else if (J == 8) return __builtin_amdgcn_update_dpp(0, v, 0x128, 0xF, 0xF, true);
    else return __shfl_xor(v, J);
}
template <int J> __device__ __forceinline__ float xchg_f(float v) { return __int_as_float(xchg_i<J>(__float_as_int(v))); }

__device__ __forceinline__ unsigned okey(float f) { const unsigned u = __float_as_uint(f); return (u & 0x80000000u) ? ~u : (u | 0x80000000u); }
template <int K, int J> __device__ __forceinline__ void bitonic_step(unsigned& k, const int lane) {
    const unsigned ok = (unsigned)xchg_i<J>((int)k);
    const bool desc = (K == 64) ? true : ((lane & K) == 0);
    const bool keepmax = ((lane & J) == 0) == desc;
    k = keepmax ? max(k, ok) : min(k, ok);
}
__device__ __forceinline__ void bitonic64(unsigned& k, const int lane) {
    bitonic_step<2, 1>(k, lane);
    bitonic_step<4, 2>(k, lane); bitonic_step<4, 1>(k, lane);
    bitonic_step<8, 4>(k, lane); bitonic_step<8, 2>(k, lane); bitonic_step<8, 1>(k, lane);
    bitonic_step<16, 8>(k, lane); bitonic_step<16, 4>(k, lane); bitonic_step<16, 2>(k, lane); bitonic_step<16, 1>(k, lane);
    bitonic_step<32, 16>(k, lane); bitonic_step<32, 8>(k, lane); bitonic_step<32, 4>(k, lane); bitonic_step<32, 2>(k, lane); bitonic_step<32, 1>(k, lane);
    bitonic_step<64, 32>(k, lane); bitonic_step<64, 16>(k, lane); bitonic_step<64, 8>(k, lane); bitonic_step<64, 4>(k, lane); bitonic_step<64, 2>(k, lane); bitonic_step<64, 1>(k, lane);
}
__device__ __forceinline__ void merge32(unsigned& k, const int lane) {
    bitonic_step<64, 16>(k, lane); bitonic_step<64, 8>(k, lane); bitonic_step<64, 4>(k, lane); bitonic_step<64, 2>(k, lane); bitonic_step<64, 1>(k, lane);
}
__device__ __forceinline__ void top16_of_128(const float* s, float& tv, int& ti, const int lane) {
    unsigned ka = (okey(s[lane]) & ~0x7Fu) | (unsigned)(127 - lane), kb = (okey(s[64 + lane]) & ~0x7Fu) | (unsigned)(63 - lane);
    bitonic64(ka, lane); bitonic64(kb, lane);
    const unsigned rb = (unsigned)__shfl((int)kb, 31 - lane);
    unsigned k = (lane < 16) ? ka : ((lane < 32) ? rb : 0u);
    merge32(k, lane);
    ti = 127 - (int)(k & 0x7Fu);
    tv = s[ti];
}

__device__ __forceinline__ unsigned mirror16(unsigned v) { return (unsigned)__builtin_amdgcn_update_dpp(0, (int)v, 0x140, 0xF, 0xF, true); }
__device__ __forceinline__ void top16_pair(const float* s1, const float* s2, float& tv, int& ti, const int lane) {
    unsigned a1 = (okey(s1[lane]) & ~0x7Fu) | (unsigned)(127 - lane), b1 = (okey(s1[64 + lane]) & ~0x7Fu) | (unsigned)(63 - lane);
    unsigned a2 = (okey(s2[lane]) & ~0x7Fu) | (unsigned)(127 - lane), b2 = (okey(s2[64 + lane]) & ~0x7Fu) | (unsigned)(63 - lane);
#define PEER_S4(K, J) bitonic_step<K, J>(a1, lane); bitonic_step<K, J>(b1, lane); bitonic_step<K, J>(a2, lane); bitonic_step<K, J>(b2, lane);
    PEER_S4(2, 1) PEER_S4(4, 2) PEER_S4(4, 1) PEER_S4(8, 4) PEER_S4(8, 2) PEER_S4(8, 1) PEER_S4(64, 8) PEER_S4(64, 4) PEER_S4(64, 2) PEER_S4(64, 1)
#undef PEER_S4
    unsigned m1 = max(a1, mirror16(b1)), m2 = max(a2, mirror16(b2));
#define PEER_S2(J) bitonic_step<64, J>(m1, lane); bitonic_step<64, J>(m2, lane);
    PEER_S2(8) PEER_S2(4) PEER_S2(2) PEER_S2(1)
#undef PEER_S2
    const bool odd = (lane & 16) != 0;
    const unsigned own = odd ? m2 : m1, snd = odd ? m1 : m2;
    unsigned c = max(own, (unsigned)__shfl_xor((int)snd, 31));
    bitonic_step<64, 8>(c, lane); bitonic_step<64, 4>(c, lane); bitonic_step<64, 2>(c, lane); bitonic_step<64, 1>(c, lane);
    c = max(c, (unsigned)__shfl_xor((int)c, 47));
    bitonic_step<64, 8>(c, lane); bitonic_step<64, 4>(c, lane); bitonic_step<64, 2>(c, lane); bitonic_step<64, 1>(c, lane);
    ti = 127 - (int)(c & 0x7Fu);
    tv = (odd ? s2 : s1)[ti];
}

#ifndef DUP_PEER
#define DUP_PEER 0
#endif
constexpr int PEER_EID_OFF = 131072, PEER_GATE_OFF = 139264;
#ifndef PGB
#define PGB 8
#endif

__device__ __forceinline__ void peer_unit(const Args& a, const int unit, unsigned char* lds) {
    const bfr* QP = (const bfr*)(a.ws + WS_QP); const bfr* SUBK = (const bfr*)(a.ws + WS_SUBK);
    const unsigned char* PU4 = a.ws + WS_PU; const unsigned char* PV4 = a.ws + WS_PV;
    const bfr* HB = (const bfr*)(a.ws + WS_HB); const float* part = (const float*)(a.ws + WS_PART);
    float* S = (float*)lds; int* EID = (int*)(lds + PEER_EID_OFF); float* GATE = (float*)(lds + PEER_GATE_OFF);
    const int tid = my_tid(), lane = tid & 63, wv = tid >> 6, fr = lane & 15, fq = lane >> 4, t0 = unit * 16;
    for (int rp_ = 0; rp_ < ((DUP_PEER & 1) ? 2 : 1); ++rp_) {
    for (int hc = wv * 2; hc < wv * 2 + 2; ++hc) {
        bf16x8 A[4];
#pragma unroll
        for (int ks = 0; ks < 4; ++ks) A[ks] = *reinterpret_cast<const bf16x8*>(&QP[(size_t)(t0 + fr) * D + hc * 128 + ks * 32 + fq * 8]);
#pragma unroll 2
        for (int nt = 0; nt < 8; ++nt) {
            f32x4 acc = {0.f, 0.f, 0.f, 0.f};
#pragma unroll
            for (int ks = 0; ks < 4; ++ks) {
                const bf16x8 B = *reinterpret_cast<const bf16x8*>(&SUBK[(size_t)(hc * 128 + nt * 16 + fr) * 128 + ks * 32 + fq * 8]);
                acc = __builtin_amdgcn_mfma_f32_16x16x32_bf16(A[ks], B, acc, 0, 0, 0);
            }
#pragma unroll
            for (int j = 0; j < 4; ++j) S[((fq * 4 + j) * 16 + hc) * 128 + nt * 16 + fr] = acc[j];
        }
    }
    __syncthreads();
    for (int job = wv * 16; job < wv * 16 + 16; ++job) {
        const int tok = job >> 3, hh = job & 7;
        const float* s1 = S + (tok * 16 + hh * 2) * 128; const float* s2 = s1 + 128;
        float vv; int ii;
        top16_pair(s1, s2, vv, ii, lane);
        int ci = -1, cj = 0;
        { int base = 0;
#pragma unroll
          for (int i = 0; i < 16; ++i) { const int cnt = 16 / (i + 1); if (lane >= base && lane < base + cnt) { ci = i; cj = lane - base; } base += cnt; } }
        const float a1 = __shfl(vv, ci < 0 ? 0 : ci), b1 = __shfl(vv, 16 + cj);
        unsigned ck = (ci >= 0) ? ((okey(a1 + b1) & ~0xFFu) | (unsigned)(255 - (ci * 16 + cj))) : 0u;
        bitonic64(ck, lane);
        const int cid = 255 - (int)(ck & 0xFFu);
        const int pi = (lane < 16) ? (cid >> 4) : 0, pj = (lane < 16) ? (cid & 15) : 0;
        const float cv = __shfl(vv, pi) + __shfl(vv, 16 + pj);
        const float mx = __shfl(cv, 0);
        float e = (lane < 16) ? __expf(cv - mx) : 0.f;
        float se = e;
#pragma unroll
        for (int o = 1; o < 16; o <<= 1) se += __shfl_xor(se, o);
        const int e1 = __shfl(ii, pi), e2 = __shfl(ii, 16 + pj);
        if (lane < 16) { EID[tok * 128 + hh * 16 + lane] = e1 * 128 + e2; GATE[tok * 128 + hh * 16 + lane] = e * frcp_(se); }
    }
    __syncthreads();
    }
    for (int rp_ = 0; rp_ < ((DUP_PEER & 2) ? 2 : 1); ++rp_)
    for (int tk = wv * 2; tk < wv * 2 + 2; ++tk) {
        const int t = t0 + tk;
        int ln = lane; asm volatile("" : "+v"(ln));
        const float rstd = row_rstd(part, t);
        unsigned q1[4], q2[4]; float h1s, h2s;
        {
            float hf[32]; float am = 0.f;
#pragma unroll
            for (int q = 0; q < 8; ++q) {
                const uint2 xr = *reinterpret_cast<const uint2*>(&HB[(size_t)t * D + q * 256 + ln * 4]);
                const float4 g0 = *reinterpret_cast<const float4*>(&a.in[I_NFG][q * 256 + ln * 4]);
                hf[q * 4] = bflo(xr.x) * rstd * g0.x; hf[q * 4 + 1] = bfhi(xr.x) * rstd * g0.y; hf[q * 4 + 2] = bflo(xr.y) * rstd * g0.z; hf[q * 4 + 3] = bfhi(xr.y) * rstd * g0.w;
                am = fmaxf(am, fmaxf(fmaxf(fabsf(hf[q * 4]), fabsf(hf[q * 4 + 1])), fmaxf(fabsf(hf[q * 4 + 2]), fabsf(hf[q * 4 + 3]))));
            }
            h1s = am * (1.f / 7.f); const float i1 = h1s > 0.f ? frcp_(h1s) : 0.f;
            float qv[32]; float am2 = 0.f;
#pragma unroll
            for (int i = 0; i < 32; ++i) { qv[i] = fminf(fmaxf(__builtin_rintf(hf[i] * i1), -7.f), 7.f); hf[i] -= qv[i] * h1s; am2 = fmaxf(am2, fabsf(hf[i])); }
            q1[0] = pack8_i4(qv); q1[1] = pack8_i4(qv + 8); q1[2] = pack8_i4(qv + 16); q1[3] = pack8_i4(qv + 24);
            h2s = am2 * (1.f / 7.f); const float i2 = h2s > 0.f ? frcp_(h2s) : 0.f;
#pragma unroll
            for (int i = 0; i < 32; ++i) qv[i] = fminf(fmaxf(__builtin_rintf(hf[i] * i2), -7.f), 7.f);
            q2[0] = pack8_i4(qv); q2[1] = pack8_i4(qv + 8); q2[2] = pack8_i4(qv + 16); q2[3] = pack8_i4(qv + 24);
        }
        float coef0 = 0.f, coef1 = 0.f;
#pragma unroll 1
        for (int half = 0; half < 2; ++half) {
            float mydot = 0.f;
#define PEER_LOAD_U(W, SC, E0) _Pragma("unroll") for (int bq = 0; bq < 4; ++bq) { \
                const int eid = EID[tk * 128 + half * 64 + (E0) + bq]; const unsigned char* rowp = PU4 + (size_t)eid * PEER_ROWB; \
                SC[bq] = *reinterpret_cast<const bfr*>(rowp + 1024 + ln * 2); W[bq] = *reinterpret_cast<const uint4*>(rowp + ln * 16); } __builtin_amdgcn_sched_barrier(0);
#define PEER_DOT_U(W, SC, E0) _Pragma("unroll") for (int bq = 0; bq < 4; ++bq) { \
                int a1 = 0, a2 = 0; \
                a1 = __builtin_amdgcn_sdot8((int)W[bq].x, (int)q1[0], a1, false); a2 = __builtin_amdgcn_sdot8((int)W[bq].x, (int)q2[0], a2, false); \
                a1 = __builtin_amdgcn_sdot8((int)W[bq].y, (int)q1[1], a1, false); a2 = __builtin_amdgcn_sdot8((int)W[bq].y, (int)q2[1], a2, false); \
                a1 = __builtin_amdgcn_sdot8((int)W[bq].z, (int)q1[2], a1, false); a2 = __builtin_amdgcn_sdot8((int)W[bq].z, (int)q2[2], a2, false); \
                a1 = __builtin_amdgcn_sdot8((int)W[bq].w, (int)q1[3], a1, false); a2 = __builtin_amdgcn_sdot8((int)W[bq].w, (int)q2[3], a2, false); \
                float p = ((float)a1 * h1s + (float)a2 * h2s) * bf2f(SC[bq]); \
                p = wave_sum(p); if (lane == (E0) + bq) mydot = p; __builtin_amdgcn_sched_barrier(0); }
            {
                uint4 wA[4], wB[4]; bfr sA[4], sB[4];
                PEER_LOAD_U(wA, sA, 0)
#pragma unroll 1
                for (int e0 = 0; e0 < 56; e0 += 8) {
                    PEER_LOAD_U(wB, sB, e0 + 4)
                    PEER_DOT_U(wA, sA, e0)
                    PEER_LOAD_U(wA, sA, e0 + 8)
                    PEER_DOT_U(wB, sB, e0 + 4)
                }
                PEER_LOAD_U(wB, sB, 60)
                PEER_DOT_U(wA, sA, 56)
                PEER_DOT_U(wB, sB, 60)
            }
            const float gl = 0.5f * mydot * (1.f + erff(mydot * 0.7071067811865476f));
            const float cfv = gl * GATE[tk * 128 + half * 64 + lane];
            if (half == 0) coef0 = cfv; else coef1 = cfv;
        }
        h16x2 ov2[16];
#pragma unroll
        for (int j = 0; j < 16; ++j) ov2[j] = h16x2{(_Float16)0.f, (_Float16)0.f};
        {
#define PEER_LOAD_V(W, SC, E0) _Pragma("unroll") for (int bq = 0; bq < 4; ++bq) { \
                const int eid = __builtin_amdgcn_readfirstlane(EID[tk * 128 + (E0) + bq]); const unsigned char* rowp = PV4 + (size_t)eid * PEER_ROWB; \
                SC[bq] = *reinterpret_cast<const bfr*>(rowp + 1024 + ln * 2); W[bq] = *reinterpret_cast<const uint4*>(rowp + ln * 16); } __builtin_amdgcn_sched_barrier(0);
#define PEER_AXPY_V(W, SC, E0) _Pragma("unroll") for (int bq = 0; bq < 4; ++bq) { \
                const float cfl = __int_as_float(__builtin_amdgcn_readlane(__float_as_int(((E0) < 64) ? coef0 : coef1), ((E0) + bq) & 63)); \
                const unsigned dw[4] = {W[bq].x, W[bq].y, W[bq].z, W[bq].w}; const _Float16 ch = (_Float16)(cfl * bf2f(SC[bq])); const h16x2 c2 = {ch, ch}; \
                _Pragma("unroll") for (int d = 0; d < 4; ++d) { \
                    ov2[d * 4 + 0] = c2 * __builtin_amdgcn_cvt_scalef32_pk_f16_fp4(dw[d], 1.0f, 0) + ov2[d * 4 + 0]; \
                    ov2[d * 4 + 1] = c2 * __builtin_amdgcn_cvt_scalef32_pk_f16_fp4(dw[d], 1.0f, 1) + ov2[d * 4 + 1]; \
                    ov2[d * 4 + 2] = c2 * __builtin_amdgcn_cvt_scalef32_pk_f16_fp4(dw[d], 1.0f, 2) + ov2[d * 4 + 2]; \
                    ov2[d * 4 + 3] = c2 * __builtin_amdgcn_cvt_scalef32_pk_f16_fp4(dw[d], 1.0f, 3) + ov2[d * 4 + 3]; } \
                __builtin_amdgcn_sched_barrier(0); }
            uint4 wA[4], wB[4]; bfr sA[4], sB[4];
            PEER_LOAD_V(wA, sA, 0)
#pragma unroll 1
            for (int e0 = 0; e0 < 120; e0 += 8) {
                PEER_LOAD_V(wB, sB, e0 + 4)
                PEER_AXPY_V(wA, sA, e0)
                PEER_LOAD_V(wA, sA, e0 + 8)
                PEER_AXPY_V(wB, sB, e0 + 4)
            }
            PEER_LOAD_V(wB, sB, 124)
            PEER_AXPY_V(wA, sA, 120)
            PEER_AXPY_V(wB, sB, 124)
        }
        float ss = 0.f;
        float hv[32];
        { int l2 = lane; asm volatile("" : "+v"(l2));
#pragma unroll
          for (int q = 0; q < 8; ++q) {
              const uint2 xr = *reinterpret_cast<const uint2*>(&HB[(size_t)t * D + q * 256 + l2 * 4]);
              float4 x0; x0.x = bflo(xr.x); x0.y = bfhi(xr.x); x0.z = bflo(xr.y); x0.w = bfhi(xr.y);
              hv[q * 4 + 0] = x0.x; hv[q * 4 + 1] = x0.y; hv[q * 4 + 2] = x0.z; hv[q * 4 + 3] = x0.w;
          } }
#pragma unroll
        for (int j = 0; j < 32; ++j) { hv[j] += (DBG_NOPEER ? 0.f : (float)ov2[j >> 1][j & 1]); ss += hv[j] * hv[j]; }
        ss = wave_sum(ss);
        const float r2 = rsqrtf(ss * (1.f / D) + EPS);
#pragma unroll
        for (int q = 0; q < 8; ++q) {
            const float4 g0 = *reinterpret_cast<const float4*>(&a.in[I_NFIN][q * 256 + ln * 4]);
            float4 o0;
            o0.x = hv[q * 4 + 0] * r2 * g0.x; o0.y = hv[q * 4 + 1] * r2 * g0.y; o0.z = hv[q * 4 + 2] * r2 * g0.z; o0.w = hv[q * 4 + 3] * r2 * g0.w;
            *reinterpret_cast<float4*>(&a.out[(size_t)t * D + q * 256 + ln * 4]) = o0;
        }
    }
    __syncthreads();
}
constexpr int NPHASE = 9;
__global__ void __launch_bounds__(512, 2) mk_fwd(Args a) {
    extern __shared__ __attribute__((aligned(16))) unsigned char lds[];
    volatile LAS unsigned* barw = (volatile LAS unsigned*)((LAS unsigned char*)lds + LDS_BARW);
    unsigned* MISC = (unsigned*)(lds + LDS_MISC);
    if (threadIdx.x < 4) barw[threadIdx.x] = 0u;
    __syncthreads();
    XcdBarrier bar; bar.bar = (unsigned*)(a.ws + WS_CTL); bar.x = 0; bar.st = barw;
#if !MK_SPLIT
    bar = xcd_barrier_post((unsigned*)(a.ws + WS_CTL), barw);
#endif
    const int lo = a.ph_lo, hi = a.ph_hi;
#ifndef PH_MASK
#define PH_MASK 0x1FF
#endif
#define IN(k) (((PH_MASK >> (k)) & 1) && lo <= (k) && (k) < hi)
#ifndef DUP_RW
#define DUP_RW 0
#endif
#ifndef DUP_CHAIN
#define DUP_CHAIN 0
#endif
#ifndef DUP_MASK
#define DUP_MASK 0
#endif
#define REP(k) for (int rep_ = 0; rep_ < (((DUP_MASK >> (k)) & 1) ? 2 : 1); ++rep_)
#define SEAM(k) do { if (IN(k) && IN((k) + 1)) xcd_barrier(bar); } while (0)
    unsigned char* ws = a.ws;
    const bfr* P = (const bfr*)(ws + WS_P);

    if (IN(0)) REP(0) {
        const int tid = my_tid(), wv = tid >> 6; (void)tid; (void)wv;
        {
            const float* x = a.in[I_X]; const float* g = a.in[I_NMG]; bfr* XN = (bfr*)(ws + WS_XN);
            const int lane = tid & 63;
            for (int row = blockIdx.x * 8 + wv; row < T; row += gridDim.x * 8) {
                float4 v[8]; float ss = 0.f;
#pragma unroll
                for (int j = 0; j < 8; ++j) { v[j] = reinterpret_cast<const float4*>(x + (size_t)row * D)[j * 64 + lane]; ss += v[j].x * v[j].x + v[j].y * v[j].y + v[j].z * v[j].z + v[j].w * v[j].w; }
                ss = wave_sum(ss);
                const float rs = rsqrtf(ss * (1.f / D) + EPS);
#pragma unroll
                for (int j = 0; j < 8; ++j) {
                    const float4 gg = reinterpret_cast<const float4*>(g)[j * 64 + lane];
                    uint2 o; o.x = pack2(v[j].x * rs * gg.x, v[j].y * rs * gg.y); o.y = pack2(v[j].z * rs * gg.z, v[j].w * rs * gg.w);
                    reinterpret_cast<uint2*>(XN + (size_t)row * D)[j * 64 + lane] = o;
                }
            }
        }
        float* tl = (float*)lds;
        tr_all(a.in[I_WIN], (bfr*)(ws + WS_WTIN), D, NIN, NINP, nullptr, tl);
        tr_all(a.in[I_WBR], (bfr*)(ws + WS_WTA), RW, D, D, nullptr, tl);
        tr_all(a.in[I_WBD], (bfr*)(ws + WS_WTB), RW, D, D, nullptr, tl);
        tr_all(a.in[I_WOUT], (bfr*)(ws + WS_WTOUT), D, D, D, nullptr, tl);
        tr_all(a.in[I_WPQ], (bfr*)(ws + WS_WTPQ), D, D, D, a.in[I_NFG], tl);
        for (int it = blockIdx.x; it < 16 * 4; it += gridDim.x) {
            const int h = it >> 2, k0 = (it & 3) * 64;
            tr_tile(a.in[I_WUV] + (size_t)h * 256 * 64, (bfr*)(ws + WS_WUVT) + (size_t)h * 64 * 256, 256, 64, k0, 0, nullptr, tl);
        }
        cvt_all(a.in[I_WUK], (bfr*)(ws + WS_WUK), (size_t)16 * 256 * 64);
        cvt_all(a.in[I_SUBK], (bfr*)(ws + WS_SUBK), (size_t)16 * 128 * 128);
    }
    SEAM(0);

    if (IN(1)) REP(1) {
        const int tid = my_tid(), wv = tid >> 6; (void)tid; (void)wv;
        EpiP E{(bfr*)(ws + WS_P)};
        const int nM = T / BM, nN = NINP / BM;
        for (int tile = blockIdx.x; tile < nM * nN; tile += gridDim.x) {
            int brow, bcol; tile_rc(tile, nM, nN, brow, bcol);
            gemm_tile((const bfr*)(ws + WS_XN), (const bfr*)(ws + WS_WTIN), D, brow, bcol, (bfr*)lds, E);
        }
        {
            const int rem = (nM * nN) % (int)gridDim.x, idle = (int)gridDim.x - rem;
            if (rem == 0) cvt_i4_rows(a.in[I_PU], ws + WS_PU, blockIdx.x, gridDim.x);
            else if ((int)blockIdx.x >= rem) cvt_i4_rows(a.in[I_PU], ws + WS_PU, (int)blockIdx.x - rem, idle);
        }
    }
    SEAM(1);

    if (IN(2)) REP(2) {
        const int tid = my_tid(), wv = tid >> 6; (void)tid; (void)wv;
        rwkv_load_weights(a, blockIdx.x & 15, lds);
        {
            const int h = blockIdx.x & 15, nun = (NUNIT - (int)blockIdx.x + (int)gridDim.x - 1) / (int)gridDim.x;
            RwIn inA, inB;
            if (nun > 0) rwkv_fetch(a, (int)blockIdx.x >> 4, h, inA);
            for (int k = 0; k < nun; k += 2) {
                const int c0 = ((int)blockIdx.x + k * (int)gridDim.x) >> 4, c1 = ((int)blockIdx.x + (k + 1) * (int)gridDim.x) >> 4, c2 = ((int)blockIdx.x + (k + 2) * (int)gridDim.x) >> 4;
                rwkv_unit(a, c0, h, lds, inA, inB, (k + 1 < nun) ? c1 : -1);
                if (k + 1 < nun) rwkv_unit(a, c1, h, lds, inB, inA, (k + 2 < nun) ? c2 : -1);
            }
        }
        dsa_cnorm(a);
        dsa_qlat(a);
    }
    SEAM(2);

    if (IN(3)) REP(3) {
        const int tid = my_tid(), wv = tid >> 6; (void)tid; (void)wv;
        if (blockIdx.x < 32) {
            if (wv == 0) rwkv_chain(a, blockIdx.x >> 1, blockIdx.x & 1);
            else cvt_fp4_rows(a.in[I_PV], ws + WS_PV, (int)blockIdx.x * 7 + (wv - 1), 32 * 7);
        }
        __syncthreads();
        for (int i = tid; i < 512; i += 512) ((float*)(lds + DSA_RELB_OFF))[i] = a.in[I_RELB][i];
        __syncthreads();
        unsigned* cnt = (unsigned*)(ws + WS_CTL + CTL_CNT) + rep_ * 64;
        for (;;) {
            if (tid == 0) MISC[0] = atomicAdd(cnt, 1u);
            __syncthreads();
            const unsigned n = MISC[0];
            __syncthreads();
            if (n >= T / 8) break;
            dsa_unit(a, (T / 8 - 1) - (int)n, lds);
        }
    }
    SEAM(3);

    if (IN(4)) REP(4) {
        const int tid = my_tid(), wv = tid >> 6; (void)tid; (void)wv;
        float* Ls = (float*)lds + wv * 4352;
        for (int u = blockIdx.x * 8 + wv; u < NUNIT; u += gridDim.x * 8) rwkv_out_unit(a, u, Ls);
        dsa_oproj(a);
    }
    SEAM(4);

    if (IN(5)) REP(5) {
        const int tid = my_tid(), wv = tid >> 6; (void)tid; (void)wv;
        const int nM = T / BM, nN = D / BM;
        for (int tile = blockIdx.x; tile < nM * nN; tile += gridDim.x) {
            int brow, bcol; tile_rc(tile, nM, nN, brow, bcol);
#pragma unroll 1
            for (int pass = 0; pass < 2; ++pass) {
                EpiMix E{(bfr*)(ws + (pass ? WS_MIX : WS_TMPA)), pass ? (const bfr*)(ws + WS_TMPA) : (const bfr*)nullptr, P + (pass ? C_GB : C_GA)};
                gemm_tile((const bfr*)(ws + (pass ? WS_DO : WS_RWO)), (const bfr*)(ws + (pass ? WS_WTB : WS_WTA)), RW, brow, bcol, (bfr*)lds, E);
                asm volatile("s_waitcnt vmcnt(0)" ::: "memory");
            }
        }
    }
    SEAM(5);

    if (IN(6)) REP(6) {
        const int tid = my_tid(), wv = tid >> 6; (void)tid; (void)wv;
        const int nM = T / BM, nN = D / BM;
        for (int tile = blockIdx.x; tile < nM * nN; tile += gridDim.x) {
            int brow, bcol; tile_rc(tile, nM, nN, brow, bcol);
            EpiH E{(bfr*)(ws + WS_HB), a.in[I_X], (float*)(ws + WS_PART), bcol >> 8};
            gemm_tile((const bfr*)(ws + WS_MIX), (const bfr*)(ws + WS_WTOUT), D, brow, bcol, (bfr*)lds, E);
        }
    }
    SEAM(6);

    if (IN(7)) REP(7) {
        const int tid = my_tid(), wv = tid >> 6; (void)tid; (void)wv;
        const int nM = T / BM, nN = D / BM;
        float* rs = (float*)(lds + 135168);
        for (int tile = blockIdx.x; tile < nM * nN; tile += gridDim.x) {
            int brow, bcol; tile_rc(tile, nM, nN, brow, bcol);
            if (tid < 256) rs[tid] = row_rstd((const float*)(ws + WS_PART), brow + tid);
            __syncthreads();
            EpiQ E{(bfr*)(ws + WS_QP), rs, brow};
            gemm_tile((const bfr*)(ws + WS_HB), (const bfr*)(ws + WS_WTPQ), D, brow, bcol, (bfr*)lds, E);
        }
    }
    SEAM(7);

    if (IN(8)) REP(8) {
        const int tid = my_tid(), wv = tid >> 6; (void)tid; (void)wv;
        for (int u = blockIdx.x; u < T / 16; u += gridDim.x) peer_unit(a, u, lds);
    }
#undef IN
#undef SEAM
}

extern "C" void kernel_launch(void* const* d_in, const int* in_sizes, int n_in, void* d_out, int out_size, void* d_ws, size_t ws_size, hipStream_t stream) {
    static int grid = 0;
    if (grid == 0) {
        if (n_in != 27 || out_size != T * D || ws_size < WS_END) { fprintf(stderr, "kernel_launch: unexpected shapes (n_in %d out %d ws %zu)\n", n_in, out_size, ws_size); grid = -1; return; }
        int dev = 0, cus = 0, per_cu = 0;
        if (hipGetDevice(&dev) != hipSuccess || hipDeviceGetAttribute(&cus, hipDeviceAttributeMultiprocessorCount, dev) != hipSuccess) { grid = -1; return; }
        if (hipFuncSetAttribute((const void*)mk_fwd, hipFuncAttributeMaxDynamicSharedMemorySize, LDS_BYTES) != hipSuccess) { fprintf(stderr, "kernel_launch: hipFuncSetAttribute failed\n"); grid = -1; return; }
        if (hipOccupancyMaxActiveBlocksPerMultiprocessor(&per_cu, (const void*)mk_fwd, 512, LDS_BYTES) != hipSuccess || per_cu < 1) { fprintf(stderr, "kernel_launch: occupancy query says %d\n", per_cu); (void)hipGetLastError(); grid = -1; return; }
        grid = cus;
    }
    if (grid < 0) return;
    if (hipMemsetAsync((char*)d_ws + WS_CTL, 0, CTL_ZERO, stream) != hipSuccess) return;
    Args a{};
    for (int i = 0; i < 27; ++i) a.in[i] = (const float*)d_in[i];
    a.out = (float*)d_out; a.ws = (unsigned char*)d_ws;
#if MK_SPLIT
    for (int ph = 0; ph < NPHASE; ++ph) { a.ph_lo = ph; a.ph_hi = ph + 1; hipLaunchKernelGGL(mk_fwd, dim3(grid), dim3(512), LDS_BYTES, stream, a); }
#elif defined(PROBE_PHASE)
    a.ph_lo = 0; a.ph_hi = PROBE_PHASE + 1;
    hipLaunchKernelGGL(mk_fwd, dim3(grid), dim3(512), LDS_BYTES, stream, a);
    (void)hipMemsetAsync((char*)d_ws + WS_CTL, 0, CTL_ZERO, stream);
    a.ph_lo = PROBE_PHASE; a.ph_hi = NPHASE;
    hipLaunchKernelGGL(mk_fwd, dim3(grid), dim3(512), LDS_BYTES, stream, a);
#else
    a.ph_lo = 0; a.ph_hi = NPHASE;
    hipLaunchKernelGGL(mk_fwd, dim3(grid), dim3(512), LDS_BYTES, stream, a);
#endif
}
```

```cpp
#include <hip/hip_runtime.h>
#include <stdint.h>
#include <stdio.h>

#ifndef MK_SPLIT
#define MK_SPLIT 0
#endif

#ifndef DBG_NOPEER
#define DBG_NOPEER 0
#endif
#ifndef DBG_NODSA
#define DBG_NODSA 0
#endif
typedef unsigned short bfr;
using bf16x8 = __attribute__((ext_vector_type(8))) short;
using bf16x4 = __attribute__((ext_vector_type(4))) short;
using f32x4  = __attribute__((ext_vector_type(4))) float;
using f32x2  = __attribute__((ext_vector_type(2))) float;
using f32x16 = __attribute__((ext_vector_type(16))) float;
using u32x4  = __attribute__((ext_vector_type(4))) unsigned;
using h16x2  = __attribute__((ext_vector_type(2))) _Float16;

constexpr int T = 8192, D = 2048, NIN = 9320, NINP = 9472;
constexpr int RW = 1024, NH = 16, HD = 64;
constexpr int C_R = 0, C_K = 1024, C_V = 2048, C_ZW = 3072, C_ZA = 3136, C_ZG = 3200, C_Q = 3360, C_CKV = 4384,
              C_IQ = 4640, C_IK = 5152, C_IW = 5216, C_GA = 5224, C_GB = 7272;
constexpr int KVR = 256, NUNIT = 128 * 16;
constexpr float EPS = 1e-6f;

constexpr size_t MiB = 1u << 20;
constexpr size_t WS_CTL = 0;
constexpr size_t CTL_ZERO = 65536;
constexpr size_t CTL_CNT = 16384;
constexpr size_t CTL_ROWSS = 32768;
constexpr size_t WS_WTA = 1 * MiB, WS_WTB = 5 * MiB, WS_WTOUT = 9 * MiB, WS_WTPQ = 17 * MiB;
constexpr size_t WS_WUK = 25 * MiB, WS_WUVT = 25 * MiB + 512 * 1024, WS_SUBK = 26 * MiB;
constexpr size_t WS_X = 27 * MiB;
constexpr size_t WS_XN = WS_X, WS_WTIN = WS_X + 32 * MiB;
constexpr size_t WS_PM = WS_X, WS_WY = WS_X + 16 * MiB, WS_GM = WS_X + 32 * MiB, WS_YLOC = WS_X + 48 * MiB;
constexpr size_t WS_MIX = WS_X;
constexpr size_t WS_P = 96 * MiB;
constexpr size_t WS_H = 96 * MiB, WS_HB = 160 * MiB, WS_QP = 192 * MiB;
constexpr size_t WS_GG = 244 * MiB, WS_BON = 260 * MiB, WS_CB = 276 * MiB;
#ifdef OLAT_SEP
constexpr size_t WS_QLAT = 280 * MiB, WS_OLAT = 456 * MiB;
#else
constexpr size_t WS_QLAT = 280 * MiB, WS_OLAT = WS_QLAT;
#endif
constexpr size_t WS_KEYS = 344 * MiB;
constexpr size_t WS_PU = 490 * MiB, WS_PV = 312 * MiB;
constexpr size_t WS_PUS = WS_PU + 32 * MiB, WS_PVS = WS_PV + 32 * MiB;
constexpr size_t WS_ZT = 408 * MiB, WS_RWO = 424 * MiB, WS_DO = 440 * MiB, WS_TMPA = 456 * MiB;
constexpr size_t WS_IKC = 489 * MiB;
constexpr size_t WS_PART = 488 * MiB;
constexpr size_t WS_END = 508 * MiB;

constexpr int LDS_BYTES = 163840 - 1024;
constexpr int LDS_BARW = LDS_BYTES - 64;
constexpr int LDS_MISC = LDS_BYTES - 512;

typedef __bf16 bf16v2_t __attribute__((ext_vector_type(2)));
__device__ __forceinline__ bfr f2bf(float f) { const __bf16 r = (__bf16)f; return __builtin_bit_cast(bfr, r); }
__device__ __forceinline__ float bf2f(bfr b) { return __uint_as_float(((unsigned)b) << 16); }
__device__ __forceinline__ unsigned pack2(float a, float b) { const f32x2 v = {a, b}; const bf16v2_t r = __builtin_convertvector(v, bf16v2_t); return __builtin_bit_cast(unsigned, r); }
__device__ __forceinline__ float bflo(unsigned u) { return __uint_as_float(u << 16); }
__device__ __forceinline__ float bfhi(unsigned u) { return __uint_as_float(u & 0xFFFF0000u); }
__device__ __forceinline__ int my_tid() { int t = threadIdx.x; asm volatile("" : "+v"(t)); return t; }

template <int CTRL> __device__ __forceinline__ float dpp_f(float v) {
    return __int_as_float(__builtin_amdgcn_update_dpp(0, __float_as_int(v), CTRL, 0xF, 0xF, true));
}
#define DPP_XOR1 0xB1
#define DPP_XOR2 0x4E
__device__ __forceinline__ float wave_sum(float v) {
    v += dpp_f<DPP_XOR1>(v); v += dpp_f<DPP_XOR2>(v); v += dpp_f<0x141>(v); v += dpp_f<0x140>(v);
    v += __shfl_xor(v, 16); v += __shfl_xor(v, 32); return v;
}
__device__ __forceinline__ float frcp_(float x) { return __builtin_amdgcn_rcpf(x); }
__device__ __forceinline__ float sigmoidf_(float x) { return frcp_(1.f + __expf(-x)); }

#define XB_TMO      128
#define XB_XCNT(j)  (256  + 64 * (j))
#define XB_XSUB(j)  (1280 + 64 * (j))
#define XB_XGEN(j)  (2304 + 64 * (j))
#define XB_TOP      3328
#define XB_TOPGEN   3392
#define XCD_BAR_WORDS 3456
#define XB_SPIN_CAP (1u << 20)
#define LAS __attribute__((address_space(3)))

__device__ __forceinline__ unsigned xb_ld(unsigned* p)              { return __hip_atomic_load(p, __ATOMIC_RELAXED, __HIP_MEMORY_SCOPE_AGENT); }
__device__ __forceinline__ unsigned xb_add(unsigned* p, unsigned v) { return __hip_atomic_fetch_add(p, v, __ATOMIC_RELAXED, __HIP_MEMORY_SCOPE_AGENT); }
__device__ __forceinline__ unsigned xb_xcc_id() { return (unsigned)__builtin_amdgcn_s_getreg((3 << 11) | 20) & 0xFu; }
#define XB_SPIN(cond, bar) do { unsigned _sp = 0; while (cond) { __builtin_amdgcn_s_sleep(1); \
    if ((++_sp & 255u) == 0u) { if (xb_ld(&(bar)[XB_TMO])) break; if (_sp > XB_SPIN_CAP) { atomicAdd(&(bar)[XB_TMO], 1u); break; } } } } while (0)

struct XcdBarrier { unsigned* bar; unsigned x; volatile LAS unsigned* st; };

__device__ __forceinline__ XcdBarrier xcd_barrier_post(unsigned* bar, volatile LAS unsigned* st) {
    XcdBarrier b; b.bar = bar; b.x = xb_xcc_id(); b.st = st;
    if (threadIdx.x == 0) (void)xb_add(&bar[XB_XCNT(b.x)], 1u);
    return b;
}
__device__ __forceinline__ void xcd_barrier_complete(unsigned* bar, unsigned x, unsigned& nloc, unsigned& nx) {
    const unsigned G = gridDim.x * gridDim.y * gridDim.z;
    unsigned sum, cnt, mine, sp = 0u;
    for (;;) {
        sum = 0u; cnt = 0u; mine = 0u;
#pragma unroll
        for (unsigned j = 0; j < 16; ++j) { const unsigned c = xb_ld(&bar[XB_XCNT(j)]); sum += c; cnt += (c > 0u) ? 1u : 0u; mine = (j == x) ? c : mine; }
        if (sum == G) break;
        __builtin_amdgcn_s_sleep(1);
        if ((++sp & 255u) == 0u) { if (xb_ld(&bar[XB_TMO])) break; if (sp > XB_SPIN_CAP) { atomicAdd(&bar[XB_TMO], 1u); break; } }
    }
    nloc = mine > 0u ? mine : 1u; nx = cnt > 0u ? cnt : 1u;
}
__device__ __forceinline__ void xcd_barrier(const XcdBarrier& b) {
    asm volatile("s_waitcnt vmcnt(0)" ::: "memory");
    __syncthreads();
    if (threadIdx.x == 0) {
        unsigned* bar = b.bar;
        __builtin_amdgcn_s_waitcnt(0);
        unsigned nloc = b.st[0], nx = b.st[1];
        if (nloc == 0u) { xcd_barrier_complete(bar, b.x, nloc, nx); b.st[0] = nloc; b.st[1] = nx; }
        const unsigned old = xb_add(&bar[XB_XSUB(b.x)], 1u);
        const unsigned gen = old / nloc;
        if (old + 1u == (gen + 1u) * nloc) {
            __builtin_amdgcn_fence(__ATOMIC_RELEASE, "agent");
            asm volatile("s_waitcnt vmcnt(0)" ::: "memory");
            const unsigned og = xb_add(&bar[XB_TOP], 1u);
            const unsigned tg = og / nx;
            if (og + 1u == (tg + 1u) * nx) xb_add(&bar[XB_TOPGEN], 1u);
            else XB_SPIN(xb_ld(&bar[XB_TOPGEN]) == tg, bar);
            __builtin_amdgcn_fence(__ATOMIC_ACQUIRE, "agent");
            xb_add(&bar[XB_XGEN(b.x)], 1u);
            asm volatile("s_waitcnt vmcnt(0)" ::: "memory");
        } else {
            XB_SPIN(xb_ld(&bar[XB_XGEN(b.x)]) == gen, bar);
            __builtin_amdgcn_fence(__ATOMIC_ACQUIRE, "agent");
            asm volatile("s_waitcnt vmcnt(0)" ::: "memory");
        }
    }
    __syncthreads();
}

struct Args { const float* in[27]; float* out; unsigned char* ws; int ph_lo, ph_hi; };
enum { I_X = 0, I_NMG, I_WIN, I_SHIFT, I_W0, I_WDEC, I_A0, I_WICL, I_WGATE, I_KK, I_KA, I_RK, I_LNW, I_LNB, I_KVG, I_WUK, I_WUV,
       I_RELB, I_WBR, I_WBD, I_WOUT, I_NFG, I_WPQ, I_SUBK, I_PU, I_PV, I_NFIN };

constexpr int BM = 256, BK = 64, HALF = 128, HT = HALF * BK;
constexpr int EPI_LDW = 260;
__device__ __forceinline__ int lds_byte(int r, int c) {
    int st = (r >> 4) * 2 + (c >> 5), rr = r & 15, cc = c & 31, ob = rr * 64 + cc * 2;
    return st * 1024 + (ob ^ (((ob >> 9) & 1) << 5));
}
__device__ __forceinline__ void stage_rc(int b, int& R, int& C) {
    int st = b / 1024, sb = b % 1024, swz = sb ^ (((sb >> 9) & 1) << 5);
    R = (st >> 1) * 16 + swz / 64; C = (st & 1) * 32 + (swz % 64) / 2;
}

template <class Epi>
__device__ __forceinline__ void gemm_tile(const bfr* __restrict__ A, const bfr* __restrict__ Bt, const int K, const int brow, const int bcol,
                                          bfr* shm, Epi& epi) {
#define SA(b,h) (shm+((b)*2+(h))*HT)
#define SB(b,h) (shm+(4+(b)*2+(h))*HT)
#define STAGE_X(TT,P,BASE,br,kt) do{long _g=(long)(br)*K+(long)(kt)*BK; \
    for(int _i=0;_i<2;++_i){int _b=(TT)*16+_i*8192;int _r,_c;stage_rc(_b,_r,_c); \
      __builtin_amdgcn_global_load_lds((const unsigned*)(BASE+_g+(long)_r*K+_c), \
        (LAS unsigned*)((LAS char*)(P)+_b),16,0,0);}}while(0)
#define STAGE(P,BASE,br,kt) STAGE_X(tq,P,BASE,br,kt)
#define LDA(dst,b,h) for(int m=0;m<4;++m)for(int k=0;k<2;++k) \
    dst[m][k]=*reinterpret_cast<const bf16x8*>((char*)SA(b,h)+lds_byte(wr*64+m*16+fr,k*32+fq*8))
#define LDB(dst,b,h) for(int n=0;n<2;++n)for(int k=0;k<2;++k) \
    dst[n][k]=*reinterpret_cast<const bf16x8*>((char*)SB(b,h)+lds_byte(wc*32+n*16+fr,k*32+fq*8))
#define MMA(ai,bj,At_,Bt_) do{__builtin_amdgcn_s_setprio(1); \
    for(int m=0;m<4;++m)for(int n=0;n<2;++n)for(int k=0;k<2;++k) \
      acc[ai][bj][m][n]=__builtin_amdgcn_mfma_f32_16x16x32_bf16(At_[m][k],Bt_[n][k],acc[ai][bj][m][n],0,0,0); \
    __builtin_amdgcn_s_setprio(0);}while(0)
#define WAIT_V(n) asm volatile("s_waitcnt vmcnt(" #n ")":::"memory")
#define WAIT_L(n) asm volatile("s_waitcnt lgkmcnt(" #n ")":::"memory")
#define BAR __builtin_amdgcn_s_barrier()
#define SCHED __builtin_amdgcn_sched_barrier(0)
    const int tq = my_tid();
    int wid = tq >> 6, lane = tq & 63, wr = wid >> 2, wc = wid & 3, fr = lane & 15, fq = lane >> 4;
    f32x4 acc[2][2][4][2] = {};
    bf16x8 At[4][2], B0[2][2], B1[2][2];
    const int nt = K / BK;
    STAGE(SB(0,0),Bt,bcol,0); STAGE(SA(0,0),A,brow,0);
    STAGE(SB(0,1),Bt,bcol+HALF,0); STAGE(SA(0,1),A,brow+HALF,0);
    if(wr==1)BAR;
    WAIT_V(4); BAR;
    STAGE(SB(1,0),Bt,bcol,1); STAGE(SA(1,0),A,brow,1); STAGE(SB(1,1),Bt,bcol+HALF,1);
    WAIT_V(6); BAR;
    for(int t=0;t<nt-2;t+=2){
        LDB(B0,0,0); SCHED; LDA(At,0,0); STAGE(SA(1,1),A,brow+HALF,t+1);
        WAIT_L(8); BAR; WAIT_L(0); MMA(0,0,At,B0); BAR; SCHED;
        LDB(B1,0,1); STAGE(SB(0,0),Bt,bcol,t+2);
        BAR; WAIT_L(0); MMA(0,1,At,B1); BAR;
        LDA(At,0,1); STAGE(SA(0,0),A,brow,t+2);
        BAR; WAIT_L(0); MMA(1,0,At,B0); BAR; SCHED;
        STAGE(SB(0,1),Bt,bcol+HALF,t+2);
        WAIT_V(6); BAR; MMA(1,1,At,B1); BAR;
        LDB(B0,1,0); SCHED; LDA(At,1,0); STAGE(SA(0,1),A,brow+HALF,t+2);
        WAIT_L(8); BAR; WAIT_L(0); MMA(0,0,At,B0); BAR; SCHED;
        LDB(B1,1,1); STAGE(SB(1,0),Bt,bcol,t+3);
        BAR; WAIT_L(0); MMA(0,1,At,B1); BAR;
        LDA(At,1,1); STAGE(SA(1,0),A,brow,t+3);
        BAR; WAIT_L(0); MMA(1,0,At,B0); BAR; SCHED;
        STAGE(SB(1,1),Bt,bcol+HALF,t+3);
        WAIT_V(6); BAR; MMA(1,1,At,B1); BAR;
    }
    int tz=threadIdx.x; asm volatile("":"+v"(tz)); wid=tz>>6; lane=tz&63; wr=wid>>2; wc=wid&3; fr=lane&15; fq=lane>>4;
    { LDB(B0,0,0); WAIT_V(0); LDA(At,0,0); STAGE_X(tz,SA(1,1),A,brow+HALF,nt-1);
      BAR; WAIT_L(0); MMA(0,0,At,B0); BAR;
      LDB(B1,0,1); BAR; WAIT_L(0); MMA(0,1,At,B1); BAR;
      LDA(At,0,1); WAIT_V(4); BAR; WAIT_L(0); MMA(1,0,At,B0); MMA(1,1,At,B1); BAR; }
    { LDB(B0,1,0); LDA(At,1,0); WAIT_V(2); BAR; WAIT_L(0); MMA(0,0,At,B0); BAR;
      LDB(B1,1,1); WAIT_V(0); BAR; WAIT_L(0); MMA(0,1,At,B1); BAR;
      LDA(At,1,1); BAR; WAIT_L(0); MMA(1,0,At,B0); MMA(1,1,At,B1); BAR; }
    if(wr==0)BAR;
    {
        float* stg = (float*)shm;
#pragma unroll
        for (int ai = 0; ai < 2; ++ai) {
            __syncthreads();
#pragma unroll
            for (int bj = 0; bj < 2; ++bj)
#pragma unroll
                for (int m = 0; m < 4; ++m)
#pragma unroll
                    for (int n = 0; n < 2; ++n)
#pragma unroll
                        for (int j = 0; j < 4; ++j) stg[(wr * 64 + m * 16 + fq * 4 + j) * EPI_LDW + bj * HALF + wc * 32 + n * 16 + fr] = acc[ai][bj][m][n][j];
            __syncthreads();
#pragma unroll 2
            for (int it = 0; it < 8; ++it) {
                const int r = it * 16 + wid * 2 + (lane >> 5), c = (lane & 31) * 8;
                const float4 v0 = *reinterpret_cast<const float4*>(&stg[r * EPI_LDW + c]);
                const float4 v1 = *reinterpret_cast<const float4*>(&stg[r * EPI_LDW + c + 4]);
                const float v[8] = {v0.x, v0.y, v0.z, v0.w, v1.x, v1.y, v1.z, v1.w};
                epi.vec8(brow + ai * HALF + r, bcol + c, v);
            }
        }
    }
    __syncthreads();
#undef SA
#undef SB
#undef STAGE_X
#undef STAGE
#undef LDA
#undef LDB
#undef MMA
}

__device__ __forceinline__ void tile_rc(int wgid, const int nM, const int nN, int& brow, int& bcol) {
    const int nwg = nM * nN;
    { int q = nwg / 8, r = nwg % 8, xcd = wgid % 8, off = wgid / 8; wgid = (xcd < r ? xcd * (q + 1) : r * (q + 1) + (xcd - r) * q) + off; }
    const int nig = 8 * nN, gid = wgid / nig, fm = gid * 8, gsz = min(nM - fm, 8);
    const int pm = fm + ((wgid % nig) % gsz), pn = (wgid % nig) / gsz;
    brow = pm * BM; bcol = pn * BM;
}

__device__ __forceinline__ uint4 pack8(const float* v) { uint4 o; o.x = pack2(v[0], v[1]); o.y = pack2(v[2], v[3]); o.z = pack2(v[4], v[5]); o.w = pack2(v[6], v[7]); return o; }
__device__ __forceinline__ void unpack8(const uint4 u, float* v) { v[0] = bflo(u.x); v[1] = bfhi(u.x); v[2] = bflo(u.y); v[3] = bfhi(u.y); v[4] = bflo(u.z); v[5] = bfhi(u.z); v[6] = bflo(u.w); v[7] = bfhi(u.w); }
struct EpiP {
    bfr* P;
    __device__ __forceinline__ void vec8(int row, int col, const float* v) { *reinterpret_cast<uint4*>(&P[(size_t)row * NINP + col]) = pack8(v); }
};
struct EpiMix {
    bfr* outp; const bfr* addp; const bfr* gate;
    __device__ __forceinline__ void vec8(int row, int col, const float* v) {
        float g[8], r[8];
        unpack8(*reinterpret_cast<const uint4*>(&gate[(size_t)row * NINP + col]), g);
#pragma unroll
        for (int i = 0; i < 8; ++i) r[i] = sigmoidf_(g[i]) * v[i];
        if (addp) { float t[8]; unpack8(*reinterpret_cast<const uint4*>(&addp[(size_t)row * D + col]), t);
#pragma unroll
            for (int i = 0; i < 8; ++i) r[i] += t[i]; }
        *reinterpret_cast<uint4*>(&outp[(size_t)row * D + col]) = pack8(r);
    }
};
struct EpiH {
    bfr* hb; const float* x; float* part; int slot;
    __device__ __forceinline__ void vec8(int row, int col, const float* v) {
        const float4 x0 = *reinterpret_cast<const float4*>(&x[(size_t)row * D + col]), x1 = *reinterpret_cast<const float4*>(&x[(size_t)row * D + col + 4]);
        float h[8] = {x0.x + v[0], x0.y + v[1], x0.z + v[2], x0.w + v[3], x1.x + v[4], x1.y + v[5], x1.z + v[6], x1.w + v[7]};
        *reinterpret_cast<uint4*>(&hb[(size_t)row * D + col]) = pack8(h);
        float s = 0.f;
#pragma unroll
        for (int i = 0; i < 8; ++i) s += h[i] * h[i];
        s += dpp_f<DPP_XOR1>(s); s += dpp_f<DPP_XOR2>(s); s += dpp_f<0x141>(s); s += dpp_f<0x140>(s);
        s += __shfl_xor(s, 16);
        if ((threadIdx.x & 31) == 0) part[(size_t)row * 8 + slot] = s;
    }
};
struct EpiQ {
    bfr* qp; const float* rs; int brow;
    __device__ __forceinline__ void vec8(int row, int col, const float* v) {
        const float sc = rs[row - brow]; float r[8];
#pragma unroll
        for (int i = 0; i < 8; ++i) r[i] = v[i] * sc;
        *reinterpret_cast<uint4*>(&qp[(size_t)row * D + col]) = pack8(r);
    }
};
__device__ __forceinline__ float row_rstd(const float* part, int row) {
    float s = 0.f;
#pragma unroll
    for (int i = 0; i < 8; ++i) s += part[(size_t)row * 8 + i];
    return rsqrtf(s * (1.f / D) + EPS);
}

__device__ __forceinline__ void tr_tile(const float* __restrict__ src, bfr* __restrict__ dst, int K, int N, int k0, int n0, const float* kscale, float* lds) {
    const int tid = my_tid(), n = tid & 63, kk = tid >> 6;
#pragma unroll
    for (int j = 0; j < 8; ++j) { int k = kk + 8 * j, gn = n0 + n; float v = (gn < N) ? src[(size_t)(k0 + k) * N + gn] : 0.f; if (kscale) v *= kscale[k0 + k]; lds[k * 65 + n] = v; }
    __syncthreads();
    const int nn = tid >> 3, ks = tid & 7;
    uint4 o;
    o.x = pack2(lds[(ks * 8 + 0) * 65 + nn], lds[(ks * 8 + 1) * 65 + nn]); o.y = pack2(lds[(ks * 8 + 2) * 65 + nn], lds[(ks * 8 + 3) * 65 + nn]);
    o.z = pack2(lds[(ks * 8 + 4) * 65 + nn], lds[(ks * 8 + 5) * 65 + nn]); o.w = pack2(lds[(ks * 8 + 6) * 65 + nn], lds[(ks * 8 + 7) * 65 + nn]);
    *reinterpret_cast<uint4*>(&dst[(size_t)(n0 + nn) * K + k0 + ks * 8]) = o;
    __syncthreads();
}
struct StripRegs { float v[8][4]; };
__device__ __forceinline__ void strip_load(const float* __restrict__ src, int N, int k0, int n0, StripRegs& R) {
    const int tid = my_tid(), n = tid & 63, kk = tid >> 6;
#pragma unroll
    for (int j = 0; j < 8; ++j)
#pragma unroll
        for (int q = 0; q < 4; ++q) { const int gn = n0 + q * 64 + n; R.v[j][q] = (gn < N) ? src[(size_t)(k0 + kk + 8 * j) * N + gn] : 0.f; }
}
__device__ __forceinline__ void strip_store(const StripRegs& R, bfr* __restrict__ dst, int K, int k0, int n0, const float* kscale, float* lds) {
    const int tid = my_tid(), n = tid & 63, kk = tid >> 6;
#pragma unroll
    for (int j = 0; j < 8; ++j) {
        const float sc = kscale ? kscale[k0 + kk + 8 * j] : 1.f;
#pragma unroll
        for (int q = 0; q < 4; ++q) lds[(kk + 8 * j) * 257 + q * 64 + n] = R.v[j][q] * sc;
    }
    __syncthreads();
    const int nn = tid >> 1, hf = tid & 1;
#pragma unroll
    for (int c = 0; c < 4; ++c) {
        const int kb = hf * 32 + c * 8;
        uint4 o;
        o.x = pack2(lds[(kb + 0) * 257 + nn], lds[(kb + 1) * 257 + nn]); o.y = pack2(lds[(kb + 2) * 257 + nn], lds[(kb + 3) * 257 + nn]);
        o.z = pack2(lds[(kb + 4) * 257 + nn], lds[(kb + 5) * 257 + nn]); o.w = pack2(lds[(kb + 6) * 257 + nn], lds[(kb + 7) * 257 + nn]);
        *reinterpret_cast<uint4*>(&dst[(size_t)(n0 + nn) * K + k0 + kb]) = o;
    }
    __syncthreads();
}
__device__ __forceinline__ void tr_all(const float* src, bfr* dst, int K, int N, int Npad, const float* kscale, float* lds) {
    if ((Npad & 255) == 0) {
        const int nk = K / 64, ns = Npad / 256, tot = nk * ns;
        StripRegs RA, RB;
        int it = blockIdx.x;
        if (it < tot) strip_load(src, N, (it % nk) * 64, (it / nk) * 256, RA);
        while (it < tot) {
            const int itn = it + gridDim.x, it2 = itn + gridDim.x;
            if (itn < tot) strip_load(src, N, (itn % nk) * 64, (itn / nk) * 256, RB);
            strip_store(RA, dst, K, (it % nk) * 64, (it / nk) * 256, kscale, lds);
            if (itn >= tot) break;
            if (it2 < tot) strip_load(src, N, (it2 % nk) * 64, (it2 / nk) * 256, RA);
            strip_store(RB, dst, K, (itn % nk) * 64, (itn / nk) * 256, kscale, lds);
            it = it2;
        }
        return;
    }
    const int nk = K / 64, nn = Npad / 64;
    for (int it = blockIdx.x; it < nk * nn; it += gridDim.x) tr_tile(src, dst, K, N, (it % nk) * 64, (it / nk) * 64, kscale, lds);
}
__device__ __forceinline__ void cvt_all(const float* __restrict__ src, bfr* __restrict__ dst, size_t n) {
    const size_t n4 = n / 4;
    for (size_t i = (size_t)blockIdx.x * 512 + my_tid(); i < n4; i += (size_t)gridDim.x * 512) {
        float4 v = reinterpret_cast<const float4*>(src)[i];
        uint2 o; o.x = pack2(v.x, v.y); o.y = pack2(v.z, v.w);
        reinterpret_cast<uint2*>(dst)[i] = o;
    }
}

constexpr int PEER_ROWB = 1152;
__device__ __forceinline__ void cvt_fp4_rows(const float* __restrict__ src, unsigned char* __restrict__ dst, const int wrank, const int nwaves) {
    const int tid = my_tid(), lane = tid & 63;
    for (int row = wrank; row < 16384; row += nwaves) {
        float v[32]; float amax = 0.f;
#pragma unroll
        for (int q = 0; q < 8; ++q) {
            const float4 x = *reinterpret_cast<const float4*>(&src[(size_t)row * D + q * 256 + lane * 4]);
            v[q * 4] = x.x; v[q * 4 + 1] = x.y; v[q * 4 + 2] = x.z; v[q * 4 + 3] = x.w;
            amax = fmaxf(amax, fmaxf(fmaxf(fabsf(x.x), fabsf(x.y)), fmaxf(fabsf(x.z), fabsf(x.w))));
        }
        const bfr sb = f2bf(amax * (1.f / 6.f));
        const float sc = bf2f(sb), inv = sc > 0.f ? frcp_(sc) : 0.f;
        unsigned dw[4];
#pragma unroll
        for (int d = 0; d < 4; ++d) {
            unsigned p = 0;
            p = __builtin_amdgcn_cvt_scalef32_pk_fp4_f32(p, v[d * 8 + 0] * inv, v[d * 8 + 1] * inv, 1.0f, 0);
            p = __builtin_amdgcn_cvt_scalef32_pk_fp4_f32(p, v[d * 8 + 2] * inv, v[d * 8 + 3] * inv, 1.0f, 1);
            p = __builtin_amdgcn_cvt_scalef32_pk_fp4_f32(p, v[d * 8 + 4] * inv, v[d * 8 + 5] * inv, 1.0f, 2);
            p = __builtin_amdgcn_cvt_scalef32_pk_fp4_f32(p, v[d * 8 + 6] * inv, v[d * 8 + 7] * inv, 1.0f, 3);
            dw[d] = p;
        }
        uint4 o4; o4.x = dw[0]; o4.y = dw[1]; o4.z = dw[2]; o4.w = dw[3];
        *reinterpret_cast<uint4*>(dst + (size_t)row * PEER_ROWB + lane * 16) = o4;
        *reinterpret_cast<bfr*>(dst + (size_t)row * PEER_ROWB + 1024 + lane * 2) = sb;
    }
}

__device__ __forceinline__ unsigned pack8_i4(const float* v) {
    unsigned d = 0;
#pragma unroll
    for (int i = 0; i < 8; ++i) d |= ((unsigned)((int)v[i]) & 0xFu) << (4 * i);
    return d;
}
__device__ __forceinline__ void cvt_i4_rows(const float* __restrict__ src, unsigned char* __restrict__ dst, const int rank, const int nranks) {
    const int tid = my_tid(), lane = tid & 63, wv = tid >> 6;
    for (int row = rank * 8 + wv; row < 16384; row += nranks * 8) {
        float v[32]; float amax = 0.f;
#pragma unroll
        for (int q = 0; q < 8; ++q) {
            const float4 x = *reinterpret_cast<const float4*>(&src[(size_t)row * D + q * 256 + lane * 4]);
            v[q * 4] = x.x; v[q * 4 + 1] = x.y; v[q * 4 + 2] = x.z; v[q * 4 + 3] = x.w;
            amax = fmaxf(amax, fmaxf(fmaxf(fabsf(x.x), fabsf(x.y)), fmaxf(fabsf(x.z), fabsf(x.w))));
        }
        const bfr sb = f2bf(amax * (1.f / 7.f));
        const float sc = bf2f(sb), inv = sc > 0.f ? frcp_(sc) : 0.f;
#pragma unroll
        for (int i = 0; i < 32; ++i) v[i] = fminf(fmaxf(__builtin_rintf(v[i] * inv), -7.f), 7.f);
        uint4 o4; o4.x = pack8_i4(v); o4.y = pack8_i4(v + 8); o4.z = pack8_i4(v + 16); o4.w = pack8_i4(v + 24);
        *reinterpret_cast<uint4*>(dst + (size_t)row * PEER_ROWB + lane * 16) = o4;
        *reinterpret_cast<bfr*>(dst + (size_t)row * PEER_ROWB + 1024 + lane * 2) = sb;
    }
}
__device__ __forceinline__ int pm_index(int kp, int k) {
    const int kpt = kp >> 5, r = kp & 31, kt = k >> 5, kk = k & 31, s = kk >> 4, rem = kk & 15;
    const int j = ((rem >> 3) << 2) | (rem & 3), hf = (rem >> 2) & 1, lane = hf * 32 + r;
    return ((((kpt * 2 + kt) * 2 + s) * 64 + lane) * 8) + j;
}
__device__ __forceinline__ int acc_index(int row, int col) {
    const int rt = row >> 5, r = row & 31, ct = col >> 5, c = col & 31;
    const int g4 = r >> 3, comp = r & 3, hf = (r >> 2) & 1, lane = hf * 32 + c;
    return ((((rt * 2 + ct) * 4 + g4) * 64 + lane) * 4) + comp;
}

constexpr int RW_ACT_STRIDE = 296, RW_LD = 72, RW_SLOT = 9216, RW_WL_OFF = 110592, RW_TOT_OFF = 148480, RW_BASE_OFF = 152576, RW_PART_OFF = 156928;
__device__ __forceinline__ f32x16 tile_mm_acc(f32x16 acc, const bfr* A, const int arow0, const bfr* Bt, const int brow0, const int r, const int hf) {
#pragma unroll
    for (int ks = 0; ks < 4; ++ks)
        acc = __builtin_amdgcn_mfma_f32_32x32x16_bf16(*reinterpret_cast<const bf16x8*>(&A[(arow0 + r) * RW_LD + ks * 16 + hf * 8]),
                                                     *reinterpret_cast<const bf16x8*>(&Bt[(brow0 + r) * RW_LD + ks * 16 + hf * 8]), acc, 0, 0, 0);
    return acc;
}
__device__ __forceinline__ f32x16 tile_mm(const bfr* A, const int arow0, const bfr* Bt, const int brow0, const int r, const int hf) {
    f32x16 z;
#pragma unroll
    for (int g = 0; g < 16; ++g) z[g] = 0.f;
    return tile_mm_acc(z, A, arow0, Bt, brow0, r, hf);
}
__device__ __forceinline__ void store_t(bfr* dst, const int col0, const int row0, const f32x16 acc, const int r, const int hf) {
#pragma unroll
    for (int g4 = 0; g4 < 4; ++g4) { uint2 p; p.x = pack2(acc[g4 * 4], acc[g4 * 4 + 1]); p.y = pack2(acc[g4 * 4 + 2], acc[g4 * 4 + 3]);
        *reinterpret_cast<uint2*>(&dst[(col0 + r) * RW_LD + row0 + g4 * 8 + hf * 4]) = p; }
}
#define DPP_HMIRROR 0x141
#define DPP_MIRROR  0x140

__device__ __forceinline__ void rwkv_load_weights(const Args& a, const int h, unsigned char* lds) {
    bfr* WL = (bfr*)(lds + RW_WL_OFF);
    const int tid = my_tid();
    for (int idx = tid; idx < 288 * 64; idx += 512) {
        const int m = idx >> 6, d = idx & 63;
        const float v = (m < 64) ? a.in[I_WDEC][(size_t)m * RW + h * 64 + d] : (m < 128) ? a.in[I_WICL][(size_t)(m - 64) * RW + h * 64 + d] : a.in[I_WGATE][(size_t)(m - 128) * RW + h * 64 + d];
        WL[d * RW_ACT_STRIDE + m] = f2bf(v);
    }
    __syncthreads();
}

struct RwIn { unsigned cu[18], pu[18]; bfr r[2][5], k[2][5], v[2][5]; };
__device__ __forceinline__ void rwkv_fetch(const Args& a, const int c, const int h, RwIn& in) {
    const bfr* __restrict__ P = (const bfr*)(a.ws + WS_P);
    const int tid = my_tid(), lane = tid & 63, wv = tid >> 6, fr = lane & 15, fq = lane >> 4, t0 = c * 64;
    {
        const int i = tid >> 3, part = tid & 7, t = t0 + i;
        const bfr* pc = P + (size_t)t * NINP + C_ZW + part * 36;
        const bfr* pp = pc - NINP;
#pragma unroll
        for (int q = 0; q < 18; ++q) { in.cu[q] = *reinterpret_cast<const unsigned*>(pc + q * 2); in.pu[q] = (t > 0) ? *reinterpret_cast<const unsigned*>(pp + q * 2) : 0u; }
    }
    const int tt = wv >> 1, dh = wv & 1;
#pragma unroll
    for (int dt = 0; dt < 2; ++dt) {
        const int hd = h * 64 + dh * 32 + dt * 16 + fr;
        const int tp = t0 + tt * 16 + fq * 4 - 1;
        const bool hp = tp >= 0;
        in.r[dt][0] = hp ? P[(size_t)(hp ? tp : 0) * NINP + C_R + hd] : (bfr)0; in.k[dt][0] = hp ? P[(size_t)(hp ? tp : 0) * NINP + C_K + hd] : (bfr)0; in.v[dt][0] = hp ? P[(size_t)(hp ? tp : 0) * NINP + C_V + hd] : (bfr)0;
#pragma unroll
        for (int j = 0; j < 4; ++j) { const size_t ro = (size_t)(tp + 1 + j) * NINP; in.r[dt][j + 1] = P[ro + C_R + hd]; in.k[dt][j + 1] = P[ro + C_K + hd]; in.v[dt][j + 1] = P[ro + C_V + hd]; }
    }
}

__device__ __forceinline__ void rwkv_unit(const Args& a, const int c, const int h, unsigned char* lds, const RwIn& in, RwIn& nxt, const int cnext) {
    const float* __restrict__ smix = a.in[I_SHIFT];
    const int tid = my_tid(), lane = tid & 63, wv = tid >> 6, fr = lane & 15, fq = lane >> 4, t0 = c * 64, u = c * 16 + h;
#define SLOT(k) ((bfr*)(lds + (k) * RW_SLOT))
    bfr* ACT = (bfr*)lds; const bfr* WL = (const bfr*)(lds + RW_WL_OFF);
    float* TOT = (float*)(lds + RW_TOT_OFF); float* BASE = (float*)(lds + RW_BASE_OFF); float* PART = (float*)(lds + RW_PART_OFF);
    {
        const int i = tid >> 3, part = tid & 7;
#pragma unroll
        for (int q = 0; q < 18; ++q) {
            const int cc = part * 36 + q * 2;
            const unsigned cu = in.cu[q], pu = in.pu[q];
            const float2 mx = *reinterpret_cast<const float2*>(&smix[C_ZW + cc]);
            const float c0 = bflo(cu), c1 = bfhi(cu);
            float z0 = c0 + (bflo(pu) - c0) * mx.x, z1 = c1 + (bfhi(pu) - c1) * mx.y;
            if (cc < 64) { z0 = 1.f - 2.f * frcp_(1.f + __expf(2.f * z0)); z1 = 1.f - 2.f * frcp_(1.f + __expf(2.f * z1)); }
            else if (cc >= 128) { z0 = sigmoidf_(z0); z1 = sigmoidf_(z1); }
            *reinterpret_cast<unsigned*>(&ACT[i * RW_ACT_STRIDE + cc]) = pack2(z0, z1);
        }
    }
    const int tt = wv >> 1, dh = wv & 1;
    float zr[2][4], zk[2][4], zv[2][4];
#pragma unroll
    for (int dt = 0; dt < 2; ++dt) {
        const int hd = h * 64 + dh * 32 + dt * 16 + fr;
        const float mr = smix[C_R + hd], mk = smix[C_K + hd], mv = smix[C_V + hd];
        float pr = bf2f(in.r[dt][0]), pk = bf2f(in.k[dt][0]), pv = bf2f(in.v[dt][0]);
#pragma unroll
        for (int j = 0; j < 4; ++j) {
            const float cr = bf2f(in.r[dt][j + 1]), ck = bf2f(in.k[dt][j + 1]), cv = bf2f(in.v[dt][j + 1]);
            zr[dt][j] = cr + (pr - cr) * mr; zk[dt][j] = ck + (pk - ck) * mk; zv[dt][j] = cv + (pv - cv) * mv;
            pr = cr; pk = ck; pv = cv;
        }
    }
    __syncthreads();
    f32x4 xw[2], xa[2], xg[2];
#pragma unroll
    for (int dt = 0; dt < 2; ++dt) {
        xw[dt] = f32x4{0.f, 0.f, 0.f, 0.f}; xa[dt] = xw[dt]; xg[dt] = xw[dt];
        const bfr* arow = ACT + (tt * 16 + fr) * RW_ACT_STRIDE + fq * 8;
        const bfr* brow = WL + (dh * 32 + dt * 16 + fr) * RW_ACT_STRIDE + fq * 8;
#pragma unroll
        for (int ks = 0; ks < 2; ++ks) {
            xw[dt] = __builtin_amdgcn_mfma_f32_16x16x32_bf16(*reinterpret_cast<const bf16x8*>(arow + ks * 32), *reinterpret_cast<const bf16x8*>(brow + ks * 32), xw[dt], 0, 0, 0);
            xa[dt] = __builtin_amdgcn_mfma_f32_16x16x32_bf16(*reinterpret_cast<const bf16x8*>(arow + 64 + ks * 32), *reinterpret_cast<const bf16x8*>(brow + 64 + ks * 32), xa[dt], 0, 0, 0);
        }
#pragma unroll
        for (int ks = 0; ks < 5; ++ks)
            xg[dt] = __builtin_amdgcn_mfma_f32_16x16x32_bf16(*reinterpret_cast<const bf16x8*>(arow + 128 + ks * 32), *reinterpret_cast<const bf16x8*>(brow + 128 + ks * 32), xg[dt], 0, 0, 0);
    }
    float lw[2][4], av[2][4], kkr[2][4], k4[2][4], n2[4], cf[4];
#pragma unroll
    for (int j = 0; j < 4; ++j) { n2[j] = 0.f; cf[j] = 0.f; }
#pragma unroll
    for (int dt = 0; dt < 2; ++dt) {
        const int hd = h * 64 + dh * 32 + dt * 16 + fr;
        const float w0 = a.in[I_W0][hd], a0 = a.in[I_A0][hd], kkm = a.in[I_KK][hd], kam = a.in[I_KA][hd], rkm = a.in[I_RK][hd];
        float run = 0.f;
#pragma unroll
        for (int j = 0; j < 4; ++j) {
            run += -0.6065306597126334f * sigmoidf_(w0 + xw[dt][j]);
            lw[dt][j] = run;
            av[dt][j] = sigmoidf_(a0 + xa[dt][j]);
            kkr[dt][j] = zk[dt][j] * kkm;
            k4[dt][j] = zk[dt][j] * (1.f + (av[dt][j] - 1.f) * kam);
            n2[j] += kkr[dt][j] * kkr[dt][j];
            cf[j] += zr[dt][j] * k4[dt][j] * rkm;
        }
        TOT[(tt * 4 + fq) * 64 + dh * 32 + dt * 16 + fr] = run;
    }
#pragma unroll
    for (int j = 0; j < 4; ++j) {
        n2[j] += dpp_f<DPP_XOR1>(n2[j]); n2[j] += dpp_f<DPP_XOR2>(n2[j]); n2[j] += dpp_f<DPP_HMIRROR>(n2[j]); n2[j] += dpp_f<DPP_MIRROR>(n2[j]);
        cf[j] += dpp_f<DPP_XOR1>(cf[j]); cf[j] += dpp_f<DPP_XOR2>(cf[j]); cf[j] += dpp_f<DPP_HMIRROR>(cf[j]); cf[j] += dpp_f<DPP_MIRROR>(cf[j]);
        if (fr == 0) { PART[(wv * 16 + fq * 4 + j) * 2] = n2[j]; PART[(wv * 16 + fq * 4 + j) * 2 + 1] = cf[j]; }
    }
    __syncthreads();
    if (tid < 64) {
        float run = 0.f;
#pragma unroll
        for (int g = 0; g < 16; ++g) { const float tv = TOT[g * 64 + tid]; BASE[g * 64 + tid] = run; run += tv; }
        BASE[16 * 64 + tid] = run;
    }
    __syncthreads();
    {
        bfr* Gg = (bfr*)(a.ws + WS_GG); bfr* Bon = (bfr*)(a.ws + WS_BON);
        const int i0 = tt * 16 + fq * 4;
        float rn[4], cft[4];
#pragma unroll
        for (int j = 0; j < 4; ++j) {
            const float n2t = n2[j] + PART[((wv ^ 1) * 16 + fq * 4 + j) * 2]; cft[j] = cf[j] + PART[((wv ^ 1) * 16 + fq * 4 + j) * 2 + 1];
            rn[j] = __builtin_amdgcn_rsqf(fmaxf(n2t, 1e-24f));
        }
#pragma unroll
        for (int dt = 0; dt < 2; ++dt) {
            const int d = dh * 32 + dt * 16 + fr;
            const float base = BASE[(tt * 4 + fq) * 64 + d], clT = BASE[16 * 64 + d];
            float vAt[4], vBh[4], vKh[4];
#pragma unroll
            for (int j = 0; j < 4; ++j) {
                const float cl = base + lw[dt][j], clm1 = (j == 0) ? base : base + lw[dt][j - 1];
                const float gi = __expf(cl), gm1 = __expf(clm1), ig = __expf(-cl), gce = __expf(clT - cl);
                const float kk = kkr[dt][j] * rn[j], beta = kk * av[dt][j];
                vAt[j] = -kk * gm1; vBh[j] = beta * gce; vKh[j] = k4[dt][j] * gce;
                SLOT(0)[(i0 + j) * RW_LD + d] = f2bf(vAt[j]);
                SLOT(1)[(i0 + j) * RW_LD + d] = f2bf(beta * ig);
                SLOT(2)[(i0 + j) * RW_LD + d] = f2bf(k4[dt][j] * ig);
                SLOT(3)[(i0 + j) * RW_LD + d] = f2bf(zr[dt][j] * gi);
                const size_t o = (size_t)(t0 + i0 + j) * RW + h * 64 + d;
                Gg[o] = f2bf(xg[dt][j]); Bon[o] = f2bf(cft[j] * zv[dt][j]);
            }
            uint2 p;
            p.x = pack2(vAt[0], vAt[1]); p.y = pack2(vAt[2], vAt[3]); *reinterpret_cast<uint2*>(&SLOT(4)[d * RW_LD + i0]) = p;
            p.x = pack2(vBh[0], vBh[1]); p.y = pack2(vBh[2], vBh[3]); *reinterpret_cast<uint2*>(&SLOT(5)[d * RW_LD + i0]) = p;
            p.x = pack2(vKh[0], vKh[1]); p.y = pack2(vKh[2], vKh[3]); *reinterpret_cast<uint2*>(&SLOT(6)[d * RW_LD + i0]) = p;
            p.x = pack2(zv[dt][0], zv[dt][1]); p.y = pack2(zv[dt][2], zv[dt][3]); *reinterpret_cast<uint2*>(&SLOT(7)[d * RW_LD + i0]) = p;
        }
    }
    __syncthreads();
    if (cnext >= 0) rwkv_fetch(a, cnext, h, nxt);
    const int r = lane & 31, hf = lane >> 5;
    {
        const int prod = wv >> 1, sub = wv & 1;
        const bfr* Aop = (prod & 1) ? SLOT(2) : SLOT(1);
        const bfr* Bop = (prod >= 2) ? SLOT(3) : SLOT(0);
        bfr* Ld = SLOT(8 + prod);
        const bool incl = prod >= 2;
        for (int job = 0; job < (sub ? 2 : 1); ++job) {
            const int jt = sub ? job : 0, it = sub ? 1 : 0;
            f32x16 acc = tile_mm(Aop, jt * 32, Bop, it * 32, r, hf);
#pragma unroll
            for (int g4 = 0; g4 < 4; ++g4) {
                const int i = it * 32 + r, j0 = jt * 32 + g4 * 8 + hf * 4;
                float v[4];
#pragma unroll
                for (int q = 0; q < 4; ++q) { const int j = j0 + q; v[q] = (incl ? (j <= i) : (j < i)) ? acc[g4 * 4 + q] : 0.f; }
                uint2 p; p.x = pack2(v[0], v[1]); p.y = pack2(v[2], v[3]);
                *reinterpret_cast<uint2*>(&Ld[i * RW_LD + j0]) = p;
            }
        }
        if (!sub) {
#pragma unroll
            for (int g4 = 0; g4 < 4; ++g4) *reinterpret_cast<uint2*>(&Ld[r * RW_LD + 32 + g4 * 8 + hf * 4]) = make_uint2(0u, 0u);
        }
    }
    __syncthreads();
    if (wv == 0) {
        bfr* Tl = SLOT(0); bfr* TlT = SLOT(1); const bfr* Lab = SLOT(8);
        for (int q = 0; q < 9; ++q) { *reinterpret_cast<uint4*>((unsigned char*)Tl + (q * 64 + lane) * 16) = make_uint4(0u, 0u, 0u, 0u); *reinterpret_cast<uint4*>((unsigned char*)TlT + (q * 64 + lane) * 16) = make_uint4(0u, 0u, 0u, 0u); }
        {
            const int bq = lane >> 4, cc = lane & 15;
            float x[16];
#pragma unroll
            for (int rr = 0; rr < 16; ++rr) {
                float lrow[16];
                unpack8(*reinterpret_cast<const uint4*>(&Lab[(bq * 16 + rr) * RW_LD + bq * 16]), lrow);
                unpack8(*reinterpret_cast<const uint4*>(&Lab[(bq * 16 + rr) * RW_LD + bq * 16 + 8]), lrow + 8);
                float sacc = (rr == cc) ? 1.f : 0.f;
#pragma unroll
                for (int m = 0; m < rr; ++m) sacc += lrow[m] * x[m];
                x[rr] = sacc;
            }
#pragma unroll
            for (int rr = 0; rr < 16; ++rr) Tl[(bq * 16 + rr) * RW_LD + bq * 16 + cc] = f2bf(x[rr]);
            *reinterpret_cast<uint4*>(&TlT[(bq * 16 + cc) * RW_LD + bq * 16]) = pack8(x);
            *reinterpret_cast<uint4*>(&TlT[(bq * 16 + cc) * RW_LD + bq * 16 + 8]) = pack8(x + 8);
        }
        asm volatile("s_waitcnt lgkmcnt(0)" ::: "memory");
#pragma unroll
        for (int bi = 1; bi < 4; ++bi) {
#pragma unroll
            for (int bj = 0; bj < bi; ++bj) {
                f32x4 acc = {0.f, 0.f, 0.f, 0.f};
#pragma unroll
                for (int bm = bj; bm < bi; ++bm) {
                    const bf16x4 Af = *reinterpret_cast<const bf16x4*>(&Lab[(bi * 16 + fr) * RW_LD + bm * 16 + fq * 4]);
                    const bf16x4 Bf = *reinterpret_cast<const bf16x4*>(&TlT[(bj * 16 + fr) * RW_LD + bm * 16 + fq * 4]);
                    acc = __builtin_amdgcn_mfma_f32_16x16x16bf16_1k(Af, Bf, acc, 0, 0, 0);
                }
                bf16x4 Bacc; Bacc[0] = (short)f2bf(acc[0]); Bacc[1] = (short)f2bf(acc[1]); Bacc[2] = (short)f2bf(acc[2]); Bacc[3] = (short)f2bf(acc[3]);
                const bf16x4 Ad = *reinterpret_cast<const bf16x4*>(&Tl[(bi * 16 + fr) * RW_LD + bi * 16 + fq * 4]);
                const f32x4 tb = __builtin_amdgcn_mfma_f32_16x16x16bf16_1k(Ad, Bacc, f32x4{0.f, 0.f, 0.f, 0.f}, 0, 0, 0);
#pragma unroll
                for (int q = 0; q < 4; ++q) Tl[(bi * 16 + fq * 4 + q) * RW_LD + bj * 16 + fr] = f2bf(tb[q]);
                uint2 p; p.x = pack2(tb[0], tb[1]); p.y = pack2(tb[2], tb[3]);
                *reinterpret_cast<uint2*>(&TlT[(bj * 16 + fr) * RW_LD + bi * 16 + fq * 4]) = p;
            }
            asm volatile("s_waitcnt lgkmcnt(0)" ::: "memory");
        }
    } else if (wv >= 4) {
        const int it = (wv >> 1) & 1, vt = wv & 1;
        const f32x16 acc = tile_mm(SLOT(9), it * 32, SLOT(7), vt * 32, r, hf);
        store_t(SLOT(2), vt * 32, it * 32, acc, r, hf);
    }
    __syncthreads();
    {
        const int which = wv >> 2, it = (wv >> 1) & 1, ct = wv & 1;
        const f32x16 acc = tile_mm(SLOT(0), it * 32, which ? SLOT(2) : SLOT(4), ct * 32, r, hf);
        store_t(which ? SLOT(9) : SLOT(8), ct * 32, it * 32, acc, r, hf);
    }
    __syncthreads();
    if (wv < 4) {
        {
            const int dtl = wv >> 1, itl = wv & 1;
            f32x16 acc = tile_mm(SLOT(8), dtl * 32, SLOT(10), itl * 32, r, hf);
            bfr* WY = (bfr*)(a.ws + WS_WY) + (size_t)u * 4096;
            const int i = itl * 32 + r;
#pragma unroll
            for (int g4 = 0; g4 < 4; ++g4) {
                const int d0 = dtl * 32 + g4 * 8 + hf * 4;
                const uint2 rr2 = *reinterpret_cast<const uint2*>(&SLOT(3)[i * RW_LD + d0]);
                uint2 p; p.x = pack2(acc[g4 * 4] + bflo(rr2.x), acc[g4 * 4 + 1] + bfhi(rr2.x)); p.y = pack2(acc[g4 * 4 + 2] + bflo(rr2.y), acc[g4 * 4 + 3] + bfhi(rr2.y));
                *reinterpret_cast<uint2*>(&WY[i * 64 + d0]) = p;
            }
        }
        {
            const int it = wv >> 1, vt = wv & 1;
            f32x16 acc = tile_mm(SLOT(10), it * 32, SLOT(9), vt * 32, r, hf);
            acc = tile_mm_acc(acc, SLOT(11), it * 32, SLOT(7), vt * 32, r, hf);
            bfr* YL = (bfr*)(a.ws + WS_YLOC) + (size_t)u * 4096;
#pragma unroll
            for (int g4 = 0; g4 < 4; ++g4) { uint2 p; p.x = pack2(acc[g4 * 4], acc[g4 * 4 + 1]); p.y = pack2(acc[g4 * 4 + 2], acc[g4 * 4 + 3]);
                *reinterpret_cast<uint2*>(&YL[(((it * 2 + vt) * 4 + g4) * 64 + lane) * 4]) = p; }
        }
    } else {
        {
            const int kt = (wv >> 1) & 1, kpt = wv & 1;
            f32x16 acc = tile_mm(SLOT(8), kt * 32, SLOT(5), kpt * 32, r, hf);
            if (kt == kpt) {
                const float gc = __expf(BASE[16 * 64 + kt * 32 + r]);
#pragma unroll
                for (int g = 0; g < 16; ++g) if (((g & 3) + 8 * (g >> 2) + 4 * hf) == r) acc[g] += gc;
            }
            bfr* PM = (bfr*)(a.ws + WS_PM) + (size_t)u * 4096;
#pragma unroll
            for (int sgrp = 0; sgrp < 2; ++sgrp) {
                float v8[8];
#pragma unroll
                for (int q = 0; q < 8; ++q) v8[q] = acc[sgrp * 8 + q];
                *reinterpret_cast<uint4*>(&PM[(((kpt * 2 + kt) * 2 + sgrp) * 64 + lane) * 8]) = pack8(v8);
            }
        }
        {
            const int kpt = (wv >> 1) & 1, vt = wv & 1;
            f32x16 acc = tile_mm(SLOT(5), kpt * 32, SLOT(9), vt * 32, r, hf);
            acc = tile_mm_acc(acc, SLOT(6), kpt * 32, SLOT(7), vt * 32, r, hf);
            bfr* GM = (bfr*)(a.ws + WS_GM) + (size_t)u * 4096;
#pragma unroll
            for (int g4 = 0; g4 < 4; ++g4) { uint2 p; p.x = pack2(acc[g4 * 4], acc[g4 * 4 + 1]); p.y = pack2(acc[g4 * 4 + 2], acc[g4 * 4 + 3]);
                *reinterpret_cast<uint2*>(&GM[(((kpt * 2 + vt) * 4 + g4) * 64 + lane) * 4]) = p; }
        }
    }
    __syncthreads();
#undef SLOT
}

__device__ __forceinline__ void rwkv_chain(const Args& a, const int h, const int vh) {
    const int lane = my_tid() & 63, r = lane & 31, hf = lane >> 5;
    const bfr* PMb = (const bfr*)(a.ws + WS_PM); const bfr* GMb = (const bfr*)(a.ws + WS_GM); bfr* ZTb = (bfr*)(a.ws + WS_ZT);
    f32x16 Z[2];
#pragma unroll
    for (int g = 0; g < 16; ++g) { Z[0][g] = 0.f; Z[1][g] = 0.f; }
    bf16x8 Acur[8], Anxt[8]; uint2 Ccur[8], Cnxt[8];
    {
        const bfr* pm = PMb + (size_t)h * 4096; const bfr* gm = GMb + (size_t)h * 4096;
#pragma unroll
        for (int f = 0; f < 8; ++f) Acur[f] = *reinterpret_cast<const bf16x8*>(&pm[(f * 64 + lane) * 8]);
#pragma unroll
        for (int kpt = 0; kpt < 2; ++kpt)
#pragma unroll
            for (int g4 = 0; g4 < 4; ++g4) Ccur[kpt * 4 + g4] = *reinterpret_cast<const uint2*>(&gm[(((kpt * 2 + vh) * 4 + g4) * 64 + lane) * 4]);
    }
    for (int c = 0; c < 128; ++c) {
        const int u = c * 16 + h;
        if (c + 1 < 128) {
            const bfr* pm = PMb + (size_t)(u + 16) * 4096; const bfr* gm = GMb + (size_t)(u + 16) * 4096;
#pragma unroll
            for (int f = 0; f < 8; ++f) Anxt[f] = *reinterpret_cast<const bf16x8*>(&pm[(f * 64 + lane) * 8]);
#pragma unroll
            for (int kpt = 0; kpt < 2; ++kpt)
#pragma unroll
                for (int g4 = 0; g4 < 4; ++g4) Cnxt[kpt * 4 + g4] = *reinterpret_cast<const uint2*>(&gm[(((kpt * 2 + vh) * 4 + g4) * 64 + lane) * 4]);
        }
        bfr* zt = ZTb + (size_t)u * 4096 + (size_t)(vh * 32 + r) * 64;
        bf16x8 Bf[2][2];
#pragma unroll
        for (int kt = 0; kt < 2; ++kt) {
#pragma unroll
            for (int g4 = 0; g4 < 4; ++g4) {
                uint2 o; o.x = pack2(Z[kt][g4 * 4], Z[kt][g4 * 4 + 1]); o.y = pack2(Z[kt][g4 * 4 + 2], Z[kt][g4 * 4 + 3]);
                *reinterpret_cast<uint2*>(&zt[kt * 32 + g4 * 8 + hf * 4]) = o;
                const int s = g4 >> 1, e = (g4 & 1) * 4;
                Bf[kt][s][e] = (short)(o.x & 0xFFFF); Bf[kt][s][e + 1] = (short)(o.x >> 16); Bf[kt][s][e + 2] = (short)(o.y & 0xFFFF); Bf[kt][s][e + 3] = (short)(o.y >> 16);
            }
        }
        f32x16 Zn[2];
#pragma unroll
        for (int kpt = 0; kpt < 2; ++kpt)
#pragma unroll
            for (int g4 = 0; g4 < 4; ++g4) {
                const uint2 cc = Ccur[kpt * 4 + g4];
                Zn[kpt][g4 * 4] = bflo(cc.x); Zn[kpt][g4 * 4 + 1] = bfhi(cc.x); Zn[kpt][g4 * 4 + 2] = bflo(cc.y); Zn[kpt][g4 * 4 + 3] = bfhi(cc.y);
            }
#pragma unroll
        for (int kpt = 0; kpt < 2; ++kpt)
#pragma unroll
            for (int kt = 0; kt < 2; ++kt)
#pragma unroll
                for (int s = 0; s < 2; ++s)
                    Zn[kpt] = __builtin_amdgcn_mfma_f32_32x32x16_bf16(Acur[(kpt * 2 + kt) * 2 + s], Bf[kt][s], Zn[kpt], 0, 0, 0);
        Z[0] = Zn[0]; Z[1] = Zn[1];
#pragma unroll
        for (int f = 0; f < 8; ++f) { Acur[f] = Anxt[f]; Ccur[f] = Cnxt[f]; }
    }
}

__device__ __forceinline__ void rwkv_out_unit(const Args& a, const int u, float* Ls) {
    const int lane = my_tid() & 63, r = lane & 31, hf = lane >> 5, c = u >> 4, h = u & 15, t0 = c * 64;
    const bfr* WY = (const bfr*)(a.ws + WS_WY) + (size_t)u * 4096; const bfr* YL = (const bfr*)(a.ws + WS_YLOC) + (size_t)u * 4096;
    const bfr* ZT = (const bfr*)(a.ws + WS_ZT) + (size_t)u * 4096;
    f32x16 acc[2][2];
#pragma unroll
    for (int it = 0; it < 2; ++it)
#pragma unroll
        for (int vt = 0; vt < 2; ++vt)
#pragma unroll
            for (int g4 = 0; g4 < 4; ++g4) {
                const uint2 cc = *reinterpret_cast<const uint2*>(&YL[(((it * 2 + vt) * 4 + g4) * 64 + lane) * 4]);
                acc[it][vt][g4 * 4] = bflo(cc.x); acc[it][vt][g4 * 4 + 1] = bfhi(cc.x); acc[it][vt][g4 * 4 + 2] = bflo(cc.y); acc[it][vt][g4 * 4 + 3] = bfhi(cc.y);
            }
#pragma unroll
    for (int ks = 0; ks < 4; ++ks) {
        bf16x8 A[2], B[2];
#pragma unroll
        for (int it = 0; it < 2; ++it) A[it] = *reinterpret_cast<const bf16x8*>(&WY[(it * 32 + r) * 64 + ks * 16 + hf * 8]);
#pragma unroll
        for (int vt = 0; vt < 2; ++vt) B[vt] = *reinterpret_cast<const bf16x8*>(&ZT[(vt * 32 + r) * 64 + ks * 16 + hf * 8]);
#pragma unroll
        for (int it = 0; it < 2; ++it)
#pragma unroll
            for (int vt = 0; vt < 2; ++vt) acc[it][vt] = __builtin_amdgcn_mfma_f32_32x32x16_bf16(A[it], B[vt], acc[it][vt], 0, 0, 0);
    }
#pragma unroll
    for (int it = 0; it < 2; ++it)
#pragma unroll
        for (int vt = 0; vt < 2; ++vt)
#pragma unroll
            for (int g = 0; g < 16; ++g) Ls[(it * 32 + (g & 3) + 8 * (g >> 2) + 4 * hf) * 68 + vt * 32 + r] = acc[it][vt][g];
    asm volatile("s_waitcnt lgkmcnt(0)" ::: "memory");
    __builtin_amdgcn_wave_barrier();
    {
        float y[64]; float s1 = 0.f, s2 = 0.f;
#pragma unroll
        for (int q = 0; q < 16; ++q) {
            const float4 x = *reinterpret_cast<const float4*>(&Ls[lane * 68 + q * 4]);
            y[q * 4] = x.x; y[q * 4 + 1] = x.y; y[q * 4 + 2] = x.z; y[q * 4 + 3] = x.w;
            s1 += (x.x + x.y) + (x.z + x.w);
        }
        const float mean = s1 * (1.f / 64.f);
#pragma unroll
        for (int v = 0; v < 64; ++v) { const float d = y[v] - mean; s2 += d * d; }
        const float rstd = rsqrtf(s2 * (1.f / 64.f) + 64e-5f);
        const bfr* Gg = (const bfr*)(a.ws + WS_GG); const bfr* Bon = (const bfr*)(a.ws + WS_BON); bfr* RWO = (bfr*)(a.ws + WS_RWO);
        const size_t o = (size_t)(t0 + lane) * RW + h * 64;
        const float* lnw = a.in[I_LNW] + h * 64; const float* lnb = a.in[I_LNB] + h * 64;
#pragma unroll
        for (int q = 0; q < 8; ++q) {
            float gg[8], bb[8], rr[8];
            unpack8(*reinterpret_cast<const uint4*>(&Gg[o + q * 8]), gg);
            unpack8(*reinterpret_cast<const uint4*>(&Bon[o + q * 8]), bb);
#pragma unroll
            for (int e = 0; e < 8; ++e) rr[e] = ((y[q * 8 + e] - mean) * rstd * lnw[q * 8 + e] + lnb[q * 8 + e] + bb[e]) * gg[e];
            *reinterpret_cast<uint4*>(&RWO[o + q * 8]) = pack8(rr);
        }
    }
    asm volatile("s_waitcnt lgkmcnt(0)" ::: "memory");
    __builtin_amdgcn_wave_barrier();
}
#ifndef DUP_DSA
#define DUP_DSA 0
#endif
constexpr float IDX_SCALE = 0.04419417382415922f;
constexpr int CT_ROW = 544;
constexpr int CT_WAVE = 18432;
constexpr int DSA_RELB_OFF = 155648;
constexpr int DSA_HIST_OFF = 131072;
constexpr int DSA_SEL_OFF = 147456;

typedef __bf16 bf16p2_t __attribute__((ext_vector_type(2)));
__device__ __forceinline__ bf16x8 fp8x8_to_bf16(const uint2 w) {
    const u32x4 r = {__builtin_bit_cast(unsigned, __builtin_amdgcn_cvt_scalef32_pk_bf16_fp8(w.x, 1.0f, false)), __builtin_bit_cast(unsigned, __builtin_amdgcn_cvt_scalef32_pk_bf16_fp8(w.x, 1.0f, true)),
                     __builtin_bit_cast(unsigned, __builtin_amdgcn_cvt_scalef32_pk_bf16_fp8(w.y, 1.0f, false)), __builtin_bit_cast(unsigned, __builtin_amdgcn_cvt_scalef32_pk_bf16_fp8(w.y, 1.0f, true))};
    return __builtin_bit_cast(bf16x8, r);
}
__device__ __forceinline__ unsigned pack4_fp8(float a0, float a1, float a2, float a3) {
    int p = 0; p = __builtin_amdgcn_cvt_pk_fp8_f32(a0, a1, p, false); p = __builtin_amdgcn_cvt_pk_fp8_f32(a2, a3, p, true); return (unsigned)p;
}
__device__ __forceinline__ int rel_bucket(int rel) {
    const int n = rel < 0 ? -rel : rel;
    const int lg = 8 + (n >= 15) + (n >= 27) + (n >= 50) + (n >= 91) + (n >= 166) + (n >= 305) + (n >= 559);
    return (n < 8 ? n : lg) + (rel > 0 ? 16 : 0);
}
__device__ __forceinline__ unsigned fkey(float f) {
    if (f == 0.f) f = 0.f;
    const unsigned u = __float_as_uint(f);
    return (u & 0x80000000u) ? ~u : (u | 0x80000000u);
}

__device__ __forceinline__ void dsa_cnorm(const Args& a) {
    const bfr* P = (const bfr*)(a.ws + WS_P); unsigned char* CB8 = a.ws + WS_CB; bfr* IKC = (bfr*)(a.ws + WS_IKC);
    const int lane = my_tid() & 63, wv = my_tid() >> 6;
    const float4 g = reinterpret_cast<const float4*>(a.in[I_KVG])[lane];
    for (int t = blockIdx.x * 8 + wv; t < T; t += gridDim.x * 8) {
        const uint2 raw = *reinterpret_cast<const uint2*>(&P[(size_t)t * NINP + C_CKV + lane * 4]);
        const float v0 = bflo(raw.x), v1 = bfhi(raw.x), v2 = bflo(raw.y), v3 = bfhi(raw.y);
        const float ss = wave_sum(v0 * v0 + v1 * v1 + v2 * v2 + v3 * v3);
        const float rs = rsqrtf(ss * (1.f / 256.f) + EPS);
        int pk = 0;
        pk = __builtin_amdgcn_cvt_pk_fp8_f32(v0 * rs * g.x, v1 * rs * g.y, pk, false);
        pk = __builtin_amdgcn_cvt_pk_fp8_f32(v2 * rs * g.z, v3 * rs * g.w, pk, true);
        *reinterpret_cast<int*>(&CB8[(size_t)t * 256 + lane * 4]) = pk;
        if (lane < 16) *reinterpret_cast<uint2*>(&IKC[(size_t)t * 64 + lane * 4]) = *reinterpret_cast<const uint2*>(&P[(size_t)t * NINP + C_IK + lane * 4]);
    }
}
__device__ __forceinline__ void dsa_qlat(const Args& a) {
    const bfr* P = (const bfr*)(a.ws + WS_P); const bfr* WUK = (const bfr*)(a.ws + WS_WUK); unsigned char* QL8 = a.ws + WS_QLAT;
    const int lane = my_tid() & 63, wv = my_tid() >> 6, fr = lane & 15, fq = lane >> 4;
    for (int it = blockIdx.x * 8 + wv; it < (T / 64) * NH; it += gridDim.x * 8) {
        const int tg = it >> 4, h = it & 15, t0 = tg * 64;
        bf16x8 Bt[4][2];
#pragma unroll
        for (int tl = 0; tl < 4; ++tl)
#pragma unroll
            for (int ks = 0; ks < 2; ++ks) Bt[tl][ks] = *reinterpret_cast<const bf16x8*>(&P[(size_t)(t0 + tl * 16 + fr) * NINP + C_Q + h * 64 + ks * 32 + fq * 8]);
#pragma unroll 2
        for (int nt = 0; nt < 16; ++nt) {
            const bf16x8 A0 = *reinterpret_cast<const bf16x8*>(&WUK[(size_t)(h * 256 + nt * 16 + fr) * 64 + fq * 8]);
            const bf16x8 A1 = *reinterpret_cast<const bf16x8*>(&WUK[(size_t)(h * 256 + nt * 16 + fr) * 64 + 32 + fq * 8]);
#pragma unroll
            for (int tl = 0; tl < 4; ++tl) {
                f32x4 acc = {0.f, 0.f, 0.f, 0.f};
                acc = __builtin_amdgcn_mfma_f32_16x16x32_bf16(A0, Bt[tl][0], acc, 0, 0, 0);
                acc = __builtin_amdgcn_mfma_f32_16x16x32_bf16(A1, Bt[tl][1], acc, 0, 0, 0);
                *reinterpret_cast<unsigned*>(&QL8[((size_t)(t0 + tl * 16 + fr) * NH + h) * 256 + nt * 16 + fq * 4]) = pack4_fp8(acc[0], acc[1], acc[2], acc[3]);
            }
        }
    }
}
__device__ __forceinline__ void dsa_oproj(const Args& a) {
    const unsigned char* OL8 = a.ws + WS_OLAT; const bfr* WUVT = (const bfr*)(a.ws + WS_WUVT); bfr* DO = (bfr*)(a.ws + WS_DO);
    const int lane = my_tid() & 63, wv = my_tid() >> 6, fr = lane & 15, fq = lane >> 4;
    for (int it = blockIdx.x * 8 + wv; it < (T / 64) * NH; it += gridDim.x * 8) {
        const int tg = it >> 4, h = it & 15, t0 = tg * 64;
        f32x4 acc[4][4];
#pragma unroll
        for (int tl = 0; tl < 4; ++tl)
#pragma unroll
            for (int nt = 0; nt < 4; ++nt) acc[tl][nt] = f32x4{0.f, 0.f, 0.f, 0.f};
#pragma unroll 2
        for (int ks = 0; ks < 8; ++ks) {
            bf16x8 A[4];
#pragma unroll
            for (int nt = 0; nt < 4; ++nt) A[nt] = *reinterpret_cast<const bf16x8*>(&WUVT[(size_t)(h * 64 + nt * 16 + fr) * 256 + ks * 32 + fq * 8]);
#pragma unroll
            for (int tl = 0; tl < 4; ++tl) {
                const bf16x8 Bt = fp8x8_to_bf16(*reinterpret_cast<const uint2*>(&OL8[((size_t)(t0 + tl * 16 + fr) * NH + h) * 256 + ks * 32 + fq * 8]));
#pragma unroll
                for (int nt = 0; nt < 4; ++nt) acc[tl][nt] = __builtin_amdgcn_mfma_f32_16x16x32_bf16(A[nt], Bt, acc[tl][nt], 0, 0, 0);
            }
        }
#pragma unroll
        for (int tl = 0; tl < 4; ++tl)
#pragma unroll
            for (int nt = 0; nt < 4; ++nt) { uint2 o; o.x = pack2(acc[tl][nt][0], acc[tl][nt][1]); o.y = pack2(acc[tl][nt][2], acc[tl][nt][3]);
                *reinterpret_cast<uint2*>(&DO[(size_t)(t0 + tl * 16 + fr) * RW + h * 64 + nt * 16 + fq * 4]) = o; }
    }
}

__device__ __forceinline__ float bin_scale(const float sumw2) { const float sg = sqrtf(32.f * sumw2); return sg > 1e-20f ? 90.f / sg : 1.f; }
__device__ __forceinline__ int score_bin(const float sc, const float bsc) { const float f = floorf(sc * bsc) + 512.f; return (int)fminf(fmaxf(f, 0.f), 1023.f); }
__device__ __forceinline__ float key_score(const unsigned k) { return __uint_as_float((k & 0x80000000u) ? (k ^ 0x80000000u) : ~k); }
__device__ __forceinline__ void hist_scan(const unsigned* hist, const int nb, const unsigned need, unsigned* res, const int lane) {
    const int per = nb >> 6;
    unsigned s = 0;
    for (int i = 0; i < per; ++i) s += hist[lane * per + i];
    unsigned S = s;
#pragma unroll
    for (int o = 1; o < 64; o <<= 1) { const unsigned tt = __shfl_down(S, o); if (lane + o < 64) S += tt; }
    const unsigned long long m = __ballot(S >= need);
    const int ls = 63 - __clzll(m);
    if (lane == ls) {
        unsigned accv = S - s; int bin = lane * per; unsigned abv = accv;
        for (int bb = lane * per + per - 1; bb >= lane * per; --bb) { const unsigned cc = hist[bb]; if (accv + cc >= need) { bin = bb; abv = accv; break; } accv += cc; }
        res[0] = (unsigned)bin; res[1] = abv;
    }
}

__device__ __forceinline__ void dsa_select4(const Args& a, const int t0, const int qs, unsigned char* lds) {
    const bfr* P = (const bfr*)(a.ws + WS_P); const bfr* IKC = (const bfr*)(a.ws + WS_IKC);
    float* SC = (float*)lds; int* SEL = (int*)(lds + DSA_SEL_OFF); unsigned* MISC = (unsigned*)(lds + LDS_MISC);
    const int tid = my_tid(), lane = tid & 63, wv = tid >> 6, r = lane & 31, hf = lane >> 5;
    const int L = 64 * (t0 / 64 + 1);
    if (L <= 256) {
        for (int i = tid; i < 4 * 256; i += 512) SEL[(qs + (i >> 8)) * 256 + (i & 255)] = (i & 255) | (rel_bucket((i & 255) - (t0 + (i >> 8))) << 16);
        if (tid < 4) MISC[16 + qs + tid] = (unsigned)L;
        __syncthreads();
        return;
    }
    for (int i = tid; i < 4096; i += 512) ((unsigned*)(lds + DSA_HIST_OFF))[i] = 0u;
    __syncthreads();
    {
        const int qq = r >> 3, hh = r & 7;
        bf16x8 B[4];
#pragma unroll
        for (int ks = 0; ks < 4; ++ks) B[ks] = *reinterpret_cast<const bf16x8*>(&P[(size_t)(t0 + qq) * NINP + C_IQ + hh * 64 + ks * 16 + hf * 8]);
        const float wgt = bf2f(P[(size_t)(t0 + qq) * NINP + C_IW + hh]) * IDX_SCALE;
        float w2 = wgt * wgt; w2 += dpp_f<DPP_XOR1>(w2); w2 += dpp_f<DPP_XOR2>(w2); w2 += dpp_f<0x141>(w2);
        const float bsc = bin_scale(w2);
        if (hh == 0 && hf == 0) ((float*)MISC)[48 + qq] = bsc;
        const int ntile = L >> 5;
        for (int rp_ = 0; rp_ < ((DUP_DSA & 1) ? 2 : 1); ++rp_) {
        bf16x8 An[4];
        if (wv < ntile) {
#pragma unroll
            for (int ks = 0; ks < 4; ++ks) An[ks] = *reinterpret_cast<const bf16x8*>(&IKC[(size_t)(wv * 32 + r) * 64 + ks * 16 + hf * 8]);
        }
        for (int kt = wv; kt < ntile; kt += 8) {
            bf16x8 Ac[4];
#pragma unroll
            for (int ks = 0; ks < 4; ++ks) Ac[ks] = An[ks];
            if (kt + 8 < ntile) {
#pragma unroll
                for (int ks = 0; ks < 4; ++ks) An[ks] = *reinterpret_cast<const bf16x8*>(&IKC[(size_t)((kt + 8) * 32 + r) * 64 + ks * 16 + hf * 8]);
            }
            f32x16 acc;
#pragma unroll
            for (int g = 0; g < 16; ++g) acc[g] = 0.f;
#pragma unroll
            for (int ks = 0; ks < 4; ++ks) acc = __builtin_amdgcn_mfma_f32_32x32x16_bf16(Ac[ks], B[ks], acc, 0, 0, 0);
            float s1[8], s2[4], s3[2];
            const bool b0 = (hh & 1) != 0, b1 = (hh & 2) != 0, b2 = (hh & 4) != 0;
#pragma unroll
            for (int p = 0; p < 8; ++p) {
                const float x0 = fmaxf(acc[2 * p], 0.f) * wgt, x1 = fmaxf(acc[2 * p + 1], 0.f) * wgt;
                s1[p] = (b0 ? x1 : x0) + dpp_f<DPP_XOR1>(b0 ? x0 : x1);
            }
#pragma unroll
            for (int p = 0; p < 4; ++p) s2[p] = (b1 ? s1[2 * p + 1] : s1[2 * p]) + dpp_f<DPP_XOR2>(b1 ? s1[2 * p] : s1[2 * p + 1]);
#pragma unroll
            for (int p = 0; p < 2; ++p) s3[p] = (b2 ? s2[2 * p + 1] : s2[2 * p]) + __shfl_xor(b2 ? s2[2 * p] : s2[2 * p + 1], 4);
#pragma unroll
            for (int p = 0; p < 2; ++p) { const int g = 8 * p + hh; const unsigned fk = fkey(s3[p]); ((unsigned*)SC)[qq * 8192 + kt * 32 + (g & 3) + 8 * (g >> 2) + 4 * hf] = fk;
                if (rp_ == 0) atomicAdd((unsigned*)(lds + DSA_HIST_OFF) + qq * 1024 + score_bin(s3[p], bsc), 1u); }
        }
        }
    }
    __syncthreads();
    const int q = wv >> 1, l128 = (wv & 1) * 64 + lane;
    const unsigned* keys = (const unsigned*)(SC + q * 8192);
    unsigned* hist = (unsigned*)(lds + DSA_HIST_OFF) + q * 1024;
    unsigned* res = MISC + 32 + q * 4;
    for (int rp_ = 0; rp_ < ((DUP_DSA & 2) ? 2 : 1); ++rp_) {
    const float bsc = ((const float*)MISC)[48 + q];
    unsigned need = 256;
    if (rp_ > 0) {
        for (int i = l128; i < 1024; i += 128) hist[i] = 0u;
        __syncthreads();
        for (int idx = l128; idx < L; idx += 128) atomicAdd(&hist[score_bin(key_score(keys[idx]), bsc)], 1u);
        __syncthreads();
    }
    if ((wv & 1) == 0) hist_scan(hist, 1024, need, res, lane);
    __syncthreads();
    const int b0 = (int)res[0]; need -= res[1];
    __syncthreads();
    unsigned* cand = hist + 256;
    if (l128 == 0) { res[2] = 0u; res[3] = 0u; }
    if (tid == 0) MISC[52] = 0u;
    __syncthreads();
    for (int idx = l128; idx < L; idx += 128) {
        const unsigned k = keys[idx];
        if (score_bin(key_score(k), bsc) == b0) { const unsigned p = atomicAdd(&res[2], 1u); if (p < 768u) cand[p] = k; }
    }
    __syncthreads();
    const unsigned ncand = res[2];
    if (l128 == 0 && ncand > 768u) MISC[52] = 1u;
    __syncthreads();
    const bool fast = MISC[52] == 0u;
    unsigned prefix = 0;
    if (fast) {
        for (unsigned i = l128; i < ncand; i += 128) {
            const unsigned me = cand[i]; unsigned cgt = 0, ceq = 0;
            for (unsigned j = 0; j < ncand; ++j) { const unsigned o = cand[j]; cgt += (o > me) ? 1u : 0u; ceq += (o == me) ? 1u : 0u; }
            if (cgt < need && need <= cgt + ceq) { res[0] = me; res[1] = cgt; }
        }
        __syncthreads();
        prefix = res[0]; need -= res[1];
        __syncthreads();
    } else {
#pragma unroll 1
        for (int pass = 0; pass < 4; ++pass) {
            const int lo_shift = 24 - 8 * pass;
            for (int i = l128; i < 256; i += 128) hist[i] = 0u;
            __syncthreads();
            for (int idx = l128; idx < L; idx += 128) {
                const unsigned k = keys[idx];
                const bool ok = (score_bin(key_score(k), bsc) == b0) && (pass == 0 || (k >> (lo_shift + 8)) == prefix);
                if (ok) atomicAdd(&hist[(k >> lo_shift) & 255u], 1u);
            }
            __syncthreads();
            if ((wv & 1) == 0) hist_scan(hist, 256, need, res, lane);
            __syncthreads();
            prefix = (prefix << 8) | res[0]; need -= res[1];
            __syncthreads();
        }
    }
    const unsigned tkey = prefix;
    if ((wv & 1) == 0) {
        const unsigned ngt = 256u - need; unsigned rg = 0, rt = 0;
        const unsigned long long lt = (1ull << lane) - 1ull;
        for (int base = 0; base < L; base += 64) {
            const unsigned k = keys[base + lane];
            const bool gt = k > tkey, tie = k == tkey;
            const unsigned long long mg = __ballot(gt), mt = __ballot(tie);
            if (gt) { const unsigned p = rg + (unsigned)__popcll(mg & lt); if (p < 256u) SEL[(qs + q) * 256 + p] = base + lane; }
            if (tie) { const unsigned p = rt + (unsigned)__popcll(mt & lt); if (p < need) SEL[(qs + q) * 256 + ngt + p] = base + lane; }
            rg += (unsigned)__popcll(mg); rt += (unsigned)__popcll(mt);
        }
        if (lane == 0) MISC[16 + qs + q] = 256u;
    }
    __syncthreads();
    for (int i = l128; i < 256; i += 128) { const int e = SEL[(qs + q) * 256 + i]; SEL[(qs + q) * 256 + i] = e | (rel_bucket(e - (t0 + q)) << 16); }
    __syncthreads();
    }
}

__device__ __forceinline__ void dsa_attend(const Args& a, const int t, const int* sel, const int nsel, unsigned char* ct, const float* relb_l) {
    const unsigned char* CB8 = a.ws + WS_CB; const unsigned char* QL8 = a.ws + WS_QLAT; unsigned char* OL8 = a.ws + WS_OLAT;
    const int lane = my_tid() & 63, fr = lane & 15, fq = lane >> 4;
    bf16x8 Bq[8];
#pragma unroll
    for (int ks = 0; ks < 8; ++ks) Bq[ks] = fp8x8_to_bf16(*reinterpret_cast<const uint2*>(&QL8[((size_t)t * NH + fr) * 256 + ks * 32 + fq * 8]));
    f32x4 o[16];
#pragma unroll
    for (int mt = 0; mt < 16; ++mt) o[mt] = f32x4{0.f, 0.f, 0.f, 0.f};
    float mrun = -1e30f, lrun = 0.f;
    const unsigned tr_addr = (unsigned)(size_t)ct + (unsigned)((4 * fq + (fr >> 2)) * CT_ROW + (fr & 3) * 8);
    const int nblk = nsel >> 5;
    uint2 Ar[2][8];
#pragma unroll
    for (int tt = 0; tt < 2; ++tt) {
        const int kidx = sel[tt * 16 + fr] & 0xFFFF;
#pragma unroll
        for (int ks = 0; ks < 8; ++ks) Ar[tt][ks] = *reinterpret_cast<const uint2*>(&CB8[(size_t)kidx * 256 + ks * 32 + fq * 8]);
    }
    for (int kb = 0; kb < nblk; ++kb) {
        f32x4 st[2];
#pragma unroll
        for (int tt = 0; tt < 2; ++tt) {
            st[tt] = f32x4{0.f, 0.f, 0.f, 0.f};
#pragma unroll
            for (int ks = 0; ks < 8; ++ks) {
                const bf16x8 Af = fp8x8_to_bf16(Ar[tt][ks]);
                st[tt] = __builtin_amdgcn_mfma_f32_16x16x32_bf16(Af, Bq[ks], st[tt], 0, 0, 0);
                *reinterpret_cast<bf16x8*>(ct + (tt * 16 + fr) * CT_ROW + (ks * 32 + fq * 8) * 2) = Af;
            }
        }
        if (kb + 1 < nblk) {
#pragma unroll
            for (int tt = 0; tt < 2; ++tt) {
                const int kidx = sel[(kb + 1) * 32 + tt * 16 + fr] & 0xFFFF;
#pragma unroll
                for (int ks = 0; ks < 8; ++ks) Ar[tt][ks] = *reinterpret_cast<const uint2*>(&CB8[(size_t)kidx * 256 + ks * 32 + fq * 8]);
            }
        }
        float lg[8]; float bmax = -1e30f;
#pragma unroll
        for (int tt = 0; tt < 2; ++tt) {
            const int4 k4 = *reinterpret_cast<const int4*>(&sel[kb * 32 + tt * 16 + fq * 4]);
            const int kk4[4] = {k4.x, k4.y, k4.z, k4.w};
#pragma unroll
            for (int j = 0; j < 4; ++j) {
                const float v = st[tt][j] * 0.125f + relb_l[(kk4[j] >> 16) * 16 + fr];
                lg[tt * 4 + j] = v; bmax = fmaxf(bmax, v);
            }
        }
        bmax = fmaxf(bmax, __shfl_xor(bmax, 16)); bmax = fmaxf(bmax, __shfl_xor(bmax, 32));
        const bool resc = __any(bmax > mrun + 8.f);
        if (resc) {
            const float mnew = fmaxf(mrun, bmax); const float alpha = __expf(mrun - mnew); mrun = mnew; lrun *= alpha;
            asm volatile("" ::: "memory");
#pragma unroll
            for (int mt = 0; mt < 16; ++mt) { o[mt][0] *= alpha; o[mt][1] *= alpha; o[mt][2] *= alpha; o[mt][3] *= alpha; }
        }
        float psum = 0.f; bf16x8 Pf;
#pragma unroll
        for (int e = 0; e < 8; e += 2) {
            const float p0 = __expf(lg[e] - mrun), p1 = __expf(lg[e + 1] - mrun); psum += p0 + p1;
            const unsigned pk = pack2(p0, p1); Pf[e] = (short)(pk & 0xFFFF); Pf[e + 1] = (short)(pk >> 16);
        }
        lrun += psum;
        asm volatile("s_waitcnt lgkmcnt(0)" ::: "memory");
        __builtin_amdgcn_wave_barrier();
#pragma unroll
        for (int m4 = 0; m4 < 4; ++m4) {
            uint2 r0[4], r1[4];
            asm volatile("ds_read_b64_tr_b16 %0, %8 offset:%9\n\tds_read_b64_tr_b16 %1, %8 offset:%10\n\t"
                         "ds_read_b64_tr_b16 %2, %8 offset:%11\n\tds_read_b64_tr_b16 %3, %8 offset:%12\n\t"
                         "ds_read_b64_tr_b16 %4, %8 offset:%13\n\tds_read_b64_tr_b16 %5, %8 offset:%14\n\t"
                         "ds_read_b64_tr_b16 %6, %8 offset:%15\n\tds_read_b64_tr_b16 %7, %8 offset:%16\n\ts_waitcnt lgkmcnt(0)"
                         : "=&v"(r0[0]), "=&v"(r1[0]), "=&v"(r0[1]), "=&v"(r1[1]), "=&v"(r0[2]), "=&v"(r1[2]), "=&v"(r0[3]), "=&v"(r1[3])
                         : "v"(tr_addr), "n"(m4 * 128), "n"(m4 * 128 + 16 * CT_ROW), "n"(m4 * 128 + 32), "n"(m4 * 128 + 32 + 16 * CT_ROW),
                           "n"(m4 * 128 + 64), "n"(m4 * 128 + 64 + 16 * CT_ROW), "n"(m4 * 128 + 96), "n"(m4 * 128 + 96 + 16 * CT_ROW)
                         : "memory");
#pragma unroll
            for (int i = 0; i < 4; ++i) {
                const int mt = m4 * 4 + i;
                const u32x4 raw = {r0[i].x, r0[i].y, r1[i].x, r1[i].y};
                const bf16x8 Av = __builtin_bit_cast(bf16x8, raw);
                o[mt] = __builtin_amdgcn_mfma_f32_16x16x32_bf16(Av, Pf, o[mt], 0, 0, 0);
            }
        }
        asm volatile("s_waitcnt lgkmcnt(0)" ::: "memory");
        __builtin_amdgcn_wave_barrier();
    }
    lrun += __shfl_xor(lrun, 16); lrun += __shfl_xor(lrun, 32);
    const float inv = frcp_(lrun);
#pragma unroll
    for (int mt = 0; mt < 16; ++mt) {
        *reinterpret_cast<unsigned*>(&OL8[((size_t)t * NH + fr) * 256 + mt * 16 + fq * 4]) = pack4_fp8(o[mt][0] * inv, o[mt][1] * inv, o[mt][2] * inv, o[mt][3] * inv);
    }
}

constexpr int DSA_CCAP = 256;
__device__ __forceinline__ bool dsa_select8(const Args& a, const int t0, unsigned char* lds) {
    const bfr* P = (const bfr*)(a.ws + WS_P); const bfr* IKC = (const bfr*)(a.ws + WS_IKC);
    unsigned* KEYS = (unsigned*)(a.ws + WS_KEYS) + (size_t)blockIdx.x * (8 * 8192);
    unsigned short* BIN = (unsigned short*)lds; unsigned* H16 = (unsigned*)(lds + DSA_HIST_OFF);
    int* SEL = (int*)(lds + DSA_SEL_OFF); unsigned* MISC = (unsigned*)(lds + LDS_MISC);
    const int tid = my_tid(), lane = tid & 63, wv = tid >> 6, r = lane & 31, hf = lane >> 5;
    const int L = 64 * (t0 / 64 + 1);
    if (L <= 256) {
        for (int i = tid; i < 8 * 256; i += 512) SEL[i] = (i & 255) | (rel_bucket((i & 255) - (t0 + (i >> 8))) << 16);
        if (tid < 8) MISC[16 + tid] = (unsigned)L;
        __syncthreads();
        return true;
    }
#ifndef DUP_DSA
#define DUP_DSA 0
#endif
    for (int rp_ = 0; rp_ < ((DUP_DSA & 1) ? 2 : 1); ++rp_) {
    if (rp_) __syncthreads();
    for (int i = tid; i < 4096; i += 512) H16[i] = 0u;
    if (tid == 0) MISC[60] = 0u;
    __syncthreads();
    {
        const int qq = r >> 3, hh = r & 7;
        bf16x8 B[2][4]; float wgt[2], bsc[2];
#pragma unroll
        for (int grp = 0; grp < 2; ++grp) {
#pragma unroll
            for (int ks = 0; ks < 4; ++ks) B[grp][ks] = *reinterpret_cast<const bf16x8*>(&P[(size_t)(t0 + grp * 4 + qq) * NINP + C_IQ + hh * 64 + ks * 16 + hf * 8]);
            wgt[grp] = bf2f(P[(size_t)(t0 + grp * 4 + qq) * NINP + C_IW + hh]) * IDX_SCALE;
            float w2 = wgt[grp] * wgt[grp]; w2 += dpp_f<DPP_XOR1>(w2); w2 += dpp_f<DPP_XOR2>(w2); w2 += dpp_f<0x141>(w2);
            bsc[grp] = bin_scale(w2);
            if (hh == 0 && hf == 0) ((float*)MISC)[48 + grp * 4 + qq] = bsc[grp];
        }
        const bool b0 = (hh & 1) != 0, b1 = (hh & 2) != 0, b2 = (hh & 4) != 0;
        const int ntile = L >> 5;
        bf16x8 An[4];
        if (wv < ntile) {
#pragma unroll
            for (int ks = 0; ks < 4; ++ks) An[ks] = *reinterpret_cast<const bf16x8*>(&IKC[(size_t)(wv * 32 + r) * 64 + ks * 16 + hf * 8]);
        }
        for (int kt = wv; kt < ntile; kt += 8) {
            bf16x8 Ac[4];
#pragma unroll
            for (int ks = 0; ks < 4; ++ks) Ac[ks] = An[ks];
            if (kt + 8 < ntile) {
#pragma unroll
                for (int ks = 0; ks < 4; ++ks) An[ks] = *reinterpret_cast<const bf16x8*>(&IKC[(size_t)((kt + 8) * 32 + r) * 64 + ks * 16 + hf * 8]);
            }
#pragma unroll
            for (int grp = 0; grp < 2; ++grp) {
                f32x16 acc;
#pragma unroll
                for (int g = 0; g < 16; ++g) acc[g] = 0.f;
#pragma unroll
                for (int ks = 0; ks < 4; ++ks) acc = __builtin_amdgcn_mfma_f32_32x32x16_bf16(Ac[ks], B[grp][ks], acc, 0, 0, 0);
                float s1[8], s2[4], s3[2];
#pragma unroll
                for (int p = 0; p < 8; ++p) {
                    const float x0 = fmaxf(acc[2 * p], 0.f) * wgt[grp], x1 = fmaxf(acc[2 * p + 1], 0.f) * wgt[grp];
                    s1[p] = (b0 ? x1 : x0) + dpp_f<DPP_XOR1>(b0 ? x0 : x1);
                }
#pragma unroll
                for (int p = 0; p < 4; ++p) s2[p] = (b1 ? s1[2 * p + 1] : s1[2 * p]) + dpp_f<DPP_XOR2>(b1 ? s1[2 * p] : s1[2 * p + 1]);
#pragma unroll
                for (int p = 0; p < 2; ++p) s3[p] = (b2 ? s2[2 * p + 1] : s2[2 * p]) + __shfl_xor(b2 ? s2[2 * p] : s2[2 * p + 1], 4);
#pragma unroll
                for (int p = 0; p < 2; ++p) {
                    const int g = 8 * p + hh, kidx = kt * 32 + (g & 3) + 8 * (g >> 2) + 4 * hf, q = grp * 4 + qq;
                    const int bin = score_bin(s3[p], bsc[grp]);
                    BIN[q * 8192 + kidx] = (unsigned short)bin;
                    atomicAdd(&H16[q * 512 + (bin >> 1)], (bin & 1) ? 0x10000u : 1u);
                    KEYS[q * 8192 + kidx] = fkey(s3[p]);
                }
            }
        }
    }
    }
    asm volatile("s_waitcnt vmcnt(0)" ::: "memory");
    __syncthreads();
    {
        const int q = wv;
        const unsigned short* bins = BIN + q * 8192;
        unsigned* hrow = H16 + q * 512;
        unsigned cnt[16]; unsigned sown = 0;
#pragma unroll
        for (int i = 0; i < 8; ++i) { const unsigned w = hrow[lane * 8 + i]; cnt[2 * i] = w & 0xFFFFu; cnt[2 * i + 1] = w >> 16; sown += cnt[2 * i] + cnt[2 * i + 1]; }
        unsigned S = sown;
#pragma unroll
        for (int o = 1; o < 64; o <<= 1) { const unsigned tt = __shfl_down(S, o); if (lane + o < 64) S += tt; }
        const unsigned long long mfound = __ballot(S >= 256u);
        const int ls = 63 - __clzll(mfound);
        int b0l = 0; unsigned abovel = 0;
        {
            unsigned accv = S - sown; bool done = false;
#pragma unroll
            for (int bb = 15; bb >= 0; --bb) { if (!done) { if (accv + cnt[bb] >= 256u) { b0l = lane * 16 + bb; abovel = accv; done = true; } else accv += cnt[bb]; } }
        }
        const int b0 = __shfl(b0l, ls); const unsigned ngt = __shfl((int)abovel, ls); const unsigned need = 256u - ngt;
        __builtin_amdgcn_wave_barrier();
        int* CL = (int*)hrow; unsigned* CK = hrow + DSA_CCAP;
        const unsigned long long lt = (1ull << lane) - 1ull;
        unsigned rg = 0, rc = 0;
        for (int base = 0; base < (L >> 1); base += 64) {
            const bool valid = (base + lane) < (L >> 1);
            const unsigned w = valid ? reinterpret_cast<const unsigned*>(bins)[base + lane] : 0u;
            const int ba = (int)(w & 0xFFFFu), bb = (int)(w >> 16), ia = 2 * (base + lane), ib = ia + 1;
            const bool ga = valid && ba > b0, gb = valid && bb > b0, ca = valid && ba == b0, cb = valid && bb == b0;
            const unsigned long long mga = __ballot(ga), mgb = __ballot(gb), mca = __ballot(ca), mcb = __ballot(cb);
            const unsigned pg = rg + (unsigned)__popcll(mga & lt) + (unsigned)__popcll(mgb & lt);
            const unsigned pc = rc + (unsigned)__popcll(mca & lt) + (unsigned)__popcll(mcb & lt);
            if (ga && pg < 256u) SEL[q * 256 + pg] = ia;
            if (gb && pg + (ga ? 1u : 0u) < 256u) SEL[q * 256 + pg + (ga ? 1u : 0u)] = ib;
            if (ca && pc < (unsigned)DSA_CCAP) CL[pc] = ia;
            if (cb && pc + (ca ? 1u : 0u) < (unsigned)DSA_CCAP) CL[pc + (ca ? 1u : 0u)] = ib;
            rg += (unsigned)__popcll(mga) + (unsigned)__popcll(mgb); rc += (unsigned)__popcll(mca) + (unsigned)__popcll(mcb);
        }
        const unsigned ncand = rc;
        if (ncand > (unsigned)DSA_CCAP) { if (lane == 0) MISC[60] = 1u; }
        else {
            asm volatile("s_waitcnt lgkmcnt(0)" ::: "memory");
            for (unsigned i = lane; i < ncand; i += 64) CK[i] = __hip_atomic_load(&KEYS[q * 8192 + CL[i]], __ATOMIC_RELAXED, __HIP_MEMORY_SCOPE_AGENT);
            asm volatile("s_waitcnt vmcnt(0) lgkmcnt(0)" ::: "memory");
            __builtin_amdgcn_wave_barrier();
            for (unsigned i = lane; i < ncand; i += 64) {
                const unsigned me = CK[i]; unsigned rk = 0;
                for (unsigned j = 0; j < ncand; ++j) { const unsigned o = CK[j]; rk += (o > me || (o == me && j < i)) ? 1u : 0u; }
                if (rk < need) SEL[q * 256 + ngt + rk] = CL[i];
            }
            asm volatile("s_waitcnt lgkmcnt(0)" ::: "memory");
            __builtin_amdgcn_wave_barrier();
            for (int i = lane; i < 256; i += 64) { const int e = SEL[q * 256 + i]; SEL[q * 256 + i] = e | (rel_bucket(e - (t0 + q)) << 16); }
            if (lane == 0) MISC[16 + q] = 256u;
        }
    }
    __syncthreads();
    return MISC[60] == 0u;
}

__device__ __forceinline__ void dsa_unit(const Args& a, const int unit, unsigned char* lds) {
    const int t0 = unit * 8, wv = my_tid() >> 6;
    if (DUP_DSA & 2) { dsa_select8(a, t0, lds); __syncthreads(); }
    if (!dsa_select8(a, t0, lds)) {
        __syncthreads();
        dsa_select4(a, t0, 0, lds);
        dsa_select4(a, t0 + 4, 4, lds);
    }
    const int* SEL = (const int*)(lds + DSA_SEL_OFF); const unsigned* MISC = (const unsigned*)(lds + LDS_MISC);
    if (DUP_DSA & 4) dsa_attend(a, t0 + wv, SEL + wv * 256, (int)MISC[16 + wv], lds + wv * CT_WAVE, (const float*)(lds + DSA_RELB_OFF));
    dsa_attend(a, t0 + wv, SEL + wv * 256, (int)MISC[16 + wv], lds + wv * CT_WAVE, (const float*)(lds + DSA_RELB_OFF));
    __syncthreads();
}
template <int J> __device__ __forceinline__ int xchg_i(int v) {
    if (J == 1) return __builtin_amdgcn_update_dpp(0, v, 0xB1, 0xF, 0xF, true);
    else if (J == 2) return __builtin_amdgcn_update_dpp(0, v, 0x4E, 0xF, 0xF, true);
    else if (J == 4) { int t = __builtin_amdgcn_update_dpp(v, v, 0x104, 0xF, 0x5, false);
                       return __builtin_amdgcn_update_dpp(t, v, 0x114, 0xF, 0xA, false); }
    else if (J == 8) return __builtin_amdgcn_update_dpp(0, v, 0x128, 0xF, 0xF, true);
    else return __shfl_xor(v, J);
}
template <int J> __device__ __forceinline__ float xchg_f(float v) { return __int_as_float(xchg_i<J>(__float_as_int(v))); }

__device__ __forceinline__ unsigned okey(float f) { const unsigned u = __float_as_uint(f); return (u & 0x80000000u) ? ~u : (u | 0x80000000u); }
template <int K, int J> __device__ __forceinline__ void bitonic_step(unsigned& k, const int lane) {
    const unsigned ok = (unsigned)xchg_i<J>((int)k);
    const bool desc = (K == 64) ? true : ((lane & K) == 0);
    const bool keepmax = ((lane & J) == 0) == desc;
    k = keepmax ? max(k, ok) : min(k, ok);
}
__device__ __forceinline__ void bitonic64(unsigned& k, const int lane) {
    bitonic_step<2, 1>(k, lane);
    bitonic_step<4, 2>(k, lane); bitonic_step<4, 1>(k, lane);
    bitonic_step<8, 4>(k, lane); bitonic_step<8, 2>(k, lane); bitonic_step<8, 1>(k, lane);
    bitonic_step<16, 8>(k, lane); bitonic_step<16, 4>(k, lane); bitonic_step<16, 2>(k, lane); bitonic_step<16, 1>(k, lane);
    bitonic_step<32, 16>(k, lane); bitonic_step<32, 8>(k, lane); bitonic_step<32, 4>(k, lane); bitonic_step<32, 2>(k, lane); bitonic_step<32, 1>(k, lane);
    bitonic_step<64, 32>(k, lane); bitonic_step<64, 16>(k, lane); bitonic_step<64, 8>(k, lane); bitonic_step<64, 4>(k, lane); bitonic_step<64, 2>(k, lane); bitonic_step<64, 1>(k, lane);
}
__device__ __forceinline__ void merge32(unsigned& k, const int lane) {
    bitonic_step<64, 16>(k, lane); bitonic_step<64, 8>(k, lane); bitonic_step<64, 4>(k, lane); bitonic_step<64, 2>(k, lane); bitonic_step<64, 1>(k, lane);
}
__device__ __forceinline__ void top16_of_128(const float* s, float& tv, int& ti, const int lane) {
    unsigned ka = (okey(s[lane]) & ~0x7Fu) | (unsigned)(127 - lane), kb = (okey(s[64 + lane]) & ~0x7Fu) | (unsigned)(63 - lane);
    bitonic64(ka, lane); bitonic64(kb, lane);
    const unsigned rb = (unsigned)__shfl((int)kb, 31 - lane);
    unsigned k = (lane < 16) ? ka : ((lane < 32) ? rb : 0u);
    merge32(k, lane);
    ti = 127 - (int)(k & 0x7Fu);
    tv = s[ti];
}

__device__ __forceinline__ unsigned mirror16(unsigned v) { return (unsigned)__builtin_amdgcn_update_dpp(0, (int)v, 0x140, 0xF, 0xF, true); }
__device__ __forceinline__ void top16_pair(const float* s1, const float* s2, float& tv, int& ti, const int lane) {
    unsigned a1 = (okey(s1[lane]) & ~0x7Fu) | (unsigned)(127 - lane), b1 = (okey(s1[64 + lane]) & ~0x7Fu) | (unsigned)(63 - lane);
    unsigned a2 = (okey(s2[lane]) & ~0x7Fu) | (unsigned)(127 - lane), b2 = (okey(s2[64 + lane]) & ~0x7Fu) | (unsigned)(63 - lane);
#define PEER_S4(K, J) bitonic_step<K, J>(a1, lane); bitonic_step<K, J>(b1, lane); bitonic_step<K, J>(a2, lane); bitonic_step<K, J>(b2, lane);
    PEER_S4(2, 1) PEER_S4(4, 2) PEER_S4(4, 1) PEER_S4(8, 4) PEER_S4(8, 2) PEER_S4(8, 1) PEER_S4(64, 8) PEER_S4(64, 4) PEER_S4(64, 2) PEER_S4(64, 1)
#undef PEER_S4
    unsigned m1 = max(a1, mirror16(b1)), m2 = max(a2, mirror16(b2));
#define PEER_S2(J) bitonic_step<64, J>(m1, lane); bitonic_step<64, J>(m2, lane);
    PEER_S2(8) PEER_S2(4) PEER_S2(2) PEER_S2(1)
#undef PEER_S2
    const bool odd = (lane & 16) != 0;
    const unsigned own = odd ? m2 : m1, snd = odd ? m1 : m2;
    unsigned c = max(own, (unsigned)__shfl_xor((int)snd, 31));
    bitonic_step<64, 8>(c, lane); bitonic_step<64, 4>(c, lane); bitonic_step<64, 2>(c, lane); bitonic_step<64, 1>(c, lane);
    c = max(c, (unsigned)__shfl_xor((int)c, 47));
    bitonic_step<64, 8>(c, lane); bitonic_step<64, 4>(c, lane); bitonic_step<64, 2>(c, lane); bitonic_step<64, 1>(c, lane);
    ti = 127 - (int)(c & 0x7Fu);
    tv = (odd ? s2 : s1)[ti];
}

#ifndef DUP_PEER
#define DUP_PEER 0
#endif
constexpr int PEER_EID_OFF = 131072, PEER_GATE_OFF = 139264;
#ifndef PGB
#define PGB 8
#endif

__device__ __forceinline__ void peer_unit(const Args& a, const int unit, unsigned char* lds) {
    const bfr* QP = (const bfr*)(a.ws + WS_QP); const bfr* SUBK = (const bfr*)(a.ws + WS_SUBK);
    const unsigned char* PU4 = a.ws + WS_PU; const unsigned char* PV4 = a.ws + WS_PV;
    const bfr* HB = (const bfr*)(a.ws + WS_HB); const float* part = (const float*)(a.ws + WS_PART);
    float* S = (float*)lds; int* EID = (int*)(lds + PEER_EID_OFF); float* GATE = (float*)(lds + PEER_GATE_OFF);
    const int tid = my_tid(), lane = tid & 63, wv = tid >> 6, fr = lane & 15, fq = lane >> 4, t0 = unit * 16;
    for (int rp_ = 0; rp_ < ((DUP_PEER & 1) ? 2 : 1); ++rp_) {
    for (int hc = wv * 2; hc < wv * 2 + 2; ++hc) {
        bf16x8 A[4];
#pragma unroll
        for (int ks = 0; ks < 4; ++ks) A[ks] = *reinterpret_cast<const bf16x8*>(&QP[(size_t)(t0 + fr) * D + hc * 128 + ks * 32 + fq * 8]);
#pragma unroll 2
        for (int nt = 0; nt < 8; ++nt) {
            f32x4 acc = {0.f, 0.f, 0.f, 0.f};
#pragma unroll
            for (int ks = 0; ks < 4; ++ks) {
                const bf16x8 B = *reinterpret_cast<const bf16x8*>(&SUBK[(size_t)(hc * 128 + nt * 16 + fr) * 128 + ks * 32 + fq * 8]);
                acc = __builtin_amdgcn_mfma_f32_16x16x32_bf16(A[ks], B, acc, 0, 0, 0);
            }
#pragma unroll
            for (int j = 0; j < 4; ++j) S[((fq * 4 + j) * 16 + hc) * 128 + nt * 16 + fr] = acc[j];
        }
    }
    __syncthreads();
    for (int job = wv * 16; job < wv * 16 + 16; ++job) {
        const int tok = job >> 3, hh = job & 7;
        const float* s1 = S + (tok * 16 + hh * 2) * 128; const float* s2 = s1 + 128;
        float vv; int ii;
        top16_pair(s1, s2, vv, ii, lane);
        int ci = -1, cj = 0;
        { int base = 0;
#pragma unroll
          for (int i = 0; i < 16; ++i) { const int cnt = 16 / (i + 1); if (lane >= base && lane < base + cnt) { ci = i; cj = lane - base; } base += cnt; } }
        const float a1 = __shfl(vv, ci < 0 ? 0 : ci), b1 = __shfl(vv, 16 + cj);
        unsigned ck = (ci >= 0) ? ((okey(a1 + b1) & ~0xFFu) | (unsigned)(255 - (ci * 16 + cj))) : 0u;
        bitonic64(ck, lane);
        const int cid = 255 - (int)(ck & 0xFFu);
        const int pi = (lane < 16) ? (cid >> 4) : 0, pj = (lane < 16) ? (cid & 15) : 0;
        const float cv = __shfl(vv, pi) + __shfl(vv, 16 + pj);
        const float mx = __shfl(cv, 0);
        float e = (lane < 16) ? __expf(cv - mx) : 0.f;
        float se = e;
#pragma unroll
        for (int o = 1; o < 16; o <<= 1) se += __shfl_xor(se, o);
        const int e1 = __shfl(ii, pi), e2 = __shfl(ii, 16 + pj);
        if (lane < 16) { EID[tok * 128 + hh * 16 + lane] = e1 * 128 + e2; GATE[tok * 128 + hh * 16 + lane] = e * frcp_(se); }
    }
    __syncthreads();
    }
    for (int rp_ = 0; rp_ < ((DUP_PEER & 2) ? 2 : 1); ++rp_)
    for (int tk = wv * 2; tk < wv * 2 + 2; ++tk) {
        const int t = t0 + tk;
        int ln = lane; asm volatile("" : "+v"(ln));
        const float rstd = row_rstd(part, t);
        unsigned q1[4], q2[4]; float h1s, h2s;
        {
            float hf[32]; float am = 0.f;
#pragma unroll
            for (int q = 0; q < 8; ++q) {
                const uint2 xr = *reinterpret_cast<const uint2*>(&HB[(size_t)t * D + q * 256 + ln * 4]);
                const float4 g0 = *reinterpret_cast<const float4*>(&a.in[I_NFG][q * 256 + ln * 4]);
                hf[q * 4] = bflo(xr.x) * rstd * g0.x; hf[q * 4 + 1] = bfhi(xr.x) * rstd * g0.y; hf[q * 4 + 2] = bflo(xr.y) * rstd * g0.z; hf[q * 4 + 3] = bfhi(xr.y) * rstd * g0.w;
                am = fmaxf(am, fmaxf(fmaxf(fabsf(hf[q * 4]), fabsf(hf[q * 4 + 1])), fmaxf(fabsf(hf[q * 4 + 2]), fabsf(hf[q * 4 + 3]))));
            }
            h1s = am * (1.f / 7.f); const float i1 = h1s > 0.f ? frcp_(h1s) : 0.f;
            float qv[32]; float am2 = 0.f;
#pragma unroll
            for (int i = 0; i < 32; ++i) { qv[i] = fminf(fmaxf(__builtin_rintf(hf[i] * i1), -7.f), 7.f); hf[i] -= qv[i] * h1s; am2 = fmaxf(am2, fabsf(hf[i])); }
            q1[0] = pack8_i4(qv); q1[1] = pack8_i4(qv + 8); q1[2] = pack8_i4(qv + 16); q1[3] = pack8_i4(qv + 24);
            h2s = am2 * (1.f / 7.f); const float i2 = h2s > 0.f ? frcp_(h2s) : 0.f;
#pragma unroll
            for (int i = 0; i < 32; ++i) qv[i] = fminf(fmaxf(__builtin_rintf(hf[i] * i2), -7.f), 7.f);
            q2[0] = pack8_i4(qv); q2[1] = pack8_i4(qv + 8); q2[2] = pack8_i4(qv + 16); q2[3] = pack8_i4(qv + 24);
        }
        float coef0 = 0.f, coef1 = 0.f;
#pragma unroll 1
        for (int half = 0; half < 2; ++half) {
            float mydot = 0.f;
#define PEER_LOAD_U(W, SC, E0) _Pragma("unroll") for (int bq = 0; bq < 4; ++bq) { \
                const int eid = EID[tk * 128 + half * 64 + (E0) + bq]; const unsigned char* rowp = PU4 + (size_t)eid * PEER_ROWB; \
                SC[bq] = *reinterpret_cast<const bfr*>(rowp + 1024 + ln * 2); W[bq] = *reinterpret_cast<const uint4*>(rowp + ln * 16); } __builtin_amdgcn_sched_barrier(0);
#define PEER_DOT_U(W, SC, E0) _Pragma("unroll") for (int bq = 0; bq < 4; ++bq) { \
                int a1 = 0, a2 = 0; \
                a1 = __builtin_amdgcn_sdot8((int)W[bq].x, (int)q1[0], a1, false); a2 = __builtin_amdgcn_sdot8((int)W[bq].x, (int)q2[0], a2, false); \
                a1 = __builtin_amdgcn_sdot8((int)W[bq].y, (int)q1[1], a1, false); a2 = __builtin_amdgcn_sdot8((int)W[bq].y, (int)q2[1], a2, false); \
                a1 = __builtin_amdgcn_sdot8((int)W[bq].z, (int)q1[2], a1, false); a2 = __builtin_amdgcn_sdot8((int)W[bq].z, (int)q2[2], a2, false); \
                a1 = __builtin_amdgcn_sdot8((int)W[bq].w, (int)q1[3], a1, false); a2 = __builtin_amdgcn_sdot8((int)W[bq].w, (int)q2[3], a2, false); \
                float p = ((float)a1 * h1s + (float)a2 * h2s) * bf2f(SC[bq]); \
                p = wave_sum(p); if (lane == (E0) + bq) mydot = p; __builtin_amdgcn_sched_barrier(0); }
            {
                uint4 wA[4], wB[4]; bfr sA[4], sB[4];
                PEER_LOAD_U(wA, sA, 0)
#pragma unroll 1
                for (int e0 = 0; e0 < 56; e0 += 8) {
                    PEER_LOAD_U(wB, sB, e0 + 4)
                    PEER_DOT_U(wA, sA, e0)
                    PEER_LOAD_U(wA, sA, e0 + 8)
                    PEER_DOT_U(wB, sB, e0 + 4)
                }
                PEER_LOAD_U(wB, sB, 60)
                PEER_DOT_U(wA, sA, 56)
                PEER_DOT_U(wB, sB, 60)
            }
            const float gl = 0.5f * mydot * (1.f + erff(mydot * 0.7071067811865476f));
            const float cfv = gl * GATE[tk * 128 + half * 64 + lane];
            if (half == 0) coef0 = cfv; else coef1 = cfv;
        }
        h16x2 ov2[16];
#pragma unroll
        for (int j = 0; j < 16; ++j) ov2[j] = h16x2{(_Float16)0.f, (_Float16)0.f};
        {
#define PEER_LOAD_V(W, SC, E0) _Pragma("unroll") for (int bq = 0; bq < 4; ++bq) { \
                const int eid = __builtin_amdgcn_readfirstlane(EID[tk * 128 + (E0) + bq]); const unsigned char* rowp = PV4 + (size_t)eid * PEER_ROWB; \
                SC[bq] = *reinterpret_cast<const bfr*>(rowp + 1024 + ln * 2); W[bq] = *reinterpret_cast<const uint4*>(rowp + ln * 16); } __builtin_amdgcn_sched_barrier(0);
#define PEER_AXPY_V(W, SC, E0) _Pragma("unroll") for (int bq = 0; bq < 4; ++bq) { \
                const float cfl = __int_as_float(__builtin_amdgcn_readlane(__float_as_int(((E0) < 64) ? coef0 : coef1), ((E0) + bq) & 63)); \
                const unsigned dw[4] = {W[bq].x, W[bq].y, W[bq].z, W[bq].w}; const _Float16 ch = (_Float16)(cfl * bf2f(SC[bq])); const h16x2 c2 = {ch, ch}; \
                _Pragma("unroll") for (int d = 0; d < 4; ++d) { \
                    ov2[d * 4 + 0] = c2 * __builtin_amdgcn_cvt_scalef32_pk_f16_fp4(dw[d], 1.0f, 0) + ov2[d * 4 + 0]; \
                    ov2[d * 4 + 1] = c2 * __builtin_amdgcn_cvt_scalef32_pk_f16_fp4(dw[d], 1.0f, 1) + ov2[d * 4 + 1]; \
                    ov2[d * 4 + 2] = c2 * __builtin_amdgcn_cvt_scalef32_pk_f16_fp4(dw[d], 1.0f, 2) + ov2[d * 4 + 2]; \
                    ov2[d * 4 + 3] = c2 * __builtin_amdgcn_cvt_scalef32_pk_f16_fp4(dw[d], 1.0f, 3) + ov2[d * 4 + 3]; } \
                __builtin_amdgcn_sched_barrier(0); }
            uint4 wA[4], wB[4]; bfr sA[4], sB[4];
            PEER_LOAD_V(wA, sA, 0)
#pragma unroll 1
            for (int e0 = 0; e0 < 120; e0 += 8) {
                PEER_LOAD_V(wB, sB, e0 + 4)
                PEER_AXPY_V(wA, sA, e0)
                PEER_LOAD_V(wA, sA, e0 + 8)
                PEER_AXPY_V(wB, sB, e0 + 4)
            }
            PEER_LOAD_V(wB, sB, 124)
            PEER_AXPY_V(wA, sA, 120)
            PEER_AXPY_V(wB, sB, 124)
        }
        float ss = 0.f;
        float hv[32];
        { int l2 = lane; asm volatile("" : "+v"(l2));
#pragma unroll
          for (int q = 0; q < 8; ++q) {
              const uint2 xr = *reinterpret_cast<const uint2*>(&HB[(size_t)t * D + q * 256 + l2 * 4]);
              float4 x0; x0.x = bflo(xr.x); x0.y = bfhi(xr.x); x0.z = bflo(xr.y); x0.w = bfhi(xr.y);
              hv[q * 4 + 0] = x0.x; hv[q * 4 + 1] = x0.y; hv[q * 4 + 2] = x0.z; hv[q * 4 + 3] = x0.w;
          } }
#pragma unroll
        for (int j = 0; j < 32; ++j) { hv[j] += (DBG_NOPEER ? 0.f : (float)ov2[j >> 1][j & 1]); ss += hv[j] * hv[j]; }
        ss = wave_sum(ss);
        const float r2 = rsqrtf(ss * (1.f / D) + EPS);
#pragma unroll
        for (int q = 0; q < 8; ++q) {
            const float4 g0 = *reinterpret_cast<const float4*>(&a.in[I_NFIN][q * 256 + ln * 4]);
            float4 o0;
            o0.x = hv[q * 4 + 0] * r2 * g0.x; o0.y = hv[q * 4 + 1] * r2 * g0.y; o0.z = hv[q * 4 + 2] * r2 * g0.z; o0.w = hv[q * 4 + 3] * r2 * g0.w;
            *reinterpret_cast<float4*>(&a.out[(size_t)t * D + q * 256 + ln * 4]) = o0;
        }
    }
    __syncthreads();
}
constexpr int NPHASE = 9;
__global__ void __launch_bounds__(512, 2) mk_fwd(Args a) {
    extern __shared__ __attribute__((aligned(16))) unsigned char lds[];
    volatile LAS unsigned* barw = (volatile LAS unsigned*)((LAS unsigned char*)lds + LDS_BARW);
    unsigned* MISC = (unsigned*)(lds + LDS_MISC);
    if (threadIdx.x < 4) barw[threadIdx.x] = 0u;
    __syncthreads();
    XcdBarrier bar; bar.bar = (unsigned*)(a.ws + WS_CTL); bar.x = 0; bar.st = barw;
#if !MK_SPLIT
    bar = xcd_barrier_post((unsigned*)(a.ws + WS_CTL), barw);
#endif
    const int lo = a.ph_lo, hi = a.ph_hi;
#ifndef PH_MASK
#define PH_MASK 0x1FF
#endif
#define IN(k) (((PH_MASK >> (k)) & 1) && lo <= (k) && (k) < hi)
#ifndef DUP_RW
#define DUP_RW 0
#endif
#ifndef DUP_CHAIN
#define DUP_CHAIN 0
#endif
#ifndef DUP_MASK
#define DUP_MASK 0
#endif
#define REP(k) for (int rep_ = 0; rep_ < (((DUP_MASK >> (k)) & 1) ? 2 : 1); ++rep_)
#define SEAM(k) do { if (IN(k) && IN((k) + 1)) xcd_barrier(bar); } while (0)
    unsigned char* ws = a.ws;
    const bfr* P = (const bfr*)(ws + WS_P);

    if (IN(0)) REP(0) {
        const int tid = my_tid(), wv = tid >> 6; (void)tid; (void)wv;
        {
            const float* x = a.in[I_X]; const float* g = a.in[I_NMG]; bfr* XN = (bfr*)(ws + WS_XN);
            const int lane = tid & 63;
            for (int row = blockIdx.x * 8 + wv; row < T; row += gridDim.x * 8) {
                float4 v[8]; float ss = 0.f;
#pragma unroll
                for (int j = 0; j < 8; ++j) { v[j] = reinterpret_cast<const float4*>(x + (size_t)row * D)[j * 64 + lane]; ss += v[j].x * v[j].x + v[j].y * v[j].y + v[j].z * v[j].z + v[j].w * v[j].w; }
                ss = wave_sum(ss);
                const float rs = rsqrtf(ss * (1.f / D) + EPS);
#pragma unroll
                for (int j = 0; j < 8; ++j) {
                    const float4 gg = reinterpret_cast<const float4*>(g)[j * 64 + lane];
                    uint2 o; o.x = pack2(v[j].x * rs * gg.x, v[j].y * rs * gg.y); o.y = pack2(v[j].z * rs * gg.z, v[j].w * rs * gg.w);
                    reinterpret_cast<uint2*>(XN + (size_t)row * D)[j * 64 + lane] = o;
                }
            }
        }
        float* tl = (float*)lds;
        tr_all(a.in[I_WIN], (bfr*)(ws + WS_WTIN), D, NIN, NINP, nullptr, tl);
        tr_all(a.in[I_WBR], (bfr*)(ws + WS_WTA), RW, D, D, nullptr, tl);
        tr_all(a.in[I_WBD], (bfr*)(ws + WS_WTB), RW, D, D, nullptr, tl);
        tr_all(a.in[I_WOUT], (bfr*)(ws + WS_WTOUT), D, D, D, nullptr, tl);
        tr_all(a.in[I_WPQ], (bfr*)(ws + WS_WTPQ), D, D, D, a.in[I_NFG], tl);
        for (int it = blockIdx.x; it < 16 * 4; it += gridDim.x) {
            const int h = it >> 2, k0 = (it & 3) * 64;
            tr_tile(a.in[I_WUV] + (size_t)h * 256 * 64, (bfr*)(ws + WS_WUVT) + (size_t)h * 64 * 256, 256, 64, k0, 0, nullptr, tl);
        }
        cvt_all(a.in[I_WUK], (bfr*)(ws + WS_WUK), (size_t)16 * 256 * 64);
        cvt_all(a.in[I_SUBK], (bfr*)(ws + WS_SUBK), (size_t)16 * 128 * 128);
    }
    SEAM(0);

    if (IN(1)) REP(1) {
        const int tid = my_tid(), wv = tid >> 6; (void)tid; (void)wv;
        EpiP E{(bfr*)(ws + WS_P)};
        const int nM = T / BM, nN = NINP / BM;
        for (int tile = blockIdx.x; tile < nM * nN; tile += gridDim.x) {
            int brow, bcol; tile_rc(tile, nM, nN, brow, bcol);
            gemm_tile((const bfr*)(ws + WS_XN), (const bfr*)(ws + WS_WTIN), D, brow, bcol, (bfr*)lds, E);
        }
        {
            const int rem = (nM * nN) % (int)gridDim.x, idle = (int)gridDim.x - rem;
            if (rem == 0) cvt_i4_rows(a.in[I_PU], ws + WS_PU, blockIdx.x, gridDim.x);
            else if ((int)blockIdx.x >= rem) cvt_i4_rows(a.in[I_PU], ws + WS_PU, (int)blockIdx.x - rem, idle);
        }
    }
    SEAM(1);

    if (IN(2)) REP(2) {
        const int tid = my_tid(), wv = tid >> 6; (void)tid; (void)wv;
        rwkv_load_weights(a, blockIdx.x & 15, lds);
        {
            const int h = blockIdx.x & 15, nun = (NUNIT - (int)blockIdx.x + (int)gridDim.x - 1) / (int)gridDim.x;
            RwIn inA, inB;
            if (nun > 0) rwkv_fetch(a, (int)blockIdx.x >> 4, h, inA);
            for (int k = 0; k < nun; k += 2) {
                const int c0 = ((int)blockIdx.x + k * (int)gridDim.x) >> 4, c1 = ((int)blockIdx.x + (k + 1) * (int)gridDim.x) >> 4, c2 = ((int)blockIdx.x + (k + 2) * (int)gridDim.x) >> 4;
                rwkv_unit(a, c0, h, lds, inA, inB, (k + 1 < nun) ? c1 : -1);
                if (k + 1 < nun) rwkv_unit(a, c1, h, lds, inB, inA, (k + 2 < nun) ? c2 : -1);
            }
        }
        dsa_cnorm(a);
        dsa_qlat(a);
    }
    SEAM(2);

    if (IN(3)) REP(3) {
        const int tid = my_tid(), wv = tid >> 6; (void)tid; (void)wv;
        if (blockIdx.x < 32) {
            if (wv == 0) rwkv_chain(a, blockIdx.x >> 1, blockIdx.x & 1);
            else cvt_fp4_rows(a.in[I_PV], ws + WS_PV, (int)blockIdx.x * 7 + (wv - 1), 32 * 7);
        }
        __syncthreads();
        for (int i = tid; i < 512; i += 512) ((float*)(lds + DSA_RELB_OFF))[i] = a.in[I_RELB][i];
        __syncthreads();
        unsigned* cnt = (unsigned*)(ws + WS_CTL + CTL_CNT) + rep_ * 64;
        for (;;) {
            if (tid == 0) MISC[0] = atomicAdd(cnt, 1u);
            __syncthreads();
            const unsigned n = MISC[0];
            __syncthreads();
            if (n >= T / 8) break;
            dsa_unit(a, (T / 8 - 1) - (int)n, lds);
        }
    }
    SEAM(3);

    if (IN(4)) REP(4) {
        const int tid = my_tid(), wv = tid >> 6; (void)tid; (void)wv;
        float* Ls = (float*)lds + wv * 4352;
        for (int u = blockIdx.x * 8 + wv; u < NUNIT; u += gridDim.x * 8) rwkv_out_unit(a, u, Ls);
        dsa_oproj(a);
    }
    SEAM(4);

    if (IN(5)) REP(5) {
        const int tid = my_tid(), wv = tid >> 6; (void)tid; (void)wv;
        const int nM = T / BM, nN = D / BM;
        for (int tile = blockIdx.x; tile < nM * nN; tile += gridDim.x) {
            int brow, bcol; tile_rc(tile, nM, nN, brow, bcol);
#pragma unroll 1
            for (int pass = 0; pass < 2; ++pass) {
                EpiMix E{(bfr*)(ws + (pass ? WS_MIX : WS_TMPA)), pass ? (const bfr*)(ws + WS_TMPA) : (const bfr*)nullptr, P + (pass ? C_GB : C_GA)};
                gemm_tile((const bfr*)(ws + (pass ? WS_DO : WS_RWO)), (const bfr*)(ws + (pass ? WS_WTB : WS_WTA)), RW, brow, bcol, (bfr*)lds, E);
                asm volatile("s_waitcnt vmcnt(0)" ::: "memory");
            }
        }
    }
    SEAM(5);

    if (IN(6)) REP(6) {
        const int tid = my_tid(), wv = tid >> 6; (void)tid; (void)wv;
        const int nM = T / BM, nN = D / BM;
        for (int tile = blockIdx.x; tile < nM * nN; tile += gridDim.x) {
            int brow, bcol; tile_rc(tile, nM, nN, brow, bcol);
            EpiH E{(bfr*)(ws + WS_HB), a.in[I_X], (float*)(ws + WS_PART), bcol >> 8};
            gemm_tile((const bfr*)(ws + WS_MIX), (const bfr*)(ws + WS_WTOUT), D, brow, bcol, (bfr*)lds, E);
        }
    }
    SEAM(6);

    if (IN(7)) REP(7) {
        const int tid = my_tid(), wv = tid >> 6; (void)tid; (void)wv;
        const int nM = T / BM, nN = D / BM;
        float* rs = (float*)(lds + 135168);
        for (int tile = blockIdx.x; tile < nM * nN; tile += gridDim.x) {
            int brow, bcol; tile_rc(tile, nM, nN, brow, bcol);
            if (tid < 256) rs[tid] = row_rstd((const float*)(ws + WS_PART), brow + tid);
            __syncthreads();
            EpiQ E{(bfr*)(ws + WS_QP), rs, brow};
            gemm_tile((const bfr*)(ws + WS_HB), (const bfr*)(ws + WS_WTPQ), D, brow, bcol, (bfr*)lds, E);
        }
    }
    SEAM(7);

    if (IN(8)) REP(8) {
        const int tid = my_tid(), wv = tid >> 6; (void)tid; (void)wv;
        for (int u = blockIdx.x; u < T / 16; u += gridDim.x) peer_unit(a, u, lds);
    }
#undef IN
#undef SEAM
}

extern "C" void kernel_launch(void* const* d_in, const int* in_sizes, int n_in, void* d_out, int out_size, void* d_ws, size_t ws_size, hipStream_t stream) {
    static int grid = 0;
    if (grid == 0) {
        if (n_in != 27 || out_size != T * D || ws_size < WS_END) { fprintf(stderr, "kernel_launch: unexpected shapes (n_in %d out %d ws %zu)\n", n_in, out_size, ws_size); grid = -1; return; }
        int dev = 0, cus = 0, per_cu = 0;
        if (hipGetDevice(&dev) != hipSuccess || hipDeviceGetAttribute(&cus, hipDeviceAttributeMultiprocessorCount, dev) != hipSuccess) { grid = -1; return; }
        if (hipFuncSetAttribute((const void*)mk_fwd, hipFuncAttributeMaxDynamicSharedMemorySize, LDS_BYTES) != hipSuccess) { fprintf(stderr, "kernel_launch: hipFuncSetAttribute failed\n"); grid = -1; return; }
        if (hipOccupancyMaxActiveBlocksPerMultiprocessor(&per_cu, (const void*)mk_fwd, 512, LDS_BYTES) != hipSuccess || per_cu < 1) { fprintf(stderr, "kernel_launch: occupancy query says %d\n", per_cu); (void)hipGetLastError(); grid = -1; return; }
        grid = cus;
    }
    if (grid < 0) return;
    if (hipMemsetAsync((char*)d_ws + WS_CTL, 0, CTL_ZERO, stream) != hipSuccess) return;
    Args a{};
    for (int i = 0; i < 27; ++i) a.in[i] = (const float*)d_in[i];
    a.out = (float*)d_out; a.ws = (unsigned char*)d_ws;
#if MK_SPLIT
    for (int ph = 0; ph < NPHASE; ++ph) { a.ph_lo = ph; a.ph_hi = ph + 1; hipLaunchKernelGGL(mk_fwd, dim3(grid), dim3(512), LDS_BYTES, stream, a); }
#elif defined(PROBE_PHASE)
    a.ph_lo = 0; a.ph_hi = PROBE_PHASE + 1;
    hipLaunchKernelGGL(mk_fwd, dim3(grid), dim3(512), LDS_BYTES, stream, a);
    (void)hipMemsetAsync((char*)d_ws + WS_CTL, 0, CTL_ZERO, stream);
    a.ph_lo = PROBE_PHASE; a.ph_hi = NPHASE;
    hipLaunchKernelGGL(mk_fwd, dim3(grid), dim3(512), LDS_BYTES, stream, a);
#else
    a.ph_lo = 0; a.ph_hi = NPHASE;
    hipLaunchKernelGGL(mk_fwd, dim3(grid), dim3(512), LDS_BYTES, stream, a);
#endif
}
```

```cpp
#include <hip/hip_runtime.h>
#include <stdint.h>
#include <stdio.h>

#ifndef MK_SPLIT
#define MK_SPLIT 0
#endif

#ifndef DBG_NOPEER
#define DBG_NOPEER 0
#endif
#ifndef DBG_NODSA
#define DBG_NODSA 0
#endif
typedef unsigned short bfr;
using bf16x8 = __attribute__((ext_vector_type(8))) short;
using bf16x4 = __attribute__((ext_vector_type(4))) short;
using f32x4  = __attribute__((ext_vector_type(4))) float;
using f32x2  = __attribute__((ext_vector_type(2))) float;
using f32x16 = __attribute__((ext_vector_type(16))) float;
using u32x4  = __attribute__((ext_vector_type(4))) unsigned;
using h16x2  = __attribute__((ext_vector_type(2))) _Float16;

constexpr int T = 8192, D = 2048, NIN = 9320, NINP = 9472;
constexpr int RW = 1024, NH = 16, HD = 64;
constexpr int C_R = 0, C_K = 1024, C_V = 2048, C_ZW = 3072, C_ZA = 3136, C_ZG = 3200, C_Q = 3360, C_CKV = 4384,
              C_IQ = 4640, C_IK = 5152, C_IW = 5216, C_GA = 5224, C_GB = 7272;
constexpr int KVR = 256, NUNIT = 128 * 16;
constexpr float EPS = 1e-6f;

constexpr size_t MiB = 1u << 20;
constexpr size_t WS_CTL = 0;
constexpr size_t CTL_ZERO = 65536;
constexpr size_t CTL_CNT = 16384;
constexpr size_t CTL_ROWSS = 32768;
constexpr size_t WS_WTA = 1 * MiB, WS_WTB = 5 * MiB, WS_WTOUT = 9 * MiB, WS_WTPQ = 17 * MiB;
constexpr size_t WS_WUK = 25 * MiB, WS_WUVT = 25 * MiB + 512 * 1024, WS_SUBK = 26 * MiB;
constexpr size_t WS_X = 27 * MiB;
constexpr size_t WS_XN = WS_X, WS_WTIN = WS_X + 32 * MiB;
constexpr size_t WS_PM = WS_X, WS_WY = WS_X + 16 * MiB, WS_GM = WS_X + 32 * MiB, WS_YLOC = WS_X + 48 * MiB;
constexpr size_t WS_MIX = WS_X;
constexpr size_t WS_P = 96 * MiB;
constexpr size_t WS_H = 96 * MiB, WS_HB = 160 * MiB, WS_QP = 192 * MiB;
constexpr size_t WS_GG = 244 * MiB, WS_BON = 260 * MiB, WS_CB = 276 * MiB;
#ifdef OLAT_SEP
constexpr size_t WS_QLAT = 280 * MiB, WS_OLAT = 456 * MiB;
#else
constexpr size_t WS_QLAT = 280 * MiB, WS_OLAT = WS_QLAT;
#endif
constexpr size_t WS_KEYS = 344 * MiB;
constexpr size_t WS_PU = 490 * MiB, WS_PV = 312 * MiB;
constexpr size_t WS_PUS = WS_PU + 32 * MiB, WS_PVS = WS_PV + 32 * MiB;
constexpr size_t WS_ZT = 408 * MiB, WS_RWO = 424 * MiB, WS_DO = 440 * MiB, WS_TMPA = 456 * MiB;
constexpr size_t WS_IKC = 489 * MiB;
constexpr size_t WS_PART = 488 * MiB;
constexpr size_t WS_END = 508 * MiB;

constexpr int LDS_BYTES = 163840 - 1024;
constexpr int LDS_BARW = LDS_BYTES - 64;
constexpr int LDS_MISC = LDS_BYTES - 512;

typedef __bf16 bf16v2_t __attribute__((ext_vector_type(2)));
__device__ __forceinline__ bfr f2bf(float f) { const __bf16 r = (__bf16)f; return __builtin_bit_cast(bfr, r); }
__device__ __forceinline__ float bf2f(bfr b) { return __uint_as_float(((unsigned)b) << 16); }
__device__ __forceinline__ unsigned pack2(float a, float b) { const f32x2 v = {a, b}; const bf16v2_t r = __builtin_convertvector(v, bf16v2_t); return __builtin_bit_cast(unsigned, r); }
__device__ __forceinline__ float bflo(unsigned u) { return __uint_as_float(u << 16); }
__device__ __forceinline__ float bfhi(unsigned u) { return __uint_as_float(u & 0xFFFF0000u); }
__device__ __forceinline__ int my_tid() { int t = threadIdx.x; asm volatile("" : "+v"(t)); return t; }

template <int CTRL> __device__ __forceinline__ float dpp_f(float v) {
    return __int_as_float(__builtin_amdgcn_update_dpp(0, __float_as_int(v), CTRL, 0xF, 0xF, true));
}
#define DPP_XOR1 0xB1
#define DPP_XOR2 0x4E
__device__ __forceinline__ float wave_sum(float v) {
    v += dpp_f<DPP_XOR1>(v); v += dpp_f<DPP_XOR2>(v); v += dpp_f<0x141>(v); v += dpp_f<0x140>(v);
    v += __shfl_xor(v, 16); v += __shfl_xor(v, 32); return v;
}
__device__ __forceinline__ float frcp_(float x) { return __builtin_amdgcn_rcpf(x); }
__device__ __forceinline__ float sigmoidf_(float x) { return frcp_(1.f + __expf(-x)); }

#define XB_TMO      128
#define XB_XCNT(j)  (256  + 64 * (j))
#define XB_XSUB(j)  (1280 + 64 * (j))
#define XB_XGEN(j)  (2304 + 64 * (j))
#define XB_TOP      3328
#define XB_TOPGEN   3392
#define XCD_BAR_WORDS 3456
#define XB_SPIN_CAP (1u << 20)
#define LAS __attribute__((address_space(3)))

__device__ __forceinline__ unsigned xb_ld(unsigned* p)              { return __hip_atomic_load(p, __ATOMIC_RELAXED, __HIP_MEMORY_SCOPE_AGENT); }
__device__ __forceinline__ unsigned xb_add(unsigned* p, unsigned v) { return __hip_atomic_fetch_add(p, v, __ATOMIC_RELAXED, __HIP_MEMORY_SCOPE_AGENT); }
__device__ __forceinline__ unsigned xb_xcc_id() { return (unsigned)__builtin_amdgcn_s_getreg((3 << 11) | 20) & 0xFu; }
#define XB_SPIN(cond, bar) do { unsigned _sp = 0; while (cond) { __builtin_amdgcn_s_sleep(1); \
    if ((++_sp & 255u) == 0u) { if (xb_ld(&(bar)[XB_TMO])) break; if (_sp > XB_SPIN_CAP) { atomicAdd(&(bar)[XB_TMO], 1u); break; } } } } while (0)

struct XcdBarrier { unsigned* bar; unsigned x; volatile LAS unsigned* st; };

__device__ __forceinline__ XcdBarrier xcd_barrier_post(unsigned* bar, volatile LAS unsigned* st) {
    XcdBarrier b; b.bar = bar; b.x = xb_xcc_id(); b.st = st;
    if (threadIdx.x == 0) (void)xb_add(&bar[XB_XCNT(b.x)], 1u);
    return b;
}
__device__ __forceinline__ void xcd_barrier_complete(unsigned* bar, unsigned x, unsigned& nloc, unsigned& nx) {
    const unsigned G = gridDim.x * gridDim.y * gridDim.z;
    unsigned sum, cnt, mine, sp = 0u;
    for (;;) {
        sum = 0u; cnt = 0u; mine = 0u;
#pragma unroll
        for (unsigned j = 0; j < 16; ++j) { const unsigned c = xb_ld(&bar[XB_XCNT(j)]); sum += c; cnt += (c > 0u) ? 1u : 0u; mine = (j == x) ? c : mine; }
        if (sum == G) break;
        __builtin_amdgcn_s_sleep(1);
        if ((++sp & 255u) == 0u) { if (xb_ld(&bar[XB_TMO])) break; if (sp > XB_SPIN_CAP) { atomicAdd(&bar[XB_TMO], 1u); break; } }
    }
    nloc = mine > 0u ? mine : 1u; nx = cnt > 0u ? cnt : 1u;
}
__device__ __forceinline__ void xcd_barrier(const XcdBarrier& b) {
    asm volatile("s_waitcnt vmcnt(0)" ::: "memory");
    __syncthreads();
    if (threadIdx.x == 0) {
        unsigned* bar = b.bar;
        __builtin_amdgcn_s_waitcnt(0);
        unsigned nloc = b.st[0], nx = b.st[1];
        if (nloc == 0u) { xcd_barrier_complete(bar, b.x, nloc, nx); b.st[0] = nloc; b.st[1] = nx; }
        const unsigned old = xb_add(&bar[XB_XSUB(b.x)], 1u);
        const unsigned gen = old / nloc;
        if (old + 1u == (gen + 1u) * nloc) {
            __builtin_amdgcn_fence(__ATOMIC_RELEASE, "agent");
            asm volatile("s_waitcnt vmcnt(0)" ::: "memory");
            const unsigned og = xb_add(&bar[XB_TOP], 1u);
            const unsigned tg = og / nx;
            if (og + 1u == (tg + 1u) * nx) xb_add(&bar[XB_TOPGEN], 1u);
            else XB_SPIN(xb_ld(&bar[XB_TOPGEN]) == tg, bar);
            __builtin_amdgcn_fence(__ATOMIC_ACQUIRE, "agent");
            xb_add(&bar[XB_XGEN(b.x)], 1u);
            asm volatile("s_waitcnt vmcnt(0)" ::: "memory");
        } else {
            XB_SPIN(xb_ld(&bar[XB_XGEN(b.x)]) == gen, bar);
            __builtin_amdgcn_fence(__ATOMIC_ACQUIRE, "agent");
            asm volatile("s_waitcnt vmcnt(0)" ::: "memory");
        }
    }
    __syncthreads();
}

struct Args { const float* in[27]; float* out; unsigned char* ws; int ph_lo, ph_hi; };
enum { I_X = 0, I_NMG, I_WIN, I_SHIFT, I_W0, I_WDEC, I_A0, I_WICL, I_WGATE, I_KK, I_KA, I_RK, I_LNW, I_LNB, I_KVG, I_WUK, I_WUV,
       I_RELB, I_WBR, I_WBD, I_WOUT, I_NFG, I_WPQ, I_SUBK, I_PU, I_PV, I_NFIN };

constexpr int BM = 256, BK = 64, HALF = 128, HT = HALF * BK;
constexpr int EPI_LDW = 260;
__device__ __forceinline__ int lds_byte(int r, int c) {
    int st = (r >> 4) * 2 + (c >> 5), rr = r & 15, cc = c & 31, ob = rr * 64 + cc * 2;
    return st * 1024 + (ob ^ (((ob >> 9) & 1) << 5));
}
__device__ __forceinline__ void stage_rc(int b, int& R, int& C) {
    int st = b / 1024, sb = b % 1024, swz = sb ^ (((sb >> 9) & 1) << 5);
    R = (st >> 1) * 16 + swz / 64; C = (st & 1) * 32 + (swz % 64) / 2;
}

template <class Epi>
__device__ __forceinline__ void gemm_tile(const bfr* __restrict__ A, const bfr* __restrict__ Bt, const int K, const int brow, const int bcol,
                                          bfr* shm, Epi& epi) {
#define SA(b,h) (shm+((b)*2+(h))*HT)
#define SB(b,h) (shm+(4+(b)*2+(h))*HT)
#define STAGE_X(TT,P,BASE,br,kt) do{long _g=(long)(br)*K+(long)(kt)*BK; \
    for(int _i=0;_i<2;++_i){int _b=(TT)*16+_i*8192;int _r,_c;stage_rc(_b,_r,_c); \
      __builtin_amdgcn_global_load_lds((const unsigned*)(BASE+_g+(long)_r*K+_c), \
        (LAS unsigned*)((LAS char*)(P)+_b),16,0,0);}}while(0)
#define STAGE(P,BASE,br,kt) STAGE_X(tq,P,BASE,br,kt)
#define LDA(dst,b,h) for(int m=0;m<4;++m)for(int k=0;k<2;++k) \
    dst[m][k]=*reinterpret_cast<const bf16x8*>((char*)SA(b,h)+lds_byte(wr*64+m*16+fr,k*32+fq*8))
#define LDB(dst,b,h) for(int n=0;n<2;++n)for(int k=0;k<2;++k) \
    dst[n][k]=*reinterpret_cast<const bf16x8*>((char*)SB(b,h)+lds_byte(wc*32+n*16+fr,k*32+fq*8))
#define MMA(ai,bj,At_,Bt_) do{__builtin_amdgcn_s_setprio(1); \
    for(int m=0;m<4;++m)for(int n=0;n<2;++n)for(int k=0;k<2;++k) \
      acc[ai][bj][m][n]=__builtin_amdgcn_mfma_f32_16x16x32_bf16(At_[m][k],Bt_[n][k],acc[ai][bj][m][n],0,0,0); \
    __builtin_amdgcn_s_setprio(0);}while(0)
#define WAIT_V(n) asm volatile("s_waitcnt vmcnt(" #n ")":::"memory")
#define WAIT_L(n) asm volatile("s_waitcnt lgkmcnt(" #n ")":::"memory")
#define BAR __builtin_amdgcn_s_barrier()
#define SCHED __builtin_amdgcn_sched_barrier(0)
    const int tq = my_tid();
    int wid = tq >> 6, lane = tq & 63, wr = wid >> 2, wc = wid & 3, fr = lane & 15, fq = lane >> 4;
    f32x4 acc[2][2][4][2] = {};
    bf16x8 At[4][2], B0[2][2], B1[2][2];
    const int nt = K / BK;
    STAGE(SB(0,0),Bt,bcol,0); STAGE(SA(0,0),A,brow,0);
    STAGE(SB(0,1),Bt,bcol+HALF,0); STAGE(SA(0,1),A,brow+HALF,0);
    if(wr==1)BAR;
    WAIT_V(4); BAR;
    STAGE(SB(1,0),Bt,bcol,1); STAGE(SA(1,0),A,brow,1); STAGE(SB(1,1),Bt,bcol+HALF,1);
    WAIT_V(6); BAR;
    for(int t=0;t<nt-2;t+=2){
        LDB(B0,0,0); SCHED; LDA(At,0,0); STAGE(SA(1,1),A,brow+HALF,t+1);
        WAIT_L(8); BAR; WAIT_L(0); MMA(0,0,At,B0); BAR; SCHED;
        LDB(B1,0,1); STAGE(SB(0,0),Bt,bcol,t+2);
        BAR; WAIT_L(0); MMA(0,1,At,B1); BAR;
        LDA(At,0,1); STAGE(SA(0,0),A,brow,t+2);
        BAR; WAIT_L(0); MMA(1,0,At,B0); BAR; SCHED;
        STAGE(SB(0,1),Bt,bcol+HALF,t+2);
        WAIT_V(6); BAR; MMA(1,1,At,B1); BAR;
        LDB(B0,1,0); SCHED; LDA(At,1,0); STAGE(SA(0,1),A,brow+HALF,t+2);
        WAIT_L(8); BAR; WAIT_L(0); MMA(0,0,At,B0); BAR; SCHED;
        LDB(B1,1,1); STAGE(SB(1,0),Bt,bcol,t+3);
        BAR; WAIT_L(0); MMA(0,1,At,B1); BAR;
        LDA(At,1,1); STAGE(SA(1,0),A,brow,t+3);
        BAR; WAIT_L(0); MMA(1,0,At,B0); BAR; SCHED;
        STAGE(SB(1,1),Bt,bcol+HALF,t+3);
        WAIT_V(6); BAR; MMA(1,1,At,B1); BAR;
    }
    int tz=threadIdx.x; asm volatile("":"+v"(tz)); wid=tz>>6; lane=tz&63; wr=wid>>2; wc=wid&3; fr=lane&15; fq=lane>>4;
    { LDB(B0,0,0); WAIT_V(0); LDA(At,0,0); STAGE_X(tz,SA(1,1),A,brow+HALF,nt-1);
      BAR; WAIT_L(0); MMA(0,0,At,B0); BAR;
      LDB(B1,0,1); BAR; WAIT_L(0); MMA(0,1,At,B1); BAR;
      LDA(At,0,1); WAIT_V(4); BAR; WAIT_L(0); MMA(1,0,At,B0); MMA(1,1,At,B1); BAR; }
    { LDB(B0,1,0); LDA(At,1,0); WAIT_V(2); BAR; WAIT_L(0); MMA(0,0,At,B0); BAR;
      LDB(B1,1,1); WAIT_V(0); BAR; WAIT_L(0); MMA(0,1,At,B1); BAR;
      LDA(At,1,1); BAR; WAIT_L(0); MMA(1,0,At,B0); MMA(1,1,At,B1); BAR; }
    if(wr==0)BAR;
    {
        float* stg = (float*)shm;
#pragma unroll
        for (int ai = 0; ai < 2; ++ai) {
            __syncthreads();
#pragma unroll
            for (int bj = 0; bj < 2; ++bj)
#pragma unroll
                for (int m = 0; m < 4; ++m)
#pragma unroll
                    for (int n = 0; n < 2; ++n)
#pragma unroll
                        for (int j = 0; j < 4; ++j) stg[(wr * 64 + m * 16 + fq * 4 + j) * EPI_LDW + bj * HALF + wc * 32 + n * 16 + fr] = acc[ai][bj][m][n][j];
            __syncthreads();
#pragma unroll 2
            for (int it = 0; it < 8; ++it) {
                const int r = it * 16 + wid * 2 + (lane >> 5), c = (lane & 31) * 8;
                const float4 v0 = *reinterpret_cast<const float4*>(&stg[r * EPI_LDW + c]);
                const float4 v1 = *reinterpret_cast<const float4*>(&stg[r * EPI_LDW + c + 4]);
                const float v[8] = {v0.x, v0.y, v0.z, v0.w, v1.x, v1.y, v1.z, v1.w};
                epi.vec8(brow + ai * HALF + r, bcol + c, v);
            }
        }
    }
    __syncthreads();
#undef SA
#undef SB
#undef STAGE_X
#undef STAGE
#undef LDA
#undef LDB
#undef MMA
}

__device__ __forceinline__ void tile_rc(int wgid, const int nM, const int nN, int& brow, int& bcol) {
    const int nwg = nM * nN;
    { int q = nwg / 8, r = nwg % 8, xcd = wgid % 8, off = wgid / 8; wgid = (xcd < r ? xcd * (q + 1) : r * (q + 1) + (xcd - r) * q) + off; }
    const int nig = 8 * nN, gid = wgid / nig, fm = gid * 8, gsz = min(nM - fm, 8);
    const int pm = fm + ((wgid % nig) % gsz), pn = (wgid % nig) / gsz;
    brow = pm * BM; bcol = pn * BM;
}

__device__ __forceinline__ uint4 pack8(const float* v) { uint4 o; o.x = pack2(v[0], v[1]); o.y = pack2(v[2], v[3]); o.z = pack2(v[4], v[5]); o.w = pack2(v[6], v[7]); return o; }
__device__ __forceinline__ void unpack8(const uint4 u, float* v) { v[0] = bflo(u.x); v[1] = bfhi(u.x); v[2] = bflo(u.y); v[3] = bfhi(u.y); v[4] = bflo(u.z); v[5] = bfhi(u.z); v[6] = bflo(u.w); v[7] = bfhi(u.w); }
struct EpiP {
    bfr* P;
    __device__ __forceinline__ void vec8(int row, int col, const float* v) { *reinterpret_cast<uint4*>(&P[(size_t)row * NINP + col]) = pack8(v); }
};
struct EpiMix {
    bfr* outp; const bfr* addp; const bfr* gate;
    __device__ __forceinline__ void vec8(int row, int col, const float* v) {
        float g[8], r[8];
        unpack8(*reinterpret_cast<const uint4*>(&gate[(size_t)row * NINP + col]), g);
#pragma unroll
        for (int i = 0; i < 8; ++i) r[i] = sigmoidf_(g[i]) * v[i];
        if (addp) { float t[8]; unpack8(*reinterpret_cast<const uint4*>(&addp[(size_t)row * D + col]), t);
#pragma unroll
            for (int i = 0; i < 8; ++i) r[i] += t[i]; }
        *reinterpret_cast<uint4*>(&outp[(size_t)row * D + col]) = pack8(r);
    }
};
struct EpiH {
    bfr* hb; const float* x; float* part; int slot;
    __device__ __forceinline__ void vec8(int row, int col, const float* v) {
        const float4 x0 = *reinterpret_cast<const float4*>(&x[(size_t)row * D + col]), x1 = *reinterpret_cast<const float4*>(&x[(size_t)row * D + col + 4]);
        float h[8] = {x0.x + v[0], x0.y + v[1], x0.z + v[2], x0.w + v[3], x1.x + v[4], x1.y + v[5], x1.z + v[6], x1.w + v[7]};
        *reinterpret_cast<uint4*>(&hb[(size_t)row * D + col]) = pack8(h);
        float s = 0.f;
#pragma unroll
        for (int i = 0; i < 8; ++i) s += h[i] * h[i];
        s += dpp_f<DPP_XOR1>(s); s += dpp_f<DPP_XOR2>(s); s += dpp_f<0x141>(s); s += dpp_f<0x140>(s);
        s += __shfl_xor(s, 16);
        if ((threadIdx.x & 31) == 0) part[(size_t)row * 8 + slot] = s;
    }
};
struct EpiQ {
    bfr* qp; const float* rs; int brow;
    __device__ __forceinline__ void vec8(int row, int col, const float* v) {
        const float sc = rs[row - brow]; float r[8];
#pragma unroll
        for (int i = 0; i < 8; ++i) r[i] = v[i] * sc;
        *reinterpret_cast<uint4*>(&qp[(size_t)row * D + col]) = pack8(r);
    }
};
__device__ __forceinline__ float row_rstd(const float* part, int row) {
    float s = 0.f;
#pragma unroll
    for (int i = 0; i < 8; ++i) s += part[(size_t)row * 8 + i];
    return rsqrtf(s * (1.f / D) + EPS);
}

__device__ __forceinline__ void tr_tile(const float* __restrict__ src, bfr* __restrict__ dst, int K, int N, int k0, int n0, const float* kscale, float* lds) {
    const int tid = my_tid(), n = tid & 63, kk = tid >> 6;
#pragma unroll
    for (int j = 0; j < 8; ++j) { int k = kk + 8 * j, gn = n0 + n; float v = (gn < N) ? src[(size_t)(k0 + k) * N + gn] : 0.f; if (kscale) v *= kscale[k0 + k]; lds[k * 65 + n] = v; }
    __syncthreads();
    const int nn = tid >> 3, ks = tid & 7;
    uint4 o;
    o.x = pack2(lds[(ks * 8 + 0) * 65 + nn], lds[(ks * 8 + 1) * 65 + nn]); o.y = pack2(lds[(ks * 8 + 2) * 65 + nn], lds[(ks * 8 + 3) * 65 + nn]);
    o.z = pack2(lds[(ks * 8 + 4) * 65 + nn], lds[(ks * 8 + 5) * 65 + nn]); o.w = pack2(lds[(ks * 8 + 6) * 65 + nn], lds[(ks * 8 + 7) * 65 + nn]);
    *reinterpret_cast<uint4*>(&dst[(size_t)(n0 + nn) * K + k0 + ks * 8]) = o;
    __syncthreads();
}
struct StripRegs { float v[8][4]; };
__device__ __forceinline__ void strip_load(const float* __restrict__ src, int N, int k0, int n0, StripRegs& R) {
    const int tid = my_tid(), n = tid & 63, kk = tid >> 6;
#pragma unroll
    for (int j = 0; j < 8; ++j)
#pragma unroll
        for (int q = 0; q < 4; ++q) { const int gn = n0 + q * 64 + n; R.v[j][q] = (gn < N) ? src[(size_t)(k0 + kk + 8 * j) * N + gn] : 0.f; }
}
__device__ __forceinline__ void strip_store(const StripRegs& R, bfr* __restrict__ dst, int K, int k0, int n0, const float* kscale, float* lds) {
    const int tid = my_tid(), n = tid & 63, kk = tid >> 6;
#pragma unroll
    for (int j = 0; j < 8; ++j) {
        const float sc = kscale ? kscale[k0 + kk + 8 * j] : 1.f;
#pragma unroll
        for (int q = 0; q < 4; ++q) lds[(kk + 8 * j) * 257 + q * 64 + n] = R.v[j][q] * sc;
    }
    __syncthreads();
    const int nn = tid >> 1, hf = tid & 1;
#pragma unroll
    for (int c = 0; c < 4; ++c) {
        const int kb = hf * 32 + c * 8;
        uint4 o;
        o.x = pack2(lds[(kb + 0) * 257 + nn], lds[(kb + 1) * 257 + nn]); o.y = pack2(lds[(kb + 2) * 257 + nn], lds[(kb + 3) * 257 + nn]);
        o.z = pack2(lds[(kb + 4) * 257 + nn], lds[(kb + 5) * 257 + nn]); o.w = pack2(lds[(kb + 6) * 257 + nn], lds[(kb + 7) * 257 + nn]);
        *reinterpret_cast<uint4*>(&dst[(size_t)(n0 + nn) * K + k0 + kb]) = o;
    }
    __syncthreads();
}
__device__ __forceinline__ void tr_all(const float* src, bfr* dst, int K, int N, int Npad, const float* kscale, float* lds) {
    if ((Npad & 255) == 0) {
        const int nk = K / 64, ns = Npad / 256, tot = nk * ns;
        StripRegs RA, RB;
        int it = blockIdx.x;
        if (it < tot) strip_load(src, N, (it % nk) * 64, (it / nk) * 256, RA);
        while (it < tot) {
            const int itn = it + gridDim.x, it2 = itn + gridDim.x;
            if (itn < tot) strip_load(src, N, (itn % nk) * 64, (itn / nk) * 256, RB);
            strip_store(RA, dst, K, (it % nk) * 64, (it / nk) * 256, kscale, lds);
            if (itn >= tot) break;
            if (it2 < tot) strip_load(src, N, (it2 % nk) * 64, (it2 / nk) * 256, RA);
            strip_store(RB, dst, K, (itn % nk) * 64, (itn / nk) * 256, kscale, lds);
            it = it2;
        }
        return;
    }
    const int nk = K / 64, nn = Npad / 64;
    for (int it = blockIdx.x; it < nk * nn; it += gridDim.x) tr_tile(src, dst, K, N, (it % nk) * 64, (it / nk) * 64, kscale, lds);
}
__device__ __forceinline__ void cvt_all(const float* __restrict__ src, bfr* __restrict__ dst, size_t n) {
    const size_t n4 = n / 4;
    for (size_t i = (size_t)blockIdx.x * 512 + my_tid(); i < n4; i += (size_t)gridDim.x * 512) {
        float4 v = reinterpret_cast<const float4*>(src)[i];
        uint2 o; o.x = pack2(v.x, v.y); o.y = pack2(v.z, v.w);
        reinterpret_cast<uint2*>(dst)[i] = o;
    }
}

constexpr int PEER_ROWB = 1152;
__device__ __forceinline__ void cvt_fp4_rows(const float* __restrict__ src, unsigned char* __restrict__ dst, const int wrank, const int nwaves) {
    const int tid = my_tid(), lane = tid & 63;
    for (int row = wrank; row < 16384; row += nwaves) {
        float v[32]; float amax = 0.f;
#pragma unroll
        for (int q = 0; q < 8; ++q) {
            const f32x4 xx = __builtin_nontemporal_load(reinterpret_cast<const f32x4*>(&src[(size_t)row * D + q * 256 + lane * 4])); float4 x; x.x = xx[0]; x.y = xx[1]; x.z = xx[2]; x.w = xx[3];
            v[q * 4] = x.x; v[q * 4 + 1] = x.y; v[q * 4 + 2] = x.z; v[q * 4 + 3] = x.w;
            amax = fmaxf(amax, fmaxf(fmaxf(fabsf(x.x), fabsf(x.y)), fmaxf(fabsf(x.z), fabsf(x.w))));
        }
        const bfr sb = f2bf(amax * (1.f / 6.f));
        const float sc = bf2f(sb), inv = sc > 0.f ? frcp_(sc) : 0.f;
        unsigned dw[4];
#pragma unroll
        for (int d = 0; d < 4; ++d) {
            unsigned p = 0;
            p = __builtin_amdgcn_cvt_scalef32_pk_fp4_f32(p, v[d * 8 + 0] * inv, v[d * 8 + 1] * inv, 1.0f, 0);
            p = __builtin_amdgcn_cvt_scalef32_pk_fp4_f32(p, v[d * 8 + 2] * inv, v[d * 8 + 3] * inv, 1.0f, 1);
            p = __builtin_amdgcn_cvt_scalef32_pk_fp4_f32(p, v[d * 8 + 4] * inv, v[d * 8 + 5] * inv, 1.0f, 2);
            p = __builtin_amdgcn_cvt_scalef32_pk_fp4_f32(p, v[d * 8 + 6] * inv, v[d * 8 + 7] * inv, 1.0f, 3);
            dw[d] = p;
        }
        uint4 o4; o4.x = dw[0]; o4.y = dw[1]; o4.z = dw[2]; o4.w = dw[3];
        *reinterpret_cast<uint4*>(dst + (size_t)row * PEER_ROWB + lane * 16) = o4;
        *reinterpret_cast<bfr*>(dst + (size_t)row * PEER_ROWB + 1024 + lane * 2) = sb;
    }
}

__device__ __forceinline__ unsigned pack8_i4(const float* v) {
    unsigned d = 0;
#pragma unroll
    for (int i = 0; i < 8; ++i) d |= ((unsigned)((int)v[i]) & 0xFu) << (4 * i);
    return d;
}
__device__ __forceinline__ void cvt_i4_rows(const float* __restrict__ src, unsigned char* __restrict__ dst, const int rank, const int nranks) {
    const int tid = my_tid(), lane = tid & 63, wv = tid >> 6;
    for (int row = rank * 8 + wv; row < 16384; row += nranks * 8) {
        float v[32]; float amax = 0.f;
#pragma unroll
        for (int q = 0; q < 8; ++q) {
            const float4 x = *reinterpret_cast<const float4*>(&src[(size_t)row * D + q * 256 + lane * 4]);
            v[q * 4] = x.x; v[q * 4 + 1] = x.y; v[q * 4 + 2] = x.z; v[q * 4 + 3] = x.w;
            amax = fmaxf(amax, fmaxf(fmaxf(fabsf(x.x), fabsf(x.y)), fmaxf(fabsf(x.z), fabsf(x.w))));
        }
        const bfr sb = f2bf(amax * (1.f / 7.f));
        const float sc = bf2f(sb), inv = sc > 0.f ? frcp_(sc) : 0.f;
#pragma unroll
        for (int i = 0; i < 32; ++i) v[i] = fminf(fmaxf(__builtin_rintf(v[i] * inv), -7.f), 7.f);
        uint4 o4; o4.x = pack8_i4(v); o4.y = pack8_i4(v + 8); o4.z = pack8_i4(v + 16); o4.w = pack8_i4(v + 24);
        *reinterpret_cast<uint4*>(dst + (size_t)row * PEER_ROWB + lane * 16) = o4;
        *reinterpret_cast<bfr*>(dst + (size_t)row * PEER_ROWB + 1024 + lane * 2) = sb;
    }
}
__device__ __forceinline__ int pm_index(int kp, int k) {
    const int kpt = kp >> 5, r = kp & 31, kt = k >> 5, kk = k & 31, s = kk >> 4, rem = kk & 15;
    const int j = ((rem >> 3) << 2) | (rem & 3), hf = (rem >> 2) & 1, lane = hf * 32 + r;
    return ((((kpt * 2 + kt) * 2 + s) * 64 + lane) * 8) + j;
}
__device__ __forceinline__ int acc_index(int row, int col) {
    const int rt = row >> 5, r = row & 31, ct = col >> 5, c = col & 31;
    const int g4 = r >> 3, comp = r & 3, hf = (r >> 2) & 1, lane = hf * 32 + c;
    return ((((rt * 2 + ct) * 4 + g4) * 64 + lane) * 4) + comp;
}

constexpr int RW_ACT_STRIDE = 296, RW_LD = 72, RW_SLOT = 9216, RW_WL_OFF = 110592, RW_TOT_OFF = 148480, RW_BASE_OFF = 152576, RW_PART_OFF = 156928;
__device__ __forceinline__ f32x16 tile_mm_acc(f32x16 acc, const bfr* A, const int arow0, const bfr* Bt, const int brow0, const int r, const int hf) {
#pragma unroll
    for (int ks = 0; ks < 4; ++ks)
        acc = __builtin_amdgcn_mfma_f32_32x32x16_bf16(*reinterpret_cast<const bf16x8*>(&A[(arow0 + r) * RW_LD + ks * 16 + hf * 8]),
                                                     *reinterpret_cast<const bf16x8*>(&Bt[(brow0 + r) * RW_LD + ks * 16 + hf * 8]), acc, 0, 0, 0);
    return acc;
}
__device__ __forceinline__ f32x16 tile_mm(const bfr* A, const int arow0, const bfr* Bt, const int brow0, const int r, const int hf) {
    f32x16 z;
#pragma unroll
    for (int g = 0; g < 16; ++g) z[g] = 0.f;
    return tile_mm_acc(z, A, arow0, Bt, brow0, r, hf);
}
__device__ __forceinline__ void store_t(bfr* dst, const int col0, const int row0, const f32x16 acc, const int r, const int hf) {
#pragma unroll
    for (int g4 = 0; g4 < 4; ++g4) { uint2 p; p.x = pack2(acc[g4 * 4], acc[g4 * 4 + 1]); p.y = pack2(acc[g4 * 4 + 2], acc[g4 * 4 + 3]);
        *reinterpret_cast<uint2*>(&dst[(col0 + r) * RW_LD + row0 + g4 * 8 + hf * 4]) = p; }
}
#define DPP_HMIRROR 0x141
#define DPP_MIRROR  0x140

__device__ __forceinline__ void rwkv_load_weights(const Args& a, const int h, unsigned char* lds) {
    bfr* WL = (bfr*)(lds + RW_WL_OFF);
    const int tid = my_tid();
    for (int idx = tid; idx < 288 * 64; idx += 512) {
        const int m = idx >> 6, d = idx & 63;
        const float v = (m < 64) ? a.in[I_WDEC][(size_t)m * RW + h * 64 + d] : (m < 128) ? a.in[I_WICL][(size_t)(m - 64) * RW + h * 64 + d] : a.in[I_WGATE][(size_t)(m - 128) * RW + h * 64 + d];
        WL[d * RW_ACT_STRIDE + m] = f2bf(v);
    }
    __syncthreads();
}

struct RwIn { unsigned cu[18], pu[18]; bfr r[2][5], k[2][5], v[2][5]; };
__device__ __forceinline__ void rwkv_fetch(const Args& a, const int c, const int h, RwIn& in) {
    const bfr* __restrict__ P = (const bfr*)(a.ws + WS_P);
    const int tid = my_tid(), lane = tid & 63, wv = tid >> 6, fr = lane & 15, fq = lane >> 4, t0 = c * 64;
    {
        const int i = tid >> 3, part = tid & 7, t = t0 + i;
        const bfr* pc = P + (size_t)t * NINP + C_ZW + part * 36;
        const bfr* pp = pc - NINP;
#pragma unroll
        for (int q = 0; q < 18; ++q) { in.cu[q] = *reinterpret_cast<const unsigned*>(pc + q * 2); in.pu[q] = (t > 0) ? *reinterpret_cast<const unsigned*>(pp + q * 2) : 0u; }
    }
    const int tt = wv >> 1, dh = wv & 1;
#pragma unroll
    for (int dt = 0; dt < 2; ++dt) {
        const int hd = h * 64 + dh * 32 + dt * 16 + fr;
        const int tp = t0 + tt * 16 + fq * 4 - 1;
        const bool hp = tp >= 0;
        in.r[dt][0] = hp ? P[(size_t)(hp ? tp : 0) * NINP + C_R + hd] : (bfr)0; in.k[dt][0] = hp ? P[(size_t)(hp ? tp : 0) * NINP + C_K + hd] : (bfr)0; in.v[dt][0] = hp ? P[(size_t)(hp ? tp : 0) * NINP + C_V + hd] : (bfr)0;
#pragma unroll
        for (int j = 0; j < 4; ++j) { const size_t ro = (size_t)(tp + 1 + j) * NINP; in.r[dt][j + 1] = P[ro + C_R + hd]; in.k[dt][j + 1] = P[ro + C_K + hd]; in.v[dt][j + 1] = P[ro + C_V + hd]; }
    }
}

__device__ __forceinline__ void rwkv_unit(const Args& a, const int c, const int h, unsigned char* lds, const RwIn& in, RwIn& nxt, const int cnext) {
    const float* __restrict__ smix = a.in[I_SHIFT];
    const int tid = my_tid(), lane = tid & 63, wv = tid >> 6, fr = lane & 15, fq = lane >> 4, t0 = c * 64, u = c * 16 + h;
#define SLOT(k) ((bfr*)(lds + (k) * RW_SLOT))
    bfr* ACT = (bfr*)lds; const bfr* WL = (const bfr*)(lds + RW_WL_OFF);
    float* TOT = (float*)(lds + RW_TOT_OFF); float* BASE = (float*)(lds + RW_BASE_OFF); float* PART = (float*)(lds + RW_PART_OFF);
    {
        const int i = tid >> 3, part = tid & 7;
#pragma unroll
        for (int q = 0; q < 18; ++q) {
            const int cc = part * 36 + q * 2;
            const unsigned cu = in.cu[q], pu = in.pu[q];
            const float2 mx = *reinterpret_cast<const float2*>(&smix[C_ZW + cc]);
            const float c0 = bflo(cu), c1 = bfhi(cu);
            float z0 = c0 + (bflo(pu) - c0) * mx.x, z1 = c1 + (bfhi(pu) - c1) * mx.y;
            if (cc < 64) { z0 = 1.f - 2.f * frcp_(1.f + __expf(2.f * z0)); z1 = 1.f - 2.f * frcp_(1.f + __expf(2.f * z1)); }
            else if (cc >= 128) { z0 = sigmoidf_(z0); z1 = sigmoidf_(z1); }
            *reinterpret_cast<unsigned*>(&ACT[i * RW_ACT_STRIDE + cc]) = pack2(z0, z1);
        }
    }
    const int tt = wv >> 1, dh = wv & 1;
    float zr[2][4], zk[2][4], zv[2][4];
#pragma unroll
    for (int dt = 0; dt < 2; ++dt) {
        const int hd = h * 64 + dh * 32 + dt * 16 + fr;
        const float mr = smix[C_R + hd], mk = smix[C_K + hd], mv = smix[C_V + hd];
        float pr = bf2f(in.r[dt][0]), pk = bf2f(in.k[dt][0]), pv = bf2f(in.v[dt][0]);
#pragma unroll
        for (int j = 0; j < 4; ++j) {
            const float cr = bf2f(in.r[dt][j + 1]), ck = bf2f(in.k[dt][j + 1]), cv = bf2f(in.v[dt][j + 1]);
            zr[dt][j] = cr + (pr - cr) * mr; zk[dt][j] = ck + (pk - ck) * mk; zv[dt][j] = cv + (pv - cv) * mv;
            pr = cr; pk = ck; pv = cv;
        }
    }
    __syncthreads();
    f32x4 xw[2], xa[2], xg[2];
#pragma unroll
    for (int dt = 0; dt < 2; ++dt) {
        xw[dt] = f32x4{0.f, 0.f, 0.f, 0.f}; xa[dt] = xw[dt]; xg[dt] = xw[dt];
        const bfr* arow = ACT + (tt * 16 + fr) * RW_ACT_STRIDE + fq * 8;
        const bfr* brow = WL + (dh * 32 + dt * 16 + fr) * RW_ACT_STRIDE + fq * 8;
#pragma unroll
        for (int ks = 0; ks < 2; ++ks) {
            xw[dt] = __builtin_amdgcn_mfma_f32_16x16x32_bf16(*reinterpret_cast<const bf16x8*>(arow + ks * 32), *reinterpret_cast<const bf16x8*>(brow + ks * 32), xw[dt], 0, 0, 0);
            xa[dt] = __builtin_amdgcn_mfma_f32_16x16x32_bf16(*reinterpret_cast<const bf16x8*>(arow + 64 + ks * 32), *reinterpret_cast<const bf16x8*>(brow + 64 + ks * 32), xa[dt], 0, 0, 0);
        }
#pragma unroll
        for (int ks = 0; ks < 5; ++ks)
            xg[dt] = __builtin_amdgcn_mfma_f32_16x16x32_bf16(*reinterpret_cast<const bf16x8*>(arow + 128 + ks * 32), *reinterpret_cast<const bf16x8*>(brow + 128 + ks * 32), xg[dt], 0, 0, 0);
    }
    float lw[2][4], av[2][4], kkr[2][4], k4[2][4], n2[4], cf[4];
#pragma unroll
    for (int j = 0; j < 4; ++j) { n2[j] = 0.f; cf[j] = 0.f; }
#pragma unroll
    for (int dt = 0; dt < 2; ++dt) {
        const int hd = h * 64 + dh * 32 + dt * 16 + fr;
        const float w0 = a.in[I_W0][hd], a0 = a.in[I_A0][hd], kkm = a.in[I_KK][hd], kam = a.in[I_KA][hd], rkm = a.in[I_RK][hd];
        float run = 0.f;
#pragma unroll
        for (int j = 0; j < 4; ++j) {
            run += -0.6065306597126334f * sigmoidf_(w0 + xw[dt][j]);
            lw[dt][j] = run;
            av[dt][j] = sigmoidf_(a0 + xa[dt][j]);
            kkr[dt][j] = zk[dt][j] * kkm;
            k4[dt][j] = zk[dt][j] * (1.f + (av[dt][j] - 1.f) * kam);
            n2[j] += kkr[dt][j] * kkr[dt][j];
            cf[j] += zr[dt][j] * k4[dt][j] * rkm;
        }
        TOT[(tt * 4 + fq) * 64 + dh * 32 + dt * 16 + fr] = run;
    }
#pragma unroll
    for (int j = 0; j < 4; ++j) {
        n2[j] += dpp_f<DPP_XOR1>(n2[j]); n2[j] += dpp_f<DPP_XOR2>(n2[j]); n2[j] += dpp_f<DPP_HMIRROR>(n2[j]); n2[j] += dpp_f<DPP_MIRROR>(n2[j]);
        cf[j] += dpp_f<DPP_XOR1>(cf[j]); cf[j] += dpp_f<DPP_XOR2>(cf[j]); cf[j] += dpp_f<DPP_HMIRROR>(cf[j]); cf[j] += dpp_f<DPP_MIRROR>(cf[j]);
        if (fr == 0) { PART[(wv * 16 + fq * 4 + j) * 2] = n2[j]; PART[(wv * 16 + fq * 4 + j) * 2 + 1] = cf[j]; }
    }
    __syncthreads();
    if (tid < 64) {
        float run = 0.f;
#pragma unroll
        for (int g = 0; g < 16; ++g) { const float tv = TOT[g * 64 + tid]; BASE[g * 64 + tid] = run; run += tv; }
        BASE[16 * 64 + tid] = run;
    }
    __syncthreads();
    {
        bfr* Gg = (bfr*)(a.ws + WS_GG); bfr* Bon = (bfr*)(a.ws + WS_BON);
        const int i0 = tt * 16 + fq * 4;
        float rn[4], cft[4];
#pragma unroll
        for (int j = 0; j < 4; ++j) {
            const float n2t = n2[j] + PART[((wv ^ 1) * 16 + fq * 4 + j) * 2]; cft[j] = cf[j] + PART[((wv ^ 1) * 16 + fq * 4 + j) * 2 + 1];
            rn[j] = __builtin_amdgcn_rsqf(fmaxf(n2t, 1e-24f));
        }
#pragma unroll
        for (int dt = 0; dt < 2; ++dt) {
            const int d = dh * 32 + dt * 16 + fr;
            const float base = BASE[(tt * 4 + fq) * 64 + d], clT = BASE[16 * 64 + d];
            float vAt[4], vBh[4], vKh[4];
#pragma unroll
            for (int j = 0; j < 4; ++j) {
                const float cl = base + lw[dt][j], clm1 = (j == 0) ? base : base + lw[dt][j - 1];
                const float gi = __expf(cl), gm1 = __expf(clm1), ig = __expf(-cl), gce = __expf(clT - cl);
                const float kk = kkr[dt][j] * rn[j], beta = kk * av[dt][j];
                vAt[j] = -kk * gm1; vBh[j] = beta * gce; vKh[j] = k4[dt][j] * gce;
                SLOT(0)[(i0 + j) * RW_LD + d] = f2bf(vAt[j]);
                SLOT(1)[(i0 + j) * RW_LD + d] = f2bf(beta * ig);
                SLOT(2)[(i0 + j) * RW_LD + d] = f2bf(k4[dt][j] * ig);
                SLOT(3)[(i0 + j) * RW_LD + d] = f2bf(zr[dt][j] * gi);
                const size_t o = (size_t)(t0 + i0 + j) * RW + h * 64 + d;
                Gg[o] = f2bf(xg[dt][j]); Bon[o] = f2bf(cft[j] * zv[dt][j]);
            }
            uint2 p;
            p.x = pack2(vAt[0], vAt[1]); p.y = pack2(vAt[2], vAt[3]); *reinterpret_cast<uint2*>(&SLOT(4)[d * RW_LD + i0]) = p;
            p.x = pack2(vBh[0], vBh[1]); p.y = pack2(vBh[2], vBh[3]); *reinterpret_cast<uint2*>(&SLOT(5)[d * RW_LD + i0]) = p;
            p.x = pack2(vKh[0], vKh[1]); p.y = pack2(vKh[2], vKh[3]); *reinterpret_cast<uint2*>(&SLOT(6)[d * RW_LD + i0]) = p;
            p.x = pack2(zv[dt][0], zv[dt][1]); p.y = pack2(zv[dt][2], zv[dt][3]); *reinterpret_cast<uint2*>(&SLOT(7)[d * RW_LD + i0]) = p;
        }
    }
    __syncthreads();
    if (cnext >= 0) rwkv_fetch(a, cnext, h, nxt);
    const int r = lane & 31, hf = lane >> 5;
    {
        const int prod = wv >> 1, sub = wv & 1;
        const bfr* Aop = (prod & 1) ? SLOT(2) : SLOT(1);
        const bfr* Bop = (prod >= 2) ? SLOT(3) : SLOT(0);
        bfr* Ld = SLOT(8 + prod);
        const bool incl = prod >= 2;
        for (int job = 0; job < (sub ? 2 : 1); ++job) {
            const int jt = sub ? job : 0, it = sub ? 1 : 0;
            f32x16 acc = tile_mm(Aop, jt * 32, Bop, it * 32, r, hf);
#pragma unroll
            for (int g4 = 0; g4 < 4; ++g4) {
                const int i = it * 32 + r, j0 = jt * 32 + g4 * 8 + hf * 4;
                float v[4];
#pragma unroll
                for (int q = 0; q < 4; ++q) { const int j = j0 + q; v[q] = (incl ? (j <= i) : (j < i)) ? acc[g4 * 4 + q] : 0.f; }
                uint2 p; p.x = pack2(v[0], v[1]); p.y = pack2(v[2], v[3]);
                *reinterpret_cast<uint2*>(&Ld[i * RW_LD + j0]) = p;
            }
        }
        if (!sub) {
#pragma unroll
            for (int g4 = 0; g4 < 4; ++g4) *reinterpret_cast<uint2*>(&Ld[r * RW_LD + 32 + g4 * 8 + hf * 4]) = make_uint2(0u, 0u);
        }
    }
    __syncthreads();
    if (wv == 0) {
        bfr* Tl = SLOT(0); bfr* TlT = SLOT(1); const bfr* Lab = SLOT(8);
        for (int q = 0; q < 9; ++q) { *reinterpret_cast<uint4*>((unsigned char*)Tl + (q * 64 + lane) * 16) = make_uint4(0u, 0u, 0u, 0u); *reinterpret_cast<uint4*>((unsigned char*)TlT + (q * 64 + lane) * 16) = make_uint4(0u, 0u, 0u, 0u); }
        {
            const int bq = lane >> 4, cc = lane & 15;
            float x[16];
#pragma unroll
            for (int rr = 0; rr < 16; ++rr) {
                float lrow[16];
                unpack8(*reinterpret_cast<const uint4*>(&Lab[(bq * 16 + rr) * RW_LD + bq * 16]), lrow);
                unpack8(*reinterpret_cast<const uint4*>(&Lab[(bq * 16 + rr) * RW_LD + bq * 16 + 8]), lrow + 8);
                float sacc = (rr == cc) ? 1.f : 0.f;
#pragma unroll
                for (int m = 0; m < rr; ++m) sacc += lrow[m] * x[m];
                x[rr] = sacc;
            }
#pragma unroll
            for (int rr = 0; rr < 16; ++rr) Tl[(bq * 16 + rr) * RW_LD + bq * 16 + cc] = f2bf(x[rr]);
            *reinterpret_cast<uint4*>(&TlT[(bq * 16 + cc) * RW_LD + bq * 16]) = pack8(x);
            *reinterpret_cast<uint4*>(&TlT[(bq * 16 + cc) * RW_LD + bq * 16 + 8]) = pack8(x + 8);
        }
        asm volatile("s_waitcnt lgkmcnt(0)" ::: "memory");
#pragma unroll
        for (int bi = 1; bi < 4; ++bi) {
#pragma unroll
            for (int bj = 0; bj < bi; ++bj) {
                f32x4 acc = {0.f, 0.f, 0.f, 0.f};
#pragma unroll
                for (int bm = bj; bm < bi; ++bm) {
                    const bf16x4 Af = *reinterpret_cast<const bf16x4*>(&Lab[(bi * 16 + fr) * RW_LD + bm * 16 + fq * 4]);
                    const bf16x4 Bf = *reinterpret_cast<const bf16x4*>(&TlT[(bj * 16 + fr) * RW_LD + bm * 16 + fq * 4]);
                    acc = __builtin_amdgcn_mfma_f32_16x16x16bf16_1k(Af, Bf, acc, 0, 0, 0);
                }
                bf16x4 Bacc; Bacc[0] = (short)f2bf(acc[0]); Bacc[1] = (short)f2bf(acc[1]); Bacc[2] = (short)f2bf(acc[2]); Bacc[3] = (short)f2bf(acc[3]);
                const bf16x4 Ad = *reinterpret_cast<const bf16x4*>(&Tl[(bi * 16 + fr) * RW_LD + bi * 16 + fq * 4]);
                const f32x4 tb = __builtin_amdgcn_mfma_f32_16x16x16bf16_1k(Ad, Bacc, f32x4{0.f, 0.f, 0.f, 0.f}, 0, 0, 0);
#pragma unroll
                for (int q = 0; q < 4; ++q) Tl[(bi * 16 + fq * 4 + q) * RW_LD + bj * 16 + fr] = f2bf(tb[q]);
                uint2 p; p.x = pack2(tb[0], tb[1]); p.y = pack2(tb[2], tb[3]);
                *reinterpret_cast<uint2*>(&TlT[(bj * 16 + fr) * RW_LD + bi * 16 + fq * 4]) = p;
            }
            asm volatile("s_waitcnt lgkmcnt(0)" ::: "memory");
        }
    } else if (wv >= 4) {
        const int it = (wv >> 1) & 1, vt = wv & 1;
        const f32x16 acc = tile_mm(SLOT(9), it * 32, SLOT(7), vt * 32, r, hf);
        store_t(SLOT(2), vt * 32, it * 32, acc, r, hf);
    }
    __syncthreads();
    {
        const int which = wv >> 2, it = (wv >> 1) & 1, ct = wv & 1;
        const f32x16 acc = tile_mm(SLOT(0), it * 32, which ? SLOT(2) : SLOT(4), ct * 32, r, hf);
        store_t(which ? SLOT(9) : SLOT(8), ct * 32, it * 32, acc, r, hf);
    }
    __syncthreads();
    if (wv < 4) {
        {
            const int dtl = wv >> 1, itl = wv & 1;
            f32x16 acc = tile_mm(SLOT(8), dtl * 32, SLOT(10), itl * 32, r, hf);
            bfr* WY = (bfr*)(a.ws + WS_WY) + (size_t)u * 4096;
            const int i = itl * 32 + r;
#pragma unroll
            for (int g4 = 0; g4 < 4; ++g4) {
                const int d0 = dtl * 32 + g4 * 8 + hf * 4;
                const uint2 rr2 = *reinterpret_cast<const uint2*>(&SLOT(3)[i * RW_LD + d0]);
                uint2 p; p.x = pack2(acc[g4 * 4] + bflo(rr2.x), acc[g4 * 4 + 1] + bfhi(rr2.x)); p.y = pack2(acc[g4 * 4 + 2] + bflo(rr2.y), acc[g4 * 4 + 3] + bfhi(rr2.y));
                *reinterpret_cast<uint2*>(&WY[i * 64 + d0]) = p;
            }
        }
        {
            const int it = wv >> 1, vt = wv & 1;
            f32x16 acc = tile_mm(SLOT(10), it * 32, SLOT(9), vt * 32, r, hf);
            acc = tile_mm_acc(acc, SLOT(11), it * 32, SLOT(7), vt * 32, r, hf);
            bfr* YL = (bfr*)(a.ws + WS_YLOC) + (size_t)u * 4096;
#pragma unroll
            for (int g4 = 0; g4 < 4; ++g4) { uint2 p; p.x = pack2(acc[g4 * 4], acc[g4 * 4 + 1]); p.y = pack2(acc[g4 * 4 + 2], acc[g4 * 4 + 3]);
                *reinterpret_cast<uint2*>(&YL[(((it * 2 + vt) * 4 + g4) * 64 + lane) * 4]) = p; }
        }
    } else {
        {
            const int kt = (wv >> 1) & 1, kpt = wv & 1;
            f32x16 acc = tile_mm(SLOT(8), kt * 32, SLOT(5), kpt * 32, r, hf);
            if (kt == kpt) {
                const float gc = __expf(BASE[16 * 64 + kt * 32 + r]);
#pragma unroll
                for (int g = 0; g < 16; ++g) if (((g & 3) + 8 * (g >> 2) + 4 * hf) == r) acc[g] += gc;
            }
            bfr* PM = (bfr*)(a.ws + WS_PM) + (size_t)u * 4096;
#pragma unroll
            for (int sgrp = 0; sgrp < 2; ++sgrp) {
                float v8[8];
#pragma unroll
                for (int q = 0; q < 8; ++q) v8[q] = acc[sgrp * 8 + q];
                *reinterpret_cast<uint4*>(&PM[(((kpt * 2 + kt) * 2 + sgrp) * 64 + lane) * 8]) = pack8(v8);
            }
        }
        {
            const int kpt = (wv >> 1) & 1, vt = wv & 1;
            f32x16 acc = tile_mm(SLOT(5), kpt * 32, SLOT(9), vt * 32, r, hf);
            acc = tile_mm_acc(acc, SLOT(6), kpt * 32, SLOT(7), vt * 32, r, hf);
            bfr* GM = (bfr*)(a.ws + WS_GM) + (size_t)u * 4096;
#pragma unroll
            for (int g4 = 0; g4 < 4; ++g4) { uint2 p; p.x = pack2(acc[g4 * 4], acc[g4 * 4 + 1]); p.y = pack2(acc[g4 * 4 + 2], acc[g4 * 4 + 3]);
                *reinterpret_cast<uint2*>(&GM[(((kpt * 2 + vt) * 4 + g4) * 64 + lane) * 4]) = p; }
        }
    }
    __syncthreads();
#undef SLOT
}

__device__ __forceinline__ void rwkv_chain(const Args& a, const int h, const int vh) {
    const int lane = my_tid() & 63, r = lane & 31, hf = lane >> 5;
    const bfr* PMb = (const bfr*)(a.ws + WS_PM); const bfr* GMb = (const bfr*)(a.ws + WS_GM); bfr* ZTb = (bfr*)(a.ws + WS_ZT);
    f32x16 Z[2];
#pragma unroll
    for (int g = 0; g < 16; ++g) { Z[0][g] = 0.f; Z[1][g] = 0.f; }
    bf16x8 Acur[8], Anxt[8]; uint2 Ccur[8], Cnxt[8];
    {
        const bfr* pm = PMb + (size_t)h * 4096; const bfr* gm = GMb + (size_t)h * 4096;
#pragma unroll
        for (int f = 0; f < 8; ++f) Acur[f] = *reinterpret_cast<const bf16x8*>(&pm[(f * 64 + lane) * 8]);
#pragma unroll
        for (int kpt = 0; kpt < 2; ++kpt)
#pragma unroll
            for (int g4 = 0; g4 < 4; ++g4) Ccur[kpt * 4 + g4] = *reinterpret_cast<const uint2*>(&gm[(((kpt * 2 + vh) * 4 + g4) * 64 + lane) * 4]);
    }
    for (int c = 0; c < 128; ++c) {
        const int u = c * 16 + h;
        if (c + 1 < 128) {
            const bfr* pm = PMb + (size_t)(u + 16) * 4096; const bfr* gm = GMb + (size_t)(u + 16) * 4096;
#pragma unroll
            for (int f = 0; f < 8; ++f) Anxt[f] = *reinterpret_cast<const bf16x8*>(&pm[(f * 64 + lane) * 8]);
#pragma unroll
            for (int kpt = 0; kpt < 2; ++kpt)
#pragma unroll
                for (int g4 = 0; g4 < 4; ++g4) Cnxt[kpt * 4 + g4] = *reinterpret_cast<const uint2*>(&gm[(((kpt * 2 + vh) * 4 + g4) * 64 + lane) * 4]);
        }
        bfr* zt = ZTb + (size_t)u * 4096 + (size_t)(vh * 32 + r) * 64;
        bf16x8 Bf[2][2];
#pragma unroll
        for (int kt = 0; kt < 2; ++kt) {
#pragma unroll
            for (int g4 = 0; g4 < 4; ++g4) {
                uint2 o; o.x = pack2(Z[kt][g4 * 4], Z[kt][g4 * 4 + 1]); o.y = pack2(Z[kt][g4 * 4 + 2], Z[kt][g4 * 4 + 3]);
                *reinterpret_cast<uint2*>(&zt[kt * 32 + g4 * 8 + hf * 4]) = o;
                const int s = g4 >> 1, e = (g4 & 1) * 4;
                Bf[kt][s][e] = (short)(o.x & 0xFFFF); Bf[kt][s][e + 1] = (short)(o.x >> 16); Bf[kt][s][e + 2] = (short)(o.y & 0xFFFF); Bf[kt][s][e + 3] = (short)(o.y >> 16);
            }
        }
        f32x16 Zn[2];
#pragma unroll
        for (int kpt = 0; kpt < 2; ++kpt)
#pragma unroll
            for (int g4 = 0; g4 < 4; ++g4) {
                const uint2 cc = Ccur[kpt * 4 + g4];
                Zn[kpt][g4 * 4] = bflo(cc.x); Zn[kpt][g4 * 4 + 1] = bfhi(cc.x); Zn[kpt][g4 * 4 + 2] = bflo(cc.y); Zn[kpt][g4 * 4 + 3] = bfhi(cc.y);
            }
#pragma unroll
        for (int kpt = 0; kpt < 2; ++kpt)
#pragma unroll
            for (int kt = 0; kt < 2; ++kt)
#pragma unroll
                for (int s = 0; s < 2; ++s)
                    Zn[kpt] = __builtin_amdgcn_mfma_f32_32x32x16_bf16(Acur[(kpt * 2 + kt) * 2 + s], Bf[kt][s], Zn[kpt], 0, 0, 0);
        Z[0] = Zn[0]; Z[1] = Zn[1];
#pragma unroll
        for (int f = 0; f < 8; ++f) { Acur[f] = Anxt[f]; Ccur[f] = Cnxt[f]; }
    }
}

__device__ __forceinline__ void rwkv_out_unit(const Args& a, const int u, float* Ls) {
    const int lane = my_tid() & 63, r = lane & 31, hf = lane >> 5, c = u >> 4, h = u & 15, t0 = c * 64;
    const bfr* WY = (const bfr*)(a.ws + WS_WY) + (size_t)u * 4096; const bfr* YL = (const bfr*)(a.ws + WS_YLOC) + (size_t)u * 4096;
    const bfr* ZT = (const bfr*)(a.ws + WS_ZT) + (size_t)u * 4096;
    f32x16 acc[2][2];
#pragma unroll
    for (int it = 0; it < 2; ++it)
#pragma unroll
        for (int vt = 0; vt < 2; ++vt)
#pragma unroll
            for (int g4 = 0; g4 < 4; ++g4) {
                const uint2 cc = *reinterpret_cast<const uint2*>(&YL[(((it * 2 + vt) * 4 + g4) * 64 + lane) * 4]);
                acc[it][vt][g4 * 4] = bflo(cc.x); acc[it][vt][g4 * 4 + 1] = bfhi(cc.x); acc[it][vt][g4 * 4 + 2] = bflo(cc.y); acc[it][vt][g4 * 4 + 3] = bfhi(cc.y);
            }
#pragma unroll
    for (int ks = 0; ks < 4; ++ks) {
        bf16x8 A[2], B[2];
#pragma unroll
        for (int it = 0; it < 2; ++it) A[it] = *reinterpret_cast<const bf16x8*>(&WY[(it * 32 + r) * 64 + ks * 16 + hf * 8]);
#pragma unroll
        for (int vt = 0; vt < 2; ++vt) B[vt] = *reinterpret_cast<const bf16x8*>(&ZT[(vt * 32 + r) * 64 + ks * 16 + hf * 8]);
#pragma unroll
        for (int it = 0; it < 2; ++it)
#pragma unroll
            for (int vt = 0; vt < 2; ++vt) acc[it][vt] = __builtin_amdgcn_mfma_f32_32x32x16_bf16(A[it], B[vt], acc[it][vt], 0, 0, 0);
    }
#pragma unroll
    for (int it = 0; it < 2; ++it)
#pragma unroll
        for (int vt = 0; vt < 2; ++vt)
#pragma unroll
            for (int g = 0; g < 16; ++g) Ls[(it * 32 + (g & 3) + 8 * (g >> 2) + 4 * hf) * 68 + vt * 32 + r] = acc[it][vt][g];
    asm volatile("s_waitcnt lgkmcnt(0)" ::: "memory");
    __builtin_amdgcn_wave_barrier();
    {
        float y[64]; float s1 = 0.f, s2 = 0.f;
#pragma unroll
        for (int q = 0; q < 16; ++q) {
            const float4 x = *reinterpret_cast<const float4*>(&Ls[lane * 68 + q * 4]);
            y[q * 4] = x.x; y[q * 4 + 1] = x.y; y[q * 4 + 2] = x.z; y[q * 4 + 3] = x.w;
            s1 += (x.x + x.y) + (x.z + x.w);
        }
        const float mean = s1 * (1.f / 64.f);
#pragma unroll
        for (int v = 0; v < 64; ++v) { const float d = y[v] - mean; s2 += d * d; }
        const float rstd = rsqrtf(s2 * (1.f / 64.f) + 64e-5f);
        const bfr* Gg = (const bfr*)(a.ws + WS_GG); const bfr* Bon = (const bfr*)(a.ws + WS_BON); bfr* RWO = (bfr*)(a.ws + WS_RWO);
        const size_t o = (size_t)(t0 + lane) * RW + h * 64;
        const float* lnw = a.in[I_LNW] + h * 64; const float* lnb = a.in[I_LNB] + h * 64;
#pragma unroll
        for (int q = 0; q < 8; ++q) {
            float gg[8], bb[8], rr[8];
            unpack8(*reinterpret_cast<const uint4*>(&Gg[o + q * 8]), gg);
            unpack8(*reinterpret_cast<const uint4*>(&Bon[o + q * 8]), bb);
#pragma unroll
            for (int e = 0; e < 8; ++e) rr[e] = ((y[q * 8 + e] - mean) * rstd * lnw[q * 8 + e] + lnb[q * 8 + e] + bb[e]) * gg[e];
            *reinterpret_cast<uint4*>(&RWO[o + q * 8]) = pack8(rr);
        }
    }
    asm volatile("s_waitcnt lgkmcnt(0)" ::: "memory");
    __builtin_amdgcn_wave_barrier();
}
#ifndef DUP_DSA
#define DUP_DSA 0
#endif
constexpr float IDX_SCALE = 0.04419417382415922f;
constexpr int CT_ROW = 544;
constexpr int CT_WAVE = 18432;
constexpr int DSA_RELB_OFF = 155648;
constexpr int DSA_HIST_OFF = 131072;
constexpr int DSA_SEL_OFF = 147456;

typedef __bf16 bf16p2_t __attribute__((ext_vector_type(2)));
__device__ __forceinline__ bf16x8 fp8x8_to_bf16(const uint2 w) {
    const u32x4 r = {__builtin_bit_cast(unsigned, __builtin_amdgcn_cvt_scalef32_pk_bf16_fp8(w.x, 1.0f, false)), __builtin_bit_cast(unsigned, __builtin_amdgcn_cvt_scalef32_pk_bf16_fp8(w.x, 1.0f, true)),
                     __builtin_bit_cast(unsigned, __builtin_amdgcn_cvt_scalef32_pk_bf16_fp8(w.y, 1.0f, false)), __builtin_bit_cast(unsigned, __builtin_amdgcn_cvt_scalef32_pk_bf16_fp8(w.y, 1.0f, true))};
    return __builtin_bit_cast(bf16x8, r);
}
__device__ __forceinline__ unsigned pack4_fp8(float a0, float a1, float a2, float a3) {
    int p = 0; p = __builtin_amdgcn_cvt_pk_fp8_f32(a0, a1, p, false); p = __builtin_amdgcn_cvt_pk_fp8_f32(a2, a3, p, true); return (unsigned)p;
}
__device__ __forceinline__ int rel_bucket(int rel) {
    const int n = rel < 0 ? -rel : rel;
    const int lg = 8 + (n >= 15) + (n >= 27) + (n >= 50) + (n >= 91) + (n >= 166) + (n >= 305) + (n >= 559);
    return (n < 8 ? n : lg) + (rel > 0 ? 16 : 0);
}
__device__ __forceinline__ unsigned fkey(float f) {
    if (f == 0.f) f = 0.f;
    const unsigned u = __float_as_uint(f);
    return (u & 0x80000000u) ? ~u : (u | 0x80000000u);
}

__device__ __forceinline__ void dsa_cnorm(const Args& a) {
    const bfr* P = (const bfr*)(a.ws + WS_P); unsigned char* CB8 = a.ws + WS_CB; bfr* IKC = (bfr*)(a.ws + WS_IKC);
    const int lane = my_tid() & 63, wv = my_tid() >> 6;
    const float4 g = reinterpret_cast<const float4*>(a.in[I_KVG])[lane];
    for (int t = blockIdx.x * 8 + wv; t < T; t += gridDim.x * 8) {
        const uint2 raw = *reinterpret_cast<const uint2*>(&P[(size_t)t * NINP + C_CKV + lane * 4]);
        const float v0 = bflo(raw.x), v1 = bfhi(raw.x), v2 = bflo(raw.y), v3 = bfhi(raw.y);
        const float ss = wave_sum(v0 * v0 + v1 * v1 + v2 * v2 + v3 * v3);
        const float rs = rsqrtf(ss * (1.f / 256.f) + EPS);
        int pk = 0;
        pk = __builtin_amdgcn_cvt_pk_fp8_f32(v0 * rs * g.x, v1 * rs * g.y, pk, false);
        pk = __builtin_amdgcn_cvt_pk_fp8_f32(v2 * rs * g.z, v3 * rs * g.w, pk, true);
        *reinterpret_cast<int*>(&CB8[(size_t)t * 256 + lane * 4]) = pk;
        if (lane < 16) *reinterpret_cast<uint2*>(&IKC[(size_t)t * 64 + lane * 4]) = *reinterpret_cast<const uint2*>(&P[(size_t)t * NINP + C_IK + lane * 4]);
    }
}
__device__ __forceinline__ void dsa_qlat(const Args& a) {
    const bfr* P = (const bfr*)(a.ws + WS_P); const bfr* WUK = (const bfr*)(a.ws + WS_WUK); unsigned char* QL8 = a.ws + WS_QLAT;
    const int lane = my_tid() & 63, wv = my_tid() >> 6, fr = lane & 15, fq = lane >> 4;
    for (int it = blockIdx.x * 8 + wv; it < (T / 64) * NH; it += gridDim.x * 8) {
        const int tg = it >> 4, h = it & 15, t0 = tg * 64;
        bf16x8 Bt[4][2];
#pragma unroll
        for (int tl = 0; tl < 4; ++tl)
#pragma unroll
            for (int ks = 0; ks < 2; ++ks) Bt[tl][ks] = *reinterpret_cast<const bf16x8*>(&P[(size_t)(t0 + tl * 16 + fr) * NINP + C_Q + h * 64 + ks * 32 + fq * 8]);
#pragma unroll 2
        for (int nt = 0; nt < 16; ++nt) {
            const bf16x8 A0 = *reinterpret_cast<const bf16x8*>(&WUK[(size_t)(h * 256 + nt * 16 + fr) * 64 + fq * 8]);
            const bf16x8 A1 = *reinterpret_cast<const bf16x8*>(&WUK[(size_t)(h * 256 + nt * 16 + fr) * 64 + 32 + fq * 8]);
#pragma unroll
            for (int tl = 0; tl < 4; ++tl) {
                f32x4 acc = {0.f, 0.f, 0.f, 0.f};
                acc = __builtin_amdgcn_mfma_f32_16x16x32_bf16(A0, Bt[tl][0], acc, 0, 0, 0);
                acc = __builtin_amdgcn_mfma_f32_16x16x32_bf16(A1, Bt[tl][1], acc, 0, 0, 0);
                *reinterpret_cast<unsigned*>(&QL8[((size_t)(t0 + tl * 16 + fr) * NH + h) * 256 + nt * 16 + fq * 4]) = pack4_fp8(acc[0], acc[1], acc[2], acc[3]);
            }
        }
    }
}
__device__ __forceinline__ void dsa_oproj(const Args& a) {
    const unsigned char* OL8 = a.ws + WS_OLAT; const bfr* WUVT = (const bfr*)(a.ws + WS_WUVT); bfr* DO = (bfr*)(a.ws + WS_DO);
    const int lane = my_tid() & 63, wv = my_tid() >> 6, fr = lane & 15, fq = lane >> 4;
    for (int it = blockIdx.x * 8 + wv; it < (T / 64) * NH; it += gridDim.x * 8) {
        const int tg = it >> 4, h = it & 15, t0 = tg * 64;
        f32x4 acc[4][4];
#pragma unroll
        for (int tl = 0; tl < 4; ++tl)
#pragma unroll
            for (int nt = 0; nt < 4; ++nt) acc[tl][nt] = f32x4{0.f, 0.f, 0.f, 0.f};
#pragma unroll 2
        for (int ks = 0; ks < 8; ++ks) {
            bf16x8 A[4];
#pragma unroll
            for (int nt = 0; nt < 4; ++nt) A[nt] = *reinterpret_cast<const bf16x8*>(&WUVT[(size_t)(h * 64 + nt * 16 + fr) * 256 + ks * 32 + fq * 8]);
#pragma unroll
            for (int tl = 0; tl < 4; ++tl) {
                const bf16x8 Bt = fp8x8_to_bf16(*reinterpret_cast<const uint2*>(&OL8[((size_t)(t0 + tl * 16 + fr) * NH + h) * 256 + ks * 32 + fq * 8]));
#pragma unroll
                for (int nt = 0; nt < 4; ++nt) acc[tl][nt] = __builtin_amdgcn_mfma_f32_16x16x32_bf16(A[nt], Bt, acc[tl][nt], 0, 0, 0);
            }
        }
#pragma unroll
        for (int tl = 0; tl < 4; ++tl)
#pragma unroll
            for (int nt = 0; nt < 4; ++nt) { uint2 o; o.x = pack2(acc[tl][nt][0], acc[tl][nt][1]); o.y = pack2(acc[tl][nt][2], acc[tl][nt][3]);
                *reinterpret_cast<uint2*>(&DO[(size_t)(t0 + tl * 16 + fr) * RW + h * 64 + nt * 16 + fq * 4]) = o; }
    }
}

__device__ __forceinline__ float bin_scale(const float sumw2) { const float sg = sqrtf(32.f * sumw2); return sg > 1e-20f ? 90.f / sg : 1.f; }
__device__ __forceinline__ int score_bin(const float sc, const float bsc) { const float f = floorf(sc * bsc) + 512.f; return (int)fminf(fmaxf(f, 0.f), 1023.f); }
__device__ __forceinline__ float key_score(const unsigned k) { return __uint_as_float((k & 0x80000000u) ? (k ^ 0x80000000u) : ~k); }
__device__ __forceinline__ void hist_scan(const unsigned* hist, const int nb, const unsigned need, unsigned* res, const int lane) {
    const int per = nb >> 6;
    unsigned s = 0;
    for (int i = 0; i < per; ++i) s += hist[lane * per + i];
    unsigned S = s;
#pragma unroll
    for (int o = 1; o < 64; o <<= 1) { const unsigned tt = __shfl_down(S, o); if (lane + o < 64) S += tt; }
    const unsigned long long m = __ballot(S >= need);
    const int ls = 63 - __clzll(m);
    if (lane == ls) {
        unsigned accv = S - s; int bin = lane * per; unsigned abv = accv;
        for (int bb = lane * per + per - 1; bb >= lane * per; --bb) { const unsigned cc = hist[bb]; if (accv + cc >= need) { bin = bb; abv = accv; break; } accv += cc; }
        res[0] = (unsigned)bin; res[1] = abv;
    }
}

__device__ __forceinline__ void dsa_select4(const Args& a, const int t0, const int qs, unsigned char* lds) {
    const bfr* P = (const bfr*)(a.ws + WS_P); const bfr* IKC = (const bfr*)(a.ws + WS_IKC);
    float* SC = (float*)lds; int* SEL = (int*)(lds + DSA_SEL_OFF); unsigned* MISC = (unsigned*)(lds + LDS_MISC);
    const int tid = my_tid(), lane = tid & 63, wv = tid >> 6, r = lane & 31, hf = lane >> 5;
    const int L = 64 * (t0 / 64 + 1);
    if (L <= 256) {
        for (int i = tid; i < 4 * 256; i += 512) SEL[(qs + (i >> 8)) * 256 + (i & 255)] = (i & 255) | (rel_bucket((i & 255) - (t0 + (i >> 8))) << 16);
        if (tid < 4) MISC[16 + qs + tid] = (unsigned)L;
        __syncthreads();
        return;
    }
    for (int i = tid; i < 4096; i += 512) ((unsigned*)(lds + DSA_HIST_OFF))[i] = 0u;
    __syncthreads();
    {
        const int qq = r >> 3, hh = r & 7;
        bf16x8 B[4];
#pragma unroll
        for (int ks = 0; ks < 4; ++ks) B[ks] = *reinterpret_cast<const bf16x8*>(&P[(size_t)(t0 + qq) * NINP + C_IQ + hh * 64 + ks * 16 + hf * 8]);
        const float wgt = bf2f(P[(size_t)(t0 + qq) * NINP + C_IW + hh]) * IDX_SCALE;
        float w2 = wgt * wgt; w2 += dpp_f<DPP_XOR1>(w2); w2 += dpp_f<DPP_XOR2>(w2); w2 += dpp_f<0x141>(w2);
        const float bsc = bin_scale(w2);
        if (hh == 0 && hf == 0) ((float*)MISC)[48 + qq] = bsc;
        const int ntile = L >> 5;
        for (int rp_ = 0; rp_ < ((DUP_DSA & 1) ? 2 : 1); ++rp_) {
        bf16x8 An[4];
        if (wv < ntile) {
#pragma unroll
            for (int ks = 0; ks < 4; ++ks) An[ks] = *reinterpret_cast<const bf16x8*>(&IKC[(size_t)(wv * 32 + r) * 64 + ks * 16 + hf * 8]);
        }
        for (int kt = wv; kt < ntile; kt += 8) {
            bf16x8 Ac[4];
#pragma unroll
            for (int ks = 0; ks < 4; ++ks) Ac[ks] = An[ks];
            if (kt + 8 < ntile) {
#pragma unroll
                for (int ks = 0; ks < 4; ++ks) An[ks] = *reinterpret_cast<const bf16x8*>(&IKC[(size_t)((kt + 8) * 32 + r) * 64 + ks * 16 + hf * 8]);
            }
            f32x16 acc;
#pragma unroll
            for (int g = 0; g < 16; ++g) acc[g] = 0.f;
#pragma unroll
            for (int ks = 0; ks < 4; ++ks) acc = __builtin_amdgcn_mfma_f32_32x32x16_bf16(Ac[ks], B[ks], acc, 0, 0, 0);
            float s1[8], s2[4], s3[2];
            const bool b0 = (hh & 1) != 0, b1 = (hh & 2) != 0, b2 = (hh & 4) != 0;
#pragma unroll
            for (int p = 0; p < 8; ++p) {
                const float x0 = fmaxf(acc[2 * p], 0.f) * wgt, x1 = fmaxf(acc[2 * p + 1], 0.f) * wgt;
                s1[p] = (b0 ? x1 : x0) + dpp_f<DPP_XOR1>(b0 ? x0 : x1);
            }
#pragma unroll
            for (int p = 0; p < 4; ++p) s2[p] = (b1 ? s1[2 * p + 1] : s1[2 * p]) + dpp_f<DPP_XOR2>(b1 ? s1[2 * p] : s1[2 * p + 1]);
#pragma unroll
            for (int p = 0; p < 2; ++p) s3[p] = (b2 ? s2[2 * p + 1] : s2[2 * p]) + __shfl_xor(b2 ? s2[2 * p] : s2[2 * p + 1], 4);
#pragma unroll
            for (int p = 0; p < 2; ++p) { const int g = 8 * p + hh; const unsigned fk = fkey(s3[p]); ((unsigned*)SC)[qq * 8192 + kt * 32 + (g & 3) + 8 * (g >> 2) + 4 * hf] = fk;
                if (rp_ == 0) atomicAdd((unsigned*)(lds + DSA_HIST_OFF) + qq * 1024 + score_bin(s3[p], bsc), 1u); }
        }
        }
    }
    __syncthreads();
    const int q = wv >> 1, l128 = (wv & 1) * 64 + lane;
    const unsigned* keys = (const unsigned*)(SC + q * 8192);
    unsigned* hist = (unsigned*)(lds + DSA_HIST_OFF) + q * 1024;
    unsigned* res = MISC + 32 + q * 4;
    for (int rp_ = 0; rp_ < ((DUP_DSA & 2) ? 2 : 1); ++rp_) {
    const float bsc = ((const float*)MISC)[48 + q];
    unsigned need = 256;
    if (rp_ > 0) {
        for (int i = l128; i < 1024; i += 128) hist[i] = 0u;
        __syncthreads();
        for (int idx = l128; idx < L; idx += 128) atomicAdd(&hist[score_bin(key_score(keys[idx]), bsc)], 1u);
        __syncthreads();
    }
    if ((wv & 1) == 0) hist_scan(hist, 1024, need, res, lane);
    __syncthreads();
    const int b0 = (int)res[0]; need -= res[1];
    __syncthreads();
    unsigned* cand = hist + 256;
    if (l128 == 0) { res[2] = 0u; res[3] = 0u; }
    if (tid == 0) MISC[52] = 0u;
    __syncthreads();
    for (int idx = l128; idx < L; idx += 128) {
        const unsigned k = keys[idx];
        if (score_bin(key_score(k), bsc) == b0) { const unsigned p = atomicAdd(&res[2], 1u); if (p < 768u) cand[p] = k; }
    }
    __syncthreads();
    const unsigned ncand = res[2];
    if (l128 == 0 && ncand > 768u) MISC[52] = 1u;
    __syncthreads();
    const bool fast = MISC[52] == 0u;
    unsigned prefix = 0;
    if (fast) {
        for (unsigned i = l128; i < ncand; i += 128) {
            const unsigned me = cand[i]; unsigned cgt = 0, ceq = 0;
            for (unsigned j = 0; j < ncand; ++j) { const unsigned o = cand[j]; cgt += (o > me) ? 1u : 0u; ceq += (o == me) ? 1u : 0u; }
            if (cgt < need && need <= cgt + ceq) { res[0] = me; res[1] = cgt; }
        }
        __syncthreads();
        prefix = res[0]; need -= res[1];
        __syncthreads();
    } else {
#pragma unroll 1
        for (int pass = 0; pass < 4; ++pass) {
            const int lo_shift = 24 - 8 * pass;
            for (int i = l128; i < 256; i += 128) hist[i] = 0u;
            __syncthreads();
            for (int idx = l128; idx < L; idx += 128) {
                const unsigned k = keys[idx];
                const bool ok = (score_bin(key_score(k), bsc) == b0) && (pass == 0 || (k >> (lo_shift + 8)) == prefix);
                if (ok) atomicAdd(&hist[(k >> lo_shift) & 255u], 1u);
            }
            __syncthreads();
            if ((wv & 1) == 0) hist_scan(hist, 256, need, res, lane);
            __syncthreads();
            prefix = (prefix << 8) | res[0]; need -= res[1];
            __syncthreads();
        }
    }
    const unsigned tkey = prefix;
    if ((wv & 1) == 0) {
        const unsigned ngt = 256u - need; unsigned rg = 0, rt = 0;
        const unsigned long long lt = (1ull << lane) - 1ull;
        for (int base = 0; base < L; base += 64) {
            const unsigned k = keys[base + lane];
            const bool gt = k > tkey, tie = k == tkey;
            const unsigned long long mg = __ballot(gt), mt = __ballot(tie);
            if (gt) { const unsigned p = rg + (unsigned)__popcll(mg & lt); if (p < 256u) SEL[(qs + q) * 256 + p] = base + lane; }
            if (tie) { const unsigned p = rt + (unsigned)__popcll(mt & lt); if (p < need) SEL[(qs + q) * 256 + ngt + p] = base + lane; }
            rg += (unsigned)__popcll(mg); rt += (unsigned)__popcll(mt);
        }
        if (lane == 0) MISC[16 + qs + q] = 256u;
    }
    __syncthreads();
    for (int i = l128; i < 256; i += 128) { const int e = SEL[(qs + q) * 256 + i]; SEL[(qs + q) * 256 + i] = e | (rel_bucket(e - (t0 + q)) << 16); }
    __syncthreads();
    }
}

__device__ __forceinline__ void dsa_attend(const Args& a, const int t, const int* sel, const int nsel, unsigned char* ct, const float* relb_l) {
    const unsigned char* CB8 = a.ws + WS_CB; const unsigned char* QL8 = a.ws + WS_QLAT; unsigned char* OL8 = a.ws + WS_OLAT;
    const int lane = my_tid() & 63, fr = lane & 15, fq = lane >> 4;
    bf16x8 Bq[8];
#pragma unroll
    for (int ks = 0; ks < 8; ++ks) Bq[ks] = fp8x8_to_bf16(*reinterpret_cast<const uint2*>(&QL8[((size_t)t * NH + fr) * 256 + ks * 32 + fq * 8]));
    f32x4 o[16];
#pragma unroll
    for (int mt = 0; mt < 16; ++mt) o[mt] = f32x4{0.f, 0.f, 0.f, 0.f};
    float mrun = -1e30f, lrun = 0.f;
    const unsigned tr_addr = (unsigned)(size_t)ct + (unsigned)((4 * fq + (fr >> 2)) * CT_ROW + (fr & 3) * 8);
    const int nblk = nsel >> 5;
    uint2 Ar[2][8];
#pragma unroll
    for (int tt = 0; tt < 2; ++tt) {
        const int kidx = sel[tt * 16 + fr] & 0xFFFF;
#pragma unroll
        for (int ks = 0; ks < 8; ++ks) Ar[tt][ks] = *reinterpret_cast<const uint2*>(&CB8[(size_t)kidx * 256 + ks * 32 + fq * 8]);
    }
    for (int kb = 0; kb < nblk; ++kb) {
        f32x4 st[2];
#pragma unroll
        for (int tt = 0; tt < 2; ++tt) {
            st[tt] = f32x4{0.f, 0.f, 0.f, 0.f};
#pragma unroll
            for (int ks = 0; ks < 8; ++ks) {
                const bf16x8 Af = fp8x8_to_bf16(Ar[tt][ks]);
                st[tt] = __builtin_amdgcn_mfma_f32_16x16x32_bf16(Af, Bq[ks], st[tt], 0, 0, 0);
                *reinterpret_cast<bf16x8*>(ct + (tt * 16 + fr) * CT_ROW + (ks * 32 + fq * 8) * 2) = Af;
            }
        }
        if (kb + 1 < nblk) {
#pragma unroll
            for (int tt = 0; tt < 2; ++tt) {
                const int kidx = sel[(kb + 1) * 32 + tt * 16 + fr] & 0xFFFF;
#pragma unroll
                for (int ks = 0; ks < 8; ++ks) Ar[tt][ks] = *reinterpret_cast<const uint2*>(&CB8[(size_t)kidx * 256 + ks * 32 + fq * 8]);
            }
        }
        float lg[8]; float bmax = -1e30f;
#pragma unroll
        for (int tt = 0; tt < 2; ++tt) {
            const int4 k4 = *reinterpret_cast<const int4*>(&sel[kb * 32 + tt * 16 + fq * 4]);
            const int kk4[4] = {k4.x, k4.y, k4.z, k4.w};
#pragma unroll
            for (int j = 0; j < 4; ++j) {
                const float v = st[tt][j] * 0.125f + relb_l[(kk4[j] >> 16) * 16 + fr];
                lg[tt * 4 + j] = v; bmax = fmaxf(bmax, v);
            }
        }
        bmax = fmaxf(bmax, __shfl_xor(bmax, 16)); bmax = fmaxf(bmax, __shfl_xor(bmax, 32));
        const bool resc = __any(bmax > mrun + 8.f);
        if (resc) {
            const float mnew = fmaxf(mrun, bmax); const float alpha = __expf(mrun - mnew); mrun = mnew; lrun *= alpha;
            asm volatile("" ::: "memory");
#pragma unroll
            for (int mt = 0; mt < 16; ++mt) { o[mt][0] *= alpha; o[mt][1] *= alpha; o[mt][2] *= alpha; o[mt][3] *= alpha; }
        }
        float psum = 0.f; bf16x8 Pf;
#pragma unroll
        for (int e = 0; e < 8; e += 2) {
            const float p0 = __expf(lg[e] - mrun), p1 = __expf(lg[e + 1] - mrun); psum += p0 + p1;
            const unsigned pk = pack2(p0, p1); Pf[e] = (short)(pk & 0xFFFF); Pf[e + 1] = (short)(pk >> 16);
        }
        lrun += psum;
        asm volatile("s_waitcnt lgkmcnt(0)" ::: "memory");
        __builtin_amdgcn_wave_barrier();
#pragma unroll
        for (int m4 = 0; m4 < 4; ++m4) {
            uint2 r0[4], r1[4];
            asm volatile("ds_read_b64_tr_b16 %0, %8 offset:%9\n\tds_read_b64_tr_b16 %1, %8 offset:%10\n\t"
                         "ds_read_b64_tr_b16 %2, %8 offset:%11\n\tds_read_b64_tr_b16 %3, %8 offset:%12\n\t"
                         "ds_read_b64_tr_b16 %4, %8 offset:%13\n\tds_read_b64_tr_b16 %5, %8 offset:%14\n\t"
                         "ds_read_b64_tr_b16 %6, %8 offset:%15\n\tds_read_b64_tr_b16 %7, %8 offset:%16\n\ts_waitcnt lgkmcnt(0)"
                         : "=&v"(r0[0]), "=&v"(r1[0]), "=&v"(r0[1]), "=&v"(r1[1]), "=&v"(r0[2]), "=&v"(r1[2]), "=&v"(r0[3]), "=&v"(r1[3])
                         : "v"(tr_addr), "n"(m4 * 128), "n"(m4 * 128 + 16 * CT_ROW), "n"(m4 * 128 + 32), "n"(m4 * 128 + 32 + 16 * CT_ROW),
                           "n"(m4 * 128 + 64), "n"(m4 * 128 + 64 + 16 * CT_ROW), "n"(m4 * 128 + 96), "n"(m4 * 128 + 96 + 16 * CT_ROW)
                         : "memory");
#pragma unroll
            for (int i = 0; i < 4; ++i) {
                const int mt = m4 * 4 + i;
                const u32x4 raw = {r0[i].x, r0[i].y, r1[i].x, r1[i].y};
                const bf16x8 Av = __builtin_bit_cast(bf16x8, raw);
                o[mt] = __builtin_amdgcn_mfma_f32_16x16x32_bf16(Av, Pf, o[mt], 0, 0, 0);
            }
        }
        asm volatile("s_waitcnt lgkmcnt(0)" ::: "memory");
        __builtin_amdgcn_wave_barrier();
    }
    lrun += __shfl_xor(lrun, 16); lrun += __shfl_xor(lrun, 32);
    const float inv = frcp_(lrun);
#pragma unroll
    for (int mt = 0; mt < 16; ++mt) {
        *reinterpret_cast<unsigned*>(&OL8[((size_t)t * NH + fr) * 256 + mt * 16 + fq * 4]) = pack4_fp8(o[mt][0] * inv, o[mt][1] * inv, o[mt][2] * inv, o[mt][3] * inv);
    }
}

constexpr int DSA_CCAP = 256;
__device__ __forceinline__ bool dsa_select8(const Args& a, const int t0, unsigned char* lds) {
    const bfr* P = (const bfr*)(a.ws + WS_P); const bfr* IKC = (const bfr*)(a.ws + WS_IKC);
    unsigned* KEYS = (unsigned*)(a.ws + WS_KEYS) + (size_t)blockIdx.x * (8 * 8192);
    unsigned short* BIN = (unsigned short*)lds; unsigned* H16 = (unsigned*)(lds + DSA_HIST_OFF);
    int* SEL = (int*)(lds + DSA_SEL_OFF); unsigned* MISC = (unsigned*)(lds + LDS_MISC);
    const int tid = my_tid(), lane = tid & 63, wv = tid >> 6, r = lane & 31, hf = lane >> 5;
    const int L = 64 * (t0 / 64 + 1);
    if (L <= 256) {
        for (int i = tid; i < 8 * 256; i += 512) SEL[i] = (i & 255) | (rel_bucket((i & 255) - (t0 + (i >> 8))) << 16);
        if (tid < 8) MISC[16 + tid] = (unsigned)L;
        __syncthreads();
        return true;
    }
#ifndef DUP_DSA
#define DUP_DSA 0
#endif
    for (int rp_ = 0; rp_ < ((DUP_DSA & 1) ? 2 : 1); ++rp_) {
    if (rp_) __syncthreads();
    for (int i = tid; i < 4096; i += 512) H16[i] = 0u;
    if (tid == 0) MISC[60] = 0u;
    __syncthreads();
    {
        const int qq = r >> 3, hh = r & 7;
        bf16x8 B[2][4]; float wgt[2], bsc[2];
#pragma unroll
        for (int grp = 0; grp < 2; ++grp) {
#pragma unroll
            for (int ks = 0; ks < 4; ++ks) B[grp][ks] = *reinterpret_cast<const bf16x8*>(&P[(size_t)(t0 + grp * 4 + qq) * NINP + C_IQ + hh * 64 + ks * 16 + hf * 8]);
            wgt[grp] = bf2f(P[(size_t)(t0 + grp * 4 + qq) * NINP + C_IW + hh]) * IDX_SCALE;
            float w2 = wgt[grp] * wgt[grp]; w2 += dpp_f<DPP_XOR1>(w2); w2 += dpp_f<DPP_XOR2>(w2); w2 += dpp_f<0x141>(w2);
            bsc[grp] = bin_scale(w2);
            if (hh == 0 && hf == 0) ((float*)MISC)[48 + grp * 4 + qq] = bsc[grp];
        }
        const bool b0 = (hh & 1) != 0, b1 = (hh & 2) != 0, b2 = (hh & 4) != 0;
        const int ntile = L >> 5;
        bf16x8 An[4];
        if (wv < ntile) {
#pragma unroll
            for (int ks = 0; ks < 4; ++ks) An[ks] = *reinterpret_cast<const bf16x8*>(&IKC[(size_t)(wv * 32 + r) * 64 + ks * 16 + hf * 8]);
        }
        for (int kt = wv; kt < ntile; kt += 8) {
            bf16x8 Ac[4];
#pragma unroll
            for (int ks = 0; ks < 4; ++ks) Ac[ks] = An[ks];
            if (kt + 8 < ntile) {
#pragma unroll
                for (int ks = 0; ks < 4; ++ks) An[ks] = *reinterpret_cast<const bf16x8*>(&IKC[(size_t)((kt + 8) * 32 + r) * 64 + ks * 16 + hf * 8]);
            }
#pragma unroll
            for (int grp = 0; grp < 2; ++grp) {
                f32x16 acc;
#pragma unroll
                for (int g = 0; g < 16; ++g) acc[g] = 0.f;
#pragma unroll
                for (int ks = 0; ks < 4; ++ks) acc = __builtin_amdgcn_mfma_f32_32x32x16_bf16(Ac[ks], B[grp][ks], acc, 0, 0, 0);
                float s1[8], s2[4], s3[2];
#pragma unroll
                for (int p = 0; p < 8; ++p) {
                    const float x0 = fmaxf(acc[2 * p], 0.f) * wgt[grp], x1 = fmaxf(acc[2 * p + 1], 0.f) * wgt[grp];
                    s1[p] = (b0 ? x1 : x0) + dpp_f<DPP_XOR1>(b0 ? x0 : x1);
                }
#pragma unroll
                for (int p = 0; p < 4; ++p) s2[p] = (b1 ? s1[2 * p + 1] : s1[2 * p]) + dpp_f<DPP_XOR2>(b1 ? s1[2 * p] : s1[2 * p + 1]);
#pragma unroll
                for (int p = 0; p < 2; ++p) s3[p] = (b2 ? s2[2 * p + 1] : s2[2 * p]) + __shfl_xor(b2 ? s2[2 * p] : s2[2 * p + 1], 4);
#pragma unroll
                for (int p = 0; p < 2; ++p) {
                    const int g = 8 * p + hh, kidx = kt * 32 + (g & 3) + 8 * (g >> 2) + 4 * hf, q = grp * 4 + qq;
                    const int bin = score_bin(s3[p], bsc[grp]);
                    BIN[q * 8192 + kidx] = (unsigned short)bin;
                    atomicAdd(&H16[q * 512 + (bin >> 1)], (bin & 1) ? 0x10000u : 1u);
                    __builtin_nontemporal_store(fkey(s3[p]), &KEYS[q * 8192 + kidx]);
                }
            }
        }
    }
    }
    asm volatile("s_waitcnt vmcnt(0)" ::: "memory");
    __syncthreads();
    {
        const int q = wv;
        const unsigned short* bins = BIN + q * 8192;
        unsigned* hrow = H16 + q * 512;
        unsigned cnt[16]; unsigned sown = 0;
#pragma unroll
        for (int i = 0; i < 8; ++i) { const unsigned w = hrow[lane * 8 + i]; cnt[2 * i] = w & 0xFFFFu; cnt[2 * i + 1] = w >> 16; sown += cnt[2 * i] + cnt[2 * i + 1]; }
        unsigned S = sown;
#pragma unroll
        for (int o = 1; o < 64; o <<= 1) { const unsigned tt = __shfl_down(S, o); if (lane + o < 64) S += tt; }
        const unsigned long long mfound = __ballot(S >= 256u);
        const int ls = 63 - __clzll(mfound);
        int b0l = 0; unsigned abovel = 0;
        {
            unsigned accv = S - sown; bool done = false;
#pragma unroll
            for (int bb = 15; bb >= 0; --bb) { if (!done) { if (accv + cnt[bb] >= 256u) { b0l = lane * 16 + bb; abovel = accv; done = true; } else accv += cnt[bb]; } }
        }
        const int b0 = __shfl(b0l, ls); const unsigned ngt = __shfl((int)abovel, ls); const unsigned need = 256u - ngt;
        __builtin_amdgcn_wave_barrier();
        int* CL = (int*)hrow; unsigned* CK = hrow + DSA_CCAP;
        const unsigned long long lt = (1ull << lane) - 1ull;
        unsigned rg = 0, rc = 0;
        for (int base = 0; base < (L >> 1); base += 64) {
            const bool valid = (base + lane) < (L >> 1);
            const unsigned w = valid ? reinterpret_cast<const unsigned*>(bins)[base + lane] : 0u;
            const int ba = (int)(w & 0xFFFFu), bb = (int)(w >> 16), ia = 2 * (base + lane), ib = ia + 1;
            const bool ga = valid && ba > b0, gb = valid && bb > b0, ca = valid && ba == b0, cb = valid && bb == b0;
            const unsigned long long mga = __ballot(ga), mgb = __ballot(gb), mca = __ballot(ca), mcb = __ballot(cb);
            const unsigned pg = rg + (unsigned)__popcll(mga & lt) + (unsigned)__popcll(mgb & lt);
            const unsigned pc = rc + (unsigned)__popcll(mca & lt) + (unsigned)__popcll(mcb & lt);
            if (ga && pg < 256u) SEL[q * 256 + pg] = ia;
            if (gb && pg + (ga ? 1u : 0u) < 256u) SEL[q * 256 + pg + (ga ? 1u : 0u)] = ib;
            if (ca && pc < (unsigned)DSA_CCAP) CL[pc] = ia;
            if (cb && pc + (ca ? 1u : 0u) < (unsigned)DSA_CCAP) CL[pc + (ca ? 1u : 0u)] = ib;
            rg += (unsigned)__popcll(mga) + (unsigned)__popcll(mgb); rc += (unsigned)__popcll(mca) + (unsigned)__popcll(mcb);
        }
        const unsigned ncand = rc;
        if (ncand > (unsigned)DSA_CCAP) { if (lane == 0) MISC[60] = 1u; }
        else {
            asm volatile("s_waitcnt lgkmcnt(0)" ::: "memory");
            for (unsigned i = lane; i < ncand; i += 64) CK[i] = __hip_atomic_load(&KEYS[q * 8192 + CL[i]], __ATOMIC_RELAXED, __HIP_MEMORY_SCOPE_AGENT);
            asm volatile("s_waitcnt vmcnt(0) lgkmcnt(0)" ::: "memory");
            __builtin_amdgcn_wave_barrier();
            for (unsigned i = lane; i < ncand; i += 64) {
                const unsigned me = CK[i]; unsigned rk = 0;
                for (unsigned j = 0; j < ncand; ++j) { const unsigned o = CK[j]; rk += (o > me || (o == me && j < i)) ? 1u : 0u; }
                if (rk < need) SEL[q * 256 + ngt + rk] = CL[i];
            }
            asm volatile("s_waitcnt lgkmcnt(0)" ::: "memory");
            __builtin_amdgcn_wave_barrier();
            for (int i = lane; i < 256; i += 64) { const int e = SEL[q * 256 + i]; SEL[q * 256 + i] = e | (rel_bucket(e - (t0 + q)) << 16); }
            if (lane == 0) MISC[16 + q] = 256u;
        }
    }
    __syncthreads();
    return MISC[60] == 0u;
}

__device__ __forceinline__ void dsa_unit(const Args& a, const int unit, unsigned char* lds) {
    const int t0 = unit * 8, wv = my_tid() >> 6;
    if (DUP_DSA & 2) { dsa_select8(a, t0, lds); __syncthreads(); }
    if (!dsa_select8(a, t0, lds)) {
        __syncthreads();
        dsa_select4(a, t0, 0, lds);
        dsa_select4(a, t0 + 4, 4, lds);
    }
    const int* SEL = (const int*)(lds + DSA_SEL_OFF); const unsigned* MISC = (const unsigned*)(lds + LDS_MISC);
    if (DUP_DSA & 4) dsa_attend(a, t0 + wv, SEL + wv * 256, (int)MISC[16 + wv], lds + wv * CT_WAVE, (const float*)(lds + DSA_RELB_OFF));
    dsa_attend(a, t0 + wv, SEL + wv * 256, (int)MISC[16 + wv], lds + wv * CT_WAVE, (const float*)(lds + DSA_RELB_OFF));
    __syncthreads();
}
template <int J> __device__ __forceinline__ int xchg_i(int v) {
    if (J == 1) return __builtin_amdgcn_update_dpp(0, v, 0xB1, 0xF, 0xF, true);
    else if (J == 2) return __builtin_amdgcn_update_dpp(0, v, 0x4E, 0xF, 0xF, true);
    else if (J == 4) { int t = __builtin_amdgcn_update_dpp(v, v, 0x104, 0xF, 0x5, false);
                       return __builtin_amdgcn_update_dpp(t, v, 0x114, 0xF, 0xA, false); }
    else if (J == 8) return __builtin_amdgcn_update_dpp(0, v, 0x128, 0xF, 0xF, true);
    else return __shfl_xor(v, J);
}
template <int J> __device__ __forceinline__ float xchg_f(float v) { return __int_as_float(xchg_i<J>(__float_as_int(v))); }

__device__ __forceinline__ unsigned okey(float f) { const unsigned u = __float_as_uint(f); return (u & 0x80000000u) ? ~u : (u | 0x80000000u); }
template <int K, int J> __device__ __forceinline__ void bitonic_step(unsigned& k, const int lane) {
    const unsigned ok = (unsigned)xchg_i<J>((int)k);
    const bool desc = (K == 64) ? true : ((lane & K) == 0);
    const bool keepmax = ((lane & J) == 0) == desc;
    k = keepmax ? max(k, ok) : min(k, ok);
}
__device__ __forceinline__ void bitonic64(unsigned& k, const int lane) {
    bitonic_step<2, 1>(k, lane);
    bitonic_step<4, 2>(k, lane); bitonic_step<4, 1>(k, lane);
    bitonic_step<8, 4>(k, lane); bitonic_step<8, 2>(k, lane); bitonic_step<8, 1>(k, lane);
    bitonic_step<16, 8>(k, lane); bitonic_step<16, 4>(k, lane); bitonic_step<16, 2>(k, lane); bitonic_step<16, 1>(k, lane);
    bitonic_step<32, 16>(k, lane); bitonic_step<32, 8>(k, lane); bitonic_step<32, 4>(k, lane); bitonic_step<32, 2>(k, lane); bitonic_step<32, 1>(k, lane);
    bitonic_step<64, 32>(k, lane); bitonic_step<64, 16>(k, lane); bitonic_step<64, 8>(k, lane); bitonic_step<64, 4>(k, lane); bitonic_step<64, 2>(k, lane); bitonic_step<64, 1>(k, lane);
}
__device__ __forceinline__ void merge32(unsigned& k, const int lane) {
    bitonic_step<64, 16>(k, lane); bitonic_step<64, 8>(k, lane); bitonic_step<64, 4>(k, lane); bitonic_step<64, 2>(k, lane); bitonic_step<64, 1>(k, lane);
}
__device__ __forceinline__ void top16_of_128(const float* s, float& tv, int& ti, const int lane) {
    unsigned ka = (okey(s[lane]) & ~0x7Fu) | (unsigned)(127 - lane), kb = (okey(s[64 + lane]) & ~0x7Fu) | (unsigned)(63 - lane);
    bitonic64(ka, lane); bitonic64(kb, lane);
    const unsigned rb = (unsigned)__shfl((int)kb, 31 - lane);
    unsigned k = (lane < 16) ? ka : ((lane < 32) ? rb : 0u);
    merge32(k, lane);
    ti = 127 - (int)(k & 0x7Fu);
    tv = s[ti];
}

__device__ __forceinline__ unsigned mirror16(unsigned v) { return (unsigned)__builtin_amdgcn_update_dpp(0, (int)v, 0x140, 0xF, 0xF, true); }
__device__ __forceinline__ void top16_pair(const float* s1, const float* s2, float& tv, int& ti, const int lane) {
    unsigned a1 = (okey(s1[lane]) & ~0x7Fu) | (unsigned)(127 - lane), b1 = (okey(s1[64 + lane]) & ~0x7Fu) | (unsigned)(63 - lane);
    unsigned a2 = (okey(s2[lane]) & ~0x7Fu) | (unsigned)(127 - lane), b2 = (okey(s2[64 + lane]) & ~0x7Fu) | (unsigned)(63 - lane);
#define PEER_S4(K, J) bitonic_step<K, J>(a1, lane); bitonic_step<K, J>(b1, lane); bitonic_step<K, J>(a2, lane); bitonic_step<K, J>(b2, lane);
    PEER_S4(2, 1) PEER_S4(4, 2) PEER_S4(4, 1) PEER_S4(8, 4) PEER_S4(8, 2) PEER_S4(8, 1) PEER_S4(64, 8) PEER_S4(64, 4) PEER_S4(64, 2) PEER_S4(64, 1)
#undef PEER_S4
    unsigned m1 = max(a1, mirror16(b1)), m2 = max(a2, mirror16(b2));
#define PEER_S2(J) bitonic_step<64, J>(m1, lane); bitonic_step<64, J>(m2, lane);
    PEER_S2(8) PEER_S2(4) PEER_S2(2) PEER_S2(1)
#undef PEER_S2
    const bool odd = (lane & 16) != 0;
    const unsigned own = odd ? m2 : m1, snd = odd ? m1 : m2;
    unsigned c = max(own, (unsigned)__shfl_xor((int)snd, 31));
    bitonic_step<64, 8>(c, lane); bitonic_step<64, 4>(c, lane); bitonic_step<64, 2>(c, lane); bitonic_step<64, 1>(c, lane);
    c = max(c, (unsigned)__shfl_xor((int)c, 47));
    bitonic_step<64, 8>(c, lane); bitonic_step<64, 4>(c, lane); bitonic_step<64, 2>(c, lane); bitonic_step<64, 1>(c, lane);
    ti = 127 - (int)(c & 0x7Fu);
    tv = (odd ? s2 : s1)[ti];
}

#ifndef DUP_PEER
#define DUP_PEER 0
#endif
constexpr int PEER_EID_OFF = 131072, PEER_GATE_OFF = 139264;
#ifndef PGB
#define PGB 8
#endif

__device__ __forceinline__ void peer_unit(const Args& a, const int unit, unsigned char* lds) {
    const bfr* QP = (const bfr*)(a.ws + WS_QP); const bfr* SUBK = (const bfr*)(a.ws + WS_SUBK);
    const unsigned char* PU4 = a.ws + WS_PU; const unsigned char* PV4 = a.ws + WS_PV;
    const bfr* HB = (const bfr*)(a.ws + WS_HB); const float* part = (const float*)(a.ws + WS_PART);
    float* S = (float*)lds; int* EID = (int*)(lds + PEER_EID_OFF); float* GATE = (float*)(lds + PEER_GATE_OFF);
    const int tid = my_tid(), lane = tid & 63, wv = tid >> 6, fr = lane & 15, fq = lane >> 4, t0 = unit * 16;
    for (int rp_ = 0; rp_ < ((DUP_PEER & 1) ? 2 : 1); ++rp_) {
    for (int hc = wv * 2; hc < wv * 2 + 2; ++hc) {
        bf16x8 A[4];
#pragma unroll
        for (int ks = 0; ks < 4; ++ks) A[ks] = *reinterpret_cast<const bf16x8*>(&QP[(size_t)(t0 + fr) * D + hc * 128 + ks * 32 + fq * 8]);
#pragma unroll 2
        for (int nt = 0; nt < 8; ++nt) {
            f32x4 acc = {0.f, 0.f, 0.f, 0.f};
#pragma unroll
            for (int ks = 0; ks < 4; ++ks) {
                const bf16x8 B = *reinterpret_cast<const bf16x8*>(&SUBK[(size_t)(hc * 128 + nt * 16 + fr) * 128 + ks * 32 + fq * 8]);
                acc = __builtin_amdgcn_mfma_f32_16x16x32_bf16(A[ks], B, acc, 0, 0, 0);
            }
#pragma unroll
            for (int j = 0; j < 4; ++j) S[((fq * 4 + j) * 16 + hc) * 128 + nt * 16 + fr] = acc[j];
        }
    }
    __syncthreads();
    for (int job = wv * 16; job < wv * 16 + 16; ++job) {
        const int tok = job >> 3, hh = job & 7;
        const float* s1 = S + (tok * 16 + hh * 2) * 128; const float* s2 = s1 + 128;
        float vv; int ii;
        top16_pair(s1, s2, vv, ii, lane);
        int ci = -1, cj = 0;
        { int base = 0;
#pragma unroll
          for (int i = 0; i < 16; ++i) { const int cnt = 16 / (i + 1); if (lane >= base && lane < base + cnt) { ci = i; cj = lane - base; } base += cnt; } }
        const float a1 = __shfl(vv, ci < 0 ? 0 : ci), b1 = __shfl(vv, 16 + cj);
        unsigned ck = (ci >= 0) ? ((okey(a1 + b1) & ~0xFFu) | (unsigned)(255 - (ci * 16 + cj))) : 0u;
        bitonic64(ck, lane);
        const int cid = 255 - (int)(ck & 0xFFu);
        const int pi = (lane < 16) ? (cid >> 4) : 0, pj = (lane < 16) ? (cid & 15) : 0;
        const float cv = __shfl(vv, pi) + __shfl(vv, 16 + pj);
        const float mx = __shfl(cv, 0);
        float e = (lane < 16) ? __expf(cv - mx) : 0.f;
        float se = e;
#pragma unroll
        for (int o = 1; o < 16; o <<= 1) se += __shfl_xor(se, o);
        const int e1 = __shfl(ii, pi), e2 = __shfl(ii, 16 + pj);
        if (lane < 16) { EID[tok * 128 + hh * 16 + lane] = e1 * 128 + e2; GATE[tok * 128 + hh * 16 + lane] = e * frcp_(se); }
    }
    __syncthreads();
    }
    for (int rp_ = 0; rp_ < ((DUP_PEER & 2) ? 2 : 1); ++rp_)
    for (int tk = wv * 2; tk < wv * 2 + 2; ++tk) {
        const int t = t0 + tk;
        int ln = lane; asm volatile("" : "+v"(ln));
        const float rstd = row_rstd(part, t);
        unsigned q1[4], q2[4]; float h1s, h2s;
        {
            float hf[32]; float am = 0.f;
#pragma unroll
            for (int q = 0; q < 8; ++q) {
                const uint2 xr = *reinterpret_cast<const uint2*>(&HB[(size_t)t * D + q * 256 + ln * 4]);
                const float4 g0 = *reinterpret_cast<const float4*>(&a.in[I_NFG][q * 256 + ln * 4]);
                hf[q * 4] = bflo(xr.x) * rstd * g0.x; hf[q * 4 + 1] = bfhi(xr.x) * rstd * g0.y; hf[q * 4 + 2] = bflo(xr.y) * rstd * g0.z; hf[q * 4 + 3] = bfhi(xr.y) * rstd * g0.w;
                am = fmaxf(am, fmaxf(fmaxf(fabsf(hf[q * 4]), fabsf(hf[q * 4 + 1])), fmaxf(fabsf(hf[q * 4 + 2]), fabsf(hf[q * 4 + 3]))));
            }
            h1s = am * (1.f / 7.f); const float i1 = h1s > 0.f ? frcp_(h1s) : 0.f;
            float qv[32]; float am2 = 0.f;
#pragma unroll
            for (int i = 0; i < 32; ++i) { qv[i] = fminf(fmaxf(__builtin_rintf(hf[i] * i1), -7.f), 7.f); hf[i] -= qv[i] * h1s; am2 = fmaxf(am2, fabsf(hf[i])); }
            q1[0] = pack8_i4(qv); q1[1] = pack8_i4(qv + 8); q1[2] = pack8_i4(qv + 16); q1[3] = pack8_i4(qv + 24);
            h2s = am2 * (1.f / 7.f); const float i2 = h2s > 0.f ? frcp_(h2s) : 0.f;
#pragma unroll
            for (int i = 0; i < 32; ++i) qv[i] = fminf(fmaxf(__builtin_rintf(hf[i] * i2), -7.f), 7.f);
            q2[0] = pack8_i4(qv); q2[1] = pack8_i4(qv + 8); q2[2] = pack8_i4(qv + 16); q2[3] = pack8_i4(qv + 24);
        }
        float coef0 = 0.f, coef1 = 0.f;
#pragma unroll 1
        for (int half = 0; half < 2; ++half) {
            float mydot = 0.f;
#define PEER_LOAD_U(W, SC, E0) _Pragma("unroll") for (int bq = 0; bq < 4; ++bq) { \
                const int eid = EID[tk * 128 + half * 64 + (E0) + bq]; const unsigned char* rowp = PU4 + (size_t)eid * PEER_ROWB; \
                SC[bq] = *reinterpret_cast<const bfr*>(rowp + 1024 + ln * 2); W[bq] = *reinterpret_cast<const uint4*>(rowp + ln * 16); } __builtin_amdgcn_sched_barrier(0);
#define PEER_DOT_U(W, SC, E0) _Pragma("unroll") for (int bq = 0; bq < 4; ++bq) { \
                int a1 = 0, a2 = 0; \
                a1 = __builtin_amdgcn_sdot8((int)W[bq].x, (int)q1[0], a1, false); a2 = __builtin_amdgcn_sdot8((int)W[bq].x, (int)q2[0], a2, false); \
                a1 = __builtin_amdgcn_sdot8((int)W[bq].y, (int)q1[1], a1, false); a2 = __builtin_amdgcn_sdot8((int)W[bq].y, (int)q2[1], a2, false); \
                a1 = __builtin_amdgcn_sdot8((int)W[bq].z, (int)q1[2], a1, false); a2 = __builtin_amdgcn_sdot8((int)W[bq].z, (int)q2[2], a2, false); \
                a1 = __builtin_amdgcn_sdot8((int)W[bq].w, (int)q1[3], a1, false); a2 = __builtin_amdgcn_sdot8((int)W[bq].w, (int)q2[3], a2, false); \
                float p = ((float)a1 * h1s + (float)a2 * h2s) * bf2f(SC[bq]); \
                p = wave_sum(p); if (lane == (E0) + bq) mydot = p; __builtin_amdgcn_sched_barrier(0); }
            {
                uint4 wA[4], wB[4]; bfr sA[4], sB[4];
                PEER_LOAD_U(wA, sA, 0)
#pragma unroll 1
                for (int e0 = 0; e0 < 56; e0 += 8) {
                    PEER_LOAD_U(wB, sB, e0 + 4)
                    PEER_DOT_U(wA, sA, e0)
                    PEER_LOAD_U(wA, sA, e0 + 8)
                    PEER_DOT_U(wB, sB, e0 + 4)
                }
                PEER_LOAD_U(wB, sB, 60)
                PEER_DOT_U(wA, sA, 56)
                PEER_DOT_U(wB, sB, 60)
            }
            const float gl = 0.5f * mydot * (1.f + erff(mydot * 0.7071067811865476f));
            const float cfv = gl * GATE[tk * 128 + half * 64 + lane];
            if (half == 0) coef0 = cfv; else coef1 = cfv;
        }
        h16x2 ov2[16];
#pragma unroll
        for (int j = 0; j < 16; ++j) ov2[j] = h16x2{(_Float16)0.f, (_Float16)0.f};
        {
#define PEER_LOAD_V(W, SC, E0) _Pragma("unroll") for (int bq = 0; bq < 4; ++bq) { \
                const int eid = __builtin_amdgcn_readfirstlane(EID[tk * 128 + (E0) + bq]); const unsigned char* rowp = PV4 + (size_t)eid * PEER_ROWB; \
                SC[bq] = *reinterpret_cast<const bfr*>(rowp + 1024 + ln * 2); W[bq] = *reinterpret_cast<const uint4*>(rowp + ln * 16); } __builtin_amdgcn_sched_barrier(0);
#define PEER_AXPY_V(W, SC, E0) _Pragma("unroll") for (int bq = 0; bq < 4; ++bq) { \
                const float cfl = __int_as_float(__builtin_amdgcn_readlane(__float_as_int(((E0) < 64) ? coef0 : coef1), ((E0) + bq) & 63)); \
                const unsigned dw[4] = {W[bq].x, W[bq].y, W[bq].z, W[bq].w}; const _Float16 ch = (_Float16)(cfl * bf2f(SC[bq])); const h16x2 c2 = {ch, ch}; \
                _Pragma("unroll") for (int d = 0; d < 4; ++d) { \
                    ov2[d * 4 + 0] = c2 * __builtin_amdgcn_cvt_scalef32_pk_f16_fp4(dw[d], 1.0f, 0) + ov2[d * 4 + 0]; \
                    ov2[d * 4 + 1] = c2 * __builtin_amdgcn_cvt_scalef32_pk_f16_fp4(dw[d], 1.0f, 1) + ov2[d * 4 + 1]; \
                    ov2[d * 4 + 2] = c2 * __builtin_amdgcn_cvt_scalef32_pk_f16_fp4(dw[d], 1.0f, 2) + ov2[d * 4 + 2]; \
                    ov2[d * 4 + 3] = c2 * __builtin_amdgcn_cvt_scalef32_pk_f16_fp4(dw[d], 1.0f, 3) + ov2[d * 4 + 3]; } \
                __builtin_amdgcn_sched_barrier(0); }
            uint4 wA[4], wB[4]; bfr sA[4], sB[4];
            PEER_LOAD_V(wA, sA, 0)
#pragma unroll 1
            for (int e0 = 0; e0 < 120; e0 += 8) {
                PEER_LOAD_V(wB, sB, e0 + 4)
                PEER_AXPY_V(wA, sA, e0)
                PEER_LOAD_V(wA, sA, e0 + 8)
                PEER_AXPY_V(wB, sB, e0 + 4)
            }
            PEER_LOAD_V(wB, sB, 124)
            PEER_AXPY_V(wA, sA, 120)
            PEER_AXPY_V(wB, sB, 124)
        }
        float ss = 0.f;
        float hv[32];
        { int l2 = lane; asm volatile("" : "+v"(l2));
#pragma unroll
          for (int q = 0; q < 8; ++q) {
              const uint2 xr = *reinterpret_cast<const uint2*>(&HB[(size_t)t * D + q * 256 + l2 * 4]);
              float4 x0; x0.x = bflo(xr.x); x0.y = bfhi(xr.x); x0.z = bflo(xr.y); x0.w = bfhi(xr.y);
              hv[q * 4 + 0] = x0.x; hv[q * 4 + 1] = x0.y; hv[q * 4 + 2] = x0.z; hv[q * 4 + 3] = x0.w;
          } }
#pragma unroll
        for (int j = 0; j < 32; ++j) { hv[j] += (DBG_NOPEER ? 0.f : (float)ov2[j >> 1][j & 1]); ss += hv[j] * hv[j]; }
        ss = wave_sum(ss);
        const float r2 = rsqrtf(ss * (1.f / D) + EPS);
#pragma unroll
        for (int q = 0; q < 8; ++q) {
            const float4 g0 = *reinterpret_cast<const float4*>(&a.in[I_NFIN][q * 256 + ln * 4]);
            float4 o0;
            o0.x = hv[q * 4 + 0] * r2 * g0.x; o0.y = hv[q * 4 + 1] * r2 * g0.y; o0.z = hv[q * 4 + 2] * r2 * g0.z; o0.w = hv[q * 4 + 3] * r2 * g0.w;
            *reinterpret_cast<float4*>(&a.out[(size_t)t * D + q * 256 + ln * 4]) = o0;
        }
    }
    __syncthreads();
}
constexpr int NPHASE = 9;
__global__ void __launch_bounds__(512, 2) mk_fwd(Args a) {
    extern __shared__ __attribute__((aligned(16))) unsigned char lds[];
    volatile LAS unsigned* barw = (volatile LAS unsigned*)((LAS unsigned char*)lds + LDS_BARW);
    unsigned* MISC = (unsigned*)(lds + LDS_MISC);
    if (threadIdx.x < 4) barw[threadIdx.x] = 0u;
    __syncthreads();
    XcdBarrier bar; bar.bar = (unsigned*)(a.ws + WS_CTL); bar.x = 0; bar.st = barw;
#if !MK_SPLIT
    bar = xcd_barrier_post((unsigned*)(a.ws + WS_CTL), barw);
#endif
    const int lo = a.ph_lo, hi = a.ph_hi;
#ifndef PH_MASK
#define PH_MASK 0x1FF
#endif
#define IN(k) (((PH_MASK >> (k)) & 1) && lo <= (k) && (k) < hi)
#ifndef DUP_RW
#define DUP_RW 0
#endif
#ifndef DUP_CHAIN
#define DUP_CHAIN 0
#endif
#ifndef DUP_MASK
#define DUP_MASK 0
#endif
#define REP(k) for (int rep_ = 0; rep_ < (((DUP_MASK >> (k)) & 1) ? 2 : 1); ++rep_)
#define SEAM(k) do { if (IN(k) && IN((k) + 1)) xcd_barrier(bar); } while (0)
    unsigned char* ws = a.ws;
    const bfr* P = (const bfr*)(ws + WS_P);

    if (IN(0)) REP(0) {
        const int tid = my_tid(), wv = tid >> 6; (void)tid; (void)wv;
        {
            const float* x = a.in[I_X]; const float* g = a.in[I_NMG]; bfr* XN = (bfr*)(ws + WS_XN);
            const int lane = tid & 63;
            for (int row = blockIdx.x * 8 + wv; row < T; row += gridDim.x * 8) {
                float4 v[8]; float ss = 0.f;
#pragma unroll
                for (int j = 0; j < 8; ++j) { v[j] = reinterpret_cast<const float4*>(x + (size_t)row * D)[j * 64 + lane]; ss += v[j].x * v[j].x + v[j].y * v[j].y + v[j].z * v[j].z + v[j].w * v[j].w; }
                ss = wave_sum(ss);
                const float rs = rsqrtf(ss * (1.f / D) + EPS);
#pragma unroll
                for (int j = 0; j < 8; ++j) {
                    const float4 gg = reinterpret_cast<const float4*>(g)[j * 64 + lane];
                    uint2 o; o.x = pack2(v[j].x * rs * gg.x, v[j].y * rs * gg.y); o.y = pack2(v[j].z * rs * gg.z, v[j].w * rs * gg.w);
                    reinterpret_cast<uint2*>(XN + (size_t)row * D)[j * 64 + lane] = o;
                }
            }
        }
        float* tl = (float*)lds;
        tr_all(a.in[I_WIN], (bfr*)(ws + WS_WTIN), D, NIN, NINP, nullptr, tl);
        tr_all(a.in[I_WBR], (bfr*)(ws + WS_WTA), RW, D, D, nullptr, tl);
        tr_all(a.in[I_WBD], (bfr*)(ws + WS_WTB), RW, D, D, nullptr, tl);
        tr_all(a.in[I_WOUT], (bfr*)(ws + WS_WTOUT), D, D, D, nullptr, tl);
        tr_all(a.in[I_WPQ], (bfr*)(ws + WS_WTPQ), D, D, D, a.in[I_NFG], tl);
        for (int it = blockIdx.x; it < 16 * 4; it += gridDim.x) {
            const int h = it >> 2, k0 = (it & 3) * 64;
            tr_tile(a.in[I_WUV] + (size_t)h * 256 * 64, (bfr*)(ws + WS_WUVT) + (size_t)h * 64 * 256, 256, 64, k0, 0, nullptr, tl);
        }
        cvt_all(a.in[I_WUK], (bfr*)(ws + WS_WUK), (size_t)16 * 256 * 64);
        cvt_all(a.in[I_SUBK], (bfr*)(ws + WS_SUBK), (size_t)16 * 128 * 128);
    }
    SEAM(0);

    if (IN(1)) REP(1) {
        const int tid = my_tid(), wv = tid >> 6; (void)tid; (void)wv;
        EpiP E{(bfr*)(ws + WS_P)};
        const int nM = T / BM, nN = NINP / BM;
        for (int tile = blockIdx.x; tile < nM * nN; tile += gridDim.x) {
            int brow, bcol; tile_rc(tile, nM, nN, brow, bcol);
            gemm_tile((const bfr*)(ws + WS_XN), (const bfr*)(ws + WS_WTIN), D, brow, bcol, (bfr*)lds, E);
        }
        {
            const int rem = (nM * nN) % (int)gridDim.x, idle = (int)gridDim.x - rem;
            if (rem == 0) cvt_i4_rows(a.in[I_PU], ws + WS_PU, blockIdx.x, gridDim.x);
            else if ((int)blockIdx.x >= rem) cvt_i4_rows(a.in[I_PU], ws + WS_PU, (int)blockIdx.x - rem, idle);
        }
    }
    SEAM(1);

    if (IN(2)) REP(2) {
        const int tid = my_tid(), wv = tid >> 6; (void)tid; (void)wv;
        rwkv_load_weights(a, blockIdx.x & 15, lds);
        {
            const int h = blockIdx.x & 15, nun = (NUNIT - (int)blockIdx.x + (int)gridDim.x - 1) / (int)gridDim.x;
            RwIn inA, inB;
            if (nun > 0) rwkv_fetch(a, (int)blockIdx.x >> 4, h, inA);
            for (int k = 0; k < nun; k += 2) {
                const int c0 = ((int)blockIdx.x + k * (int)gridDim.x) >> 4, c1 = ((int)blockIdx.x + (k + 1) * (int)gridDim.x) >> 4, c2 = ((int)blockIdx.x + (k + 2) * (int)gridDim.x) >> 4;
                rwkv_unit(a, c0, h, lds, inA, inB, (k + 1 < nun) ? c1 : -1);
                if (k + 1 < nun) rwkv_unit(a, c1, h, lds, inB, inA, (k + 2 < nun) ? c2 : -1);
            }
        }
        dsa_cnorm(a);
        dsa_qlat(a);
    }
    SEAM(2);

    if (IN(3)) REP(3) {
        const int tid = my_tid(), wv = tid >> 6; (void)tid; (void)wv;
        if (blockIdx.x < 32) {
            if (wv == 0) rwkv_chain(a, blockIdx.x >> 1, blockIdx.x & 1);
            else cvt_fp4_rows(a.in[I_PV], ws + WS_PV, (int)blockIdx.x * 7 + (wv - 1), 32 * 7);
        }
        __syncthreads();
        for (int i = tid; i < 512; i += 512) ((float*)(lds + DSA_RELB_OFF))[i] = a.in[I_RELB][i];
        __syncthreads();
        unsigned* cnt = (unsigned*)(ws + WS_CTL + CTL_CNT) + rep_ * 64;
        for (;;) {
            if (tid == 0) MISC[0] = atomicAdd(cnt, 1u);
            __syncthreads();
            const unsigned n = MISC[0];
            __syncthreads();
            if (n >= T / 8) break;
            dsa_unit(a, (T / 8 - 1) - (int)n, lds);
        }
    }
    SEAM(3);

    if (IN(4)) REP(4) {
        const int tid = my_tid(), wv = tid >> 6; (void)tid; (void)wv;
        float* Ls = (float*)lds + wv * 4352;
        for (int u = blockIdx.x * 8 + wv; u < NUNIT; u += gridDim.x * 8) rwkv_out_unit(a, u, Ls);
        dsa_oproj(a);
    }
    SEAM(4);

    if (IN(5)) REP(5) {
        const int tid = my_tid(), wv = tid >> 6; (void)tid; (void)wv;
        const int nM = T / BM, nN = D / BM;
        for (int tile = blockIdx.x; tile < nM * nN; tile += gridDim.x) {
            int brow, bcol; tile_rc(tile, nM, nN, brow, bcol);
#pragma unroll 1
            for (int pass = 0; pass < 2; ++pass) {
                EpiMix E{(bfr*)(ws + (pass ? WS_MIX : WS_TMPA)), pass ? (const bfr*)(ws + WS_TMPA) : (const bfr*)nullptr, P + (pass ? C_GB : C_GA)};
                gemm_tile((const bfr*)(ws + (pass ? WS_DO : WS_RWO)), (const bfr*)(ws + (pass ? WS_WTB : WS_WTA)), RW, brow, bcol, (bfr*)lds, E);
                asm volatile("s_waitcnt vmcnt(0)" ::: "memory");
            }
        }
    }
    SEAM(5);

    if (IN(6)) REP(6) {
        const int tid = my_tid(), wv = tid >> 6; (void)tid; (void)wv;
        const int nM = T / BM, nN = D / BM;
        for (int tile = blockIdx.x; tile < nM * nN; tile += gridDim.x) {
            int brow, bcol; tile_rc(tile, nM, nN, brow, bcol);
            EpiH E{(bfr*)(ws + WS_HB), a.in[I_X], (float*)(ws + WS_PART), bcol >> 8};
            gemm_tile((const bfr*)(ws + WS_MIX), (const bfr*)(ws + WS_WTOUT), D, brow, bcol, (bfr*)lds, E);
        }
    }
    SEAM(6);

    if (IN(7)) REP(7) {
        const int tid = my_tid(), wv = tid >> 6; (void)tid; (void)wv;
        const int nM = T / BM, nN = D / BM;
        float* rs = (float*)(lds + 135168);
        for (int tile = blockIdx.x; tile < nM * nN; tile += gridDim.x) {
            int brow, bcol; tile_rc(tile, nM, nN, brow, bcol);
            if (tid < 256) rs[tid] = row_rstd((const float*)(ws + WS_PART), brow + tid);
            __syncthreads();
            EpiQ E{(bfr*)(ws + WS_QP), rs, brow};
            gemm_tile((const bfr*)(ws + WS_HB), (const bfr*)(ws + WS_WTPQ), D, brow, bcol, (bfr*)lds, E);
        }
    }
    SEAM(7);

    if (IN(8)) REP(8) {
        const int tid = my_tid(), wv = tid >> 6; (void)tid; (void)wv;
        for (int u = blockIdx.x; u < T / 16; u += gridDim.x) peer_unit(a, u, lds);
    }
#undef IN
#undef SEAM
}

extern "C" void kernel_launch(void* const* d_in, const int* in_sizes, int n_in, void* d_out, int out_size, void* d_ws, size_t ws_size, hipStream_t stream) {
    static int grid = 0;
    if (grid == 0) {
        if (n_in != 27 || out_size != T * D || ws_size < WS_END) { fprintf(stderr, "kernel_launch: unexpected shapes (n_in %d out %d ws %zu)\n", n_in, out_size, ws_size); grid = -1; return; }
        int dev = 0, cus = 0, per_cu = 0;
        if (hipGetDevice(&dev) != hipSuccess || hipDeviceGetAttribute(&cus, hipDeviceAttributeMultiprocessorCount, dev) != hipSuccess) { grid = -1; return; }
        if (hipFuncSetAttribute((const void*)mk_fwd, hipFuncAttributeMaxDynamicSharedMemorySize, LDS_BYTES) != hipSuccess) { fprintf(stderr, "kernel_launch: hipFuncSetAttribute failed\n"); grid = -1; return; }
        if (hipOccupancyMaxActiveBlocksPerMultiprocessor(&per_cu, (const void*)mk_fwd, 512, LDS_BYTES) != hipSuccess || per_cu < 1) { fprintf(stderr, "kernel_launch: occupancy query says %d\n", per_cu); (void)hipGetLastError(); grid = -1; return; }
        grid = cus;
    }
    if (grid < 0) return;
    if (hipMemsetAsync((char*)d_ws + WS_CTL, 0, CTL_ZERO, stream) != hipSuccess) return;
    Args a{};
    for (int i = 0; i < 27; ++i) a.in[i] = (const float*)d_in[i];
    a.out = (float*)d_out; a.ws = (unsigned char*)d_ws;
#if MK_SPLIT
    for (int ph = 0; ph < NPHASE; ++ph) { a.ph_lo = ph; a.ph_hi = ph + 1; hipLaunchKernelGGL(mk_fwd, dim3(grid), dim3(512), LDS_BYTES, stream, a); }
#elif defined(PROBE_PHASE)
    a.ph_lo = 0; a.ph_hi = PROBE_PHASE + 1;
    hipLaunchKernelGGL(mk_fwd, dim3(grid), dim3(512), LDS_BYTES, stream, a);
    (void)hipMemsetAsync((char*)d_ws + WS_CTL, 0, CTL_ZERO, stream);
    a.ph_lo = PROBE_PHASE; a.ph_hi = NPHASE;
    hipLaunchKernelGGL(mk_fwd, dim3(grid), dim3(512), LDS_BYTES, stream, a);
#else
    a.ph_lo = 0; a.ph_hi = NPHASE;
    hipLaunchKernelGGL(mk_fwd, dim3(grid), dim3(512), LDS_BYTES, stream, a);
#endif
}
```

```cpp
#include <hip/hip_runtime.h>
#include <stdint.h>
#include <stdio.h>

#ifndef MK_SPLIT
#define MK_SPLIT 0
#endif

#ifndef DBG_NOPEER
#define DBG_NOPEER 0
#endif
#ifndef DBG_NODSA
#define DBG_NODSA 0
#endif
typedef unsigned short bfr;
using bf16x8 = __attribute__((ext_vector_type(8))) short;
using bf16x4 = __attribute__((ext_vector_type(4))) short;
using f32x4  = __attribute__((ext_vector_type(4))) float;
using f32x2  = __attribute__((ext_vector_type(2))) float;
using f32x16 = __attribute__((ext_vector_type(16))) float;
using u32x4  = __attribute__((ext_vector_type(4))) unsigned;
using h16x2  = __attribute__((ext_vector_type(2))) _Float16;

constexpr int T = 8192, D = 2048, NIN = 9320, NINP = 9472;
constexpr int RW = 1024, NH = 16, HD = 64;
constexpr int C_R = 0, C_K = 1024, C_V = 2048, C_ZW = 3072, C_ZA = 3136, C_ZG = 3200, C_Q = 3360, C_CKV = 4384,
              C_IQ = 4640, C_IK = 5152, C_IW = 5216, C_GA = 5224, C_GB = 7272;
constexpr int KVR = 256, NUNIT = 128 * 16;
constexpr float EPS = 1e-6f;

constexpr size_t MiB = 1u << 20;
constexpr size_t WS_CTL = 0;
constexpr size_t CTL_ZERO = 65536;
constexpr size_t CTL_CNT = 16384;
constexpr size_t CTL_ROWSS = 32768;
constexpr size_t WS_WTA = 1 * MiB, WS_WTB = 5 * MiB, WS_WTOUT = 9 * MiB, WS_WTPQ = 17 * MiB;
constexpr size_t WS_WUK = 25 * MiB, WS_WUVT = 25 * MiB + 512 * 1024, WS_SUBK = 26 * MiB;
constexpr size_t WS_X = 27 * MiB;
constexpr size_t WS_XN = WS_X, WS_WTIN = WS_X + 32 * MiB;
constexpr size_t WS_PM = WS_X, WS_WY = WS_X + 16 * MiB, WS_GM = WS_X + 32 * MiB, WS_YLOC = WS_X + 48 * MiB;
constexpr size_t WS_MIX = WS_X;
constexpr size_t WS_P = 96 * MiB;
constexpr size_t WS_H = 96 * MiB, WS_HB = 160 * MiB, WS_QP = 192 * MiB;
constexpr size_t WS_GG = 244 * MiB, WS_BON = 260 * MiB, WS_CB = 276 * MiB;
#ifdef OLAT_SEP
constexpr size_t WS_QLAT = 280 * MiB, WS_OLAT = 456 * MiB;
#else
constexpr size_t WS_QLAT = 280 * MiB, WS_OLAT = WS_QLAT;
#endif
constexpr size_t WS_KEYS = 344 * MiB;
constexpr size_t WS_PU = 490 * MiB, WS_PV = 312 * MiB;
constexpr size_t WS_PUS = WS_PU + 32 * MiB, WS_PVS = WS_PV + 32 * MiB;
constexpr size_t WS_ZT = 408 * MiB, WS_RWO = 424 * MiB, WS_DO = 440 * MiB, WS_TMPA = 456 * MiB;
constexpr size_t WS_IKC = 489 * MiB;
constexpr size_t WS_PART = 488 * MiB;
constexpr size_t WS_END = 508 * MiB;

constexpr int LDS_BYTES = 163840 - 1024;
constexpr int LDS_BARW = LDS_BYTES - 64;
constexpr int LDS_MISC = LDS_BYTES - 512;

typedef __bf16 bf16v2_t __attribute__((ext_vector_type(2)));
__device__ __forceinline__ bfr f2bf(float f) { const __bf16 r = (__bf16)f; return __builtin_bit_cast(bfr, r); }
__device__ __forceinline__ float bf2f(bfr b) { return __uint_as_float(((unsigned)b) << 16); }
__device__ __forceinline__ unsigned pack2(float a, float b) { const f32x2 v = {a, b}; const bf16v2_t r = __builtin_convertvector(v, bf16v2_t); return __builtin_bit_cast(unsigned, r); }
__device__ __forceinline__ float bflo(unsigned u) { return __uint_as_float(u << 16); }
__device__ __forceinline__ float bfhi(unsigned u) { return __uint_as_float(u & 0xFFFF0000u); }
__device__ __forceinline__ int my_tid() { int t = threadIdx.x; asm volatile("" : "+v"(t)); return t; }

template <int CTRL> __device__ __forceinline__ float dpp_f(float v) {
    return __int_as_float(__builtin_amdgcn_update_dpp(0, __float_as_int(v), CTRL, 0xF, 0xF, true));
}
#define DPP_XOR1 0xB1
#define DPP_XOR2 0x4E
__device__ __forceinline__ float wave_sum(float v) {
    v += dpp_f<DPP_XOR1>(v); v += dpp_f<DPP_XOR2>(v); v += dpp_f<0x141>(v); v += dpp_f<0x140>(v);
    v += __shfl_xor(v, 16); v += __shfl_xor(v, 32); return v;
}
__device__ __forceinline__ float frcp_(float x) { return __builtin_amdgcn_rcpf(x); }
__device__ __forceinline__ float sigmoidf_(float x) { return frcp_(1.f + __expf(-x)); }

#define XB_TMO      128
#define XB_XCNT(j)  (256  + 64 * (j))
#define XB_XSUB(j)  (1280 + 64 * (j))
#define XB_XGEN(j)  (2304 + 64 * (j))
#define XB_TOP      3328
#define XB_TOPGEN   3392
#define XCD_BAR_WORDS 3456
#define XB_SPIN_CAP (1u << 20)
#define LAS __attribute__((address_space(3)))

__device__ __forceinline__ unsigned xb_ld(unsigned* p)              { return __hip_atomic_load(p, __ATOMIC_RELAXED, __HIP_MEMORY_SCOPE_AGENT); }
__device__ __forceinline__ unsigned xb_add(unsigned* p, unsigned v) { return __hip_atomic_fetch_add(p, v, __ATOMIC_RELAXED, __HIP_MEMORY_SCOPE_AGENT); }
__device__ __forceinline__ unsigned xb_xcc_id() { return (unsigned)__builtin_amdgcn_s_getreg((3 << 11) | 20) & 0xFu; }
#define XB_SPIN(cond, bar) do { unsigned _sp = 0; while (cond) { __builtin_amdgcn_s_sleep(1); \
    if ((++_sp & 255u) == 0u) { if (xb_ld(&(bar)[XB_TMO])) break; if (_sp > XB_SPIN_CAP) { atomicAdd(&(bar)[XB_TMO], 1u); break; } } } } while (0)

struct XcdBarrier { unsigned* bar; unsigned x; volatile LAS unsigned* st; };

__device__ __forceinline__ XcdBarrier xcd_barrier_post(unsigned* bar, volatile LAS unsigned* st) {
    XcdBarrier b; b.bar = bar; b.x = xb_xcc_id(); b.st = st;
    if (threadIdx.x == 0) (void)xb_add(&bar[XB_XCNT(b.x)], 1u);
    return b;
}
__device__ __forceinline__ void xcd_barrier_complete(unsigned* bar, unsigned x, unsigned& nloc, unsigned& nx) {
    const unsigned G = gridDim.x * gridDim.y * gridDim.z;
    unsigned sum, cnt, mine, sp = 0u;
    for (;;) {
        sum = 0u; cnt = 0u; mine = 0u;
#pragma unroll
        for (unsigned j = 0; j < 16; ++j) { const unsigned c = xb_ld(&bar[XB_XCNT(j)]); sum += c; cnt += (c > 0u) ? 1u : 0u; mine = (j == x) ? c : mine; }
        if (sum == G) break;
        __builtin_amdgcn_s_sleep(1);
        if ((++sp & 255u) == 0u) { if (xb_ld(&bar[XB_TMO])) break; if (sp > XB_SPIN_CAP) { atomicAdd(&bar[XB_TMO], 1u); break; } }
    }
    nloc = mine > 0u ? mine : 1u; nx = cnt > 0u ? cnt : 1u;
}
__device__ __forceinline__ void xcd_barrier(const XcdBarrier& b) {
    asm volatile("s_waitcnt vmcnt(0)" ::: "memory");
    __syncthreads();
    if (threadIdx.x == 0) {
        unsigned* bar = b.bar;
        __builtin_amdgcn_s_waitcnt(0);
        unsigned nloc = b.st[0], nx = b.st[1];
        if (nloc == 0u) { xcd_barrier_complete(bar, b.x, nloc, nx); b.st[0] = nloc; b.st[1] = nx; }
        const unsigned old = xb_add(&bar[XB_XSUB(b.x)], 1u);
        const unsigned gen = old / nloc;
        if (old + 1u == (gen + 1u) * nloc) {
            __builtin_amdgcn_fence(__ATOMIC_RELEASE, "agent");
            asm volatile("s_waitcnt vmcnt(0)" ::: "memory");
            const unsigned og = xb_add(&bar[XB_TOP], 1u);
            const unsigned tg = og / nx;
            if (og + 1u == (tg + 1u) * nx) xb_add(&bar[XB_TOPGEN], 1u);
            else XB_SPIN(xb_ld(&bar[XB_TOPGEN]) == tg, bar);
            __builtin_amdgcn_fence(__ATOMIC_ACQUIRE, "agent");
            xb_add(&bar[XB_XGEN(b.x)], 1u);
            asm volatile("s_waitcnt vmcnt(0)" ::: "memory");
        } else {
            XB_SPIN(xb_ld(&bar[XB_XGEN(b.x)]) == gen, bar);
            __builtin_amdgcn_fence(__ATOMIC_ACQUIRE, "agent");
            asm volatile("s_waitcnt vmcnt(0)" ::: "memory");
        }
    }
    __syncthreads();
}

struct Args { const float* in[27]; float* out; unsigned char* ws; int ph_lo, ph_hi; };
enum { I_X = 0, I_NMG, I_WIN, I_SHIFT, I_W0, I_WDEC, I_A0, I_WICL, I_WGATE, I_KK, I_KA, I_RK, I_LNW, I_LNB, I_KVG, I_WUK, I_WUV,
       I_RELB, I_WBR, I_WBD, I_WOUT, I_NFG, I_WPQ, I_SUBK, I_PU, I_PV, I_NFIN };

constexpr int BM = 256, BK = 64, HALF = 128, HT = HALF * BK;
constexpr int EPI_LDW = 260;
__device__ __forceinline__ int lds_byte(int r, int c) {
    int st = (r >> 4) * 2 + (c >> 5), rr = r & 15, cc = c & 31, ob = rr * 64 + cc * 2;
    return st * 1024 + (ob ^ (((ob >> 9) & 1) << 5));
}
__device__ __forceinline__ void stage_rc(int b, int& R, int& C) {
    int st = b / 1024, sb = b % 1024, swz = sb ^ (((sb >> 9) & 1) << 5);
    R = (st >> 1) * 16 + swz / 64; C = (st & 1) * 32 + (swz % 64) / 2;
}

template <class Epi>
__device__ __forceinline__ void gemm_tile(const bfr* __restrict__ A, const bfr* __restrict__ Bt, const int K, const int brow, const int bcol,
                                          bfr* shm, Epi& epi) {
#define SA(b,h) (shm+((b)*2+(h))*HT)
#define SB(b,h) (shm+(4+(b)*2+(h))*HT)
#define STAGE_X(TT,P,BASE,br,kt) do{long _g=(long)(br)*K+(long)(kt)*BK; \
    for(int _i=0;_i<2;++_i){int _b=(TT)*16+_i*8192;int _r,_c;stage_rc(_b,_r,_c); \
      __builtin_amdgcn_global_load_lds((const unsigned*)(BASE+_g+(long)_r*K+_c), \
        (LAS unsigned*)((LAS char*)(P)+_b),16,0,0);}}while(0)
#define STAGE(P,BASE,br,kt) STAGE_X(tq,P,BASE,br,kt)
#define LDA(dst,b,h) for(int m=0;m<4;++m)for(int k=0;k<2;++k) \
    dst[m][k]=*reinterpret_cast<const bf16x8*>((char*)SA(b,h)+lds_byte(wr*64+m*16+fr,k*32+fq*8))
#define LDB(dst,b,h) for(int n=0;n<2;++n)for(int k=0;k<2;++k) \
    dst[n][k]=*reinterpret_cast<const bf16x8*>((char*)SB(b,h)+lds_byte(wc*32+n*16+fr,k*32+fq*8))
#define MMA(ai,bj,At_,Bt_) do{__builtin_amdgcn_s_setprio(1); \
    for(int m=0;m<4;++m)for(int n=0;n<2;++n)for(int k=0;k<2;++k) \
      acc[ai][bj][m][n]=__builtin_amdgcn_mfma_f32_16x16x32_bf16(At_[m][k],Bt_[n][k],acc[ai][bj][m][n],0,0,0); \
    __builtin_amdgcn_s_setprio(0);}while(0)
#define WAIT_V(n) asm volatile("s_waitcnt vmcnt(" #n ")":::"memory")
#define WAIT_L(n) asm volatile("s_waitcnt lgkmcnt(" #n ")":::"memory")
#define BAR __builtin_amdgcn_s_barrier()
#define SCHED __builtin_amdgcn_sched_barrier(0)
    const int tq = my_tid();
    int wid = tq >> 6, lane = tq & 63, wr = wid >> 2, wc = wid & 3, fr = lane & 15, fq = lane >> 4;
    f32x4 acc[2][2][4][2] = {};
    bf16x8 At[4][2], B0[2][2], B1[2][2];
    const int nt = K / BK;
    STAGE(SB(0,0),Bt,bcol,0); STAGE(SA(0,0),A,brow,0);
    STAGE(SB(0,1),Bt,bcol+HALF,0); STAGE(SA(0,1),A,brow+HALF,0);
    if(wr==1)BAR;
    WAIT_V(4); BAR;
    STAGE(SB(1,0),Bt,bcol,1); STAGE(SA(1,0),A,brow,1); STAGE(SB(1,1),Bt,bcol+HALF,1);
    WAIT_V(6); BAR;
    for(int t=0;t<nt-2;t+=2){
        LDB(B0,0,0); SCHED; LDA(At,0,0); STAGE(SA(1,1),A,brow+HALF,t+1);
        WAIT_L(8); BAR; WAIT_L(0); MMA(0,0,At,B0); BAR; SCHED;
        LDB(B1,0,1); STAGE(SB(0,0),Bt,bcol,t+2);
        BAR; WAIT_L(0); MMA(0,1,At,B1); BAR;
        LDA(At,0,1); STAGE(SA(0,0),A,brow,t+2);
        BAR; WAIT_L(0); MMA(1,0,At,B0); BAR; SCHED;
        STAGE(SB(0,1),Bt,bcol+HALF,t+2);
        WAIT_V(6); BAR; MMA(1,1,At,B1); BAR;
        LDB(B0,1,0); SCHED; LDA(At,1,0); STAGE(SA(0,1),A,brow+HALF,t+2);
        WAIT_L(8); BAR; WAIT_L(0); MMA(0,0,At,B0); BAR; SCHED;
        LDB(B1,1,1); STAGE(SB(1,0),Bt,bcol,t+3);
        BAR; WAIT_L(0); MMA(0,1,At,B1); BAR;
        LDA(At,1,1); STAGE(SA(1,0),A,brow,t+3);
        BAR; WAIT_L(0); MMA(1,0,At,B0); BAR; SCHED;
        STAGE(SB(1,1),Bt,bcol+HALF,t+3);
        WAIT_V(6); BAR; MMA(1,1,At,B1); BAR;
    }
    int tz=threadIdx.x; asm volatile("":"+v"(tz)); wid=tz>>6; lane=tz&63; wr=wid>>2; wc=wid&3; fr=lane&15; fq=lane>>4;
    { LDB(B0,0,0); WAIT_V(0); LDA(At,0,0); STAGE_X(tz,SA(1,1),A,brow+HALF,nt-1);
      BAR; WAIT_L(0); MMA(0,0,At,B0); BAR;
      LDB(B1,0,1); BAR; WAIT_L(0); MMA(0,1,At,B1); BAR;
      LDA(At,0,1); WAIT_V(4); BAR; WAIT_L(0); MMA(1,0,At,B0); MMA(1,1,At,B1); BAR; }
    { LDB(B0,1,0); LDA(At,1,0); WAIT_V(2); BAR; WAIT_L(0); MMA(0,0,At,B0); BAR;
      LDB(B1,1,1); WAIT_V(0); BAR; WAIT_L(0); MMA(0,1,At,B1); BAR;
      LDA(At,1,1); BAR; WAIT_L(0); MMA(1,0,At,B0); MMA(1,1,At,B1); BAR; }
    if(wr==0)BAR;
    {
        float* stg = (float*)shm;
#pragma unroll
        for (int ai = 0; ai < 2; ++ai) {
            __syncthreads();
#pragma unroll
            for (int bj = 0; bj < 2; ++bj)
#pragma unroll
                for (int m = 0; m < 4; ++m)
#pragma unroll
                    for (int n = 0; n < 2; ++n)
#pragma unroll
                        for (int j = 0; j < 4; ++j) stg[(wr * 64 + m * 16 + fq * 4 + j) * EPI_LDW + bj * HALF + wc * 32 + n * 16 + fr] = acc[ai][bj][m][n][j];
            __syncthreads();
#pragma unroll 2
            for (int it = 0; it < 8; ++it) {
                const int r = it * 16 + wid * 2 + (lane >> 5), c = (lane & 31) * 8;
                const float4 v0 = *reinterpret_cast<const float4*>(&stg[r * EPI_LDW + c]);
                const float4 v1 = *reinterpret_cast<const float4*>(&stg[r * EPI_LDW + c + 4]);
                const float v[8] = {v0.x, v0.y, v0.z, v0.w, v1.x, v1.y, v1.z, v1.w};
                epi.vec8(brow + ai * HALF + r, bcol + c, v);
            }
        }
    }
    __syncthreads();
#undef SA
#undef SB
#undef STAGE_X
#undef STAGE
#undef LDA
#undef LDB
#undef MMA
}

__device__ __forceinline__ void tile_rc(int wgid, const int nM, const int nN, int& brow, int& bcol) {
    const int nwg = nM * nN;
    { int q = nwg / 8, r = nwg % 8, xcd = wgid % 8, off = wgid / 8; wgid = (xcd < r ? xcd * (q + 1) : r * (q + 1) + (xcd - r) * q) + off; }
    const int nig = 8 * nN, gid = wgid / nig, fm = gid * 8, gsz = min(nM - fm, 8);
    const int pm = fm + ((wgid % nig) % gsz), pn = (wgid % nig) / gsz;
    brow = pm * BM; bcol = pn * BM;
}

__device__ __forceinline__ uint4 pack8(const float* v) { uint4 o; o.x = pack2(v[0], v[1]); o.y = pack2(v[2], v[3]); o.z = pack2(v[4], v[5]); o.w = pack2(v[6], v[7]); return o; }
__device__ __forceinline__ void unpack8(const uint4 u, float* v) { v[0] = bflo(u.x); v[1] = bfhi(u.x); v[2] = bflo(u.y); v[3] = bfhi(u.y); v[4] = bflo(u.z); v[5] = bfhi(u.z); v[6] = bflo(u.w); v[7] = bfhi(u.w); }
struct EpiP {
    bfr* P;
    __device__ __forceinline__ void vec8(int row, int col, const float* v) { *reinterpret_cast<uint4*>(&P[(size_t)row * NINP + col]) = pack8(v); }
};
struct EpiMix {
    bfr* outp; const bfr* addp; const bfr* gate;
    __device__ __forceinline__ void vec8(int row, int col, const float* v) {
        float g[8], r[8];
        unpack8(*reinterpret_cast<const uint4*>(&gate[(size_t)row * NINP + col]), g);
#pragma unroll
        for (int i = 0; i < 8; ++i) r[i] = sigmoidf_(g[i]) * v[i];
        if (addp) { float t[8]; unpack8(*reinterpret_cast<const uint4*>(&addp[(size_t)row * D + col]), t);
#pragma unroll
            for (int i = 0; i < 8; ++i) r[i] += t[i]; }
        *reinterpret_cast<uint4*>(&outp[(size_t)row * D + col]) = pack8(r);
    }
};
struct EpiH {
    bfr* hb; const float* x; float* part; int slot;
    __device__ __forceinline__ void vec8(int row, int col, const float* v) {
        const float4 x0 = *reinterpret_cast<const float4*>(&x[(size_t)row * D + col]), x1 = *reinterpret_cast<const float4*>(&x[(size_t)row * D + col + 4]);
        float h[8] = {x0.x + v[0], x0.y + v[1], x0.z + v[2], x0.w + v[3], x1.x + v[4], x1.y + v[5], x1.z + v[6], x1.w + v[7]};
        *reinterpret_cast<uint4*>(&hb[(size_t)row * D + col]) = pack8(h);
        float s = 0.f;
#pragma unroll
        for (int i = 0; i < 8; ++i) s += h[i] * h[i];
        s += dpp_f<DPP_XOR1>(s); s += dpp_f<DPP_XOR2>(s); s += dpp_f<0x141>(s); s += dpp_f<0x140>(s);
        s += __shfl_xor(s, 16);
        if ((threadIdx.x & 31) == 0) part[(size_t)row * 8 + slot] = s;
    }
};
struct EpiQ {
    bfr* qp; const float* rs; int brow;
    __device__ __forceinline__ void vec8(int row, int col, const float* v) {
        const float sc = rs[row - brow]; float r[8];
#pragma unroll
        for (int i = 0; i < 8; ++i) r[i] = v[i] * sc;
        *reinterpret_cast<uint4*>(&qp[(size_t)row * D + col]) = pack8(r);
    }
};
__device__ __forceinline__ float row_rstd(const float* part, int row) {
    float s = 0.f;
#pragma unroll
    for (int i = 0; i < 8; ++i) s += part[(size_t)row * 8 + i];
    return rsqrtf(s * (1.f / D) + EPS);
}

__device__ __forceinline__ void tr_tile(const float* __restrict__ src, bfr* __restrict__ dst, int K, int N, int k0, int n0, const float* kscale, float* lds) {
    const int tid = my_tid(), n = tid & 63, kk = tid >> 6;
#pragma unroll
    for (int j = 0; j < 8; ++j) { int k = kk + 8 * j, gn = n0 + n; float v = (gn < N) ? src[(size_t)(k0 + k) * N + gn] : 0.f; if (kscale) v *= kscale[k0 + k]; lds[k * 65 + n] = v; }
    __syncthreads();
    const int nn = tid >> 3, ks = tid & 7;
    uint4 o;
    o.x = pack2(lds[(ks * 8 + 0) * 65 + nn], lds[(ks * 8 + 1) * 65 + nn]); o.y = pack2(lds[(ks * 8 + 2) * 65 + nn], lds[(ks * 8 + 3) * 65 + nn]);
    o.z = pack2(lds[(ks * 8 + 4) * 65 + nn], lds[(ks * 8 + 5) * 65 + nn]); o.w = pack2(lds[(ks * 8 + 6) * 65 + nn], lds[(ks * 8 + 7) * 65 + nn]);
    *reinterpret_cast<uint4*>(&dst[(size_t)(n0 + nn) * K + k0 + ks * 8]) = o;
    __syncthreads();
}
struct StripRegs { float v[8][4]; };
__device__ __forceinline__ void strip_load(const float* __restrict__ src, int N, int k0, int n0, StripRegs& R) {
    const int tid = my_tid(), n = tid & 63, kk = tid >> 6;
#pragma unroll
    for (int j = 0; j < 8; ++j)
#pragma unroll
        for (int q = 0; q < 4; ++q) { const int gn = n0 + q * 64 + n; R.v[j][q] = (gn < N) ? src[(size_t)(k0 + kk + 8 * j) * N + gn] : 0.f; }
}
__device__ __forceinline__ void strip_store(const StripRegs& R, bfr* __restrict__ dst, int K, int k0, int n0, const float* kscale, float* lds) {
    const int tid = my_tid(), n = tid & 63, kk = tid >> 6;
#pragma unroll
    for (int j = 0; j < 8; ++j) {
        const float sc = kscale ? kscale[k0 + kk + 8 * j] : 1.f;
#pragma unroll
        for (int q = 0; q < 4; ++q) lds[(kk + 8 * j) * 257 + q * 64 + n] = R.v[j][q] * sc;
    }
    __syncthreads();
    const int nn = tid >> 1, hf = tid & 1;
#pragma unroll
    for (int c = 0; c < 4; ++c) {
        const int kb = hf * 32 + c * 8;
        uint4 o;
        o.x = pack2(lds[(kb + 0) * 257 + nn], lds[(kb + 1) * 257 + nn]); o.y = pack2(lds[(kb + 2) * 257 + nn], lds[(kb + 3) * 257 + nn]);
        o.z = pack2(lds[(kb + 4) * 257 + nn], lds[(kb + 5) * 257 + nn]); o.w = pack2(lds[(kb + 6) * 257 + nn], lds[(kb + 7) * 257 + nn]);
        *reinterpret_cast<uint4*>(&dst[(size_t)(n0 + nn) * K + k0 + kb]) = o;
    }
    __syncthreads();
}
__device__ __forceinline__ void tr_all(const float* src, bfr* dst, int K, int N, int Npad, const float* kscale, float* lds) {
    if ((Npad & 255) == 0) {
        const int nk = K / 64, ns = Npad / 256, tot = nk * ns;
        StripRegs RA, RB;
        int it = blockIdx.x;
        if (it < tot) strip_load(src, N, (it % nk) * 64, (it / nk) * 256, RA);
        while (it < tot) {
            const int itn = it + gridDim.x, it2 = itn + gridDim.x;
            if (itn < tot) strip_load(src, N, (itn % nk) * 64, (itn / nk) * 256, RB);
            strip_store(RA, dst, K, (it % nk) * 64, (it / nk) * 256, kscale, lds);
            if (itn >= tot) break;
            if (it2 < tot) strip_load(src, N, (it2 % nk) * 64, (it2 / nk) * 256, RA);
            strip_store(RB, dst, K, (itn % nk) * 64, (itn / nk) * 256, kscale, lds);
            it = it2;
        }
        return;
    }
    const int nk = K / 64, nn = Npad / 64;
    for (int it = blockIdx.x; it < nk * nn; it += gridDim.x) tr_tile(src, dst, K, N, (it % nk) * 64, (it / nk) * 64, kscale, lds);
}
__device__ __forceinline__ void cvt_all(const float* __restrict__ src, bfr* __restrict__ dst, size_t n) {
    const size_t n4 = n / 4;
    for (size_t i = (size_t)blockIdx.x * 512 + my_tid(); i < n4; i += (size_t)gridDim.x * 512) {
        float4 v = reinterpret_cast<const float4*>(src)[i];
        uint2 o; o.x = pack2(v.x, v.y); o.y = pack2(v.z, v.w);
        reinterpret_cast<uint2*>(dst)[i] = o;
    }
}

constexpr int PEER_ROWB = 1152;
__device__ __forceinline__ void cvt_fp4_rows(const float* __restrict__ src, unsigned char* __restrict__ dst, const int wrank, const int nwaves) {
    const int tid = my_tid(), lane = tid & 63;
    for (int row = wrank; row < 16384; row += nwaves) {
        float v[32]; float amax = 0.f;
#pragma unroll
        for (int q = 0; q < 8; ++q) {
            const f32x4 xx = __builtin_nontemporal_load(reinterpret_cast<const f32x4*>(&src[(size_t)row * D + q * 256 + lane * 4])); float4 x; x.x = xx[0]; x.y = xx[1]; x.z = xx[2]; x.w = xx[3];
            v[q * 4] = x.x; v[q * 4 + 1] = x.y; v[q * 4 + 2] = x.z; v[q * 4 + 3] = x.w;
            amax = fmaxf(amax, fmaxf(fmaxf(fabsf(x.x), fabsf(x.y)), fmaxf(fabsf(x.z), fabsf(x.w))));
        }
        const bfr sb = f2bf(amax * (1.f / 6.f));
        const float sc = bf2f(sb), inv = sc > 0.f ? frcp_(sc) : 0.f;
        unsigned dw[4];
#pragma unroll
        for (int d = 0; d < 4; ++d) {
            unsigned p = 0;
            p = __builtin_amdgcn_cvt_scalef32_pk_fp4_f32(p, v[d * 8 + 0] * inv, v[d * 8 + 1] * inv, 1.0f, 0);
            p = __builtin_amdgcn_cvt_scalef32_pk_fp4_f32(p, v[d * 8 + 2] * inv, v[d * 8 + 3] * inv, 1.0f, 1);
            p = __builtin_amdgcn_cvt_scalef32_pk_fp4_f32(p, v[d * 8 + 4] * inv, v[d * 8 + 5] * inv, 1.0f, 2);
            p = __builtin_amdgcn_cvt_scalef32_pk_fp4_f32(p, v[d * 8 + 6] * inv, v[d * 8 + 7] * inv, 1.0f, 3);
            dw[d] = p;
        }
        uint4 o4; o4.x = dw[0]; o4.y = dw[1]; o4.z = dw[2]; o4.w = dw[3];
        *reinterpret_cast<uint4*>(dst + (size_t)row * PEER_ROWB + lane * 16) = o4;
        *reinterpret_cast<bfr*>(dst + (size_t)row * PEER_ROWB + 1024 + lane * 2) = sb;
    }
}

__device__ __forceinline__ unsigned pack8_i4(const float* v) {
    unsigned d = 0;
#pragma unroll
    for (int i = 0; i < 8; ++i) d |= ((unsigned)((int)v[i]) & 0xFu) << (4 * i);
    return d;
}
__device__ __forceinline__ void cvt_i4_rows(const float* __restrict__ src, unsigned char* __restrict__ dst, const int rank, const int nranks) {
    const int tid = my_tid(), lane = tid & 63, wv = tid >> 6;
    for (int row = rank * 8 + wv; row < 16384; row += nranks * 8) {
        float v[32]; float amax = 0.f;
#pragma unroll
        for (int q = 0; q < 8; ++q) {
            const float4 x = *reinterpret_cast<const float4*>(&src[(size_t)row * D + q * 256 + lane * 4]);
            v[q * 4] = x.x; v[q * 4 + 1] = x.y; v[q * 4 + 2] = x.z; v[q * 4 + 3] = x.w;
            amax = fmaxf(amax, fmaxf(fmaxf(fabsf(x.x), fabsf(x.y)), fmaxf(fabsf(x.z), fabsf(x.w))));
        }
        const bfr sb = f2bf(amax * (1.f / 7.f));
        const float sc = bf2f(sb), inv = sc > 0.f ? frcp_(sc) : 0.f;
#pragma unroll
        for (int i = 0; i < 32; ++i) v[i] = fminf(fmaxf(__builtin_rintf(v[i] * inv), -7.f), 7.f);
        uint4 o4; o4.x = pack8_i4(v); o4.y = pack8_i4(v + 8); o4.z = pack8_i4(v + 16); o4.w = pack8_i4(v + 24);
        *reinterpret_cast<uint4*>(dst + (size_t)row * PEER_ROWB + lane * 16) = o4;
        *reinterpret_cast<bfr*>(dst + (size_t)row * PEER_ROWB + 1024 + lane * 2) = sb;
    }
}
__device__ __forceinline__ int pm_index(int kp, int k) {
    const int kpt = kp >> 5, r = kp & 31, kt = k >> 5, kk = k & 31, s = kk >> 4, rem = kk & 15;
    const int j = ((rem >> 3) << 2) | (rem & 3), hf = (rem >> 2) & 1, lane = hf * 32 + r;
    return ((((kpt * 2 + kt) * 2 + s) * 64 + lane) * 8) + j;
}
__device__ __forceinline__ int acc_index(int row, int col) {
    const int rt = row >> 5, r = row & 31, ct = col >> 5, c = col & 31;
    const int g4 = r >> 3, comp = r & 3, hf = (r >> 2) & 1, lane = hf * 32 + c;
    return ((((rt * 2 + ct) * 4 + g4) * 64 + lane) * 4) + comp;
}

constexpr int RW_ACT_STRIDE = 296, RW_LD = 72, RW_SLOT = 9216, RW_WL_OFF = 110592, RW_TOT_OFF = 148480, RW_BASE_OFF = 152576, RW_PART_OFF = 156928;
__device__ __forceinline__ f32x16 tile_mm_acc(f32x16 acc, const bfr* A, const int arow0, const bfr* Bt, const int brow0, const int r, const int hf) {
#pragma unroll
    for (int ks = 0; ks < 4; ++ks)
        acc = __builtin_amdgcn_mfma_f32_32x32x16_bf16(*reinterpret_cast<const bf16x8*>(&A[(arow0 + r) * RW_LD + ks * 16 + hf * 8]),
                                                     *reinterpret_cast<const bf16x8*>(&Bt[(brow0 + r) * RW_LD + ks * 16 + hf * 8]), acc, 0, 0, 0);
    return acc;
}
__device__ __forceinline__ f32x16 tile_mm(const bfr* A, const int arow0, const bfr* Bt, const int brow0, const int r, const int hf) {
    f32x16 z;
#pragma unroll
    for (int g = 0; g < 16; ++g) z[g] = 0.f;
    return tile_mm_acc(z, A, arow0, Bt, brow0, r, hf);
}
__device__ __forceinline__ void store_t(bfr* dst, const int col0, const int row0, const f32x16 acc, const int r, const int hf) {
#pragma unroll
    for (int g4 = 0; g4 < 4; ++g4) { uint2 p; p.x = pack2(acc[g4 * 4], acc[g4 * 4 + 1]); p.y = pack2(acc[g4 * 4 + 2], acc[g4 * 4 + 3]);
        *reinterpret_cast<uint2*>(&dst[(col0 + r) * RW_LD + row0 + g4 * 8 + hf * 4]) = p; }
}
#define DPP_HMIRROR 0x141
#define DPP_MIRROR  0x140

__device__ __forceinline__ void rwkv_load_weights(const Args& a, const int h, unsigned char* lds) {
    bfr* WL = (bfr*)(lds + RW_WL_OFF);
    const int tid = my_tid();
    for (int idx = tid; idx < 288 * 64; idx += 512) {
        const int m = idx >> 6, d = idx & 63;
        const float v = (m < 64) ? a.in[I_WDEC][(size_t)m * RW + h * 64 + d] : (m < 128) ? a.in[I_WICL][(size_t)(m - 64) * RW + h * 64 + d] : a.in[I_WGATE][(size_t)(m - 128) * RW + h * 64 + d];
        WL[d * RW_ACT_STRIDE + m] = f2bf(v);
    }
    __syncthreads();
}

struct RwIn { unsigned cu[18], pu[18]; bfr r[2][5], k[2][5], v[2][5]; };
__device__ __forceinline__ void rwkv_fetch(const Args& a, const int c, const int h, RwIn& in) {
    const bfr* __restrict__ P = (const bfr*)(a.ws + WS_P);
    const int tid = my_tid(), lane = tid & 63, wv = tid >> 6, fr = lane & 15, fq = lane >> 4, t0 = c * 64;
    {
        const int i = tid >> 3, part = tid & 7, t = t0 + i;
        const bfr* pc = P + (size_t)t * NINP + C_ZW + part * 36;
        const bfr* pp = pc - NINP;
#pragma unroll
        for (int q = 0; q < 18; ++q) { in.cu[q] = *reinterpret_cast<const unsigned*>(pc + q * 2); in.pu[q] = (t > 0) ? *reinterpret_cast<const unsigned*>(pp + q * 2) : 0u; }
    }
    const int tt = wv >> 1, dh = wv & 1;
#pragma unroll
    for (int dt = 0; dt < 2; ++dt) {
        const int hd = h * 64 + dh * 32 + dt * 16 + fr;
        const int tp = t0 + tt * 16 + fq * 4 - 1;
        const bool hp = tp >= 0;
        in.r[dt][0] = hp ? P[(size_t)(hp ? tp : 0) * NINP + C_R + hd] : (bfr)0; in.k[dt][0] = hp ? P[(size_t)(hp ? tp : 0) * NINP + C_K + hd] : (bfr)0; in.v[dt][0] = hp ? P[(size_t)(hp ? tp : 0) * NINP + C_V + hd] : (bfr)0;
#pragma unroll
        for (int j = 0; j < 4; ++j) { const size_t ro = (size_t)(tp + 1 + j) * NINP; in.r[dt][j + 1] = P[ro + C_R + hd]; in.k[dt][j + 1] = P[ro + C_K + hd]; in.v[dt][j + 1] = P[ro + C_V + hd]; }
    }
}

__device__ __forceinline__ void rwkv_unit(const Args& a, const int c, const int h, unsigned char* lds, const RwIn& in, RwIn& nxt, const int cnext) {
    const float* __restrict__ smix = a.in[I_SHIFT];
    const int tid = my_tid(), lane = tid & 63, wv = tid >> 6, fr = lane & 15, fq = lane >> 4, t0 = c * 64, u = c * 16 + h;
#define SLOT(k) ((bfr*)(lds + (k) * RW_SLOT))
    bfr* ACT = (bfr*)lds; const bfr* WL = (const bfr*)(lds + RW_WL_OFF);
    float* TOT = (float*)(lds + RW_TOT_OFF); float* BASE = (float*)(lds + RW_BASE_OFF); float* PART = (float*)(lds + RW_PART_OFF);
    {
        const int i = tid >> 3, part = tid & 7;
#pragma unroll
        for (int q = 0; q < 18; ++q) {
            const int cc = part * 36 + q * 2;
            const unsigned cu = in.cu[q], pu = in.pu[q];
            const float2 mx = *reinterpret_cast<const float2*>(&smix[C_ZW + cc]);
            const float c0 = bflo(cu), c1 = bfhi(cu);
            float z0 = c0 + (bflo(pu) - c0) * mx.x, z1 = c1 + (bfhi(pu) - c1) * mx.y;
            if (cc < 64) { z0 = 1.f - 2.f * frcp_(1.f + __expf(2.f * z0)); z1 = 1.f - 2.f * frcp_(1.f + __expf(2.f * z1)); }
            else if (cc >= 128) { z0 = sigmoidf_(z0); z1 = sigmoidf_(z1); }
            *reinterpret_cast<unsigned*>(&ACT[i * RW_ACT_STRIDE + cc]) = pack2(z0, z1);
        }
    }
    const int tt = wv >> 1, dh = wv & 1;
    float zr[2][4], zk[2][4], zv[2][4];
#pragma unroll
    for (int dt = 0; dt < 2; ++dt) {
        const int hd = h * 64 + dh * 32 + dt * 16 + fr;
        const float mr = smix[C_R + hd], mk = smix[C_K + hd], mv = smix[C_V + hd];
        float pr = bf2f(in.r[dt][0]), pk = bf2f(in.k[dt][0]), pv = bf2f(in.v[dt][0]);
#pragma unroll
        for (int j = 0; j < 4; ++j) {
            const float cr = bf2f(in.r[dt][j + 1]), ck = bf2f(in.k[dt][j + 1]), cv = bf2f(in.v[dt][j + 1]);
            zr[dt][j] = cr + (pr - cr) * mr; zk[dt][j] = ck + (pk - ck) * mk; zv[dt][j] = cv + (pv - cv) * mv;
            pr = cr; pk = ck; pv = cv;
        }
    }
    __syncthreads();
    f32x4 xw[2], xa[2], xg[2];
#pragma unroll
    for (int dt = 0; dt < 2; ++dt) {
        xw[dt] = f32x4{0.f, 0.f, 0.f, 0.f}; xa[dt] = xw[dt]; xg[dt] = xw[dt];
        const bfr* arow = ACT + (tt * 16 + fr) * RW_ACT_STRIDE + fq * 8;
        const bfr* brow = WL + (dh * 32 + dt * 16 + fr) * RW_ACT_STRIDE + fq * 8;
#pragma unroll
        for (int ks = 0; ks < 2; ++ks) {
            xw[dt] = __builtin_amdgcn_mfma_f32_16x16x32_bf16(*reinterpret_cast<const bf16x8*>(arow + ks * 32), *reinterpret_cast<const bf16x8*>(brow + ks * 32), xw[dt], 0, 0, 0);
            xa[dt] = __builtin_amdgcn_mfma_f32_16x16x32_bf16(*reinterpret_cast<const bf16x8*>(arow + 64 + ks * 32), *reinterpret_cast<const bf16x8*>(brow + 64 + ks * 32), xa[dt], 0, 0, 0);
        }
#pragma unroll
        for (int ks = 0; ks < 5; ++ks)
            xg[dt] = __builtin_amdgcn_mfma_f32_16x16x32_bf16(*reinterpret_cast<const bf16x8*>(arow + 128 + ks * 32), *reinterpret_cast<const bf16x8*>(brow + 128 + ks * 32), xg[dt], 0, 0, 0);
    }
    float lw[2][4], av[2][4], kkr[2][4], k4[2][4], n2[4], cf[4];
#pragma unroll
    for (int j = 0; j < 4; ++j) { n2[j] = 0.f; cf[j] = 0.f; }
#pragma unroll
    for (int dt = 0; dt < 2; ++dt) {
        const int hd = h * 64 + dh * 32 + dt * 16 + fr;
        const float w0 = a.in[I_W0][hd], a0 = a.in[I_A0][hd], kkm = a.in[I_KK][hd], kam = a.in[I_KA][hd], rkm = a.in[I_RK][hd];
        float run = 0.f;
#pragma unroll
        for (int j = 0; j < 4; ++j) {
            run += -0.6065306597126334f * sigmoidf_(w0 + xw[dt][j]);
            lw[dt][j] = run;
            av[dt][j] = sigmoidf_(a0 + xa[dt][j]);
            kkr[dt][j] = zk[dt][j] * kkm;
            k4[dt][j] = zk[dt][j] * (1.f + (av[dt][j] - 1.f) * kam);
            n2[j] += kkr[dt][j] * kkr[dt][j];
            cf[j] += zr[dt][j] * k4[dt][j] * rkm;
        }
        TOT[(tt * 4 + fq) * 64 + dh * 32 + dt * 16 + fr] = run;
    }
#pragma unroll
    for (int j = 0; j < 4; ++j) {
        n2[j] += dpp_f<DPP_XOR1>(n2[j]); n2[j] += dpp_f<DPP_XOR2>(n2[j]); n2[j] += dpp_f<DPP_HMIRROR>(n2[j]); n2[j] += dpp_f<DPP_MIRROR>(n2[j]);
        cf[j] += dpp_f<DPP_XOR1>(cf[j]); cf[j] += dpp_f<DPP_XOR2>(cf[j]); cf[j] += dpp_f<DPP_HMIRROR>(cf[j]); cf[j] += dpp_f<DPP_MIRROR>(cf[j]);
        if (fr == 0) { PART[(wv * 16 + fq * 4 + j) * 2] = n2[j]; PART[(wv * 16 + fq * 4 + j) * 2 + 1] = cf[j]; }
    }
    __syncthreads();
    if (tid < 64) {
        float run = 0.f;
#pragma unroll
        for (int g = 0; g < 16; ++g) { const float tv = TOT[g * 64 + tid]; BASE[g * 64 + tid] = run; run += tv; }
        BASE[16 * 64 + tid] = run;
    }
    __syncthreads();
    {
        bfr* Gg = (bfr*)(a.ws + WS_GG); bfr* Bon = (bfr*)(a.ws + WS_BON);
        const int i0 = tt * 16 + fq * 4;
        float rn[4], cft[4];
#pragma unroll
        for (int j = 0; j < 4; ++j) {
            const float n2t = n2[j] + PART[((wv ^ 1) * 16 + fq * 4 + j) * 2]; cft[j] = cf[j] + PART[((wv ^ 1) * 16 + fq * 4 + j) * 2 + 1];
            rn[j] = __builtin_amdgcn_rsqf(fmaxf(n2t, 1e-24f));
        }
#pragma unroll
        for (int dt = 0; dt < 2; ++dt) {
            const int d = dh * 32 + dt * 16 + fr;
            const float base = BASE[(tt * 4 + fq) * 64 + d], clT = BASE[16 * 64 + d];
            float vAt[4], vBh[4], vKh[4];
#pragma unroll
            for (int j = 0; j < 4; ++j) {
                const float cl = base + lw[dt][j], clm1 = (j == 0) ? base : base + lw[dt][j - 1];
                const float gi = __expf(cl), gm1 = __expf(clm1), ig = __expf(-cl), gce = __expf(clT - cl);
                const float kk = kkr[dt][j] * rn[j], beta = kk * av[dt][j];
                vAt[j] = -kk * gm1; vBh[j] = beta * gce; vKh[j] = k4[dt][j] * gce;
                SLOT(0)[(i0 + j) * RW_LD + d] = f2bf(vAt[j]);
                SLOT(1)[(i0 + j) * RW_LD + d] = f2bf(beta * ig);
                SLOT(2)[(i0 + j) * RW_LD + d] = f2bf(k4[dt][j] * ig);
                SLOT(3)[(i0 + j) * RW_LD + d] = f2bf(zr[dt][j] * gi);
                const size_t o = (size_t)(t0 + i0 + j) * RW + h * 64 + d;
                Gg[o] = f2bf(xg[dt][j]); Bon[o] = f2bf(cft[j] * zv[dt][j]);
            }
            uint2 p;
            p.x = pack2(vAt[0], vAt[1]); p.y = pack2(vAt[2], vAt[3]); *reinterpret_cast<uint2*>(&SLOT(4)[d * RW_LD + i0]) = p;
            p.x = pack2(vBh[0], vBh[1]); p.y = pack2(vBh[2], vBh[3]); *reinterpret_cast<uint2*>(&SLOT(5)[d * RW_LD + i0]) = p;
            p.x = pack2(vKh[0], vKh[1]); p.y = pack2(vKh[2], vKh[3]); *reinterpret_cast<uint2*>(&SLOT(6)[d * RW_LD + i0]) = p;
            p.x = pack2(zv[dt][0], zv[dt][1]); p.y = pack2(zv[dt][2], zv[dt][3]); *reinterpret_cast<uint2*>(&SLOT(7)[d * RW_LD + i0]) = p;
        }
    }
    __syncthreads();
    if (cnext >= 0) rwkv_fetch(a, cnext, h, nxt);
    const int r = lane & 31, hf = lane >> 5;
    {
        const int prod = wv >> 1, sub = wv & 1;
        const bfr* Aop = (prod & 1) ? SLOT(2) : SLOT(1);
        const bfr* Bop = (prod >= 2) ? SLOT(3) : SLOT(0);
        bfr* Ld = SLOT(8 + prod);
        const bool incl = prod >= 2;
        for (int job = 0; job < (sub ? 2 : 1); ++job) {
            const int jt = sub ? job : 0, it = sub ? 1 : 0;
            f32x16 acc = tile_mm(Aop, jt * 32, Bop, it * 32, r, hf);
#pragma unroll
            for (int g4 = 0; g4 < 4; ++g4) {
                const int i = it * 32 + r, j0 = jt * 32 + g4 * 8 + hf * 4;
                float v[4];
#pragma unroll
                for (int q = 0; q < 4; ++q) { const int j = j0 + q; v[q] = (incl ? (j <= i) : (j < i)) ? acc[g4 * 4 + q] : 0.f; }
                uint2 p; p.x = pack2(v[0], v[1]); p.y = pack2(v[2], v[3]);
                *reinterpret_cast<uint2*>(&Ld[i * RW_LD + j0]) = p;
            }
        }
        if (!sub) {
#pragma unroll
            for (int g4 = 0; g4 < 4; ++g4) *reinterpret_cast<uint2*>(&Ld[r * RW_LD + 32 + g4 * 8 + hf * 4]) = make_uint2(0u, 0u);
        }
    }
    __syncthreads();
    if (wv == 0) {
        bfr* Tl = SLOT(0); bfr* TlT = SLOT(1); const bfr* Lab = SLOT(8);
        for (int q = 0; q < 9; ++q) { *reinterpret_cast<uint4*>((unsigned char*)Tl + (q * 64 + lane) * 16) = make_uint4(0u, 0u, 0u, 0u); *reinterpret_cast<uint4*>((unsigned char*)TlT + (q * 64 + lane) * 16) = make_uint4(0u, 0u, 0u, 0u); }
        {
            const int bq = lane >> 4, cc = lane & 15;
            float x[16];
#pragma unroll
            for (int rr = 0; rr < 16; ++rr) {
                float lrow[16];
                unpack8(*reinterpret_cast<const uint4*>(&Lab[(bq * 16 + rr) * RW_LD + bq * 16]), lrow);
                unpack8(*reinterpret_cast<const uint4*>(&Lab[(bq * 16 + rr) * RW_LD + bq * 16 + 8]), lrow + 8);
                float sacc = (rr == cc) ? 1.f : 0.f;
#pragma unroll
                for (int m = 0; m < rr; ++m) sacc += lrow[m] * x[m];
                x[rr] = sacc;
            }
#pragma unroll
            for (int rr = 0; rr < 16; ++rr) Tl[(bq * 16 + rr) * RW_LD + bq * 16 + cc] = f2bf(x[rr]);
            *reinterpret_cast<uint4*>(&TlT[(bq * 16 + cc) * RW_LD + bq * 16]) = pack8(x);
            *reinterpret_cast<uint4*>(&TlT[(bq * 16 + cc) * RW_LD + bq * 16 + 8]) = pack8(x + 8);
        }
        asm volatile("s_waitcnt lgkmcnt(0)" ::: "memory");
#pragma unroll
        for (int bi = 1; bi < 4; ++bi) {
#pragma unroll
            for (int bj = 0; bj < bi; ++bj) {
                f32x4 acc = {0.f, 0.f, 0.f, 0.f};
#pragma unroll
                for (int bm = bj; bm < bi; ++bm) {
                    const bf16x4 Af = *reinterpret_cast<const bf16x4*>(&Lab[(bi * 16 + fr) * RW_LD + bm * 16 + fq * 4]);
                    const bf16x4 Bf = *reinterpret_cast<const bf16x4*>(&TlT[(bj * 16 + fr) * RW_LD + bm * 16 + fq * 4]);
                    acc = __builtin_amdgcn_mfma_f32_16x16x16bf16_1k(Af, Bf, acc, 0, 0, 0);
                }
                bf16x4 Bacc; Bacc[0] = (short)f2bf(acc[0]); Bacc[1] = (short)f2bf(acc[1]); Bacc[2] = (short)f2bf(acc[2]); Bacc[3] = (short)f2bf(acc[3]);
                const bf16x4 Ad = *reinterpret_cast<const bf16x4*>(&Tl[(bi * 16 + fr) * RW_LD + bi * 16 + fq * 4]);
                const f32x4 tb = __builtin_amdgcn_mfma_f32_16x16x16bf16_1k(Ad, Bacc, f32x4{0.f, 0.f, 0.f, 0.f}, 0, 0, 0);
#pragma unroll
                for (int q = 0; q < 4; ++q) Tl[(bi * 16 + fq * 4 + q) * RW_LD + bj * 16 + fr] = f2bf(tb[q]);
                uint2 p; p.x = pack2(tb[0], tb[1]); p.y = pack2(tb[2], tb[3]);
                *reinterpret_cast<uint2*>(&TlT[(bj * 16 + fr) * RW_LD + bi * 16 + fq * 4]) = p;
            }
            asm volatile("s_waitcnt lgkmcnt(0)" ::: "memory");
        }
    } else if (wv >= 4) {
        const int it = (wv >> 1) & 1, vt = wv & 1;
        const f32x16 acc = tile_mm(SLOT(9), it * 32, SLOT(7), vt * 32, r, hf);
        store_t(SLOT(2), vt * 32, it * 32, acc, r, hf);
    }
    __syncthreads();
    {
        const int which = wv >> 2, it = (wv >> 1) & 1, ct = wv & 1;
        const f32x16 acc = tile_mm(SLOT(0), it * 32, which ? SLOT(2) : SLOT(4), ct * 32, r, hf);
        store_t(which ? SLOT(9) : SLOT(8), ct * 32, it * 32, acc, r, hf);
    }
    __syncthreads();
    if (wv < 4) {
        {
            const int dtl = wv >> 1, itl = wv & 1;
            f32x16 acc = tile_mm(SLOT(8), dtl * 32, SLOT(10), itl * 32, r, hf);
            bfr* WY = (bfr*)(a.ws + WS_WY) + (size_t)u * 4096;
            const int i = itl * 32 + r;
#pragma unroll
            for (int g4 = 0; g4 < 4; ++g4) {
                const int d0 = dtl * 32 + g4 * 8 + hf * 4;
                const uint2 rr2 = *reinterpret_cast<const uint2*>(&SLOT(3)[i * RW_LD + d0]);
                uint2 p; p.x = pack2(acc[g4 * 4] + bflo(rr2.x), acc[g4 * 4 + 1] + bfhi(rr2.x)); p.y = pack2(acc[g4 * 4 + 2] + bflo(rr2.y), acc[g4 * 4 + 3] + bfhi(rr2.y));
                *reinterpret_cast<uint2*>(&WY[i * 64 + d0]) = p;
            }
        }
        {
            const int it = wv >> 1, vt = wv & 1;
            f32x16 acc = tile_mm(SLOT(10), it * 32, SLOT(9), vt * 32, r, hf);
            acc = tile_mm_acc(acc, SLOT(11), it * 32, SLOT(7), vt * 32, r, hf);
            bfr* YL = (bfr*)(a.ws + WS_YLOC) + (size_t)u * 4096;
#pragma unroll
            for (int g4 = 0; g4 < 4; ++g4) { uint2 p; p.x = pack2(acc[g4 * 4], acc[g4 * 4 + 1]); p.y = pack2(acc[g4 * 4 + 2], acc[g4 * 4 + 3]);
                *reinterpret_cast<uint2*>(&YL[(((it * 2 + vt) * 4 + g4) * 64 + lane) * 4]) = p; }
        }
    } else {
        {
            const int kt = (wv >> 1) & 1, kpt = wv & 1;
            f32x16 acc = tile_mm(SLOT(8), kt * 32, SLOT(5), kpt * 32, r, hf);
            if (kt == kpt) {
                const float gc = __expf(BASE[16 * 64 + kt * 32 + r]);
#pragma unroll
                for (int g = 0; g < 16; ++g) if (((g & 3) + 8 * (g >> 2) + 4 * hf) == r) acc[g] += gc;
            }
            bfr* PM = (bfr*)(a.ws + WS_PM) + (size_t)u * 4096;
#pragma unroll
            for (int sgrp = 0; sgrp < 2; ++sgrp) {
                float v8[8];
#pragma unroll
                for (int q = 0; q < 8; ++q) v8[q] = acc[sgrp * 8 + q];
                *reinterpret_cast<uint4*>(&PM[(((kpt * 2 + kt) * 2 + sgrp) * 64 + lane) * 8]) = pack8(v8);
            }
        }
        {
            const int kpt = (wv >> 1) & 1, vt = wv & 1;
            f32x16 acc = tile_mm(SLOT(5), kpt * 32, SLOT(9), vt * 32, r, hf);
            acc = tile_mm_acc(acc, SLOT(6), kpt * 32, SLOT(7), vt * 32, r, hf);
            bfr* GM = (bfr*)(a.ws + WS_GM) + (size_t)u * 4096;
#pragma unroll
            for (int g4 = 0; g4 < 4; ++g4) { uint2 p; p.x = pack2(acc[g4 * 4], acc[g4 * 4 + 1]); p.y = pack2(acc[g4 * 4 + 2], acc[g4 * 4 + 3]);
                *reinterpret_cast<uint2*>(&GM[(((kpt * 2 + vt) * 4 + g4) * 64 + lane) * 4]) = p; }
        }
    }
    __syncthreads();
#undef SLOT
}

__device__ __forceinline__ void rwkv_chain(const Args& a, const int h, const int vh) {
    const int lane = my_tid() & 63, r = lane & 31, hf = lane >> 5;
    const bfr* PMb = (const bfr*)(a.ws + WS_PM); const bfr* GMb = (const bfr*)(a.ws + WS_GM); bfr* ZTb = (bfr*)(a.ws + WS_ZT);
    f32x16 Z[2];
#pragma unroll
    for (int g = 0; g < 16; ++g) { Z[0][g] = 0.f; Z[1][g] = 0.f; }
    bf16x8 Acur[8], Anxt[8]; uint2 Ccur[8], Cnxt[8];
    {
        const bfr* pm = PMb + (size_t)h * 4096; const bfr* gm = GMb + (size_t)h * 4096;
#pragma unroll
        for (int f = 0; f < 8; ++f) Acur[f] = *reinterpret_cast<const bf16x8*>(&pm[(f * 64 + lane) * 8]);
#pragma unroll
        for (int kpt = 0; kpt < 2; ++kpt)
#pragma unroll
            for (int g4 = 0; g4 < 4; ++g4) Ccur[kpt * 4 + g4] = *reinterpret_cast<const uint2*>(&gm[(((kpt * 2 + vh) * 4 + g4) * 64 + lane) * 4]);
    }
    for (int c = 0; c < 128; ++c) {
        const int u = c * 16 + h;
        if (c + 1 < 128) {
            const bfr* pm = PMb + (size_t)(u + 16) * 4096; const bfr* gm = GMb + (size_t)(u + 16) * 4096;
#pragma unroll
            for (int f = 0; f < 8; ++f) Anxt[f] = *reinterpret_cast<const bf16x8*>(&pm[(f * 64 + lane) * 8]);
#pragma unroll
            for (int kpt = 0; kpt < 2; ++kpt)
#pragma unroll
                for (int g4 = 0; g4 < 4; ++g4) Cnxt[kpt * 4 + g4] = *reinterpret_cast<const uint2*>(&gm[(((kpt * 2 + vh) * 4 + g4) * 64 + lane) * 4]);
        }
        bfr* zt = ZTb + (size_t)u * 4096 + (size_t)(vh * 32 + r) * 64;
        bf16x8 Bf[2][2];
#pragma unroll
        for (int kt = 0; kt < 2; ++kt) {
#pragma unroll
            for (int g4 = 0; g4 < 4; ++g4) {
                uint2 o; o.x = pack2(Z[kt][g4 * 4], Z[kt][g4 * 4 + 1]); o.y = pack2(Z[kt][g4 * 4 + 2], Z[kt][g4 * 4 + 3]);
                *reinterpret_cast<uint2*>(&zt[kt * 32 + g4 * 8 + hf * 4]) = o;
                const int s = g4 >> 1, e = (g4 & 1) * 4;
                Bf[kt][s][e] = (short)(o.x & 0xFFFF); Bf[kt][s][e + 1] = (short)(o.x >> 16); Bf[kt][s][e + 2] = (short)(o.y & 0xFFFF); Bf[kt][s][e + 3] = (short)(o.y >> 16);
            }
        }
        f32x16 Zn[2];
#pragma unroll
        for (int kpt = 0; kpt < 2; ++kpt)
#pragma unroll
            for (int g4 = 0; g4 < 4; ++g4) {
                const uint2 cc = Ccur[kpt * 4 + g4];
                Zn[kpt][g4 * 4] = bflo(cc.x); Zn[kpt][g4 * 4 + 1] = bfhi(cc.x); Zn[kpt][g4 * 4 + 2] = bflo(cc.y); Zn[kpt][g4 * 4 + 3] = bfhi(cc.y);
            }
#pragma unroll
        for (int kpt = 0; kpt < 2; ++kpt)
#pragma unroll
            for (int kt = 0; kt < 2; ++kt)
#pragma unroll
                for (int s = 0; s < 2; ++s)
                    Zn[kpt] = __builtin_amdgcn_mfma_f32_32x32x16_bf16(Acur[(kpt * 2 + kt) * 2 + s], Bf[kt][s], Zn[kpt], 0, 0, 0);
        Z[0] = Zn[0]; Z[1] = Zn[1];
#pragma unroll
        for (int f = 0; f < 8; ++f) { Acur[f] = Anxt[f]; Ccur[f] = Cnxt[f]; }
    }
}

__device__ __forceinline__ void rwkv_out_unit(const Args& a, const int u, float* Ls) {
    const int lane = my_tid() & 63, r = lane & 31, hf = lane >> 5, c = u >> 4, h = u & 15, t0 = c * 64;
    const bfr* WY = (const bfr*)(a.ws + WS_WY) + (size_t)u * 4096; const bfr* YL = (const bfr*)(a.ws + WS_YLOC) + (size_t)u * 4096;
    const bfr* ZT = (const bfr*)(a.ws + WS_ZT) + (size_t)u * 4096;
    f32x16 acc[2][2];
#pragma unroll
    for (int it = 0; it < 2; ++it)
#pragma unroll
        for (int vt = 0; vt < 2; ++vt)
#pragma unroll
            for (int g4 = 0; g4 < 4; ++g4) {
                const uint2 cc = *reinterpret_cast<const uint2*>(&YL[(((it * 2 + vt) * 4 + g4) * 64 + lane) * 4]);
                acc[it][vt][g4 * 4] = bflo(cc.x); acc[it][vt][g4 * 4 + 1] = bfhi(cc.x); acc[it][vt][g4 * 4 + 2] = bflo(cc.y); acc[it][vt][g4 * 4 + 3] = bfhi(cc.y);
            }
#pragma unroll
    for (int ks = 0; ks < 4; ++ks) {
        bf16x8 A[2], B[2];
#pragma unroll
        for (int it = 0; it < 2; ++it) A[it] = *reinterpret_cast<const bf16x8*>(&WY[(it * 32 + r) * 64 + ks * 16 + hf * 8]);
#pragma unroll
        for (int vt = 0; vt < 2; ++vt) B[vt] = *reinterpret_cast<const bf16x8*>(&ZT[(vt * 32 + r) * 64 + ks * 16 + hf * 8]);
#pragma unroll
        for (int it = 0; it < 2; ++it)
#pragma unroll
            for (int vt = 0; vt < 2; ++vt) acc[it][vt] = __builtin_amdgcn_mfma_f32_32x32x16_bf16(A[it], B[vt], acc[it][vt], 0, 0, 0);
    }
#pragma unroll
    for (int it = 0; it < 2; ++it)
#pragma unroll
        for (int vt = 0; vt < 2; ++vt)
#pragma unroll
            for (int g = 0; g < 16; ++g) Ls[(it * 32 + (g & 3) + 8 * (g >> 2) + 4 * hf) * 68 + vt * 32 + r] = acc[it][vt][g];
    asm volatile("s_waitcnt lgkmcnt(0)" ::: "memory");
    __builtin_amdgcn_wave_barrier();
    {
        float y[64]; float s1 = 0.f, s2 = 0.f;
#pragma unroll
        for (int q = 0; q < 16; ++q) {
            const float4 x = *reinterpret_cast<const float4*>(&Ls[lane * 68 + q * 4]);
            y[q * 4] = x.x; y[q * 4 + 1] = x.y; y[q * 4 + 2] = x.z; y[q * 4 + 3] = x.w;
            s1 += (x.x + x.y) + (x.z + x.w);
        }
        const float mean = s1 * (1.f / 64.f);
#pragma unroll
        for (int v = 0; v < 64; ++v) { const float d = y[v] - mean; s2 += d * d; }
        const float rstd = rsqrtf(s2 * (1.f / 64.f) + 64e-5f);
        const bfr* Gg = (const bfr*)(a.ws + WS_GG); const bfr* Bon = (const bfr*)(a.ws + WS_BON); bfr* RWO = (bfr*)(a.ws + WS_RWO);
        const size_t o = (size_t)(t0 + lane) * RW + h * 64;
        const float* lnw = a.in[I_LNW] + h * 64; const float* lnb = a.in[I_LNB] + h * 64;
#pragma unroll
        for (int q = 0; q < 8; ++q) {
            float gg[8], bb[8], rr[8];
            unpack8(*reinterpret_cast<const uint4*>(&Gg[o + q * 8]), gg);
            unpack8(*reinterpret_cast<const uint4*>(&Bon[o + q * 8]), bb);
#pragma unroll
            for (int e = 0; e < 8; ++e) rr[e] = ((y[q * 8 + e] - mean) * rstd * lnw[q * 8 + e] + lnb[q * 8 + e] + bb[e]) * gg[e];
            *reinterpret_cast<uint4*>(&RWO[o + q * 8]) = pack8(rr);
        }
    }
    asm volatile("s_waitcnt lgkmcnt(0)" ::: "memory");
    __builtin_amdgcn_wave_barrier();
}
#ifndef DUP_DSA
#define DUP_DSA 0
#endif
constexpr float IDX_SCALE = 0.04419417382415922f;
constexpr int CT_ROW = 544;
constexpr int CT_WAVE = 18432;
constexpr int DSA_RELB_OFF = 155648;
constexpr int DSA_HIST_OFF = 131072;
constexpr int DSA_SEL_OFF = 147456;

typedef __bf16 bf16p2_t __attribute__((ext_vector_type(2)));
__device__ __forceinline__ bf16x8 fp8x8_to_bf16(const uint2 w) {
    const u32x4 r = {__builtin_bit_cast(unsigned, __builtin_amdgcn_cvt_scalef32_pk_bf16_fp8(w.x, 1.0f, false)), __builtin_bit_cast(unsigned, __builtin_amdgcn_cvt_scalef32_pk_bf16_fp8(w.x, 1.0f, true)),
                     __builtin_bit_cast(unsigned, __builtin_amdgcn_cvt_scalef32_pk_bf16_fp8(w.y, 1.0f, false)), __builtin_bit_cast(unsigned, __builtin_amdgcn_cvt_scalef32_pk_bf16_fp8(w.y, 1.0f, true))};
    return __builtin_bit_cast(bf16x8, r);
}
__device__ __forceinline__ unsigned pack4_fp8(float a0, float a1, float a2, float a3) {
    int p = 0; p = __builtin_amdgcn_cvt_pk_fp8_f32(a0, a1, p, false); p = __builtin_amdgcn_cvt_pk_fp8_f32(a2, a3, p, true); return (unsigned)p;
}
__device__ __forceinline__ int rel_bucket(int rel) {
    const int n = rel < 0 ? -rel : rel;
    const int lg = 8 + (n >= 15) + (n >= 27) + (n >= 50) + (n >= 91) + (n >= 166) + (n >= 305) + (n >= 559);
    return (n < 8 ? n : lg) + (rel > 0 ? 16 : 0);
}
__device__ __forceinline__ unsigned fkey(float f) {
    if (f == 0.f) f = 0.f;
    const unsigned u = __float_as_uint(f);
    return (u & 0x80000000u) ? ~u : (u | 0x80000000u);
}

__device__ __forceinline__ void dsa_cnorm(const Args& a) {
    const bfr* P = (const bfr*)(a.ws + WS_P); unsigned char* CB8 = a.ws + WS_CB; bfr* IKC = (bfr*)(a.ws + WS_IKC);
    const int lane = my_tid() & 63, wv = my_tid() >> 6;
    const float4 g = reinterpret_cast<const float4*>(a.in[I_KVG])[lane];
    for (int t = blockIdx.x * 8 + wv; t < T; t += gridDim.x * 8) {
        const uint2 raw = *reinterpret_cast<const uint2*>(&P[(size_t)t * NINP + C_CKV + lane * 4]);
        const float v0 = bflo(raw.x), v1 = bfhi(raw.x), v2 = bflo(raw.y), v3 = bfhi(raw.y);
        const float ss = wave_sum(v0 * v0 + v1 * v1 + v2 * v2 + v3 * v3);
        const float rs = rsqrtf(ss * (1.f / 256.f) + EPS);
        int pk = 0;
        pk = __builtin_amdgcn_cvt_pk_fp8_f32(v0 * rs * g.x, v1 * rs * g.y, pk, false);
        pk = __builtin_amdgcn_cvt_pk_fp8_f32(v2 * rs * g.z, v3 * rs * g.w, pk, true);
        *reinterpret_cast<int*>(&CB8[(size_t)t * 256 + lane * 4]) = pk;
        if (lane < 16) *reinterpret_cast<uint2*>(&IKC[(size_t)t * 64 + lane * 4]) = *reinterpret_cast<const uint2*>(&P[(size_t)t * NINP + C_IK + lane * 4]);
    }
}
__device__ __forceinline__ void dsa_qlat(const Args& a) {
    const bfr* P = (const bfr*)(a.ws + WS_P); const bfr* WUK = (const bfr*)(a.ws + WS_WUK); unsigned char* QL8 = a.ws + WS_QLAT;
    const int lane = my_tid() & 63, wv = my_tid() >> 6, fr = lane & 15, fq = lane >> 4;
    for (int it = blockIdx.x * 8 + wv; it < (T / 64) * NH; it += gridDim.x * 8) {
        const int tg = it >> 4, h = it & 15, t0 = tg * 64;
        bf16x8 Bt[4][2];
#pragma unroll
        for (int tl = 0; tl < 4; ++tl)
#pragma unroll
            for (int ks = 0; ks < 2; ++ks) Bt[tl][ks] = *reinterpret_cast<const bf16x8*>(&P[(size_t)(t0 + tl * 16 + fr) * NINP + C_Q + h * 64 + ks * 32 + fq * 8]);
#pragma unroll 2
        for (int nt = 0; nt < 16; ++nt) {
            const bf16x8 A0 = *reinterpret_cast<const bf16x8*>(&WUK[(size_t)(h * 256 + nt * 16 + fr) * 64 + fq * 8]);
            const bf16x8 A1 = *reinterpret_cast<const bf16x8*>(&WUK[(size_t)(h * 256 + nt * 16 + fr) * 64 + 32 + fq * 8]);
#pragma unroll
            for (int tl = 0; tl < 4; ++tl) {
                f32x4 acc = {0.f, 0.f, 0.f, 0.f};
                acc = __builtin_amdgcn_mfma_f32_16x16x32_bf16(A0, Bt[tl][0], acc, 0, 0, 0);
                acc = __builtin_amdgcn_mfma_f32_16x16x32_bf16(A1, Bt[tl][1], acc, 0, 0, 0);
                *reinterpret_cast<unsigned*>(&QL8[((size_t)(t0 + tl * 16 + fr) * NH + h) * 256 + nt * 16 + fq * 4]) = pack4_fp8(acc[0], acc[1], acc[2], acc[3]);
            }
        }
    }
}
__device__ __forceinline__ void dsa_oproj(const Args& a) {
    const unsigned char* OL8 = a.ws + WS_OLAT; const bfr* WUVT = (const bfr*)(a.ws + WS_WUVT); bfr* DO = (bfr*)(a.ws + WS_DO);
    const int lane = my_tid() & 63, wv = my_tid() >> 6, fr = lane & 15, fq = lane >> 4;
    for (int it = blockIdx.x * 8 + wv; it < (T / 64) * NH; it += gridDim.x * 8) {
        const int tg = it >> 4, h = it & 15, t0 = tg * 64;
        f32x4 acc[4][4];
#pragma unroll
        for (int tl = 0; tl < 4; ++tl)
#pragma unroll
            for (int nt = 0; nt < 4; ++nt) acc[tl][nt] = f32x4{0.f, 0.f, 0.f, 0.f};
#pragma unroll 2
        for (int ks = 0; ks < 8; ++ks) {
            bf16x8 A[4];
#pragma unroll
            for (int nt = 0; nt < 4; ++nt) A[nt] = *reinterpret_cast<const bf16x8*>(&WUVT[(size_t)(h * 64 + nt * 16 + fr) * 256 + ks * 32 + fq * 8]);
#pragma unroll
            for (int tl = 0; tl < 4; ++tl) {
                const bf16x8 Bt = fp8x8_to_bf16(*reinterpret_cast<const uint2*>(&OL8[((size_t)(t0 + tl * 16 + fr) * NH + h) * 256 + ks * 32 + fq * 8]));
#pragma unroll
                for (int nt = 0; nt < 4; ++nt) acc[tl][nt] = __builtin_amdgcn_mfma_f32_16x16x32_bf16(A[nt], Bt, acc[tl][nt], 0, 0, 0);
            }
        }
#pragma unroll
        for (int tl = 0; tl < 4; ++tl)
#pragma unroll
            for (int nt = 0; nt < 4; ++nt) { uint2 o; o.x = pack2(acc[tl][nt][0], acc[tl][nt][1]); o.y = pack2(acc[tl][nt][2], acc[tl][nt][3]);
                *reinterpret_cast<uint2*>(&DO[(size_t)(t0 + tl * 16 + fr) * RW + h * 64 + nt * 16 + fq * 4]) = o; }
    }
}

__device__ __forceinline__ float bin_scale(const float sumw2) { const float sg = sqrtf(32.f * sumw2); return sg > 1e-20f ? 90.f / sg : 1.f; }
__device__ __forceinline__ int score_bin(const float sc, const float bsc) { const float f = floorf(sc * bsc) + 512.f; return (int)fminf(fmaxf(f, 0.f), 1023.f); }
__device__ __forceinline__ float key_score(const unsigned k) { return __uint_as_float((k & 0x80000000u) ? (k ^ 0x80000000u) : ~k); }
__device__ __forceinline__ void hist_scan(const unsigned* hist, const int nb, const unsigned need, unsigned* res, const int lane) {
    const int per = nb >> 6;
    unsigned s = 0;
    for (int i = 0; i < per; ++i) s += hist[lane * per + i];
    unsigned S = s;
#pragma unroll
    for (int o = 1; o < 64; o <<= 1) { const unsigned tt = __shfl_down(S, o); if (lane + o < 64) S += tt; }
    const unsigned long long m = __ballot(S >= need);
    const int ls = 63 - __clzll(m);
    if (lane == ls) {
        unsigned accv = S - s; int bin = lane * per; unsigned abv = accv;
        for (int bb = lane * per + per - 1; bb >= lane * per; --bb) { const unsigned cc = hist[bb]; if (accv + cc >= need) { bin = bb; abv = accv; break; } accv += cc; }
        res[0] = (unsigned)bin; res[1] = abv;
    }
}

__device__ __forceinline__ void dsa_select4(const Args& a, const int t0, const int qs, unsigned char* lds) {
    const bfr* P = (const bfr*)(a.ws + WS_P); const bfr* IKC = (const bfr*)(a.ws + WS_IKC);
    float* SC = (float*)lds; int* SEL = (int*)(lds + DSA_SEL_OFF); unsigned* MISC = (unsigned*)(lds + LDS_MISC);
    const int tid = my_tid(), lane = tid & 63, wv = tid >> 6, r = lane & 31, hf = lane >> 5;
    const int L = 64 * (t0 / 64 + 1);
    if (L <= 256) {
        for (int i = tid; i < 4 * 256; i += 512) SEL[(qs + (i >> 8)) * 256 + (i & 255)] = (i & 255) | (rel_bucket((i & 255) - (t0 + (i >> 8))) << 16);
        if (tid < 4) MISC[16 + qs + tid] = (unsigned)L;
        __syncthreads();
        return;
    }
    for (int i = tid; i < 4096; i += 512) ((unsigned*)(lds + DSA_HIST_OFF))[i] = 0u;
    __syncthreads();
    {
        const int qq = r >> 3, hh = r & 7;
        bf16x8 B[4];
#pragma unroll
        for (int ks = 0; ks < 4; ++ks) B[ks] = *reinterpret_cast<const bf16x8*>(&P[(size_t)(t0 + qq) * NINP + C_IQ + hh * 64 + ks * 16 + hf * 8]);
        const float wgt = bf2f(P[(size_t)(t0 + qq) * NINP + C_IW + hh]) * IDX_SCALE;
        float w2 = wgt * wgt; w2 += dpp_f<DPP_XOR1>(w2); w2 += dpp_f<DPP_XOR2>(w2); w2 += dpp_f<0x141>(w2);
        const float bsc = bin_scale(w2);
        if (hh == 0 && hf == 0) ((float*)MISC)[48 + qq] = bsc;
        const int ntile = L >> 5;
        for (int rp_ = 0; rp_ < ((DUP_DSA & 1) ? 2 : 1); ++rp_) {
        bf16x8 An[4];
        if (wv < ntile) {
#pragma unroll
            for (int ks = 0; ks < 4; ++ks) An[ks] = *reinterpret_cast<const bf16x8*>(&IKC[(size_t)(wv * 32 + r) * 64 + ks * 16 + hf * 8]);
        }
        for (int kt = wv; kt < ntile; kt += 8) {
            bf16x8 Ac[4];
#pragma unroll
            for (int ks = 0; ks < 4; ++ks) Ac[ks] = An[ks];
            if (kt + 8 < ntile) {
#pragma unroll
                for (int ks = 0; ks < 4; ++ks) An[ks] = *reinterpret_cast<const bf16x8*>(&IKC[(size_t)((kt + 8) * 32 + r) * 64 + ks * 16 + hf * 8]);
            }
            f32x16 acc;
#pragma unroll
            for (int g = 0; g < 16; ++g) acc[g] = 0.f;
#pragma unroll
            for (int ks = 0; ks < 4; ++ks) acc = __builtin_amdgcn_mfma_f32_32x32x16_bf16(Ac[ks], B[ks], acc, 0, 0, 0);
            float s1[8], s2[4], s3[2];
            const bool b0 = (hh & 1) != 0, b1 = (hh & 2) != 0, b2 = (hh & 4) != 0;
#pragma unroll
            for (int p = 0; p < 8; ++p) {
                const float x0 = fmaxf(acc[2 * p], 0.f) * wgt, x1 = fmaxf(acc[2 * p + 1], 0.f) * wgt;
                s1[p] = (b0 ? x1 : x0) + dpp_f<DPP_XOR1>(b0 ? x0 : x1);
            }
#pragma unroll
            for (int p = 0; p < 4; ++p) s2[p] = (b1 ? s1[2 * p + 1] : s1[2 * p]) + dpp_f<DPP_XOR2>(b1 ? s1[2 * p] : s1[2 * p + 1]);
#pragma unroll
            for (int p = 0; p < 2; ++p) s3[p] = (b2 ? s2[2 * p + 1] : s2[2 * p]) + __shfl_xor(b2 ? s2[2 * p] : s2[2 * p + 1], 4);
#pragma unroll
            for (int p = 0; p < 2; ++p) { const int g = 8 * p + hh; const unsigned fk = fkey(s3[p]); ((unsigned*)SC)[qq * 8192 + kt * 32 + (g & 3) + 8 * (g >> 2) + 4 * hf] = fk;
                if (rp_ == 0) atomicAdd((unsigned*)(lds + DSA_HIST_OFF) + qq * 1024 + score_bin(s3[p], bsc), 1u); }
        }
        }
    }
    __syncthreads();
    const int q = wv >> 1, l128 = (wv & 1) * 64 + lane;
    const unsigned* keys = (const unsigned*)(SC + q * 8192);
    unsigned* hist = (unsigned*)(lds + DSA_HIST_OFF) + q * 1024;
    unsigned* res = MISC + 32 + q * 4;
    for (int rp_ = 0; rp_ < ((DUP_DSA & 2) ? 2 : 1); ++rp_) {
    const float bsc = ((const float*)MISC)[48 + q];
    unsigned need = 256;
    if (rp_ > 0) {
        for (int i = l128; i < 1024; i += 128) hist[i] = 0u;
        __syncthreads();
        for (int idx = l128; idx < L; idx += 128) atomicAdd(&hist[score_bin(key_score(keys[idx]), bsc)], 1u);
        __syncthreads();
    }
    if ((wv & 1) == 0) hist_scan(hist, 1024, need, res, lane);
    __syncthreads();
    const int b0 = (int)res[0]; need -= res[1];
    __syncthreads();
    unsigned* cand = hist + 256;
    if (l128 == 0) { res[2] = 0u; res[3] = 0u; }
    if (tid == 0) MISC[52] = 0u;
    __syncthreads();
    for (int idx = l128; idx < L; idx += 128) {
        const unsigned k = keys[idx];
        if (score_bin(key_score(k), bsc) == b0) { const unsigned p = atomicAdd(&res[2], 1u); if (p < 768u) cand[p] = k; }
    }
    __syncthreads();
    const unsigned ncand = res[2];
    if (l128 == 0 && ncand > 768u) MISC[52] = 1u;
    __syncthreads();
    const bool fast = MISC[52] == 0u;
    unsigned prefix = 0;
    if (fast) {
        for (unsigned i = l128; i < ncand; i += 128) {
            const unsigned me = cand[i]; unsigned cgt = 0, ceq = 0;
            for (unsigned j = 0; j < ncand; ++j) { const unsigned o = cand[j]; cgt += (o > me) ? 1u : 0u; ceq += (o == me) ? 1u : 0u; }
            if (cgt < need && need <= cgt + ceq) { res[0] = me; res[1] = cgt; }
        }
        __syncthreads();
        prefix = res[0]; need -= res[1];
        __syncthreads();
    } else {
#pragma unroll 1
        for (int pass = 0; pass < 4; ++pass) {
            const int lo_shift = 24 - 8 * pass;
            for (int i = l128; i < 256; i += 128) hist[i] = 0u;
            __syncthreads();
            for (int idx = l128; idx < L; idx += 128) {
                const unsigned k = keys[idx];
                const bool ok = (score_bin(key_score(k), bsc) == b0) && (pass == 0 || (k >> (lo_shift + 8)) == prefix);
                if (ok) atomicAdd(&hist[(k >> lo_shift) & 255u], 1u);
            }
            __syncthreads();
            if ((wv & 1) == 0) hist_scan(hist, 256, need, res, lane);
            __syncthreads();
            prefix = (prefix << 8) | res[0]; need -= res[1];
            __syncthreads();
        }
    }
    const unsigned tkey = prefix;
    if ((wv & 1) == 0) {
        const unsigned ngt = 256u - need; unsigned rg = 0, rt = 0;
        const unsigned long long lt = (1ull << lane) - 1ull;
        for (int base = 0; base < L; base += 64) {
            const unsigned k = keys[base + lane];
            const bool gt = k > tkey, tie = k == tkey;
            const unsigned long long mg = __ballot(gt), mt = __ballot(tie);
            if (gt) { const unsigned p = rg + (unsigned)__popcll(mg & lt); if (p < 256u) SEL[(qs + q) * 256 + p] = base + lane; }
            if (tie) { const unsigned p = rt + (unsigned)__popcll(mt & lt); if (p < need) SEL[(qs + q) * 256 + ngt + p] = base + lane; }
            rg += (unsigned)__popcll(mg); rt += (unsigned)__popcll(mt);
        }
        if (lane == 0) MISC[16 + qs + q] = 256u;
    }
    __syncthreads();
    for (int i = l128; i < 256; i += 128) { const int e = SEL[(qs + q) * 256 + i]; SEL[(qs + q) * 256 + i] = e | (rel_bucket(e - (t0 + q)) << 16); }
    __syncthreads();
    }
}

__device__ __forceinline__ void dsa_attend(const Args& a, const int t, const int* sel, const int nsel, unsigned char* ct, const float* relb_l) {
    const unsigned char* CB8 = a.ws + WS_CB; const unsigned char* QL8 = a.ws + WS_QLAT; unsigned char* OL8 = a.ws + WS_OLAT;
    const int lane = my_tid() & 63, fr = lane & 15, fq = lane >> 4;
    bf16x8 Bq[8];
#pragma unroll
    for (int j = 0; j < 4; ++j) {
        const uint4 w = *reinterpret_cast<const uint4*>(&QL8[((size_t)t * NH + fr) * 256 + j * 64 + fq * 16]);
        Bq[2 * j] = fp8x8_to_bf16(uint2{w.x, w.y}); Bq[2 * j + 1] = fp8x8_to_bf16(uint2{w.z, w.w});
    }
    f32x4 o[16];
#pragma unroll
    for (int mt = 0; mt < 16; ++mt) o[mt] = f32x4{0.f, 0.f, 0.f, 0.f};
    float mrun = -1e30f, lrun = 0.f;
    const unsigned tr_addr = (unsigned)(size_t)ct + (unsigned)((4 * fq + (fr >> 2)) * CT_ROW + (fr & 3) * 8);
    const int nblk = nsel >> 5;
    uint4 ArA[2][4], ArB[2][4];
#define ATT_LOAD(AR, KB) _Pragma("unroll") for (int tt = 0; tt < 2; ++tt) { \
        const int kidx = sel[(KB) * 32 + tt * 16 + fr] & 0xFFFF; \
        _Pragma("unroll") for (int j = 0; j < 4; ++j) AR[tt][j] = *reinterpret_cast<const uint4*>(&CB8[(size_t)kidx * 256 + j * 64 + fq * 16]); }
#define ATT_QK(AR) _Pragma("unroll") for (int tt = 0; tt < 2; ++tt) { \
        st[tt] = f32x4{0.f, 0.f, 0.f, 0.f}; \
        _Pragma("unroll") for (int j = 0; j < 4; ++j) { \
            const bf16x8 A0 = fp8x8_to_bf16(uint2{AR[tt][j].x, AR[tt][j].y}), A1 = fp8x8_to_bf16(uint2{AR[tt][j].z, AR[tt][j].w}); \
            st[tt] = __builtin_amdgcn_mfma_f32_16x16x32_bf16(A0, Bq[2 * j], st[tt], 0, 0, 0); \
            st[tt] = __builtin_amdgcn_mfma_f32_16x16x32_bf16(A1, Bq[2 * j + 1], st[tt], 0, 0, 0); \
            *reinterpret_cast<bf16x8*>(ct + (tt * 16 + fr) * CT_ROW + (j * 64 + fq * 16) * 2) = A0; \
            *reinterpret_cast<bf16x8*>(ct + (tt * 16 + fr) * CT_ROW + (j * 64 + fq * 16 + 8) * 2) = A1; } }
#define ATT_SMPV(KB) { \
        float lg[8]; float bmax = -1e30f; \
        _Pragma("unroll") for (int tt = 0; tt < 2; ++tt) { \
            const int4 k4 = *reinterpret_cast<const int4*>(&sel[(KB) * 32 + tt * 16 + fq * 4]); \
            const int kk4[4] = {k4.x, k4.y, k4.z, k4.w}; \
            _Pragma("unroll") for (int j = 0; j < 4; ++j) { \
                const float v = st[tt][j] * 0.125f + relb_l[(kk4[j] >> 16) * 16 + fr]; \
                lg[tt * 4 + j] = v; bmax = fmaxf(bmax, v); } } \
        bmax = fmaxf(bmax, __shfl_xor(bmax, 16)); bmax = fmaxf(bmax, __shfl_xor(bmax, 32)); \
        const bool resc = __any(bmax > mrun + 8.f);             \
        if (resc) {                           \
            const float mnew = fmaxf(mrun, bmax); const float alpha = __expf(mrun - mnew); mrun = mnew; lrun *= alpha; \
            asm volatile("" ::: "memory"); \
            _Pragma("unroll") for (int mt = 0; mt < 16; ++mt) { o[mt][0] *= alpha; o[mt][1] *= alpha; o[mt][2] *= alpha; o[mt][3] *= alpha; } } \
        float psum = 0.f; bf16x8 Pf; \
        _Pragma("unroll") for (int e = 0; e < 8; e += 2) { \
            const float p0 = __expf(lg[e] - mrun), p1 = __expf(lg[e + 1] - mrun); psum += p0 + p1; \
            const unsigned pk = pack2(p0, p1); Pf[e] = (short)(pk & 0xFFFF); Pf[e + 1] = (short)(pk >> 16); } \
        lrun += psum; \
        asm volatile("s_waitcnt lgkmcnt(0)" ::: "memory"); \
        __builtin_amdgcn_wave_barrier(); \
        _Pragma("unroll") for (int m4 = 0; m4 < 4; ++m4) { \
            uint2 r0[4], r1[4]; \
            asm volatile("ds_read_b64_tr_b16 %0, %8 offset:%9\n\tds_read_b64_tr_b16 %1, %8 offset:%10\n\t" \
                         "ds_read_b64_tr_b16 %2, %8 offset:%11\n\tds_read_b64_tr_b16 %3, %8 offset:%12\n\t" \
                         "ds_read_b64_tr_b16 %4, %8 offset:%13\n\tds_read_b64_tr_b16 %5, %8 offset:%14\n\t" \
                         "ds_read_b64_tr_b16 %6, %8 offset:%15\n\tds_read_b64_tr_b16 %7, %8 offset:%16\n\ts_waitcnt lgkmcnt(0)" \
                         : "=&v"(r0[0]), "=&v"(r1[0]), "=&v"(r0[1]), "=&v"(r1[1]), "=&v"(r0[2]), "=&v"(r1[2]), "=&v"(r0[3]), "=&v"(r1[3]) \
                         : "v"(tr_addr), "n"(m4 * 128), "n"(m4 * 128 + 16 * CT_ROW), "n"(m4 * 128 + 32), "n"(m4 * 128 + 32 + 16 * CT_ROW), \
                           "n"(m4 * 128 + 64), "n"(m4 * 128 + 64 + 16 * CT_ROW), "n"(m4 * 128 + 96), "n"(m4 * 128 + 96 + 16 * CT_ROW) \
                         : "memory"); \
            _Pragma("unroll") for (int i = 0; i < 4; ++i) { \
                const int mt = m4 * 4 + i; \
                const u32x4 raw = {r0[i].x, r0[i].y, r1[i].x, r1[i].y}; \
                const bf16x8 Av = __builtin_bit_cast(bf16x8, raw); \
                o[mt] = __builtin_amdgcn_mfma_f32_16x16x32_bf16(Av, Pf, o[mt], 0, 0, 0); } } \
        asm volatile("s_waitcnt lgkmcnt(0)" ::: "memory"); \
        __builtin_amdgcn_wave_barrier(); }
    f32x4 st[2];
    ATT_LOAD(ArA, 0)
    ATT_LOAD(ArB, 1)
    int kb = 0;
#pragma unroll 1
    for (; kb + 2 < nblk; kb += 2) {
        ATT_QK(ArA) ATT_LOAD(ArA, kb + 2) ATT_SMPV(kb)
        ATT_QK(ArB) ATT_LOAD(ArB, kb + 3) ATT_SMPV(kb + 1)
    }
    ATT_QK(ArA) ATT_SMPV(kb)
    ATT_QK(ArB) ATT_SMPV(kb + 1)
#undef ATT_LOAD
#undef ATT_QK
#undef ATT_SMPV
    lrun += __shfl_xor(lrun, 16); lrun += __shfl_xor(lrun, 32);
    const float inv = frcp_(lrun);
#pragma unroll
    for (int mt = 0; mt < 16; ++mt) {
        *reinterpret_cast<unsigned*>(&OL8[((size_t)t * NH + fr) * 256 + mt * 16 + fq * 4]) = pack4_fp8(o[mt][0] * inv, o[mt][1] * inv, o[mt][2] * inv, o[mt][3] * inv);
    }
}

constexpr int DSA_CCAP = 256;
__device__ __forceinline__ bool dsa_select8(const Args& a, const int t0, unsigned char* lds) {
    const bfr* P = (const bfr*)(a.ws + WS_P); const bfr* IKC = (const bfr*)(a.ws + WS_IKC);
    unsigned* KEYS = (unsigned*)(a.ws + WS_KEYS) + (size_t)blockIdx.x * (8 * 8192);
    unsigned short* BIN = (unsigned short*)lds; unsigned* H16 = (unsigned*)(lds + DSA_HIST_OFF);
    int* SEL = (int*)(lds + DSA_SEL_OFF); unsigned* MISC = (unsigned*)(lds + LDS_MISC);
    const int tid = my_tid(), lane = tid & 63, wv = tid >> 6, r = lane & 31, hf = lane >> 5;
    const int L = 64 * (t0 / 64 + 1);
    if (L <= 256) {
        for (int i = tid; i < 8 * 256; i += 512) SEL[i] = (i & 255) | (rel_bucket((i & 255) - (t0 + (i >> 8))) << 16);
        if (tid < 8) MISC[16 + tid] = (unsigned)L;
        __syncthreads();
        return true;
    }
#ifndef DUP_DSA
#define DUP_DSA 0
#endif
    for (int rp_ = 0; rp_ < ((DUP_DSA & 1) ? 2 : 1); ++rp_) {
    if (rp_) __syncthreads();
    for (int i = tid; i < 4096; i += 512) H16[i] = 0u;
    if (tid == 0) MISC[60] = 0u;
    __syncthreads();
    {
        const int qq = r >> 3, hh = r & 7;
        bf16x8 B[2][4]; float wgt[2], bsc[2];
#pragma unroll
        for (int grp = 0; grp < 2; ++grp) {
#pragma unroll
            for (int ks = 0; ks < 4; ++ks) B[grp][ks] = *reinterpret_cast<const bf16x8*>(&P[(size_t)(t0 + grp * 4 + qq) * NINP + C_IQ + hh * 64 + ks * 16 + hf * 8]);
            wgt[grp] = bf2f(P[(size_t)(t0 + grp * 4 + qq) * NINP + C_IW + hh]) * IDX_SCALE;
            float w2 = wgt[grp] * wgt[grp]; w2 += dpp_f<DPP_XOR1>(w2); w2 += dpp_f<DPP_XOR2>(w2); w2 += dpp_f<0x141>(w2);
            bsc[grp] = bin_scale(w2);
            if (hh == 0 && hf == 0) ((float*)MISC)[48 + grp * 4 + qq] = bsc[grp];
        }
        const bool b0 = (hh & 1) != 0, b1 = (hh & 2) != 0, b2 = (hh & 4) != 0;
        const int ntile = L >> 5;
        bf16x8 An[4];
        if (wv < ntile) {
#pragma unroll
            for (int ks = 0; ks < 4; ++ks) An[ks] = *reinterpret_cast<const bf16x8*>(&IKC[(size_t)(wv * 32 + r) * 64 + ks * 16 + hf * 8]);
        }
        for (int kt = wv; kt < ntile; kt += 8) {
            bf16x8 Ac[4];
#pragma unroll
            for (int ks = 0; ks < 4; ++ks) Ac[ks] = An[ks];
            if (kt + 8 < ntile) {
#pragma unroll
                for (int ks = 0; ks < 4; ++ks) An[ks] = *reinterpret_cast<const bf16x8*>(&IKC[(size_t)((kt + 8) * 32 + r) * 64 + ks * 16 + hf * 8]);
            }
#pragma unroll
            for (int grp = 0; grp < 2; ++grp) {
                f32x16 acc;
#pragma unroll
                for (int g = 0; g < 16; ++g) acc[g] = 0.f;
#pragma unroll
                for (int ks = 0; ks < 4; ++ks) acc = __builtin_amdgcn_mfma_f32_32x32x16_bf16(Ac[ks], B[grp][ks], acc, 0, 0, 0);
                float s1[8], s2[4], s3[2];
#pragma unroll
                for (int p = 0; p < 8; ++p) {
                    const float x0 = fmaxf(acc[2 * p], 0.f) * wgt[grp], x1 = fmaxf(acc[2 * p + 1], 0.f) * wgt[grp];
                    s1[p] = (b0 ? x1 : x0) + dpp_f<DPP_XOR1>(b0 ? x0 : x1);
                }
#pragma unroll
                for (int p = 0; p < 4; ++p) s2[p] = (b1 ? s1[2 * p + 1] : s1[2 * p]) + dpp_f<DPP_XOR2>(b1 ? s1[2 * p] : s1[2 * p + 1]);
#pragma unroll
                for (int p = 0; p < 2; ++p) s3[p] = (b2 ? s2[2 * p + 1] : s2[2 * p]) + __shfl_xor(b2 ? s2[2 * p] : s2[2 * p + 1], 4);
#pragma unroll
                for (int p = 0; p < 2; ++p) {
                    const int g = 8 * p + hh, kidx = kt * 32 + (g & 3) + 8 * (g >> 2) + 4 * hf, q = grp * 4 + qq;
                    const int bin = score_bin(s3[p], bsc[grp]);
                    BIN[q * 8192 + kidx] = (unsigned short)bin;
                    atomicAdd(&H16[q * 512 + (bin >> 1)], (bin & 1) ? 0x10000u : 1u);
                    __builtin_nontemporal_store(fkey(s3[p]), &KEYS[q * 8192 + kidx]);
                }
            }
        }
    }
    }
    asm volatile("s_waitcnt vmcnt(0)" ::: "memory");
    __syncthreads();
    {
        const int q = wv;
        const unsigned short* bins = BIN + q * 8192;
        unsigned* hrow = H16 + q * 512;
        unsigned cnt[16]; unsigned sown = 0;
#pragma unroll
        for (int i = 0; i < 8; ++i) { const unsigned w = hrow[lane * 8 + i]; cnt[2 * i] = w & 0xFFFFu; cnt[2 * i + 1] = w >> 16; sown += cnt[2 * i] + cnt[2 * i + 1]; }
        unsigned S = sown;
#pragma unroll
        for (int o = 1; o < 64; o <<= 1) { const unsigned tt = __shfl_down(S, o); if (lane + o < 64) S += tt; }
        const unsigned long long mfound = __ballot(S >= 256u);
        const int ls = 63 - __clzll(mfound);
        int b0l = 0; unsigned abovel = 0;
        {
            unsigned accv = S - sown; bool done = false;
#pragma unroll
            for (int bb = 15; bb >= 0; --bb) { if (!done) { if (accv + cnt[bb] >= 256u) { b0l = lane * 16 + bb; abovel = accv; done = true; } else accv += cnt[bb]; } }
        }
        const int b0 = __shfl(b0l, ls); const unsigned ngt = __shfl((int)abovel, ls); const unsigned need = 256u - ngt;
        __builtin_amdgcn_wave_barrier();
        int* CL = (int*)hrow; unsigned* CK = hrow + DSA_CCAP;
        const unsigned long long lt = (1ull << lane) - 1ull;
        unsigned rg = 0, rc = 0;
        for (int base = 0; base < (L >> 1); base += 64) {
            const bool valid = (base + lane) < (L >> 1);
            const unsigned w = valid ? reinterpret_cast<const unsigned*>(bins)[base + lane] : 0u;
            const int ba = (int)(w & 0xFFFFu), bb = (int)(w >> 16), ia = 2 * (base + lane), ib = ia + 1;
            const bool ga = valid && ba > b0, gb = valid && bb > b0, ca = valid && ba == b0, cb = valid && bb == b0;
            const unsigned long long mga = __ballot(ga), mgb = __ballot(gb), mca = __ballot(ca), mcb = __ballot(cb);
            const unsigned pg = rg + (unsigned)__popcll(mga & lt) + (unsigned)__popcll(mgb & lt);
            const unsigned pc = rc + (unsigned)__popcll(mca & lt) + (unsigned)__popcll(mcb & lt);
            if (ga && pg < 256u) SEL[q * 256 + pg] = ia;
            if (gb && pg + (ga ? 1u : 0u) < 256u) SEL[q * 256 + pg + (ga ? 1u : 0u)] = ib;
            if (ca && pc < (unsigned)DSA_CCAP) CL[pc] = ia;
            if (cb && pc + (ca ? 1u : 0u) < (unsigned)DSA_CCAP) CL[pc + (ca ? 1u : 0u)] = ib;
            rg += (unsigned)__popcll(mga) + (unsigned)__popcll(mgb); rc += (unsigned)__popcll(mca) + (unsigned)__popcll(mcb);
        }
        const unsigned ncand = rc;
        if (ncand > (unsigned)DSA_CCAP) { if (lane == 0) MISC[60] = 1u; }
        else {
            asm volatile("s_waitcnt lgkmcnt(0)" ::: "memory");
            for (unsigned i = lane; i < ncand; i += 64) CK[i] = __hip_atomic_load(&KEYS[q * 8192 + CL[i]], __ATOMIC_RELAXED, __HIP_MEMORY_SCOPE_AGENT);
            asm volatile("s_waitcnt vmcnt(0) lgkmcnt(0)" ::: "memory");
            __builtin_amdgcn_wave_barrier();
            for (unsigned i = lane; i < ncand; i += 64) {
                const unsigned me = CK[i]; unsigned rk = 0;
                for (unsigned j = 0; j < ncand; ++j) { const unsigned o = CK[j]; rk += (o > me || (o == me && j < i)) ? 1u : 0u; }
                if (rk < need) SEL[q * 256 + ngt + rk] = CL[i];
            }
            asm volatile("s_waitcnt lgkmcnt(0)" ::: "memory");
            __builtin_amdgcn_wave_barrier();
            for (int i = lane; i < 256; i += 64) { const int e = SEL[q * 256 + i]; SEL[q * 256 + i] = e | (rel_bucket(e - (t0 + q)) << 16); }
            if (lane == 0) MISC[16 + q] = 256u;
        }
    }
    __syncthreads();
    return MISC[60] == 0u;
}

__device__ __forceinline__ void dsa_unit(const Args& a, const int unit, unsigned char* lds) {
    const int t0 = unit * 8, wv = my_tid() >> 6;
    if (DUP_DSA & 2) { dsa_select8(a, t0, lds); __syncthreads(); }
    if (!dsa_select8(a, t0, lds)) {
        __syncthreads();
        dsa_select4(a, t0, 0, lds);
        dsa_select4(a, t0 + 4, 4, lds);
    }
    const int* SEL = (const int*)(lds + DSA_SEL_OFF); const unsigned* MISC = (const unsigned*)(lds + LDS_MISC);
    if (DUP_DSA & 4) dsa_attend(a, t0 + wv, SEL + wv * 256, (int)MISC[16 + wv], lds + wv * CT_WAVE, (const float*)(lds + DSA_RELB_OFF));
    dsa_attend(a, t0 + wv, SEL + wv * 256, (int)MISC[16 + wv], lds + wv * CT_WAVE, (const float*)(lds + DSA_RELB_OFF));
    __syncthreads();
}
template <int J> __device__ __forceinline__ int xchg_i(int v) {
    if (J == 1) return __builtin_amdgcn_update_dpp(0, v, 0xB1, 0xF, 0xF, true);
    else if (J == 2) return __builtin_amdgcn_update_dpp(0, v, 0x4E, 0xF, 0xF, true);
    else if (J == 4) { int t = __builtin_amdgcn_update_dpp(v, v, 0x104, 0xF, 0x5, false);
                       return __builtin_amdgcn_update_dpp(t, v, 0x114, 0xF, 0xA, false); }
    else if (J == 8) return __builtin_amdgcn_update_dpp(0, v, 0x128, 0xF, 0xF, true);
    else return __shfl_xor(v, J);
}
template <int J> __device__ __forceinline__ float xchg_f(float v) { return __int_as_float(xchg_i<J>(__float_as_int(v))); }

__device__ __forceinline__ unsigned okey(float f) { const unsigned u = __float_as_uint(f); return (u & 0x80000000u) ? ~u : (u | 0x80000000u); }
template <int K, int J> __device__ __forceinline__ void bitonic_step(unsigned& k, const int lane) {
    const unsigned ok = (unsigned)xchg_i<J>((int)k);
    const bool desc = (K == 64) ? true : ((lane & K) == 0);
    const bool keepmax = ((lane & J) == 0) == desc;
    k = keepmax ? max(k, ok) : min(k, ok);
}
__device__ __forceinline__ void bitonic64(unsigned& k, const int lane) {
    bitonic_step<2, 1>(k, lane);
    bitonic_step<4, 2>(k, lane); bitonic_step<4, 1>(k, lane);
    bitonic_step<8, 4>(k, lane); bitonic_step<8, 2>(k, lane); bitonic_step<8, 1>(k, lane);
    bitonic_step<16, 8>(k, lane); bitonic_step<16, 4>(k, lane); bitonic_step<16, 2>(k, lane); bitonic_step<16, 1>(k, lane);
    bitonic_step<32, 16>(k, lane); bitonic_step<32, 8>(k, lane); bitonic_step<32, 4>(k, lane); bitonic_step<32, 2>(k, lane); bitonic_step<32, 1>(k, lane);
    bitonic_step<64, 32>(k, lane); bitonic_step<64, 16>(k, lane); bitonic_step<64, 8>(k, lane); bitonic_step<64, 4>(k, lane); bitonic_step<64, 2>(k, lane); bitonic_step<64, 1>(k, lane);
}
__device__ __forceinline__ void merge32(unsigned& k, const int lane) {
    bitonic_step<64, 16>(k, lane); bitonic_step<64, 8>(k, lane); bitonic_step<64, 4>(k, lane); bitonic_step<64, 2>(k, lane); bitonic_step<64, 1>(k, lane);
}
__device__ __forceinline__ void top16_of_128(const float* s, float& tv, int& ti, const int lane) {
    unsigned ka = (okey(s[lane]) & ~0x7Fu) | (unsigned)(127 - lane), kb = (okey(s[64 + lane]) & ~0x7Fu) | (unsigned)(63 - lane);
    bitonic64(ka, lane); bitonic64(kb, lane);
    const unsigned rb = (unsigned)__shfl((int)kb, 31 - lane);
    unsigned k = (lane < 16) ? ka : ((lane < 32) ? rb : 0u);
    merge32(k, lane);
    ti = 127 - (int)(k & 0x7Fu);
    tv = s[ti];
}

__device__ __forceinline__ unsigned mirror16(unsigned v) { return (unsigned)__builtin_amdgcn_update_dpp(0, (int)v, 0x140, 0xF, 0xF, true); }
__device__ __forceinline__ void top16_pair(const float* s1, const float* s2, float& tv, int& ti, const int lane) {
    unsigned a1 = (okey(s1[lane]) & ~0x7Fu) | (unsigned)(127 - lane), b1 = (okey(s1[64 + lane]) & ~0x7Fu) | (unsigned)(63 - lane);
    unsigned a2 = (okey(s2[lane]) & ~0x7Fu) | (unsigned)(127 - lane), b2 = (okey(s2[64 + lane]) & ~0x7Fu) | (unsigned)(63 - lane);
#define PEER_S4(K, J) bitonic_step<K, J>(a1, lane); bitonic_step<K, J>(b1, lane); bitonic_step<K, J>(a2, lane); bitonic_step<K, J>(b2, lane);
    PEER_S4(2, 1) PEER_S4(4, 2) PEER_S4(4, 1) PEER_S4(8, 4) PEER_S4(8, 2) PEER_S4(8, 1) PEER_S4(64, 8) PEER_S4(64, 4) PEER_S4(64, 2) PEER_S4(64, 1)
#undef PEER_S4
    unsigned m1 = max(a1, mirror16(b1)), m2 = max(a2, mirror16(b2));
#define PEER_S2(J) bitonic_step<64, J>(m1, lane); bitonic_step<64, J>(m2, lane);
    PEER_S2(8) PEER_S2(4) PEER_S2(2) PEER_S2(1)
#undef PEER_S2
    const bool odd = (lane & 16) != 0;
    const unsigned own = odd ? m2 : m1, snd = odd ? m1 : m2;
    unsigned c = max(own, (unsigned)__shfl_xor((int)snd, 31));
    bitonic_step<64, 8>(c, lane); bitonic_step<64, 4>(c, lane); bitonic_step<64, 2>(c, lane); bitonic_step<64, 1>(c, lane);
    c = max(c, (unsigned)__shfl_xor((int)c, 47));
    bitonic_step<64, 8>(c, lane); bitonic_step<64, 4>(c, lane); bitonic_step<64, 2>(c, lane); bitonic_step<64, 1>(c, lane);
    ti = 127 - (int)(c & 0x7Fu);
    tv = (odd ? s2 : s1)[ti];
}

#ifndef DUP_PEER
#define DUP_PEER 0
#endif
constexpr int PEER_EID_OFF = 131072, PEER_GATE_OFF = 139264;
#ifndef PGB
#define PGB 8
#endif

__device__ __forceinline__ void peer_unit(const Args& a, const int unit, unsigned char* lds) {
    const bfr* QP = (const bfr*)(a.ws + WS_QP); const bfr* SUBK = (const bfr*)(a.ws + WS_SUBK);
    const unsigned char* PU4 = a.ws + WS_PU; const unsigned char* PV4 = a.ws + WS_PV;
    const bfr* HB = (const bfr*)(a.ws + WS_HB); const float* part = (const float*)(a.ws + WS_PART);
    float* S = (float*)lds; int* EID = (int*)(lds + PEER_EID_OFF); float* GATE = (float*)(lds + PEER_GATE_OFF);
    const int tid = my_tid(), lane = tid & 63, wv = tid >> 6, fr = lane & 15, fq = lane >> 4, t0 = unit * 16;
    for (int rp_ = 0; rp_ < ((DUP_PEER & 1) ? 2 : 1); ++rp_) {
    for (int hc = wv * 2; hc < wv * 2 + 2; ++hc) {
        bf16x8 A[4];
#pragma unroll
        for (int ks = 0; ks < 4; ++ks) A[ks] = *reinterpret_cast<const bf16x8*>(&QP[(size_t)(t0 + fr) * D + hc * 128 + ks * 32 + fq * 8]);
#pragma unroll 2
        for (int nt = 0; nt < 8; ++nt) {
            f32x4 acc = {0.f, 0.f, 0.f, 0.f};
#pragma unroll
            for (int ks = 0; ks < 4; ++ks) {
                const bf16x8 B = *reinterpret_cast<const bf16x8*>(&SUBK[(size_t)(hc * 128 + nt * 16 + fr) * 128 + ks * 32 + fq * 8]);
                acc = __builtin_amdgcn_mfma_f32_16x16x32_bf16(A[ks], B, acc, 0, 0, 0);
            }
#pragma unroll
            for (int j = 0; j < 4; ++j) S[((fq * 4 + j) * 16 + hc) * 128 + nt * 16 + fr] = acc[j];
        }
    }
    __syncthreads();
    for (int job = wv * 16; job < wv * 16 + 16; ++job) {
        const int tok = job >> 3, hh = job & 7;
        const float* s1 = S + (tok * 16 + hh * 2) * 128; const float* s2 = s1 + 128;
        float vv; int ii;
        top16_pair(s1, s2, vv, ii, lane);
        int ci = -1, cj = 0;
        { int base = 0;
#pragma unroll
          for (int i = 0; i < 16; ++i) { const int cnt = 16 / (i + 1); if (lane >= base && lane < base + cnt) { ci = i; cj = lane - base; } base += cnt; } }
        const float a1 = __shfl(vv, ci < 0 ? 0 : ci), b1 = __shfl(vv, 16 + cj);
        unsigned ck = (ci >= 0) ? ((okey(a1 + b1) & ~0xFFu) | (unsigned)(255 - (ci * 16 + cj))) : 0u;
        bitonic64(ck, lane);
        const int cid = 255 - (int)(ck & 0xFFu);
        const int pi = (lane < 16) ? (cid >> 4) : 0, pj = (lane < 16) ? (cid & 15) : 0;
        const float cv = __shfl(vv, pi) + __shfl(vv, 16 + pj);
        const float mx = __shfl(cv, 0);
        float e = (lane < 16) ? __expf(cv - mx) : 0.f;
        float se = e;
#pragma unroll
        for (int o = 1; o < 16; o <<= 1) se += __shfl_xor(se, o);
        const int e1 = __shfl(ii, pi), e2 = __shfl(ii, 16 + pj);
        if (lane < 16) { EID[tok * 128 + hh * 16 + lane] = e1 * 128 + e2; GATE[tok * 128 + hh * 16 + lane] = e * frcp_(se); }
    }
    __syncthreads();
    }
    for (int rp_ = 0; rp_ < ((DUP_PEER & 2) ? 2 : 1); ++rp_)
    for (int tk = wv * 2; tk < wv * 2 + 2; ++tk) {
        const int t = t0 + tk;
        int ln = lane; asm volatile("" : "+v"(ln));
        const float rstd = row_rstd(part, t);
        unsigned q1[4], q2[4]; float h1s, h2s;
        {
            float hf[32]; float am = 0.f;
#pragma unroll
            for (int q = 0; q < 8; ++q) {
                const uint2 xr = *reinterpret_cast<const uint2*>(&HB[(size_t)t * D + q * 256 + ln * 4]);
                const float4 g0 = *reinterpret_cast<const float4*>(&a.in[I_NFG][q * 256 + ln * 4]);
                hf[q * 4] = bflo(xr.x) * rstd * g0.x; hf[q * 4 + 1] = bfhi(xr.x) * rstd * g0.y; hf[q * 4 + 2] = bflo(xr.y) * rstd * g0.z; hf[q * 4 + 3] = bfhi(xr.y) * rstd * g0.w;
                am = fmaxf(am, fmaxf(fmaxf(fabsf(hf[q * 4]), fabsf(hf[q * 4 + 1])), fmaxf(fabsf(hf[q * 4 + 2]), fabsf(hf[q * 4 + 3]))));
            }
            h1s = am * (1.f / 7.f); const float i1 = h1s > 0.f ? frcp_(h1s) : 0.f;
            float qv[32]; float am2 = 0.f;
#pragma unroll
            for (int i = 0; i < 32; ++i) { qv[i] = fminf(fmaxf(__builtin_rintf(hf[i] * i1), -7.f), 7.f); hf[i] -= qv[i] * h1s; am2 = fmaxf(am2, fabsf(hf[i])); }
            q1[0] = pack8_i4(qv); q1[1] = pack8_i4(qv + 8); q1[2] = pack8_i4(qv + 16); q1[3] = pack8_i4(qv + 24);
            h2s = am2 * (1.f / 7.f); const float i2 = h2s > 0.f ? frcp_(h2s) : 0.f;
#pragma unroll
            for (int i = 0; i < 32; ++i) qv[i] = fminf(fmaxf(__builtin_rintf(hf[i] * i2), -7.f), 7.f);
            q2[0] = pack8_i4(qv); q2[1] = pack8_i4(qv + 8); q2[2] = pack8_i4(qv + 16); q2[3] = pack8_i4(qv + 24);
        }
        float coef0 = 0.f, coef1 = 0.f;
#pragma unroll 1
        for (int half = 0; half < 2; ++half) {
            float mydot = 0.f;
#define PEER_LOAD_U(W, SC, E0) _Pragma("unroll") for (int bq = 0; bq < 4; ++bq) { \
                const int eid = EID[tk * 128 + half * 64 + (E0) + bq]; const unsigned char* rowp = PU4 + (size_t)eid * PEER_ROWB; \
                SC[bq] = *reinterpret_cast<const bfr*>(rowp + 1024 + ln * 2); W[bq] = *reinterpret_cast<const uint4*>(rowp + ln * 16); } __builtin_amdgcn_sched_barrier(0);
#define PEER_DOT_U(W, SC, E0) _Pragma("unroll") for (int bq = 0; bq < 4; ++bq) { \
                int a1 = 0, a2 = 0; \
                a1 = __builtin_amdgcn_sdot8((int)W[bq].x, (int)q1[0], a1, false); a2 = __builtin_amdgcn_sdot8((int)W[bq].x, (int)q2[0], a2, false); \
                a1 = __builtin_amdgcn_sdot8((int)W[bq].y, (int)q1[1], a1, false); a2 = __builtin_amdgcn_sdot8((int)W[bq].y, (int)q2[1], a2, false); \
                a1 = __builtin_amdgcn_sdot8((int)W[bq].z, (int)q1[2], a1, false); a2 = __builtin_amdgcn_sdot8((int)W[bq].z, (int)q2[2], a2, false); \
                a1 = __builtin_amdgcn_sdot8((int)W[bq].w, (int)q1[3], a1, false); a2 = __builtin_amdgcn_sdot8((int)W[bq].w, (int)q2[3], a2, false); \
                float p = ((float)a1 * h1s + (float)a2 * h2s) * bf2f(SC[bq]); \
                p = wave_sum(p); if (lane == (E0) + bq) mydot = p; __builtin_amdgcn_sched_barrier(0); }
            {
                uint4 wA[4], wB[4]; bfr sA[4], sB[4];
                PEER_LOAD_U(wA, sA, 0)
#pragma unroll 1
                for (int e0 = 0; e0 < 56; e0 += 8) {
                    PEER_LOAD_U(wB, sB, e0 + 4)
                    PEER_DOT_U(wA, sA, e0)
                    PEER_LOAD_U(wA, sA, e0 + 8)
                    PEER_DOT_U(wB, sB, e0 + 4)
                }
                PEER_LOAD_U(wB, sB, 60)
                PEER_DOT_U(wA, sA, 56)
                PEER_DOT_U(wB, sB, 60)
            }
            const float gl = 0.5f * mydot * (1.f + erff(mydot * 0.7071067811865476f));
            const float cfv = gl * GATE[tk * 128 + half * 64 + lane];
            if (half == 0) coef0 = cfv; else coef1 = cfv;
        }
        h16x2 ov2[16];
#pragma unroll
        for (int j = 0; j < 16; ++j) ov2[j] = h16x2{(_Float16)0.f, (_Float16)0.f};
        {
#define PEER_LOAD_V(W, SC, E0) _Pragma("unroll") for (int bq = 0; bq < 4; ++bq) { \
                const int eid = __builtin_amdgcn_readfirstlane(EID[tk * 128 + (E0) + bq]); const unsigned char* rowp = PV4 + (size_t)eid * PEER_ROWB; \
                SC[bq] = *reinterpret_cast<const bfr*>(rowp + 1024 + ln * 2); W[bq] = *reinterpret_cast<const uint4*>(rowp + ln * 16); } __builtin_amdgcn_sched_barrier(0);
#define PEER_AXPY_V(W, SC, E0) _Pragma("unroll") for (int bq = 0; bq < 4; ++bq) { \
                const float cfl = __int_as_float(__builtin_amdgcn_readlane(__float_as_int(((E0) < 64) ? coef0 : coef1), ((E0) + bq) & 63)); \
                const unsigned dw[4] = {W[bq].x, W[bq].y, W[bq].z, W[bq].w}; const _Float16 ch = (_Float16)(cfl * bf2f(SC[bq])); const h16x2 c2 = {ch, ch}; \
                _Pragma("unroll") for (int d = 0; d < 4; ++d) { \
                    ov2[d * 4 + 0] = c2 * __builtin_amdgcn_cvt_scalef32_pk_f16_fp4(dw[d], 1.0f, 0) + ov2[d * 4 + 0]; \
                    ov2[d * 4 + 1] = c2 * __builtin_amdgcn_cvt_scalef32_pk_f16_fp4(dw[d], 1.0f, 1) + ov2[d * 4 + 1]; \
                    ov2[d * 4 + 2] = c2 * __builtin_amdgcn_cvt_scalef32_pk_f16_fp4(dw[d], 1.0f, 2) + ov2[d * 4 + 2]; \
                    ov2[d * 4 + 3] = c2 * __builtin_amdgcn_cvt_scalef32_pk_f16_fp4(dw[d], 1.0f, 3) + ov2[d * 4 + 3]; } \
                __builtin_amdgcn_sched_barrier(0); }
            uint4 wA[4], wB[4]; bfr sA[4], sB[4];
            PEER_LOAD_V(wA, sA, 0)
#pragma unroll 1
            for (int e0 = 0; e0 < 120; e0 += 8) {
                PEER_LOAD_V(wB, sB, e0 + 4)
                PEER_AXPY_V(wA, sA, e0)
                PEER_LOAD_V(wA, sA, e0 + 8)
                PEER_AXPY_V(wB, sB, e0 + 4)
            }
            PEER_LOAD_V(wB, sB, 124)
            PEER_AXPY_V(wA, sA, 120)
            PEER_AXPY_V(wB, sB, 124)
        }
        float ss = 0.f;
        float hv[32];
        { int l2 = lane; asm volatile("" : "+v"(l2));
#pragma unroll
          for (int q = 0; q < 8; ++q) {
              const uint2 xr = *reinterpret_cast<const uint2*>(&HB[(size_t)t * D + q * 256 + l2 * 4]);
              float4 x0; x0.x = bflo(xr.x); x0.y = bfhi(xr.x); x0.z = bflo(xr.y); x0.w = bfhi(xr.y);
              hv[q * 4 + 0] = x0.x; hv[q * 4 + 1] = x0.y; hv[q * 4 + 2] = x0.z; hv[q * 4 + 3] = x0.w;
          } }
#pragma unroll
        for (int j = 0; j < 32; ++j) { hv[j] += (DBG_NOPEER ? 0.f : (float)ov2[j >> 1][j & 1]); ss += hv[j] * hv[j]; }
        ss = wave_sum(ss);
        const float r2 = rsqrtf(ss * (1.f / D) + EPS);
#pragma unroll
        for (int q = 0; q < 8; ++q) {
            const float4 g0 = *reinterpret_cast<const float4*>(&a.in[I_NFIN][q * 256 + ln * 4]);
            float4 o0;
            o0.x = hv[q * 4 + 0] * r2 * g0.x; o0.y = hv[q * 4 + 1] * r2 * g0.y; o0.z = hv[q * 4 + 2] * r2 * g0.z; o0.w = hv[q * 4 + 3] * r2 * g0.w;
            *reinterpret_cast<float4*>(&a.out[(size_t)t * D + q * 256 + ln * 4]) = o0;
        }
    }
    __syncthreads();
}
constexpr int NPHASE = 9;
__global__ void __launch_bounds__(512, 2) mk_fwd(Args a) {
    extern __shared__ __attribute__((aligned(16))) unsigned char lds[];
    volatile LAS unsigned* barw = (volatile LAS unsigned*)((LAS unsigned char*)lds + LDS_BARW);
    unsigned* MISC = (unsigned*)(lds + LDS_MISC);
    if (threadIdx.x < 4) barw[threadIdx.x] = 0u;
    __syncthreads();
    XcdBarrier bar; bar.bar = (unsigned*)(a.ws + WS_CTL); bar.x = 0; bar.st = barw;
#if !MK_SPLIT
    bar = xcd_barrier_post((unsigned*)(a.ws + WS_CTL), barw);
#endif
    const int lo = a.ph_lo, hi = a.ph_hi;
#ifndef PH_MASK
#define PH_MASK 0x1FF
#endif
#define IN(k) (((PH_MASK >> (k)) & 1) && lo <= (k) && (k) < hi)
#ifndef DUP_RW
#define DUP_RW 0
#endif
#ifndef DUP_CHAIN
#define DUP_CHAIN 0
#endif
#ifndef DUP_MASK
#define DUP_MASK 0
#endif
#define REP(k) for (int rep_ = 0; rep_ < (((DUP_MASK >> (k)) & 1) ? 2 : 1); ++rep_)
#define SEAM(k) do { if (IN(k) && IN((k) + 1)) xcd_barrier(bar); } while (0)
    unsigned char* ws = a.ws;
    const bfr* P = (const bfr*)(ws + WS_P);

    if (IN(0)) REP(0) {
        const int tid = my_tid(), wv = tid >> 6; (void)tid; (void)wv;
        {
            const float* x = a.in[I_X]; const float* g = a.in[I_NMG]; bfr* XN = (bfr*)(ws + WS_XN);
            const int lane = tid & 63;
            for (int row = blockIdx.x * 8 + wv; row < T; row += gridDim.x * 8) {
                float4 v[8]; float ss = 0.f;
#pragma unroll
                for (int j = 0; j < 8; ++j) { v[j] = reinterpret_cast<const float4*>(x + (size_t)row * D)[j * 64 + lane]; ss += v[j].x * v[j].x + v[j].y * v[j].y + v[j].z * v[j].z + v[j].w * v[j].w; }
                ss = wave_sum(ss);
                const float rs = rsqrtf(ss * (1.f / D) + EPS);
#pragma unroll
                for (int j = 0; j < 8; ++j) {
                    const float4 gg = reinterpret_cast<const float4*>(g)[j * 64 + lane];
                    uint2 o; o.x = pack2(v[j].x * rs * gg.x, v[j].y * rs * gg.y); o.y = pack2(v[j].z * rs * gg.z, v[j].w * rs * gg.w);
                    reinterpret_cast<uint2*>(XN + (size_t)row * D)[j * 64 + lane] = o;
                }
            }
        }
        float* tl = (float*)lds;
        tr_all(a.in[I_WIN], (bfr*)(ws + WS_WTIN), D, NIN, NINP, nullptr, tl);
        tr_all(a.in[I_WBR], (bfr*)(ws + WS_WTA), RW, D, D, nullptr, tl);
        tr_all(a.in[I_WBD], (bfr*)(ws + WS_WTB), RW, D, D, nullptr, tl);
        tr_all(a.in[I_WOUT], (bfr*)(ws + WS_WTOUT), D, D, D, nullptr, tl);
        tr_all(a.in[I_WPQ], (bfr*)(ws + WS_WTPQ), D, D, D, a.in[I_NFG], tl);
        for (int it = blockIdx.x; it < 16 * 4; it += gridDim.x) {
            const int h = it >> 2, k0 = (it & 3) * 64;
            tr_tile(a.in[I_WUV] + (size_t)h * 256 * 64, (bfr*)(ws + WS_WUVT) + (size_t)h * 64 * 256, 256, 64, k0, 0, nullptr, tl);
        }
        cvt_all(a.in[I_WUK], (bfr*)(ws + WS_WUK), (size_t)16 * 256 * 64);
        cvt_all(a.in[I_SUBK], (bfr*)(ws + WS_SUBK), (size_t)16 * 128 * 128);
    }
    SEAM(0);

    if (IN(1)) REP(1) {
        const int tid = my_tid(), wv = tid >> 6; (void)tid; (void)wv;
        EpiP E{(bfr*)(ws + WS_P)};
        const int nM = T / BM, nN = NINP / BM;
        for (int tile = blockIdx.x; tile < nM * nN; tile += gridDim.x) {
            int brow, bcol; tile_rc(tile, nM, nN, brow, bcol);
            gemm_tile((const bfr*)(ws + WS_XN), (const bfr*)(ws + WS_WTIN), D, brow, bcol, (bfr*)lds, E);
        }
        {
            const int rem = (nM * nN) % (int)gridDim.x, idle = (int)gridDim.x - rem;
            if (rem == 0) cvt_i4_rows(a.in[I_PU], ws + WS_PU, blockIdx.x, gridDim.x);
            else if ((int)blockIdx.x >= rem) cvt_i4_rows(a.in[I_PU], ws + WS_PU, (int)blockIdx.x - rem, idle);
        }
    }
    SEAM(1);

    if (IN(2)) REP(2) {
        const int tid = my_tid(), wv = tid >> 6; (void)tid; (void)wv;
        rwkv_load_weights(a, blockIdx.x & 15, lds);
        {
            const int h = blockIdx.x & 15, nun = (NUNIT - (int)blockIdx.x + (int)gridDim.x - 1) / (int)gridDim.x;
            RwIn inA, inB;
            if (nun > 0) rwkv_fetch(a, (int)blockIdx.x >> 4, h, inA);
            for (int k = 0; k < nun; k += 2) {
                const int c0 = ((int)blockIdx.x + k * (int)gridDim.x) >> 4, c1 = ((int)blockIdx.x + (k + 1) * (int)gridDim.x) >> 4, c2 = ((int)blockIdx.x + (k + 2) * (int)gridDim.x) >> 4;
                rwkv_unit(a, c0, h, lds, inA, inB, (k + 1 < nun) ? c1 : -1);
                if (k + 1 < nun) rwkv_unit(a, c1, h, lds, inB, inA, (k + 2 < nun) ? c2 : -1);
            }
        }
        dsa_cnorm(a);
        dsa_qlat(a);
    }
    SEAM(2);

    if (IN(3)) REP(3) {
        const int tid = my_tid(), wv = tid >> 6; (void)tid; (void)wv;
        if (blockIdx.x < 32) {
            if (wv == 0) rwkv_chain(a, blockIdx.x >> 1, blockIdx.x & 1);
            else cvt_fp4_rows(a.in[I_PV], ws + WS_PV, (int)blockIdx.x * 7 + (wv - 1), 32 * 7);
        }
        __syncthreads();
        for (int i = tid; i < 512; i += 512) ((float*)(lds + DSA_RELB_OFF))[i] = a.in[I_RELB][i];
        __syncthreads();
        unsigned* cnt = (unsigned*)(ws + WS_CTL + CTL_CNT) + rep_ * 64;
        for (;;) {
            if (tid == 0) MISC[0] = atomicAdd(cnt, 1u);
            __syncthreads();
            const unsigned n = MISC[0];
            __syncthreads();
            if (n >= T / 8) break;
            dsa_unit(a, (T / 8 - 1) - (int)n, lds);
        }
    }
    SEAM(3);

    if (IN(4)) REP(4) {
        const int tid = my_tid(), wv = tid >> 6; (void)tid; (void)wv;
        float* Ls = (float*)lds + wv * 4352;
        for (int u = blockIdx.x * 8 + wv; u < NUNIT; u += gridDim.x * 8) rwkv_out_unit(a, u, Ls);
        dsa_oproj(a);
    }
    SEAM(4);

    if (IN(5)) REP(5) {
        const int tid = my_tid(), wv = tid >> 6; (void)tid; (void)wv;
        const int nM = T / BM, nN = D / BM;
        for (int tile = blockIdx.x; tile < nM * nN; tile += gridDim.x) {
            int brow, bcol; tile_rc(tile, nM, nN, brow, bcol);
#pragma unroll 1
            for (int pass = 0; pass < 2; ++pass) {
                EpiMix E{(bfr*)(ws + (pass ? WS_MIX : WS_TMPA)), pass ? (const bfr*)(ws + WS_TMPA) : (const bfr*)nullptr, P + (pass ? C_GB : C_GA)};
                gemm_tile((const bfr*)(ws + (pass ? WS_DO : WS_RWO)), (const bfr*)(ws + (pass ? WS_WTB : WS_WTA)), RW, brow, bcol, (bfr*)lds, E);
                asm volatile("s_waitcnt vmcnt(0)" ::: "memory");
            }
        }
    }
    SEAM(5);

    if (IN(6)) REP(6) {
        const int tid = my_tid(), wv = tid >> 6; (void)tid; (void)wv;
        const int nM = T / BM, nN = D / BM;
        for (int tile = blockIdx.x; tile < nM * nN; tile += gridDim.x) {
            int brow, bcol; tile_rc(tile, nM, nN, brow, bcol);
            EpiH E{(bfr*)(ws + WS_HB), a.in[I_X], (float*)(ws + WS_PART), bcol >> 8};
            gemm_tile((const bfr*)(ws + WS_MIX), (const bfr*)(ws + WS_WTOUT), D, brow, bcol, (bfr*)lds, E);
        }
    }
    SEAM(6);

    if (IN(7)) REP(7) {
        const int tid = my_tid(), wv = tid >> 6; (void)tid; (void)wv;
        const int nM = T / BM, nN = D / BM;
        float* rs = (float*)(lds + 135168);
        for (int tile = blockIdx.x; tile < nM * nN; tile += gridDim.x) {
            int brow, bcol; tile_rc(tile, nM, nN, brow, bcol);
            if (tid < 256) rs[tid] = row_rstd((const float*)(ws + WS_PART), brow + tid);
            __syncthreads();
            EpiQ E{(bfr*)(ws + WS_QP), rs, brow};
            gemm_tile((const bfr*)(ws + WS_HB), (const bfr*)(ws + WS_WTPQ), D, brow, bcol, (bfr*)lds, E);
        }
    }
    SEAM(7);

    if (IN(8)) REP(8) {
        const int tid = my_tid(), wv = tid >> 6; (void)tid; (void)wv;
        for (int u = blockIdx.x; u < T / 16; u += gridDim.x) peer_unit(a, u, lds);
    }
#undef IN
#undef SEAM
}

extern "C" void kernel_launch(void* const* d_in, const int* in_sizes, int n_in, void* d_out, int out_size, void* d_ws, size_t ws_size, hipStream_t stream) {
    static int grid = 0;
    if (grid == 0) {
        if (n_in != 27 || out_size != T * D || ws_size < WS_END) { fprintf(stderr, "kernel_launch: unexpected shapes (n_in %d out %d ws %zu)\n", n_in, out_size, ws_size); grid = -1; return; }
        int dev = 0, cus = 0, per_cu = 0;
        if (hipGetDevice(&dev) != hipSuccess || hipDeviceGetAttribute(&cus, hipDeviceAttributeMultiprocessorCount, dev) != hipSuccess) { grid = -1; return; }
        if (hipFuncSetAttribute((const void*)mk_fwd, hipFuncAttributeMaxDynamicSharedMemorySize, LDS_BYTES) != hipSuccess) { fprintf(stderr, "kernel_launch: hipFuncSetAttribute failed\n"); grid = -1; return; }
        if (hipOccupancyMaxActiveBlocksPerMultiprocessor(&per_cu, (const void*)mk_fwd, 512, LDS_BYTES) != hipSuccess || per_cu < 1) { fprintf(stderr, "kernel_launch: occupancy query says %d\n", per_cu); (void)hipGetLastError(); grid = -1; return; }
        grid = cus;
    }
    if (grid < 0) return;
    if (hipMemsetAsync((char*)d_ws + WS_CTL, 0, CTL_ZERO, stream) != hipSuccess) return;
    Args a{};
    for (int i = 0; i < 27; ++i) a.in[i] = (const float*)d_in[i];
    a.out = (float*)d_out; a.ws = (unsigned char*)d_ws;
#if MK_SPLIT
    for (int ph = 0; ph < NPHASE; ++ph) { a.ph_lo = ph; a.ph_hi = ph + 1; hipLaunchKernelGGL(mk_fwd, dim3(grid), dim3(512), LDS_BYTES, stream, a); }
#elif defined(PROBE_PHASE)
    a.ph_lo = 0; a.ph_hi = PROBE_PHASE + 1;
    hipLaunchKernelGGL(mk_fwd, dim3(grid), dim3(512), LDS_BYTES, stream, a);
    (void)hipMemsetAsync((char*)d_ws + WS_CTL, 0, CTL_ZERO, stream);
    a.ph_lo = PROBE_PHASE; a.ph_hi = NPHASE;
    hipLaunchKernelGGL(mk_fwd, dim3(grid), dim3(512), LDS_BYTES, stream, a);
#else
    a.ph_lo = 0; a.ph_hi = NPHASE;
    hipLaunchKernelGGL(mk_fwd, dim3(grid), dim3(512), LDS_BYTES, stream, a);
#endif
}
```

```cpp
#include <hip/hip_runtime.h>
#include <stdint.h>
#include <stdio.h>

#ifndef MK_SPLIT
#define MK_SPLIT 0
#endif

#ifndef DBG_NOPEER
#define DBG_NOPEER 0
#endif
#ifndef DBG_NODSA
#define DBG_NODSA 0
#endif
typedef unsigned short bfr;
using bf16x8 = __attribute__((ext_vector_type(8))) short;
using bf16x4 = __attribute__((ext_vector_type(4))) short;
using f32x4  = __attribute__((ext_vector_type(4))) float;
using f32x2  = __attribute__((ext_vector_type(2))) float;
using f32x16 = __attribute__((ext_vector_type(16))) float;
using u32x4  = __attribute__((ext_vector_type(4))) unsigned;
using h16x2  = __attribute__((ext_vector_type(2))) _Float16;

constexpr int T = 8192, D = 2048, NIN = 9320, NINP = 9472;
constexpr int RW = 1024, NH = 16, HD = 64;
constexpr int C_R = 0, C_K = 1024, C_V = 2048, C_ZW = 3072, C_ZA = 3136, C_ZG = 3200, C_Q = 3360, C_CKV = 4384,
              C_IQ = 4640, C_IK = 5152, C_IW = 5216, C_GA = 5224, C_GB = 7272;
constexpr int KVR = 256, NUNIT = 128 * 16;
constexpr float EPS = 1e-6f;

constexpr size_t MiB = 1u << 20;
constexpr size_t WS_CTL = 0;
constexpr size_t CTL_ZERO = 65536;
constexpr size_t CTL_CNT = 16384;
constexpr size_t CTL_ROWSS = 32768;
constexpr size_t WS_WTA = 1 * MiB, WS_WTB = 5 * MiB, WS_WTOUT = 9 * MiB, WS_WTPQ = 17 * MiB;
constexpr size_t WS_WUK = 25 * MiB, WS_WUVT = 25 * MiB + 512 * 1024, WS_SUBK = 26 * MiB;
constexpr size_t WS_X = 27 * MiB;
constexpr size_t WS_XN = WS_X, WS_WTIN = WS_X + 32 * MiB;
constexpr size_t WS_PM = WS_X, WS_WY = WS_X + 16 * MiB, WS_GM = WS_X + 32 * MiB, WS_YLOC = WS_X + 48 * MiB;
constexpr size_t WS_MIX = WS_X;
constexpr size_t WS_P = 96 * MiB;
constexpr size_t WS_H = 96 * MiB, WS_HB = 160 * MiB, WS_QP = 192 * MiB;
constexpr size_t WS_GG = 244 * MiB, WS_BON = 260 * MiB, WS_CB = 276 * MiB;
#ifdef OLAT_SEP
constexpr size_t WS_QLAT = 280 * MiB, WS_OLAT = 456 * MiB;
#else
constexpr size_t WS_QLAT = 280 * MiB, WS_OLAT = WS_QLAT;
#endif
constexpr size_t WS_KEYS = 344 * MiB;
constexpr size_t WS_PU = 490 * MiB, WS_PV = 312 * MiB;
constexpr size_t WS_PUS = WS_PU + 32 * MiB, WS_PVS = WS_PV + 32 * MiB;
constexpr size_t WS_ZT = 408 * MiB, WS_RWO = 424 * MiB, WS_DO = 440 * MiB, WS_TMPA = 456 * MiB;
constexpr size_t WS_IKC = 489 * MiB;
constexpr size_t WS_PART = 488 * MiB;
constexpr size_t WS_END = 508 * MiB;

constexpr int LDS_BYTES = 163840 - 1024;
constexpr int LDS_BARW = LDS_BYTES - 64;
constexpr int LDS_MISC = LDS_BYTES - 512;

typedef __bf16 bf16v2_t __attribute__((ext_vector_type(2)));
__device__ __forceinline__ bfr f2bf(float f) { const __bf16 r = (__bf16)f; return __builtin_bit_cast(bfr, r); }
__device__ __forceinline__ float bf2f(bfr b) { return __uint_as_float(((unsigned)b) << 16); }
__device__ __forceinline__ unsigned pack2(float a, float b) { const f32x2 v = {a, b}; const bf16v2_t r = __builtin_convertvector(v, bf16v2_t); return __builtin_bit_cast(unsigned, r); }
__device__ __forceinline__ float bflo(unsigned u) { return __uint_as_float(u << 16); }
__device__ __forceinline__ float bfhi(unsigned u) { return __uint_as_float(u & 0xFFFF0000u); }
__device__ __forceinline__ int my_tid() { int t = threadIdx.x; asm volatile("" : "+v"(t)); return t; }

template <int CTRL> __device__ __forceinline__ float dpp_f(float v) {
    return __int_as_float(__builtin_amdgcn_update_dpp(0, __float_as_int(v), CTRL, 0xF, 0xF, true));
}
#define DPP_XOR1 0xB1
#define DPP_XOR2 0x4E
__device__ __forceinline__ float wave_sum(float v) {
    v += dpp_f<DPP_XOR1>(v); v += dpp_f<DPP_XOR2>(v); v += dpp_f<0x141>(v); v += dpp_f<0x140>(v);
    v += __shfl_xor(v, 16); v += __shfl_xor(v, 32); return v;
}
__device__ __forceinline__ float frcp_(float x) { return __builtin_amdgcn_rcpf(x); }
__device__ __forceinline__ float sigmoidf_(float x) { return frcp_(1.f + __expf(-x)); }

#define XB_TMO      128
#define XB_XCNT(j)  (256  + 64 * (j))
#define XB_XSUB(j)  (1280 + 64 * (j))
#define XB_XGEN(j)  (2304 + 64 * (j))
#define XB_TOP      3328
#define XB_TOPGEN   3392
#define XCD_BAR_WORDS 3456
#define XB_SPIN_CAP (1u << 20)
#define LAS __attribute__((address_space(3)))

__device__ __forceinline__ unsigned xb_ld(unsigned* p)              { return __hip_atomic_load(p, __ATOMIC_RELAXED, __HIP_MEMORY_SCOPE_AGENT); }
__device__ __forceinline__ unsigned xb_add(unsigned* p, unsigned v) { return __hip_atomic_fetch_add(p, v, __ATOMIC_RELAXED, __HIP_MEMORY_SCOPE_AGENT); }
__device__ __forceinline__ unsigned xb_xcc_id() { return (unsigned)__builtin_amdgcn_s_getreg((3 << 11) | 20) & 0xFu; }
#define XB_SPIN(cond, bar) do { unsigned _sp = 0; while (cond) { __builtin_amdgcn_s_sleep(1); \
    if ((++_sp & 255u) == 0u) { if (xb_ld(&(bar)[XB_TMO])) break; if (_sp > XB_SPIN_CAP) { atomicAdd(&(bar)[XB_TMO], 1u); break; } } } } while (0)

struct XcdBarrier { unsigned* bar; unsigned x; volatile LAS unsigned* st; };

__device__ __forceinline__ XcdBarrier xcd_barrier_post(unsigned* bar, volatile LAS unsigned* st) {
    XcdBarrier b; b.bar = bar; b.x = xb_xcc_id(); b.st = st;
    if (threadIdx.x == 0) (void)xb_add(&bar[XB_XCNT(b.x)], 1u);
    return b;
}
__device__ __forceinline__ void xcd_barrier_complete(unsigned* bar, unsigned x, unsigned& nloc, unsigned& nx) {
    const unsigned G = gridDim.x * gridDim.y * gridDim.z;
    unsigned sum, cnt, mine, sp = 0u;
    for (;;) {
        sum = 0u; cnt = 0u; mine = 0u;
#pragma unroll
        for (unsigned j = 0; j < 16; ++j) { const unsigned c = xb_ld(&bar[XB_XCNT(j)]); sum += c; cnt += (c > 0u) ? 1u : 0u; mine = (j == x) ? c : mine; }
        if (sum == G) break;
        __builtin_amdgcn_s_sleep(1);
        if ((++sp & 255u) == 0u) { if (xb_ld(&bar[XB_TMO])) break; if (sp > XB_SPIN_CAP) { atomicAdd(&bar[XB_TMO], 1u); break; } }
    }
    nloc = mine > 0u ? mine : 1u; nx = cnt > 0u ? cnt : 1u;
}
__device__ __forceinline__ void xcd_barrier(const XcdBarrier& b) {
    asm volatile("s_waitcnt vmcnt(0)" ::: "memory");
    __syncthreads();
    if (threadIdx.x == 0) {
        unsigned* bar = b.bar;
        __builtin_amdgcn_s_waitcnt(0);
        unsigned nloc = b.st[0], nx = b.st[1];
        if (nloc == 0u) { xcd_barrier_complete(bar, b.x, nloc, nx); b.st[0] = nloc; b.st[1] = nx; }
        const unsigned old = xb_add(&bar[XB_XSUB(b.x)], 1u);
        const unsigned gen = old / nloc;
        if (old + 1u == (gen + 1u) * nloc) {
            __builtin_amdgcn_fence(__ATOMIC_RELEASE, "agent");
            asm volatile("s_waitcnt vmcnt(0)" ::: "memory");
            const unsigned og = xb_add(&bar[XB_TOP], 1u);
            const unsigned tg = og / nx;
            if (og + 1u == (tg + 1u) * nx) xb_add(&bar[XB_TOPGEN], 1u);
            else XB_SPIN(xb_ld(&bar[XB_TOPGEN]) == tg, bar);
            __builtin_amdgcn_fence(__ATOMIC_ACQUIRE, "agent");
            xb_add(&bar[XB_XGEN(b.x)], 1u);
            asm volatile("s_waitcnt vmcnt(0)" ::: "memory");
        } else {
            XB_SPIN(xb_ld(&bar[XB_XGEN(b.x)]) == gen, bar);
            __builtin_amdgcn_fence(__ATOMIC_ACQUIRE, "agent");
            asm volatile("s_waitcnt vmcnt(0)" ::: "memory");
        }
    }
    __syncthreads();
}

struct Args { const float* in[27]; float* out; unsigned char* ws; int ph_lo, ph_hi; };
enum { I_X = 0, I_NMG, I_WIN, I_SHIFT, I_W0, I_WDEC, I_A0, I_WICL, I_WGATE, I_KK, I_KA, I_RK, I_LNW, I_LNB, I_KVG, I_WUK, I_WUV,
       I_RELB, I_WBR, I_WBD, I_WOUT, I_NFG, I_WPQ, I_SUBK, I_PU, I_PV, I_NFIN };

constexpr int BM = 256, BK = 64, HALF = 128, HT = HALF * BK;
constexpr int EPI_LDW = 260;
__device__ __forceinline__ int lds_byte(int r, int c) {
    int st = (r >> 4) * 2 + (c >> 5), rr = r & 15, cc = c & 31, ob = rr * 64 + cc * 2;
    return st * 1024 + (ob ^ (((ob >> 9) & 1) << 5));
}
__device__ __forceinline__ void stage_rc(int b, int& R, int& C) {
    int st = b / 1024, sb = b % 1024, swz = sb ^ (((sb >> 9) & 1) << 5);
    R = (st >> 1) * 16 + swz / 64; C = (st & 1) * 32 + (swz % 64) / 2;
}

template <class Epi>
__device__ __forceinline__ void gemm_tile(const bfr* __restrict__ A, const bfr* __restrict__ Bt, const int K, const int brow, const int bcol,
                                          bfr* shm, Epi& epi) {
#define SA(b,h) (shm+((b)*2+(h))*HT)
#define SB(b,h) (shm+(4+(b)*2+(h))*HT)
#define STAGE_X(TT,P,BASE,br,kt) do{long _g=(long)(br)*K+(long)(kt)*BK; \
    for(int _i=0;_i<2;++_i){int _b=(TT)*16+_i*8192;int _r,_c;stage_rc(_b,_r,_c); \
      __builtin_amdgcn_global_load_lds((const unsigned*)(BASE+_g+(long)_r*K+_c), \
        (LAS unsigned*)((LAS char*)(P)+_b),16,0,0);}}while(0)
#define STAGE(P,BASE,br,kt) STAGE_X(tq,P,BASE,br,kt)
#define LDA(dst,b,h) for(int m=0;m<4;++m)for(int k=0;k<2;++k) \
    dst[m][k]=*reinterpret_cast<const bf16x8*>((char*)SA(b,h)+lds_byte(wr*64+m*16+fr,k*32+fq*8))
#define LDB(dst,b,h) for(int n=0;n<2;++n)for(int k=0;k<2;++k) \
    dst[n][k]=*reinterpret_cast<const bf16x8*>((char*)SB(b,h)+lds_byte(wc*32+n*16+fr,k*32+fq*8))
#define MMA(ai,bj,At_,Bt_) do{__builtin_amdgcn_s_setprio(1); \
    for(int m=0;m<4;++m)for(int n=0;n<2;++n)for(int k=0;k<2;++k) \
      acc[ai][bj][m][n]=__builtin_amdgcn_mfma_f32_16x16x32_bf16(At_[m][k],Bt_[n][k],acc[ai][bj][m][n],0,0,0); \
    __builtin_amdgcn_s_setprio(0);}while(0)
#define WAIT_V(n) asm volatile("s_waitcnt vmcnt(" #n ")":::"memory")
#define WAIT_L(n) asm volatile("s_waitcnt lgkmcnt(" #n ")":::"memory")
#define BAR __builtin_amdgcn_s_barrier()
#define SCHED __builtin_amdgcn_sched_barrier(0)
    const int tq = my_tid();
    int wid = tq >> 6, lane = tq & 63, wr = wid >> 2, wc = wid & 3, fr = lane & 15, fq = lane >> 4;
    f32x4 acc[2][2][4][2] = {};
    bf16x8 At[4][2], B0[2][2], B1[2][2];
    const int nt = K / BK;
    STAGE(SB(0,0),Bt,bcol,0); STAGE(SA(0,0),A,brow,0);
    STAGE(SB(0,1),Bt,bcol+HALF,0); STAGE(SA(0,1),A,brow+HALF,0);
    if(wr==1)BAR;
    WAIT_V(4); BAR;
    STAGE(SB(1,0),Bt,bcol,1); STAGE(SA(1,0),A,brow,1); STAGE(SB(1,1),Bt,bcol+HALF,1);
    WAIT_V(6); BAR;
    for(int t=0;t<nt-2;t+=2){
        LDB(B0,0,0); SCHED; LDA(At,0,0); STAGE(SA(1,1),A,brow+HALF,t+1);
        WAIT_L(8); BAR; WAIT_L(0); MMA(0,0,At,B0); BAR; SCHED;
        LDB(B1,0,1); STAGE(SB(0,0),Bt,bcol,t+2);
        BAR; WAIT_L(0); MMA(0,1,At,B1); BAR;
        LDA(At,0,1); STAGE(SA(0,0),A,brow,t+2);
        BAR; WAIT_L(0); MMA(1,0,At,B0); BAR; SCHED;
        STAGE(SB(0,1),Bt,bcol+HALF,t+2);
        WAIT_V(6); BAR; MMA(1,1,At,B1); BAR;
        LDB(B0,1,0); SCHED; LDA(At,1,0); STAGE(SA(0,1),A,brow+HALF,t+2);
        WAIT_L(8); BAR; WAIT_L(0); MMA(0,0,At,B0); BAR; SCHED;
        LDB(B1,1,1); STAGE(SB(1,0),Bt,bcol,t+3);
        BAR; WAIT_L(0); MMA(0,1,At,B1); BAR;
        LDA(At,1,1); STAGE(SA(1,0),A,brow,t+3);
        BAR; WAIT_L(0); MMA(1,0,At,B0); BAR; SCHED;
        STAGE(SB(1,1),Bt,bcol+HALF,t+3);
        WAIT_V(6); BAR; MMA(1,1,At,B1); BAR;
    }
    int tz=threadIdx.x; asm volatile("":"+v"(tz)); wid=tz>>6; lane=tz&63; wr=wid>>2; wc=wid&3; fr=lane&15; fq=lane>>4;
    { LDB(B0,0,0); WAIT_V(0); LDA(At,0,0); STAGE_X(tz,SA(1,1),A,brow+HALF,nt-1);
      BAR; WAIT_L(0); MMA(0,0,At,B0); BAR;
      LDB(B1,0,1); BAR; WAIT_L(0); MMA(0,1,At,B1); BAR;
      LDA(At,0,1); WAIT_V(4); BAR; WAIT_L(0); MMA(1,0,At,B0); MMA(1,1,At,B1); BAR; }
    { LDB(B0,1,0); LDA(At,1,0); WAIT_V(2); BAR; WAIT_L(0); MMA(0,0,At,B0); BAR;
      LDB(B1,1,1); WAIT_V(0); BAR; WAIT_L(0); MMA(0,1,At,B1); BAR;
      LDA(At,1,1); BAR; WAIT_L(0); MMA(1,0,At,B0); MMA(1,1,At,B1); BAR; }
    if(wr==0)BAR;
    {
        float* stg = (float*)shm;
#pragma unroll
        for (int ai = 0; ai < 2; ++ai) {
            __syncthreads();
#pragma unroll
            for (int bj = 0; bj < 2; ++bj)
#pragma unroll
                for (int m = 0; m < 4; ++m)
#pragma unroll
                    for (int n = 0; n < 2; ++n)
#pragma unroll
                        for (int j = 0; j < 4; ++j) stg[(wr * 64 + m * 16 + fq * 4 + j) * EPI_LDW + bj * HALF + wc * 32 + n * 16 + fr] = acc[ai][bj][m][n][j];
            __syncthreads();
#pragma unroll 2
            for (int it = 0; it < 8; ++it) {
                const int r = it * 16 + wid * 2 + (lane >> 5), c = (lane & 31) * 8;
                const float4 v0 = *reinterpret_cast<const float4*>(&stg[r * EPI_LDW + c]);
                const float4 v1 = *reinterpret_cast<const float4*>(&stg[r * EPI_LDW + c + 4]);
                const float v[8] = {v0.x, v0.y, v0.z, v0.w, v1.x, v1.y, v1.z, v1.w};
                epi.vec8(brow + ai * HALF + r, bcol + c, v);
            }
        }
    }
    __syncthreads();
#undef SA
#undef SB
#undef STAGE_X
#undef STAGE
#undef LDA
#undef LDB
#undef MMA
}

__device__ __forceinline__ void tile_rc(int wgid, const int nM, const int nN, int& brow, int& bcol) {
    const int nwg = nM * nN;
    { int q = nwg / 8, r = nwg % 8, xcd = wgid % 8, off = wgid / 8; wgid = (xcd < r ? xcd * (q + 1) : r * (q + 1) + (xcd - r) * q) + off; }
    const int nig = 8 * nN, gid = wgid / nig, fm = gid * 8, gsz = min(nM - fm, 8);
    const int pm = fm + ((wgid % nig) % gsz), pn = (wgid % nig) / gsz;
    brow = pm * BM; bcol = pn * BM;
}

__device__ __forceinline__ uint4 pack8(const float* v) { uint4 o; o.x = pack2(v[0], v[1]); o.y = pack2(v[2], v[3]); o.z = pack2(v[4], v[5]); o.w = pack2(v[6], v[7]); return o; }
__device__ __forceinline__ void unpack8(const uint4 u, float* v) { v[0] = bflo(u.x); v[1] = bfhi(u.x); v[2] = bflo(u.y); v[3] = bfhi(u.y); v[4] = bflo(u.z); v[5] = bfhi(u.z); v[6] = bflo(u.w); v[7] = bfhi(u.w); }
struct EpiP {
    bfr* P;
    __device__ __forceinline__ void vec8(int row, int col, const float* v) { *reinterpret_cast<uint4*>(&P[(size_t)row * NINP + col]) = pack8(v); }
};
struct EpiMix {
    bfr* outp; const bfr* addp; const bfr* gate;
    __device__ __forceinline__ void vec8(int row, int col, const float* v) {
        float g[8], r[8];
        unpack8(*reinterpret_cast<const uint4*>(&gate[(size_t)row * NINP + col]), g);
#pragma unroll
        for (int i = 0; i < 8; ++i) r[i] = sigmoidf_(g[i]) * v[i];
        if (addp) { float t[8]; unpack8(*reinterpret_cast<const uint4*>(&addp[(size_t)row * D + col]), t);
#pragma unroll
            for (int i = 0; i < 8; ++i) r[i] += t[i]; }
        *reinterpret_cast<uint4*>(&outp[(size_t)row * D + col]) = pack8(r);
    }
};
struct EpiH {
    bfr* hb; const float* x; float* part; int slot;
    __device__ __forceinline__ void vec8(int row, int col, const float* v) {
        const float4 x0 = *reinterpret_cast<const float4*>(&x[(size_t)row * D + col]), x1 = *reinterpret_cast<const float4*>(&x[(size_t)row * D + col + 4]);
        float h[8] = {x0.x + v[0], x0.y + v[1], x0.z + v[2], x0.w + v[3], x1.x + v[4], x1.y + v[5], x1.z + v[6], x1.w + v[7]};
        *reinterpret_cast<uint4*>(&hb[(size_t)row * D + col]) = pack8(h);
        float s = 0.f;
#pragma unroll
        for (int i = 0; i < 8; ++i) s += h[i] * h[i];
        s += dpp_f<DPP_XOR1>(s); s += dpp_f<DPP_XOR2>(s); s += dpp_f<0x141>(s); s += dpp_f<0x140>(s);
        s += __shfl_xor(s, 16);
        if ((threadIdx.x & 31) == 0) part[(size_t)row * 8 + slot] = s;
    }
};
struct EpiQ {
    bfr* qp; const float* rs; int brow;
    __device__ __forceinline__ void vec8(int row, int col, const float* v) {
        const float sc = rs[row - brow]; float r[8];
#pragma unroll
        for (int i = 0; i < 8; ++i) r[i] = v[i] * sc;
        *reinterpret_cast<uint4*>(&qp[(size_t)row * D + col]) = pack8(r);
    }
};
__device__ __forceinline__ float row_rstd(const float* part, int row) {
    float s = 0.f;
#pragma unroll
    for (int i = 0; i < 8; ++i) s += part[(size_t)row * 8 + i];
    return rsqrtf(s * (1.f / D) + EPS);
}

__device__ __forceinline__ void tr_tile(const float* __restrict__ src, bfr* __restrict__ dst, int K, int N, int k0, int n0, const float* kscale, float* lds) {
    const int tid = my_tid(), n = tid & 63, kk = tid >> 6;
#pragma unroll
    for (int j = 0; j < 8; ++j) { int k = kk + 8 * j, gn = n0 + n; float v = (gn < N) ? src[(size_t)(k0 + k) * N + gn] : 0.f; if (kscale) v *= kscale[k0 + k]; lds[k * 65 + n] = v; }
    __syncthreads();
    const int nn = tid >> 3, ks = tid & 7;
    uint4 o;
    o.x = pack2(lds[(ks * 8 + 0) * 65 + nn], lds[(ks * 8 + 1) * 65 + nn]); o.y = pack2(lds[(ks * 8 + 2) * 65 + nn], lds[(ks * 8 + 3) * 65 + nn]);
    o.z = pack2(lds[(ks * 8 + 4) * 65 + nn], lds[(ks * 8 + 5) * 65 + nn]); o.w = pack2(lds[(ks * 8 + 6) * 65 + nn], lds[(ks * 8 + 7) * 65 + nn]);
    *reinterpret_cast<uint4*>(&dst[(size_t)(n0 + nn) * K + k0 + ks * 8]) = o;
    __syncthreads();
}
struct StripRegs { float v[8][4]; };
__device__ __forceinline__ void strip_load(const float* __restrict__ src, int N, int k0, int n0, StripRegs& R) {
    const int tid = my_tid(), n = tid & 63, kk = tid >> 6;
#pragma unroll
    for (int j = 0; j < 8; ++j)
#pragma unroll
        for (int q = 0; q < 4; ++q) { const int gn = n0 + q * 64 + n; R.v[j][q] = (gn < N) ? src[(size_t)(k0 + kk + 8 * j) * N + gn] : 0.f; }
}
__device__ __forceinline__ void strip_store(const StripRegs& R, bfr* __restrict__ dst, int K, int k0, int n0, const float* kscale, float* lds) {
    const int tid = my_tid(), n = tid & 63, kk = tid >> 6;
#pragma unroll
    for (int j = 0; j < 8; ++j) {
        const float sc = kscale ? kscale[k0 + kk + 8 * j] : 1.f;
#pragma unroll
        for (int q = 0; q < 4; ++q) lds[(kk + 8 * j) * 257 + q * 64 + n] = R.v[j][q] * sc;
    }
    __syncthreads();
    const int nn = tid >> 1, hf = tid & 1;
#pragma unroll
    for (int c = 0; c < 4; ++c) {
        const int kb = hf * 32 + c * 8;
        uint4 o;
        o.x = pack2(lds[(kb + 0) * 257 + nn], lds[(kb + 1) * 257 + nn]); o.y = pack2(lds[(kb + 2) * 257 + nn], lds[(kb + 3) * 257 + nn]);
        o.z = pack2(lds[(kb + 4) * 257 + nn], lds[(kb + 5) * 257 + nn]); o.w = pack2(lds[(kb + 6) * 257 + nn], lds[(kb + 7) * 257 + nn]);
        *reinterpret_cast<uint4*>(&dst[(size_t)(n0 + nn) * K + k0 + kb]) = o;
    }
    __syncthreads();
}
__device__ __forceinline__ void tr_all(const float* src, bfr* dst, int K, int N, int Npad, const float* kscale, float* lds) {
    if ((Npad & 255) == 0) {
        const int nk = K / 64, ns = Npad / 256, tot = nk * ns;
        StripRegs RA, RB;
        int it = blockIdx.x;
        if (it < tot) strip_load(src, N, (it % nk) * 64, (it / nk) * 256, RA);
        while (it < tot) {
            const int itn = it + gridDim.x, it2 = itn + gridDim.x;
            if (itn < tot) strip_load(src, N, (itn % nk) * 64, (itn / nk) * 256, RB);
            strip_store(RA, dst, K, (it % nk) * 64, (it / nk) * 256, kscale, lds);
            if (itn >= tot) break;
            if (it2 < tot) strip_load(src, N, (it2 % nk) * 64, (it2 / nk) * 256, RA);
            strip_store(RB, dst, K, (itn % nk) * 64, (itn / nk) * 256, kscale, lds);
            it = it2;
        }
        return;
    }
    const int nk = K / 64, nn = Npad / 64;
    for (int it = blockIdx.x; it < nk * nn; it += gridDim.x) tr_tile(src, dst, K, N, (it % nk) * 64, (it / nk) * 64, kscale, lds);
}
__device__ __forceinline__ void cvt_all(const float* __restrict__ src, bfr* __restrict__ dst, size_t n) {
    const size_t n4 = n / 4;
    for (size_t i = (size_t)blockIdx.x * 512 + my_tid(); i < n4; i += (size_t)gridDim.x * 512) {
        float4 v = reinterpret_cast<const float4*>(src)[i];
        uint2 o; o.x = pack2(v.x, v.y); o.y = pack2(v.z, v.w);
        reinterpret_cast<uint2*>(dst)[i] = o;
    }
}

constexpr int PEER_ROWB = 1152;
__device__ __forceinline__ void cvt_fp4_rows(const float* __restrict__ src, unsigned char* __restrict__ dst, const int wrank, const int nwaves) {
    const int tid = my_tid(), lane = tid & 63;
    for (int row = wrank; row < 16384; row += nwaves) {
        float v[32]; float amax = 0.f;
#pragma unroll
        for (int q = 0; q < 8; ++q) {
            const f32x4 xx = __builtin_nontemporal_load(reinterpret_cast<const f32x4*>(&src[(size_t)row * D + q * 256 + lane * 4])); float4 x; x.x = xx[0]; x.y = xx[1]; x.z = xx[2]; x.w = xx[3];
            v[q * 4] = x.x; v[q * 4 + 1] = x.y; v[q * 4 + 2] = x.z; v[q * 4 + 3] = x.w;
            amax = fmaxf(amax, fmaxf(fmaxf(fabsf(x.x), fabsf(x.y)), fmaxf(fabsf(x.z), fabsf(x.w))));
        }
        const bfr sb = f2bf(amax * (1.f / 6.f));
        const float sc = bf2f(sb), inv = sc > 0.f ? frcp_(sc) : 0.f;
        unsigned dw[4];
#pragma unroll
        for (int d = 0; d < 4; ++d) {
            unsigned p = 0;
            p = __builtin_amdgcn_cvt_scalef32_pk_fp4_f32(p, v[d * 8 + 0] * inv, v[d * 8 + 1] * inv, 1.0f, 0);
            p = __builtin_amdgcn_cvt_scalef32_pk_fp4_f32(p, v[d * 8 + 2] * inv, v[d * 8 + 3] * inv, 1.0f, 1);
            p = __builtin_amdgcn_cvt_scalef32_pk_fp4_f32(p, v[d * 8 + 4] * inv, v[d * 8 + 5] * inv, 1.0f, 2);
            p = __builtin_amdgcn_cvt_scalef32_pk_fp4_f32(p, v[d * 8 + 6] * inv, v[d * 8 + 7] * inv, 1.0f, 3);
            dw[d] = p;
        }
        uint4 o4; o4.x = dw[0]; o4.y = dw[1]; o4.z = dw[2]; o4.w = dw[3];
        *reinterpret_cast<uint4*>(dst + (size_t)row * PEER_ROWB + lane * 16) = o4;
        *reinterpret_cast<bfr*>(dst + (size_t)row * PEER_ROWB + 1024 + lane * 2) = sb;
    }
}

__device__ __forceinline__ unsigned pack8_i4(const float* v) {
    unsigned d = 0;
#pragma unroll
    for (int i = 0; i < 8; ++i) d |= ((unsigned)((int)v[i]) & 0xFu) << (4 * i);
    return d;
}
__device__ __forceinline__ void cvt_i4_rows(const float* __restrict__ src, unsigned char* __restrict__ dst, const int rank, const int nranks) {
    const int tid = my_tid(), lane = tid & 63, wv = tid >> 6;
    for (int row = rank * 8 + wv; row < 16384; row += nranks * 8) {
        float v[32]; float amax = 0.f;
#pragma unroll
        for (int q = 0; q < 8; ++q) {
            const float4 x = *reinterpret_cast<const float4*>(&src[(size_t)row * D + q * 256 + lane * 4]);
            v[q * 4] = x.x; v[q * 4 + 1] = x.y; v[q * 4 + 2] = x.z; v[q * 4 + 3] = x.w;
            amax = fmaxf(amax, fmaxf(fmaxf(fabsf(x.x), fabsf(x.y)), fmaxf(fabsf(x.z), fabsf(x.w))));
        }
        const bfr sb = f2bf(amax * (1.f / 7.f));
        const float sc = bf2f(sb), inv = sc > 0.f ? frcp_(sc) : 0.f;
#pragma unroll
        for (int i = 0; i < 32; ++i) v[i] = fminf(fmaxf(__builtin_rintf(v[i] * inv), -7.f), 7.f);
        uint4 o4; o4.x = pack8_i4(v); o4.y = pack8_i4(v + 8); o4.z = pack8_i4(v + 16); o4.w = pack8_i4(v + 24);
        *reinterpret_cast<uint4*>(dst + (size_t)row * PEER_ROWB + lane * 16) = o4;
        *reinterpret_cast<bfr*>(dst + (size_t)row * PEER_ROWB + 1024 + lane * 2) = sb;
    }
}
__device__ __forceinline__ int pm_index(int kp, int k) {
    const int kpt = kp >> 5, r = kp & 31, kt = k >> 5, kk = k & 31, s = kk >> 4, rem = kk & 15;
    const int j = ((rem >> 3) << 2) | (rem & 3), hf = (rem >> 2) & 1, lane = hf * 32 + r;
    return ((((kpt * 2 + kt) * 2 + s) * 64 + lane) * 8) + j;
}
__device__ __forceinline__ int acc_index(int row, int col) {
    const int rt = row >> 5, r = row & 31, ct = col >> 5, c = col & 31;
    const int g4 = r >> 3, comp = r & 3, hf = (r >> 2) & 1, lane = hf * 32 + c;
    return ((((rt * 2 + ct) * 4 + g4) * 64 + lane) * 4) + comp;
}

constexpr int RW_ACT_STRIDE = 296, RW_LD = 72, RW_SLOT = 9216, RW_WL_OFF = 110592, RW_TOT_OFF = 148480, RW_BASE_OFF = 152576, RW_PART_OFF = 156928;
__device__ __forceinline__ f32x16 tile_mm_acc(f32x16 acc, const bfr* A, const int arow0, const bfr* Bt, const int brow0, const int r, const int hf) {
#pragma unroll
    for (int ks = 0; ks < 4; ++ks)
        acc = __builtin_amdgcn_mfma_f32_32x32x16_bf16(*reinterpret_cast<const bf16x8*>(&A[(arow0 + r) * RW_LD + ks * 16 + hf * 8]),
                                                     *reinterpret_cast<const bf16x8*>(&Bt[(brow0 + r) * RW_LD + ks * 16 + hf * 8]), acc, 0, 0, 0);
    return acc;
}
__device__ __forceinline__ f32x16 tile_mm(const bfr* A, const int arow0, const bfr* Bt, const int brow0, const int r, const int hf) {
    f32x16 z;
#pragma unroll
    for (int g = 0; g < 16; ++g) z[g] = 0.f;
    return tile_mm_acc(z, A, arow0, Bt, brow0, r, hf);
}
__device__ __forceinline__ void store_t(bfr* dst, const int col0, const int row0, const f32x16 acc, const int r, const int hf) {
#pragma unroll
    for (int g4 = 0; g4 < 4; ++g4) { uint2 p; p.x = pack2(acc[g4 * 4], acc[g4 * 4 + 1]); p.y = pack2(acc[g4 * 4 + 2], acc[g4 * 4 + 3]);
        *reinterpret_cast<uint2*>(&dst[(col0 + r) * RW_LD + row0 + g4 * 8 + hf * 4]) = p; }
}
#define DPP_HMIRROR 0x141
#define DPP_MIRROR  0x140

__device__ __forceinline__ void rwkv_load_weights(const Args& a, const int h, unsigned char* lds) {
    bfr* WL = (bfr*)(lds + RW_WL_OFF);
    const int tid = my_tid();
    for (int idx = tid; idx < 288 * 64; idx += 512) {
        const int m = idx >> 6, d = idx & 63;
        const float v = (m < 64) ? a.in[I_WDEC][(size_t)m * RW + h * 64 + d] : (m < 128) ? a.in[I_WICL][(size_t)(m - 64) * RW + h * 64 + d] : a.in[I_WGATE][(size_t)(m - 128) * RW + h * 64 + d];
        WL[d * RW_ACT_STRIDE + m] = f2bf(v);
    }
    __syncthreads();
}

struct RwIn { unsigned cu[18], pu[18]; bfr r[2][5], k[2][5], v[2][5]; };
__device__ __forceinline__ void rwkv_fetch(const Args& a, const int c, const int h, RwIn& in) {
    const bfr* __restrict__ P = (const bfr*)(a.ws + WS_P);
    const int tid = my_tid(), lane = tid & 63, wv = tid >> 6, fr = lane & 15, fq = lane >> 4, t0 = c * 64;
    {
        const int i = tid >> 3, part = tid & 7, t = t0 + i;
        const bfr* pc = P + (size_t)t * NINP + C_ZW + part * 36;
        const bfr* pp = pc - NINP;
#pragma unroll
        for (int q = 0; q < 18; ++q) { in.cu[q] = *reinterpret_cast<const unsigned*>(pc + q * 2); in.pu[q] = (t > 0) ? *reinterpret_cast<const unsigned*>(pp + q * 2) : 0u; }
    }
    const int tt = wv >> 1, dh = wv & 1;
#pragma unroll
    for (int dt = 0; dt < 2; ++dt) {
        const int hd = h * 64 + dh * 32 + dt * 16 + fr;
        const int tp = t0 + tt * 16 + fq * 4 - 1;
        const bool hp = tp >= 0;
        in.r[dt][0] = hp ? P[(size_t)(hp ? tp : 0) * NINP + C_R + hd] : (bfr)0; in.k[dt][0] = hp ? P[(size_t)(hp ? tp : 0) * NINP + C_K + hd] : (bfr)0; in.v[dt][0] = hp ? P[(size_t)(hp ? tp : 0) * NINP + C_V + hd] : (bfr)0;
#pragma unroll
        for (int j = 0; j < 4; ++j) { const size_t ro = (size_t)(tp + 1 + j) * NINP; in.r[dt][j + 1] = P[ro + C_R + hd]; in.k[dt][j + 1] = P[ro + C_K + hd]; in.v[dt][j + 1] = P[ro + C_V + hd]; }
    }
}

__device__ __forceinline__ void rwkv_unit(const Args& a, const int c, const int h, unsigned char* lds, const RwIn& in, RwIn& nxt, const int cnext) {
    const float* __restrict__ smix = a.in[I_SHIFT];
    const int tid = my_tid(), lane = tid & 63, wv = tid >> 6, fr = lane & 15, fq = lane >> 4, t0 = c * 64, u = c * 16 + h;
#define SLOT(k) ((bfr*)(lds + (k) * RW_SLOT))
    bfr* ACT = (bfr*)lds; const bfr* WL = (const bfr*)(lds + RW_WL_OFF);
    float* TOT = (float*)(lds + RW_TOT_OFF); float* BASE = (float*)(lds + RW_BASE_OFF); float* PART = (float*)(lds + RW_PART_OFF);
    {
        const int i = tid >> 3, part = tid & 7;
#pragma unroll
        for (int q = 0; q < 18; ++q) {
            const int cc = part * 36 + q * 2;
            const unsigned cu = in.cu[q], pu = in.pu[q];
            const float2 mx = *reinterpret_cast<const float2*>(&smix[C_ZW + cc]);
            const float c0 = bflo(cu), c1 = bfhi(cu);
            float z0 = c0 + (bflo(pu) - c0) * mx.x, z1 = c1 + (bfhi(pu) - c1) * mx.y;
            if (cc < 64) { z0 = 1.f - 2.f * frcp_(1.f + __expf(2.f * z0)); z1 = 1.f - 2.f * frcp_(1.f + __expf(2.f * z1)); }
            else if (cc >= 128) { z0 = sigmoidf_(z0); z1 = sigmoidf_(z1); }
            *reinterpret_cast<unsigned*>(&ACT[i * RW_ACT_STRIDE + cc]) = pack2(z0, z1);
        }
    }
    const int tt = wv >> 1, dh = wv & 1;
    float zr[2][4], zk[2][4], zv[2][4];
#pragma unroll
    for (int dt = 0; dt < 2; ++dt) {
        const int hd = h * 64 + dh * 32 + dt * 16 + fr;
        const float mr = smix[C_R + hd], mk = smix[C_K + hd], mv = smix[C_V + hd];
        float pr = bf2f(in.r[dt][0]), pk = bf2f(in.k[dt][0]), pv = bf2f(in.v[dt][0]);
#pragma unroll
        for (int j = 0; j < 4; ++j) {
            const float cr = bf2f(in.r[dt][j + 1]), ck = bf2f(in.k[dt][j + 1]), cv = bf2f(in.v[dt][j + 1]);
            zr[dt][j] = cr + (pr - cr) * mr; zk[dt][j] = ck + (pk - ck) * mk; zv[dt][j] = cv + (pv - cv) * mv;
            pr = cr; pk = ck; pv = cv;
        }
    }
    __syncthreads();
    f32x4 xw[2], xa[2], xg[2];
#pragma unroll
    for (int dt = 0; dt < 2; ++dt) {
        xw[dt] = f32x4{0.f, 0.f, 0.f, 0.f}; xa[dt] = xw[dt]; xg[dt] = xw[dt];
        const bfr* arow = ACT + (tt * 16 + fr) * RW_ACT_STRIDE + fq * 8;
        const bfr* brow = WL + (dh * 32 + dt * 16 + fr) * RW_ACT_STRIDE + fq * 8;
#pragma unroll
        for (int ks = 0; ks < 2; ++ks) {
            xw[dt] = __builtin_amdgcn_mfma_f32_16x16x32_bf16(*reinterpret_cast<const bf16x8*>(arow + ks * 32), *reinterpret_cast<const bf16x8*>(brow + ks * 32), xw[dt], 0, 0, 0);
            xa[dt] = __builtin_amdgcn_mfma_f32_16x16x32_bf16(*reinterpret_cast<const bf16x8*>(arow + 64 + ks * 32), *reinterpret_cast<const bf16x8*>(brow + 64 + ks * 32), xa[dt], 0, 0, 0);
        }
#pragma unroll
        for (int ks = 0; ks < 5; ++ks)
            xg[dt] = __builtin_amdgcn_mfma_f32_16x16x32_bf16(*reinterpret_cast<const bf16x8*>(arow + 128 + ks * 32), *reinterpret_cast<const bf16x8*>(brow + 128 + ks * 32), xg[dt], 0, 0, 0);
    }
    float lw[2][4], av[2][4], kkr[2][4], k4[2][4], n2[4], cf[4];
#pragma unroll
    for (int j = 0; j < 4; ++j) { n2[j] = 0.f; cf[j] = 0.f; }
#pragma unroll
    for (int dt = 0; dt < 2; ++dt) {
        const int hd = h * 64 + dh * 32 + dt * 16 + fr;
        const float w0 = a.in[I_W0][hd], a0 = a.in[I_A0][hd], kkm = a.in[I_KK][hd], kam = a.in[I_KA][hd], rkm = a.in[I_RK][hd];
        float run = 0.f;
#pragma unroll
        for (int j = 0; j < 4; ++j) {
            run += -0.6065306597126334f * sigmoidf_(w0 + xw[dt][j]);
            lw[dt][j] = run;
            av[dt][j] = sigmoidf_(a0 + xa[dt][j]);
            kkr[dt][j] = zk[dt][j] * kkm;
            k4[dt][j] = zk[dt][j] * (1.f + (av[dt][j] - 1.f) * kam);
            n2[j] += kkr[dt][j] * kkr[dt][j];
            cf[j] += zr[dt][j] * k4[dt][j] * rkm;
        }
        TOT[(tt * 4 + fq) * 64 + dh * 32 + dt * 16 + fr] = run;
    }
#pragma unroll
    for (int j = 0; j < 4; ++j) {
        n2[j] += dpp_f<DPP_XOR1>(n2[j]); n2[j] += dpp_f<DPP_XOR2>(n2[j]); n2[j] += dpp_f<DPP_HMIRROR>(n2[j]); n2[j] += dpp_f<DPP_MIRROR>(n2[j]);
        cf[j] += dpp_f<DPP_XOR1>(cf[j]); cf[j] += dpp_f<DPP_XOR2>(cf[j]); cf[j] += dpp_f<DPP_HMIRROR>(cf[j]); cf[j] += dpp_f<DPP_MIRROR>(cf[j]);
        if (fr == 0) { PART[(wv * 16 + fq * 4 + j) * 2] = n2[j]; PART[(wv * 16 + fq * 4 + j) * 2 + 1] = cf[j]; }
    }
    __syncthreads();
    if (tid < 64) {
        float run = 0.f;
#pragma unroll
        for (int g = 0; g < 16; ++g) { const float tv = TOT[g * 64 + tid]; BASE[g * 64 + tid] = run; run += tv; }
        BASE[16 * 64 + tid] = run;
    }
    __syncthreads();
    {
        bfr* Gg = (bfr*)(a.ws + WS_GG); bfr* Bon = (bfr*)(a.ws + WS_BON);
        const int i0 = tt * 16 + fq * 4;
        float rn[4], cft[4];
#pragma unroll
        for (int j = 0; j < 4; ++j) {
            const float n2t = n2[j] + PART[((wv ^ 1) * 16 + fq * 4 + j) * 2]; cft[j] = cf[j] + PART[((wv ^ 1) * 16 + fq * 4 + j) * 2 + 1];
            rn[j] = __builtin_amdgcn_rsqf(fmaxf(n2t, 1e-24f));
        }
#pragma unroll
        for (int dt = 0; dt < 2; ++dt) {
            const int d = dh * 32 + dt * 16 + fr;
            const float base = BASE[(tt * 4 + fq) * 64 + d], clT = BASE[16 * 64 + d];
            float vAt[4], vBh[4], vKh[4];
#pragma unroll
            for (int j = 0; j < 4; ++j) {
                const float cl = base + lw[dt][j], clm1 = (j == 0) ? base : base + lw[dt][j - 1];
                const float gi = __expf(cl), gm1 = __expf(clm1), ig = __expf(-cl), gce = __expf(clT - cl);
                const float kk = kkr[dt][j] * rn[j], beta = kk * av[dt][j];
                vAt[j] = -kk * gm1; vBh[j] = beta * gce; vKh[j] = k4[dt][j] * gce;
                SLOT(0)[(i0 + j) * RW_LD + d] = f2bf(vAt[j]);
                SLOT(1)[(i0 + j) * RW_LD + d] = f2bf(beta * ig);
                SLOT(2)[(i0 + j) * RW_LD + d] = f2bf(k4[dt][j] * ig);
                SLOT(3)[(i0 + j) * RW_LD + d] = f2bf(zr[dt][j] * gi);
                const size_t o = (size_t)(t0 + i0 + j) * RW + h * 64 + d;
                Gg[o] = f2bf(xg[dt][j]); Bon[o] = f2bf(cft[j] * zv[dt][j]);
            }
            uint2 p;
            p.x = pack2(vAt[0], vAt[1]); p.y = pack2(vAt[2], vAt[3]); *reinterpret_cast<uint2*>(&SLOT(4)[d * RW_LD + i0]) = p;
            p.x = pack2(vBh[0], vBh[1]); p.y = pack2(vBh[2], vBh[3]); *reinterpret_cast<uint2*>(&SLOT(5)[d * RW_LD + i0]) = p;
            p.x = pack2(vKh[0], vKh[1]); p.y = pack2(vKh[2], vKh[3]); *reinterpret_cast<uint2*>(&SLOT(6)[d * RW_LD + i0]) = p;
            p.x = pack2(zv[dt][0], zv[dt][1]); p.y = pack2(zv[dt][2], zv[dt][3]); *reinterpret_cast<uint2*>(&SLOT(7)[d * RW_LD + i0]) = p;
        }
    }
    __syncthreads();
    if (cnext >= 0) rwkv_fetch(a, cnext, h, nxt);
    const int r = lane & 31, hf = lane >> 5;
    {
        const int prod = wv >> 1, sub = wv & 1;
        const bfr* Aop = (prod & 1) ? SLOT(2) : SLOT(1);
        const bfr* Bop = (prod >= 2) ? SLOT(3) : SLOT(0);
        bfr* Ld = SLOT(8 + prod);
        const bool incl = prod >= 2;
        for (int job = 0; job < (sub ? 2 : 1); ++job) {
            const int jt = sub ? job : 0, it = sub ? 1 : 0;
            f32x16 acc = tile_mm(Aop, jt * 32, Bop, it * 32, r, hf);
#pragma unroll
            for (int g4 = 0; g4 < 4; ++g4) {
                const int i = it * 32 + r, j0 = jt * 32 + g4 * 8 + hf * 4;
                float v[4];
#pragma unroll
                for (int q = 0; q < 4; ++q) { const int j = j0 + q; v[q] = (incl ? (j <= i) : (j < i)) ? acc[g4 * 4 + q] : 0.f; }
                uint2 p; p.x = pack2(v[0], v[1]); p.y = pack2(v[2], v[3]);
                *reinterpret_cast<uint2*>(&Ld[i * RW_LD + j0]) = p;
            }
        }
        if (!sub) {
#pragma unroll
            for (int g4 = 0; g4 < 4; ++g4) *reinterpret_cast<uint2*>(&Ld[r * RW_LD + 32 + g4 * 8 + hf * 4]) = make_uint2(0u, 0u);
        }
    }
    __syncthreads();
    if (wv == 0) {
        bfr* Tl = SLOT(0); bfr* TlT = SLOT(1); const bfr* Lab = SLOT(8);
        for (int q = 0; q < 9; ++q) { *reinterpret_cast<uint4*>((unsigned char*)Tl + (q * 64 + lane) * 16) = make_uint4(0u, 0u, 0u, 0u); *reinterpret_cast<uint4*>((unsigned char*)TlT + (q * 64 + lane) * 16) = make_uint4(0u, 0u, 0u, 0u); }
        {
            const int bq = lane >> 4, cc = lane & 15;
            float x[16];
#pragma unroll
            for (int rr = 0; rr < 16; ++rr) {
                float lrow[16];
                unpack8(*reinterpret_cast<const uint4*>(&Lab[(bq * 16 + rr) * RW_LD + bq * 16]), lrow);
                unpack8(*reinterpret_cast<const uint4*>(&Lab[(bq * 16 + rr) * RW_LD + bq * 16 + 8]), lrow + 8);
                float sacc = (rr == cc) ? 1.f : 0.f;
#pragma unroll
                for (int m = 0; m < rr; ++m) sacc += lrow[m] * x[m];
                x[rr] = sacc;
            }
#pragma unroll
            for (int rr = 0; rr < 16; ++rr) Tl[(bq * 16 + rr) * RW_LD + bq * 16 + cc] = f2bf(x[rr]);
            *reinterpret_cast<uint4*>(&TlT[(bq * 16 + cc) * RW_LD + bq * 16]) = pack8(x);
            *reinterpret_cast<uint4*>(&TlT[(bq * 16 + cc) * RW_LD + bq * 16 + 8]) = pack8(x + 8);
        }
        asm volatile("s_waitcnt lgkmcnt(0)" ::: "memory");
#pragma unroll
        for (int bi = 1; bi < 4; ++bi) {
#pragma unroll
            for (int bj = 0; bj < bi; ++bj) {
                f32x4 acc = {0.f, 0.f, 0.f, 0.f};
#pragma unroll
                for (int bm = bj; bm < bi; ++bm) {
                    const bf16x4 Af = *reinterpret_cast<const bf16x4*>(&Lab[(bi * 16 + fr) * RW_LD + bm * 16 + fq * 4]);
                    const bf16x4 Bf = *reinterpret_cast<const bf16x4*>(&TlT[(bj * 16 + fr) * RW_LD + bm * 16 + fq * 4]);
                    acc = __builtin_amdgcn_mfma_f32_16x16x16bf16_1k(Af, Bf, acc, 0, 0, 0);
                }
                bf16x4 Bacc; Bacc[0] = (short)f2bf(acc[0]); Bacc[1] = (short)f2bf(acc[1]); Bacc[2] = (short)f2bf(acc[2]); Bacc[3] = (short)f2bf(acc[3]);
                const bf16x4 Ad = *reinterpret_cast<const bf16x4*>(&Tl[(bi * 16 + fr) * RW_LD + bi * 16 + fq * 4]);
                const f32x4 tb = __builtin_amdgcn_mfma_f32_16x16x16bf16_1k(Ad, Bacc, f32x4{0.f, 0.f, 0.f, 0.f}, 0, 0, 0);
#pragma unroll
                for (int q = 0; q < 4; ++q) Tl[(bi * 16 + fq * 4 + q) * RW_LD + bj * 16 + fr] = f2bf(tb[q]);
                uint2 p; p.x = pack2(tb[0], tb[1]); p.y = pack2(tb[2], tb[3]);
                *reinterpret_cast<uint2*>(&TlT[(bj * 16 + fr) * RW_LD + bi * 16 + fq * 4]) = p;
            }
            asm volatile("s_waitcnt lgkmcnt(0)" ::: "memory");
        }
    } else if (wv >= 4) {
        const int it = (wv >> 1) & 1, vt = wv & 1;
        const f32x16 acc = tile_mm(SLOT(9), it * 32, SLOT(7), vt * 32, r, hf);
        store_t(SLOT(2), vt * 32, it * 32, acc, r, hf);
    }
    __syncthreads();
    {
        const int which = wv >> 2, it = (wv >> 1) & 1, ct = wv & 1;
        const f32x16 acc = tile_mm(SLOT(0), it * 32, which ? SLOT(2) : SLOT(4), ct * 32, r, hf);
        store_t(which ? SLOT(9) : SLOT(8), ct * 32, it * 32, acc, r, hf);
    }
    __syncthreads();
    if (wv < 4) {
        {
            const int dtl = wv >> 1, itl = wv & 1;
            f32x16 acc = tile_mm(SLOT(8), dtl * 32, SLOT(10), itl * 32, r, hf);
            bfr* WY = (bfr*)(a.ws + WS_WY) + (size_t)u * 4096;
            const int i = itl * 32 + r;
#pragma unroll
            for (int g4 = 0; g4 < 4; ++g4) {
                const int d0 = dtl * 32 + g4 * 8 + hf * 4;
                const uint2 rr2 = *reinterpret_cast<const uint2*>(&SLOT(3)[i * RW_LD + d0]);
                uint2 p; p.x = pack2(acc[g4 * 4] + bflo(rr2.x), acc[g4 * 4 + 1] + bfhi(rr2.x)); p.y = pack2(acc[g4 * 4 + 2] + bflo(rr2.y), acc[g4 * 4 + 3] + bfhi(rr2.y));
                *reinterpret_cast<uint2*>(&WY[i * 64 + d0]) = p;
            }
        }
        {
            const int it = wv >> 1, vt = wv & 1;
            f32x16 acc = tile_mm(SLOT(10), it * 32, SLOT(9), vt * 32, r, hf);
            acc = tile_mm_acc(acc, SLOT(11), it * 32, SLOT(7), vt * 32, r, hf);
            bfr* YL = (bfr*)(a.ws + WS_YLOC) + (size_t)u * 4096;
#pragma unroll
            for (int g4 = 0; g4 < 4; ++g4) { uint2 p; p.x = pack2(acc[g4 * 4], acc[g4 * 4 + 1]); p.y = pack2(acc[g4 * 4 + 2], acc[g4 * 4 + 3]);
                *reinterpret_cast<uint2*>(&YL[(((it * 2 + vt) * 4 + g4) * 64 + lane) * 4]) = p; }
        }
    } else {
        {
            const int kt = (wv >> 1) & 1, kpt = wv & 1;
            f32x16 acc = tile_mm(SLOT(8), kt * 32, SLOT(5), kpt * 32, r, hf);
            if (kt == kpt) {
                const float gc = __expf(BASE[16 * 64 + kt * 32 + r]);
#pragma unroll
                for (int g = 0; g < 16; ++g) if (((g & 3) + 8 * (g >> 2) + 4 * hf) == r) acc[g] += gc;
            }
            bfr* PM = (bfr*)(a.ws + WS_PM) + (size_t)u * 4096;
#pragma unroll
            for (int sgrp = 0; sgrp < 2; ++sgrp) {
                float v8[8];
#pragma unroll
                for (int q = 0; q < 8; ++q) v8[q] = acc[sgrp * 8 + q];
                *reinterpret_cast<uint4*>(&PM[(((kpt * 2 + kt) * 2 + sgrp) * 64 + lane) * 8]) = pack8(v8);
            }
        }
        {
            const int kpt = (wv >> 1) & 1, vt = wv & 1;
            f32x16 acc = tile_mm(SLOT(5), kpt * 32, SLOT(9), vt * 32, r, hf);
            acc = tile_mm_acc(acc, SLOT(6), kpt * 32, SLOT(7), vt * 32, r, hf);
            bfr* GM = (bfr*)(a.ws + WS_GM) + (size_t)u * 4096;
#pragma unroll
            for (int g4 = 0; g4 < 4; ++g4) { uint2 p; p.x = pack2(acc[g4 * 4], acc[g4 * 4 + 1]); p.y = pack2(acc[g4 * 4 + 2], acc[g4 * 4 + 3]);
                *reinterpret_cast<uint2*>(&GM[(((kpt * 2 + vt) * 4 + g4) * 64 + lane) * 4]) = p; }
        }
    }
    __syncthreads();
#undef SLOT
}

__device__ __forceinline__ void rwkv_chain(const Args& a, const int h, const int vh) {
    const int lane = my_tid() & 63, r = lane & 31, hf = lane >> 5;
    const bfr* PMb = (const bfr*)(a.ws + WS_PM); const bfr* GMb = (const bfr*)(a.ws + WS_GM); bfr* ZTb = (bfr*)(a.ws + WS_ZT);
    f32x16 Z[2];
#pragma unroll
    for (int g = 0; g < 16; ++g) { Z[0][g] = 0.f; Z[1][g] = 0.f; }
    bf16x8 Acur[8], Anxt[8]; uint2 Ccur[8], Cnxt[8];
    {
        const bfr* pm = PMb + (size_t)h * 4096; const bfr* gm = GMb + (size_t)h * 4096;
#pragma unroll
        for (int f = 0; f < 8; ++f) Acur[f] = *reinterpret_cast<const bf16x8*>(&pm[(f * 64 + lane) * 8]);
#pragma unroll
        for (int kpt = 0; kpt < 2; ++kpt)
#pragma unroll
            for (int g4 = 0; g4 < 4; ++g4) Ccur[kpt * 4 + g4] = *reinterpret_cast<const uint2*>(&gm[(((kpt * 2 + vh) * 4 + g4) * 64 + lane) * 4]);
    }
    for (int c = 0; c < 128; ++c) {
        const int u = c * 16 + h;
        if (c + 1 < 128) {
            const bfr* pm = PMb + (size_t)(u + 16) * 4096; const bfr* gm = GMb + (size_t)(u + 16) * 4096;
#pragma unroll
            for (int f = 0; f < 8; ++f) Anxt[f] = *reinterpret_cast<const bf16x8*>(&pm[(f * 64 + lane) * 8]);
#pragma unroll
            for (int kpt = 0; kpt < 2; ++kpt)
#pragma unroll
                for (int g4 = 0; g4 < 4; ++g4) Cnxt[kpt * 4 + g4] = *reinterpret_cast<const uint2*>(&gm[(((kpt * 2 + vh) * 4 + g4) * 64 + lane) * 4]);
        }
        bfr* zt = ZTb + (size_t)u * 4096 + (size_t)(vh * 32 + r) * 64;
        bf16x8 Bf[2][2];
#pragma unroll
        for (int kt = 0; kt < 2; ++kt) {
#pragma unroll
            for (int g4 = 0; g4 < 4; ++g4) {
                uint2 o; o.x = pack2(Z[kt][g4 * 4], Z[kt][g4 * 4 + 1]); o.y = pack2(Z[kt][g4 * 4 + 2], Z[kt][g4 * 4 + 3]);
                *reinterpret_cast<uint2*>(&zt[kt * 32 + g4 * 8 + hf * 4]) = o;
                const int s = g4 >> 1, e = (g4 & 1) * 4;
                Bf[kt][s][e] = (short)(o.x & 0xFFFF); Bf[kt][s][e + 1] = (short)(o.x >> 16); Bf[kt][s][e + 2] = (short)(o.y & 0xFFFF); Bf[kt][s][e + 3] = (short)(o.y >> 16);
            }
        }
        f32x16 Zn[2];
#pragma unroll
        for (int kpt = 0; kpt < 2; ++kpt)
#pragma unroll
            for (int g4 = 0; g4 < 4; ++g4) {
                const uint2 cc = Ccur[kpt * 4 + g4];
                Zn[kpt][g4 * 4] = bflo(cc.x); Zn[kpt][g4 * 4 + 1] = bfhi(cc.x); Zn[kpt][g4 * 4 + 2] = bflo(cc.y); Zn[kpt][g4 * 4 + 3] = bfhi(cc.y);
            }
#pragma unroll
        for (int kpt = 0; kpt < 2; ++kpt)
#pragma unroll
            for (int kt = 0; kt < 2; ++kt)
#pragma unroll
                for (int s = 0; s < 2; ++s)
                    Zn[kpt] = __builtin_amdgcn_mfma_f32_32x32x16_bf16(Acur[(kpt * 2 + kt) * 2 + s], Bf[kt][s], Zn[kpt], 0, 0, 0);
        Z[0] = Zn[0]; Z[1] = Zn[1];
#pragma unroll
        for (int f = 0; f < 8; ++f) { Acur[f] = Anxt[f]; Ccur[f] = Cnxt[f]; }
    }
}

__device__ __forceinline__ void rwkv_out_unit(const Args& a, const int u, float* Ls) {
    const int lane = my_tid() & 63, r = lane & 31, hf = lane >> 5, c = u >> 4, h = u & 15, t0 = c * 64;
    const bfr* WY = (const bfr*)(a.ws + WS_WY) + (size_t)u * 4096; const bfr* YL = (const bfr*)(a.ws + WS_YLOC) + (size_t)u * 4096;
    const bfr* ZT = (const bfr*)(a.ws + WS_ZT) + (size_t)u * 4096;
    f32x16 acc[2][2];
#pragma unroll
    for (int it = 0; it < 2; ++it)
#pragma unroll
        for (int vt = 0; vt < 2; ++vt)
#pragma unroll
            for (int g4 = 0; g4 < 4; ++g4) {
                const uint2 cc = *reinterpret_cast<const uint2*>(&YL[(((it * 2 + vt) * 4 + g4) * 64 + lane) * 4]);
                acc[it][vt][g4 * 4] = bflo(cc.x); acc[it][vt][g4 * 4 + 1] = bfhi(cc.x); acc[it][vt][g4 * 4 + 2] = bflo(cc.y); acc[it][vt][g4 * 4 + 3] = bfhi(cc.y);
            }
#pragma unroll
    for (int ks = 0; ks < 4; ++ks) {
        bf16x8 A[2], B[2];
#pragma unroll
        for (int it = 0; it < 2; ++it) A[it] = *reinterpret_cast<const bf16x8*>(&WY[(it * 32 + r) * 64 + ks * 16 + hf * 8]);
#pragma unroll
        for (int vt = 0; vt < 2; ++vt) B[vt] = *reinterpret_cast<const bf16x8*>(&ZT[(vt * 32 + r) * 64 + ks * 16 + hf * 8]);
#pragma unroll
        for (int it = 0; it < 2; ++it)
#pragma unroll
            for (int vt = 0; vt < 2; ++vt) acc[it][vt] = __builtin_amdgcn_mfma_f32_32x32x16_bf16(A[it], B[vt], acc[it][vt], 0, 0, 0);
    }
#pragma unroll
    for (int it = 0; it < 2; ++it)
#pragma unroll
        for (int vt = 0; vt < 2; ++vt)
#pragma unroll
            for (int g = 0; g < 16; ++g) Ls[(it * 32 + (g & 3) + 8 * (g >> 2) + 4 * hf) * 68 + vt * 32 + r] = acc[it][vt][g];
    asm volatile("s_waitcnt lgkmcnt(0)" ::: "memory");
    __builtin_amdgcn_wave_barrier();
    {
        float y[64]; float s1 = 0.f, s2 = 0.f;
#pragma unroll
        for (int q = 0; q < 16; ++q) {
            const float4 x = *reinterpret_cast<const float4*>(&Ls[lane * 68 + q * 4]);
            y[q * 4] = x.x; y[q * 4 + 1] = x.y; y[q * 4 + 2] = x.z; y[q * 4 + 3] = x.w;
            s1 += (x.x + x.y) + (x.z + x.w);
        }
        const float mean = s1 * (1.f / 64.f);
#pragma unroll
        for (int v = 0; v < 64; ++v) { const float d = y[v] - mean; s2 += d * d; }
        const float rstd = rsqrtf(s2 * (1.f / 64.f) + 64e-5f);
        const bfr* Gg = (const bfr*)(a.ws + WS_GG); const bfr* Bon = (const bfr*)(a.ws + WS_BON); bfr* RWO = (bfr*)(a.ws + WS_RWO);
        const size_t o = (size_t)(t0 + lane) * RW + h * 64;
        const float* lnw = a.in[I_LNW] + h * 64; const float* lnb = a.in[I_LNB] + h * 64;
#pragma unroll
        for (int q = 0; q < 8; ++q) {
            float gg[8], bb[8], rr[8];
            unpack8(*reinterpret_cast<const uint4*>(&Gg[o + q * 8]), gg);
            unpack8(*reinterpret_cast<const uint4*>(&Bon[o + q * 8]), bb);
#pragma unroll
            for (int e = 0; e < 8; ++e) rr[e] = ((y[q * 8 + e] - mean) * rstd * lnw[q * 8 + e] + lnb[q * 8 + e] + bb[e]) * gg[e];
            *reinterpret_cast<uint4*>(&RWO[o + q * 8]) = pack8(rr);
        }
    }
    asm volatile("s_waitcnt lgkmcnt(0)" ::: "memory");
    __builtin_amdgcn_wave_barrier();
}
#ifndef DUP_DSA
#define DUP_DSA 0
#endif
constexpr float IDX_SCALE = 0.04419417382415922f;
constexpr int CT_ROW = 544;
constexpr int CT_WAVE = 18432;
constexpr int DSA_RELB_OFF = 155648;
constexpr int DSA_HIST_OFF = 131072;
constexpr int DSA_SEL_OFF = 147456;

typedef __bf16 bf16p2_t __attribute__((ext_vector_type(2)));
__device__ __forceinline__ bf16x8 fp8x8_to_bf16(const uint2 w) {
    const u32x4 r = {__builtin_bit_cast(unsigned, __builtin_amdgcn_cvt_scalef32_pk_bf16_fp8(w.x, 1.0f, false)), __builtin_bit_cast(unsigned, __builtin_amdgcn_cvt_scalef32_pk_bf16_fp8(w.x, 1.0f, true)),
                     __builtin_bit_cast(unsigned, __builtin_amdgcn_cvt_scalef32_pk_bf16_fp8(w.y, 1.0f, false)), __builtin_bit_cast(unsigned, __builtin_amdgcn_cvt_scalef32_pk_bf16_fp8(w.y, 1.0f, true))};
    return __builtin_bit_cast(bf16x8, r);
}
__device__ __forceinline__ unsigned pack4_fp8(float a0, float a1, float a2, float a3) {
    int p = 0; p = __builtin_amdgcn_cvt_pk_fp8_f32(a0, a1, p, false); p = __builtin_amdgcn_cvt_pk_fp8_f32(a2, a3, p, true); return (unsigned)p;
}
__device__ __forceinline__ int rel_bucket(int rel) {
    const int n = rel < 0 ? -rel : rel;
    const int lg = 8 + (n >= 15) + (n >= 27) + (n >= 50) + (n >= 91) + (n >= 166) + (n >= 305) + (n >= 559);
    return (n < 8 ? n : lg) + (rel > 0 ? 16 : 0);
}
__device__ __forceinline__ unsigned fkey(float f) {
    if (f == 0.f) f = 0.f;
    const unsigned u = __float_as_uint(f);
    return (u & 0x80000000u) ? ~u : (u | 0x80000000u);
}

__device__ __forceinline__ void dsa_cnorm(const Args& a) {
    const bfr* P = (const bfr*)(a.ws + WS_P); unsigned char* CB8 = a.ws + WS_CB; bfr* IKC = (bfr*)(a.ws + WS_IKC);
    const int lane = my_tid() & 63, wv = my_tid() >> 6;
    const float4 g = reinterpret_cast<const float4*>(a.in[I_KVG])[lane];
    for (int t = blockIdx.x * 8 + wv; t < T; t += gridDim.x * 8) {
        const uint2 raw = *reinterpret_cast<const uint2*>(&P[(size_t)t * NINP + C_CKV + lane * 4]);
        const float v0 = bflo(raw.x), v1 = bfhi(raw.x), v2 = bflo(raw.y), v3 = bfhi(raw.y);
        const float ss = wave_sum(v0 * v0 + v1 * v1 + v2 * v2 + v3 * v3);
        const float rs = rsqrtf(ss * (1.f / 256.f) + EPS);
        int pk = 0;
        pk = __builtin_amdgcn_cvt_pk_fp8_f32(v0 * rs * g.x, v1 * rs * g.y, pk, false);
        pk = __builtin_amdgcn_cvt_pk_fp8_f32(v2 * rs * g.z, v3 * rs * g.w, pk, true);
        *reinterpret_cast<int*>(&CB8[(size_t)t * 256 + lane * 4]) = pk;
        if (lane < 16) *reinterpret_cast<uint2*>(&IKC[(size_t)t * 64 + lane * 4]) = *reinterpret_cast<const uint2*>(&P[(size_t)t * NINP + C_IK + lane * 4]);
    }
}
__device__ __forceinline__ void dsa_qlat(const Args& a) {
    const bfr* P = (const bfr*)(a.ws + WS_P); const bfr* WUK = (const bfr*)(a.ws + WS_WUK); unsigned char* QL8 = a.ws + WS_QLAT;
    const int lane = my_tid() & 63, wv = my_tid() >> 6, fr = lane & 15, fq = lane >> 4;
    for (int it = blockIdx.x * 8 + wv; it < (T / 64) * NH; it += gridDim.x * 8) {
        const int tg = it >> 4, h = it & 15, t0 = tg * 64;
        bf16x8 Bt[4][2];
#pragma unroll
        for (int tl = 0; tl < 4; ++tl)
#pragma unroll
            for (int ks = 0; ks < 2; ++ks) Bt[tl][ks] = *reinterpret_cast<const bf16x8*>(&P[(size_t)(t0 + tl * 16 + fr) * NINP + C_Q + h * 64 + ks * 32 + fq * 8]);
#pragma unroll 2
        for (int nt = 0; nt < 16; ++nt) {
            const bf16x8 A0 = *reinterpret_cast<const bf16x8*>(&WUK[(size_t)(h * 256 + nt * 16 + fr) * 64 + fq * 8]);
            const bf16x8 A1 = *reinterpret_cast<const bf16x8*>(&WUK[(size_t)(h * 256 + nt * 16 + fr) * 64 + 32 + fq * 8]);
#pragma unroll
            for (int tl = 0; tl < 4; ++tl) {
                f32x4 acc = {0.f, 0.f, 0.f, 0.f};
                acc = __builtin_amdgcn_mfma_f32_16x16x32_bf16(A0, Bt[tl][0], acc, 0, 0, 0);
                acc = __builtin_amdgcn_mfma_f32_16x16x32_bf16(A1, Bt[tl][1], acc, 0, 0, 0);
                *reinterpret_cast<unsigned*>(&QL8[((size_t)(t0 + tl * 16 + fr) * NH + h) * 256 + nt * 16 + fq * 4]) = pack4_fp8(acc[0], acc[1], acc[2], acc[3]);
            }
        }
    }
}
__device__ __forceinline__ void dsa_oproj(const Args& a) {
    const unsigned char* OL8 = a.ws + WS_OLAT; const bfr* WUVT = (const bfr*)(a.ws + WS_WUVT); bfr* DO = (bfr*)(a.ws + WS_DO);
    const int lane = my_tid() & 63, wv = my_tid() >> 6, fr = lane & 15, fq = lane >> 4;
    for (int it = blockIdx.x * 8 + wv; it < (T / 64) * NH; it += gridDim.x * 8) {
        const int tg = it >> 4, h = it & 15, t0 = tg * 64;
        f32x4 acc[4][4];
#pragma unroll
        for (int tl = 0; tl < 4; ++tl)
#pragma unroll
            for (int nt = 0; nt < 4; ++nt) acc[tl][nt] = f32x4{0.f, 0.f, 0.f, 0.f};
#pragma unroll 2
        for (int ks = 0; ks < 8; ++ks) {
            bf16x8 A[4];
#pragma unroll
            for (int nt = 0; nt < 4; ++nt) A[nt] = *reinterpret_cast<const bf16x8*>(&WUVT[(size_t)(h * 64 + nt * 16 + fr) * 256 + ks * 32 + fq * 8]);
#pragma unroll
            for (int tl = 0; tl < 4; ++tl) {
                const bf16x8 Bt = fp8x8_to_bf16(*reinterpret_cast<const uint2*>(&OL8[((size_t)(t0 + tl * 16 + fr) * NH + h) * 256 + ks * 32 + fq * 8]));
#pragma unroll
                for (int nt = 0; nt < 4; ++nt) acc[tl][nt] = __builtin_amdgcn_mfma_f32_16x16x32_bf16(A[nt], Bt, acc[tl][nt], 0, 0, 0);
            }
        }
#pragma unroll
        for (int tl = 0; tl < 4; ++tl)
#pragma unroll
            for (int nt = 0; nt < 4; ++nt) { uint2 o; o.x = pack2(acc[tl][nt][0], acc[tl][nt][1]); o.y = pack2(acc[tl][nt][2], acc[tl][nt][3]);
                *reinterpret_cast<uint2*>(&DO[(size_t)(t0 + tl * 16 + fr) * RW + h * 64 + nt * 16 + fq * 4]) = o; }
    }
}

__device__ __forceinline__ float bin_scale(const float sumw2) { const float sg = sqrtf(32.f * sumw2); return sg > 1e-20f ? 90.f / sg : 1.f; }
__device__ __forceinline__ int score_bin(const float sc, const float bsc) { const float f = floorf(sc * bsc) + 512.f; return (int)fminf(fmaxf(f, 0.f), 1023.f); }
__device__ __forceinline__ float key_score(const unsigned k) { return __uint_as_float((k & 0x80000000u) ? (k ^ 0x80000000u) : ~k); }
__device__ __forceinline__ void hist_scan(const unsigned* hist, const int nb, const unsigned need, unsigned* res, const int lane) {
    const int per = nb >> 6;
    unsigned s = 0;
    for (int i = 0; i < per; ++i) s += hist[lane * per + i];
    unsigned S = s;
#pragma unroll
    for (int o = 1; o < 64; o <<= 1) { const unsigned tt = __shfl_down(S, o); if (lane + o < 64) S += tt; }
    const unsigned long long m = __ballot(S >= need);
    const int ls = 63 - __clzll(m);
    if (lane == ls) {
        unsigned accv = S - s; int bin = lane * per; unsigned abv = accv;
        for (int bb = lane * per + per - 1; bb >= lane * per; --bb) { const unsigned cc = hist[bb]; if (accv + cc >= need) { bin = bb; abv = accv; break; } accv += cc; }
        res[0] = (unsigned)bin; res[1] = abv;
    }
}

__device__ __forceinline__ void dsa_select4(const Args& a, const int t0, const int qs, unsigned char* lds) {
    const bfr* P = (const bfr*)(a.ws + WS_P); const bfr* IKC = (const bfr*)(a.ws + WS_IKC);
    float* SC = (float*)lds; int* SEL = (int*)(lds + DSA_SEL_OFF); unsigned* MISC = (unsigned*)(lds + LDS_MISC);
    const int tid = my_tid(), lane = tid & 63, wv = tid >> 6, r = lane & 31, hf = lane >> 5;
    const int L = 64 * (t0 / 64 + 1);
    if (L <= 256) {
        for (int i = tid; i < 4 * 256; i += 512) SEL[(qs + (i >> 8)) * 256 + (i & 255)] = (i & 255) | (rel_bucket((i & 255) - (t0 + (i >> 8))) << 16);
        if (tid < 4) MISC[16 + qs + tid] = (unsigned)L;
        __syncthreads();
        return;
    }
    for (int i = tid; i < 4096; i += 512) ((unsigned*)(lds + DSA_HIST_OFF))[i] = 0u;
    __syncthreads();
    {
        const int qq = r >> 3, hh = r & 7;
        bf16x8 B[4];
#pragma unroll
        for (int ks = 0; ks < 4; ++ks) B[ks] = *reinterpret_cast<const bf16x8*>(&P[(size_t)(t0 + qq) * NINP + C_IQ + hh * 64 + ks * 16 + hf * 8]);
        const float wgt = bf2f(P[(size_t)(t0 + qq) * NINP + C_IW + hh]) * IDX_SCALE;
        float w2 = wgt * wgt; w2 += dpp_f<DPP_XOR1>(w2); w2 += dpp_f<DPP_XOR2>(w2); w2 += dpp_f<0x141>(w2);
        const float bsc = bin_scale(w2);
        if (hh == 0 && hf == 0) ((float*)MISC)[48 + qq] = bsc;
        const int ntile = L >> 5;
        for (int rp_ = 0; rp_ < ((DUP_DSA & 1) ? 2 : 1); ++rp_) {
        bf16x8 An[4];
        if (wv < ntile) {
#pragma unroll
            for (int ks = 0; ks < 4; ++ks) An[ks] = *reinterpret_cast<const bf16x8*>(&IKC[(size_t)(wv * 32 + r) * 64 + ks * 16 + hf * 8]);
        }
        for (int kt = wv; kt < ntile; kt += 8) {
            bf16x8 Ac[4];
#pragma unroll
            for (int ks = 0; ks < 4; ++ks) Ac[ks] = An[ks];
            if (kt + 8 < ntile) {
#pragma unroll
                for (int ks = 0; ks < 4; ++ks) An[ks] = *reinterpret_cast<const bf16x8*>(&IKC[(size_t)((kt + 8) * 32 + r) * 64 + ks * 16 + hf * 8]);
            }
            f32x16 acc;
#pragma unroll
            for (int g = 0; g < 16; ++g) acc[g] = 0.f;
#pragma unroll
            for (int ks = 0; ks < 4; ++ks) acc = __builtin_amdgcn_mfma_f32_32x32x16_bf16(Ac[ks], B[ks], acc, 0, 0, 0);
            float s1[8], s2[4], s3[2];
            const bool b0 = (hh & 1) != 0, b1 = (hh & 2) != 0, b2 = (hh & 4) != 0;
#pragma unroll
            for (int p = 0; p < 8; ++p) {
                const float x0 = fmaxf(acc[2 * p], 0.f) * wgt, x1 = fmaxf(acc[2 * p + 1], 0.f) * wgt;
                s1[p] = (b0 ? x1 : x0) + dpp_f<DPP_XOR1>(b0 ? x0 : x1);
            }
#pragma unroll
            for (int p = 0; p < 4; ++p) s2[p] = (b1 ? s1[2 * p + 1] : s1[2 * p]) + dpp_f<DPP_XOR2>(b1 ? s1[2 * p] : s1[2 * p + 1]);
#pragma unroll
            for (int p = 0; p < 2; ++p) s3[p] = (b2 ? s2[2 * p + 1] : s2[2 * p]) + __shfl_xor(b2 ? s2[2 * p] : s2[2 * p + 1], 4);
#pragma unroll
            for (int p = 0; p < 2; ++p) { const int g = 8 * p + hh; const unsigned fk = fkey(s3[p]); ((unsigned*)SC)[qq * 8192 + kt * 32 + (g & 3) + 8 * (g >> 2) + 4 * hf] = fk;
                if (rp_ == 0) atomicAdd((unsigned*)(lds + DSA_HIST_OFF) + qq * 1024 + score_bin(s3[p], bsc), 1u); }
        }
        }
    }
    __syncthreads();
    const int q = wv >> 1, l128 = (wv & 1) * 64 + lane;
    const unsigned* keys = (const unsigned*)(SC + q * 8192);
    unsigned* hist = (unsigned*)(lds + DSA_HIST_OFF) + q * 1024;
    unsigned* res = MISC + 32 + q * 4;
    for (int rp_ = 0; rp_ < ((DUP_DSA & 2) ? 2 : 1); ++rp_) {
    const float bsc = ((const float*)MISC)[48 + q];
    unsigned need = 256;
    if (rp_ > 0) {
        for (int i = l128; i < 1024; i += 128) hist[i] = 0u;
        __syncthreads();
        for (int idx = l128; idx < L; idx += 128) atomicAdd(&hist[score_bin(key_score(keys[idx]), bsc)], 1u);
        __syncthreads();
    }
    if ((wv & 1) == 0) hist_scan(hist, 1024, need, res, lane);
    __syncthreads();
    const int b0 = (int)res[0]; need -= res[1];
    __syncthreads();
    unsigned* cand = hist + 256;
    if (l128 == 0) { res[2] = 0u; res[3] = 0u; }
    if (tid == 0) MISC[52] = 0u;
    __syncthreads();
    for (int idx = l128; idx < L; idx += 128) {
        const unsigned k = keys[idx];
        if (score_bin(key_score(k), bsc) == b0) { const unsigned p = atomicAdd(&res[2], 1u); if (p < 768u) cand[p] = k; }
    }
    __syncthreads();
    const unsigned ncand = res[2];
    if (l128 == 0 && ncand > 768u) MISC[52] = 1u;
    __syncthreads();
    const bool fast = MISC[52] == 0u;
    unsigned prefix = 0;
    if (fast) {
        for (unsigned i = l128; i < ncand; i += 128) {
            const unsigned me = cand[i]; unsigned cgt = 0, ceq = 0;
            for (unsigned j = 0; j < ncand; ++j) { const unsigned o = cand[j]; cgt += (o > me) ? 1u : 0u; ceq += (o == me) ? 1u : 0u; }
            if (cgt < need && need <= cgt + ceq) { res[0] = me; res[1] = cgt; }
        }
        __syncthreads();
        prefix = res[0]; need -= res[1];
        __syncthreads();
    } else {
#pragma unroll 1
        for (int pass = 0; pass < 4; ++pass) {
            const int lo_shift = 24 - 8 * pass;
            for (int i = l128; i < 256; i += 128) hist[i] = 0u;
            __syncthreads();
            for (int idx = l128; idx < L; idx += 128) {
                const unsigned k = keys[idx];
                const bool ok = (score_bin(key_score(k), bsc) == b0) && (pass == 0 || (k >> (lo_shift + 8)) == prefix);
                if (ok) atomicAdd(&hist[(k >> lo_shift) & 255u], 1u);
            }
            __syncthreads();
            if ((wv & 1) == 0) hist_scan(hist, 256, need, res, lane);
            __syncthreads();
            prefix = (prefix << 8) | res[0]; need -= res[1];
            __syncthreads();
        }
    }
    const unsigned tkey = prefix;
    if ((wv & 1) == 0) {
        const unsigned ngt = 256u - need; unsigned rg = 0, rt = 0;
        const unsigned long long lt = (1ull << lane) - 1ull;
        for (int base = 0; base < L; base += 64) {
            const unsigned k = keys[base + lane];
            const bool gt = k > tkey, tie = k == tkey;
            const unsigned long long mg = __ballot(gt), mt = __ballot(tie);
            if (gt) { const unsigned p = rg + (unsigned)__popcll(mg & lt); if (p < 256u) SEL[(qs + q) * 256 + p] = base + lane; }
            if (tie) { const unsigned p = rt + (unsigned)__popcll(mt & lt); if (p < need) SEL[(qs + q) * 256 + ngt + p] = base + lane; }
            rg += (unsigned)__popcll(mg); rt += (unsigned)__popcll(mt);
        }
        if (lane == 0) MISC[16 + qs + q] = 256u;
    }
    __syncthreads();
    for (int i = l128; i < 256; i += 128) { const int e = SEL[(qs + q) * 256 + i]; SEL[(qs + q) * 256 + i] = e | (rel_bucket(e - (t0 + q)) << 16); }
    __syncthreads();
    }
}

__device__ __forceinline__ void dsa_attend(const Args& a, const int t, const int* sel, const int nsel, unsigned char* ct, const float* relb_l) {
    const unsigned char* CB8 = a.ws + WS_CB; const unsigned char* QL8 = a.ws + WS_QLAT; unsigned char* OL8 = a.ws + WS_OLAT;
    const int lane = my_tid() & 63, fr = lane & 15, fq = lane >> 4;
    bf16x8 Bq[8];
#pragma unroll
    for (int j = 0; j < 4; ++j) {
        const uint4 w = *reinterpret_cast<const uint4*>(&QL8[((size_t)t * NH + fr) * 256 + j * 64 + fq * 16]);
        Bq[2 * j] = fp8x8_to_bf16(uint2{w.x, w.y}); Bq[2 * j + 1] = fp8x8_to_bf16(uint2{w.z, w.w});
    }
    f32x4 o[16];
#pragma unroll
    for (int mt = 0; mt < 16; ++mt) o[mt] = f32x4{0.f, 0.f, 0.f, 0.f};
    float mrun = -1e30f, lrun = 0.f;
    const unsigned tr_addr = (unsigned)(size_t)ct + (unsigned)((4 * fq + (fr >> 2)) * CT_ROW + (fr & 3) * 8);
    const int nblk = nsel >> 5;
    uint4 ArA[2][4], ArB[2][4];
#define ATT_LOAD(AR, KB) _Pragma("unroll") for (int tt = 0; tt < 2; ++tt) { \
        const int kidx = sel[(KB) * 32 + tt * 16 + fr] & 0xFFFF; \
        _Pragma("unroll") for (int j = 0; j < 4; ++j) AR[tt][j] = *reinterpret_cast<const uint4*>(&CB8[(size_t)kidx * 256 + j * 64 + fq * 16]); }
#define ATT_QK(AR) _Pragma("unroll") for (int tt = 0; tt < 2; ++tt) { \
        st[tt] = f32x4{0.f, 0.f, 0.f, 0.f}; \
        _Pragma("unroll") for (int j = 0; j < 4; ++j) { \
            const bf16x8 A0 = fp8x8_to_bf16(uint2{AR[tt][j].x, AR[tt][j].y}), A1 = fp8x8_to_bf16(uint2{AR[tt][j].z, AR[tt][j].w}); \
            st[tt] = __builtin_amdgcn_mfma_f32_16x16x32_bf16(A0, Bq[2 * j], st[tt], 0, 0, 0); \
            st[tt] = __builtin_amdgcn_mfma_f32_16x16x32_bf16(A1, Bq[2 * j + 1], st[tt], 0, 0, 0); \
            *reinterpret_cast<bf16x8*>(ct + (tt * 16 + fr) * CT_ROW + (j * 64 + fq * 16) * 2) = A0; \
            *reinterpret_cast<bf16x8*>(ct + (tt * 16 + fr) * CT_ROW + (j * 64 + fq * 16 + 8) * 2) = A1; } }
#define ATT_SMPV(KB) { \
        float lg[8]; float bmax = -1e30f; \
        _Pragma("unroll") for (int tt = 0; tt < 2; ++tt) { \
            const int4 k4 = *reinterpret_cast<const int4*>(&sel[(KB) * 32 + tt * 16 + fq * 4]); \
            const int kk4[4] = {k4.x, k4.y, k4.z, k4.w}; \
            _Pragma("unroll") for (int j = 0; j < 4; ++j) { \
                const float v = st[tt][j] * 0.125f + relb_l[(kk4[j] >> 16) * 16 + fr]; \
                lg[tt * 4 + j] = v; bmax = fmaxf(bmax, v); } } \
        bmax = fmaxf(bmax, __shfl_xor(bmax, 16)); bmax = fmaxf(bmax, __shfl_xor(bmax, 32)); \
        const bool resc = __any(bmax > mrun + 8.f);             \
        if (resc) {                           \
            const float mnew = fmaxf(mrun, bmax); const float alpha = __expf(mrun - mnew); mrun = mnew; lrun *= alpha; \
            asm volatile("" ::: "memory"); \
            _Pragma("unroll") for (int mt = 0; mt < 16; ++mt) { o[mt][0] *= alpha; o[mt][1] *= alpha; o[mt][2] *= alpha; o[mt][3] *= alpha; } } \
        float psum = 0.f; bf16x8 Pf; \
        _Pragma("unroll") for (int e = 0; e < 8; e += 2) { \
            const float p0 = __expf(lg[e] - mrun), p1 = __expf(lg[e + 1] - mrun); psum += p0 + p1; \
            const unsigned pk = pack2(p0, p1); Pf[e] = (short)(pk & 0xFFFF); Pf[e + 1] = (short)(pk >> 16); } \
        lrun += psum; \
        asm volatile("s_waitcnt lgkmcnt(0)" ::: "memory"); \
        __builtin_amdgcn_wave_barrier(); \
        _Pragma("unroll") for (int m4 = 0; m4 < 4; ++m4) { \
            uint2 r0[4], r1[4]; \
            asm volatile("ds_read_b64_tr_b16 %0, %8 offset:%9\n\tds_read_b64_tr_b16 %1, %8 offset:%10\n\t" \
                         "ds_read_b64_tr_b16 %2, %8 offset:%11\n\tds_read_b64_tr_b16 %3, %8 offset:%12\n\t" \
                         "ds_read_b64_tr_b16 %4, %8 offset:%13\n\tds_read_b64_tr_b16 %5, %8 offset:%14\n\t" \
                         "ds_read_b64_tr_b16 %6, %8 offset:%15\n\tds_read_b64_tr_b16 %7, %8 offset:%16\n\ts_waitcnt lgkmcnt(0)" \
                         : "=&v"(r0[0]), "=&v"(r1[0]), "=&v"(r0[1]), "=&v"(r1[1]), "=&v"(r0[2]), "=&v"(r1[2]), "=&v"(r0[3]), "=&v"(r1[3]) \
                         : "v"(tr_addr), "n"(m4 * 128), "n"(m4 * 128 + 16 * CT_ROW), "n"(m4 * 128 + 32), "n"(m4 * 128 + 32 + 16 * CT_ROW), \
                           "n"(m4 * 128 + 64), "n"(m4 * 128 + 64 + 16 * CT_ROW), "n"(m4 * 128 + 96), "n"(m4 * 128 + 96 + 16 * CT_ROW) \
                         : "memory"); \
            _Pragma("unroll") for (int i = 0; i < 4; ++i) { \
                const int mt = m4 * 4 + i; \
                const u32x4 raw = {r0[i].x, r0[i].y, r1[i].x, r1[i].y}; \
                const bf16x8 Av = __builtin_bit_cast(bf16x8, raw); \
                o[mt] = __builtin_amdgcn_mfma_f32_16x16x32_bf16(Av, Pf, o[mt], 0, 0, 0); } } \
        asm volatile("s_waitcnt lgkmcnt(0)" ::: "memory"); \
        __builtin_amdgcn_wave_barrier(); }
    f32x4 st[2];
    ATT_LOAD(ArA, 0)
    ATT_LOAD(ArB, 1)
    int kb = 0;
#pragma unroll 1
    for (; kb + 2 < nblk; kb += 2) {
        ATT_QK(ArA) ATT_LOAD(ArA, kb + 2) ATT_SMPV(kb)
        ATT_QK(ArB) ATT_LOAD(ArB, kb + 3) ATT_SMPV(kb + 1)
    }
    ATT_QK(ArA) ATT_SMPV(kb)
    ATT_QK(ArB) ATT_SMPV(kb + 1)
#undef ATT_LOAD
#undef ATT_QK
#undef ATT_SMPV
    lrun += __shfl_xor(lrun, 16); lrun += __shfl_xor(lrun, 32);
    const float inv = frcp_(lrun);
#pragma unroll
    for (int mt = 0; mt < 16; ++mt) {
        *reinterpret_cast<unsigned*>(&OL8[((size_t)t * NH + fr) * 256 + mt * 16 + fq * 4]) = pack4_fp8(o[mt][0] * inv, o[mt][1] * inv, o[mt][2] * inv, o[mt][3] * inv);
    }
}

constexpr int DSA_CCAP = 256;
__device__ __forceinline__ bool dsa_select8(const Args& a, const int t0, unsigned char* lds) {
    const bfr* P = (const bfr*)(a.ws + WS_P); const bfr* IKC = (const bfr*)(a.ws + WS_IKC);
    unsigned* KEYS = (unsigned*)(a.ws + WS_KEYS) + (size_t)blockIdx.x * (8 * 8192);
    unsigned short* BIN = (unsigned short*)lds; unsigned* H16 = (unsigned*)(lds + DSA_HIST_OFF);
    int* SEL = (int*)(lds + DSA_SEL_OFF); unsigned* MISC = (unsigned*)(lds + LDS_MISC);
    const int tid = my_tid(), lane = tid & 63, wv = tid >> 6, r = lane & 31, hf = lane >> 5;
    const int L = 64 * (t0 / 64 + 1);
    if (L <= 256) {
        for (int i = tid; i < 8 * 256; i += 512) SEL[i] = (i & 255) | (rel_bucket((i & 255) - (t0 + (i >> 8))) << 16);
        if (tid < 8) MISC[16 + tid] = (unsigned)L;
        __syncthreads();
        return true;
    }
#ifndef DUP_DSA
#define DUP_DSA 0
#endif
    for (int rp_ = 0; rp_ < ((DUP_DSA & 1) ? 2 : 1); ++rp_) {
    if (rp_) __syncthreads();
    for (int i = tid; i < 4096; i += 512) H16[i] = 0u;
    if (tid == 0) MISC[60] = 0u;
    __syncthreads();
    {
        const int qq = r >> 3, hh = r & 7;
        bf16x8 Q[2][4]; float w4[2][4][4], bs[2][2], bsq[2][4];
#pragma unroll
        for (int grp = 0; grp < 2; ++grp) {
#pragma unroll
            for (int ks = 0; ks < 4; ++ks) Q[grp][ks] = *reinterpret_cast<const bf16x8*>(&P[(size_t)(t0 + grp * 4 + qq) * NINP + C_IQ + hh * 64 + ks * 16 + hf * 8]);
#pragma unroll
            for (int q = 0; q < 4; ++q) {
                const uint4 wr = *reinterpret_cast<const uint4*>(&P[(size_t)(t0 + grp * 4 + q) * NINP + C_IW]);
                const float f0 = bflo(wr.x) * IDX_SCALE, f1 = bfhi(wr.x) * IDX_SCALE, f2 = bflo(wr.y) * IDX_SCALE, f3 = bfhi(wr.y) * IDX_SCALE;
                const float f4 = bflo(wr.z) * IDX_SCALE, f5 = bfhi(wr.z) * IDX_SCALE, f6 = bflo(wr.w) * IDX_SCALE, f7 = bfhi(wr.w) * IDX_SCALE;
                const float bq = bin_scale(f0 * f0 + f1 * f1 + f2 * f2 + f3 * f3 + f4 * f4 + f5 * f5 + f6 * f6 + f7 * f7);
                w4[grp][q][0] = hf ? f4 : f0; w4[grp][q][1] = hf ? f5 : f1; w4[grp][q][2] = hf ? f6 : f2; w4[grp][q][3] = hf ? f7 : f3;
                bsq[grp][q] = bq;
            }
            bs[grp][0] = hf ? bsq[grp][2] : bsq[grp][0]; bs[grp][1] = hf ? bsq[grp][3] : bsq[grp][1];
        }
        const int ntile = L >> 5;
        bf16x8 An[4];
        if (wv < ntile) {
#pragma unroll
            for (int ks = 0; ks < 4; ++ks) An[ks] = *reinterpret_cast<const bf16x8*>(&IKC[(size_t)(wv * 32 + r) * 64 + ks * 16 + hf * 8]);
        }
        for (int kt = wv; kt < ntile; kt += 8) {
            bf16x8 Ac[4];
#pragma unroll
            for (int ks = 0; ks < 4; ++ks) Ac[ks] = An[ks];
            if (kt + 8 < ntile) {
#pragma unroll
                for (int ks = 0; ks < 4; ++ks) An[ks] = *reinterpret_cast<const bf16x8*>(&IKC[(size_t)((kt + 8) * 32 + r) * 64 + ks * 16 + hf * 8]);
            }
#pragma unroll
            for (int grp = 0; grp < 2; ++grp) {
                f32x16 acc;
#pragma unroll
                for (int g = 0; g < 16; ++g) acc[g] = 0.f;
#pragma unroll
                for (int ks = 0; ks < 4; ++ks) acc = __builtin_amdgcn_mfma_f32_32x32x16_bf16(Q[grp][ks], Ac[ks], acc, 0, 0, 0);
                float ps[4];
#pragma unroll
                for (int q = 0; q < 4; ++q) {
                    ps[q] = fmaxf(acc[4 * q], 0.f) * w4[grp][q][0];
#pragma unroll
                    for (int j = 1; j < 4; ++j) ps[q] = fmaf(fmaxf(acc[4 * q + j], 0.f), w4[grp][q][j], ps[q]);
                }
                const auto r02 = __builtin_amdgcn_permlane32_swap(__float_as_uint(ps[0]), __float_as_uint(ps[2]), false, false);
                const auto r13 = __builtin_amdgcn_permlane32_swap(__float_as_uint(ps[1]), __float_as_uint(ps[3]), false, false);
                const float sc2[2] = {__uint_as_float(r02[0]) + __uint_as_float(r02[1]), __uint_as_float(r13[0]) + __uint_as_float(r13[1])};
#pragma unroll
                for (int p = 0; p < 2; ++p) {
                    const int q = grp * 4 + 2 * hf + p, kidx = kt * 32 + r;
                    const int bin = score_bin(sc2[p], bs[grp][p]);
                    BIN[q * 8192 + kidx] = (unsigned short)bin;
                    atomicAdd(&H16[q * 512 + (bin >> 1)], (bin & 1) ? 0x10000u : 1u);
                    __builtin_nontemporal_store(fkey(sc2[p]), &KEYS[q * 8192 + kidx]);
                }
            }
        }
    }
    }
    asm volatile("s_waitcnt vmcnt(0)" ::: "memory");
    __syncthreads();
    {
        const int q = wv;
        const unsigned short* bins = BIN + q * 8192;
        unsigned* hrow = H16 + q * 512;
        unsigned cnt[16]; unsigned sown = 0;
#pragma unroll
        for (int i = 0; i < 8; ++i) { const unsigned w = hrow[lane * 8 + i]; cnt[2 * i] = w & 0xFFFFu; cnt[2 * i + 1] = w >> 16; sown += cnt[2 * i] + cnt[2 * i + 1]; }
        unsigned S = sown;
#pragma unroll
        for (int o = 1; o < 64; o <<= 1) { const unsigned tt = __shfl_down(S, o); if (lane + o < 64) S += tt; }
        const unsigned long long mfound = __ballot(S >= 256u);
        const int ls = 63 - __clzll(mfound);
        int b0l = 0; unsigned abovel = 0;
        {
            unsigned accv = S - sown; bool done = false;
#pragma unroll
            for (int bb = 15; bb >= 0; --bb) { if (!done) { if (accv + cnt[bb] >= 256u) { b0l = lane * 16 + bb; abovel = accv; done = true; } else accv += cnt[bb]; } }
        }
        const int b0 = __shfl(b0l, ls); const unsigned ngt = __shfl((int)abovel, ls); const unsigned need = 256u - ngt;
        __builtin_amdgcn_wave_barrier();
        int* CL = (int*)hrow; unsigned* CK = hrow + DSA_CCAP;
        const unsigned long long lt = (1ull << lane) - 1ull;
        unsigned rg = 0, rc = 0;
        for (int base = 0; base < (L >> 1); base += 64) {
            const bool valid = (base + lane) < (L >> 1);
            const unsigned w = valid ? reinterpret_cast<const unsigned*>(bins)[base + lane] : 0u;
            const int ba = (int)(w & 0xFFFFu), bb = (int)(w >> 16), ia = 2 * (base + lane), ib = ia + 1;
            const bool ga = valid && ba > b0, gb = valid && bb > b0, ca = valid && ba == b0, cb = valid && bb == b0;
            const unsigned long long mga = __ballot(ga), mgb = __ballot(gb), mca = __ballot(ca), mcb = __ballot(cb);
            const unsigned pg = rg + (unsigned)__popcll(mga & lt) + (unsigned)__popcll(mgb & lt);
            const unsigned pc = rc + (unsigned)__popcll(mca & lt) + (unsigned)__popcll(mcb & lt);
            if (ga && pg < 256u) SEL[q * 256 + pg] = ia;
            if (gb && pg + (ga ? 1u : 0u) < 256u) SEL[q * 256 + pg + (ga ? 1u : 0u)] = ib;
            if (ca && pc < (unsigned)DSA_CCAP) CL[pc] = ia;
            if (cb && pc + (ca ? 1u : 0u) < (unsigned)DSA_CCAP) CL[pc + (ca ? 1u : 0u)] = ib;
            rg += (unsigned)__popcll(mga) + (unsigned)__popcll(mgb); rc += (unsigned)__popcll(mca) + (unsigned)__popcll(mcb);
        }
        const unsigned ncand = rc;
        if (ncand > (unsigned)DSA_CCAP) { if (lane == 0) MISC[60] = 1u; }
        else {
            asm volatile("s_waitcnt lgkmcnt(0)" ::: "memory");
            for (unsigned i = lane; i < ncand; i += 64) CK[i] = __hip_atomic_load(&KEYS[q * 8192 + CL[i]], __ATOMIC_RELAXED, __HIP_MEMORY_SCOPE_AGENT);
            asm volatile("s_waitcnt vmcnt(0) lgkmcnt(0)" ::: "memory");
            __builtin_amdgcn_wave_barrier();
            for (unsigned i = lane; i < ncand; i += 64) {
                const unsigned me = CK[i]; unsigned rk = 0;
                for (unsigned j = 0; j < ncand; ++j) { const unsigned o = CK[j]; rk += (o > me || (o == me && j < i)) ? 1u : 0u; }
                if (rk < need) SEL[q * 256 + ngt + rk] = CL[i];
            }
            asm volatile("s_waitcnt lgkmcnt(0)" ::: "memory");
            __builtin_amdgcn_wave_barrier();
            for (int i = lane; i < 256; i += 64) { const int e = SEL[q * 256 + i]; SEL[q * 256 + i] = e | (rel_bucket(e - (t0 + q)) << 16); }
            if (lane == 0) MISC[16 + q] = 256u;
        }
    }
    __syncthreads();
    return MISC[60] == 0u;
}

__device__ __forceinline__ void dsa_unit(const Args& a, const int unit, unsigned char* lds) {
    const int t0 = unit * 8, wv = my_tid() >> 6;
    if (DUP_DSA & 2) { dsa_select8(a, t0, lds); __syncthreads(); }
    if (!dsa_select8(a, t0, lds)) {
        __syncthreads();
        dsa_select4(a, t0, 0, lds);
        dsa_select4(a, t0 + 4, 4, lds);
    }
    const int* SEL = (const int*)(lds + DSA_SEL_OFF); const unsigned* MISC = (const unsigned*)(lds + LDS_MISC);
    if (DUP_DSA & 4) dsa_attend(a, t0 + wv, SEL + wv * 256, (int)MISC[16 + wv], lds + wv * CT_WAVE, (const float*)(lds + DSA_RELB_OFF));
    dsa_attend(a, t0 + wv, SEL + wv * 256, (int)MISC[16 + wv], lds + wv * CT_WAVE, (const float*)(lds + DSA_RELB_OFF));
    __syncthreads();
}
template <int J> __device__ __forceinline__ int xchg_i(int v) {
    if (J == 1) return __builtin_amdgcn_update_dpp(0, v, 0xB1, 0xF, 0xF, true);
    else if (J == 2) return __builtin_amdgcn_update_dpp(0, v, 0x4E, 0xF, 0xF, true);
    else if (J == 4) { int t = __builtin_amdgcn_update_dpp(v, v, 0x104, 0xF, 0x5, false);
                       return __builtin_amdgcn_update_dpp(t, v, 0x114, 0xF, 0xA, false); }
    else if (J == 8) return __builtin_amdgcn_update_dpp(0, v, 0x128, 0xF, 0xF, true);
    else return __shfl_xor(v, J);
}
template <int J> __device__ __forceinline__ float xchg_f(float v) { return __int_as_float(xchg_i<J>(__float_as_int(v))); }

__device__ __forceinline__ unsigned okey(float f) { const unsigned u = __float_as_uint(f); return (u & 0x80000000u) ? ~u : (u | 0x80000000u); }
template <int K, int J> __device__ __forceinline__ void bitonic_step(unsigned& k, const int lane) {
    const unsigned ok = (unsigned)xchg_i<J>((int)k);
    const bool desc = (K == 64) ? true : ((lane & K) == 0);
    const bool keepmax = ((lane & J) == 0) == desc;
    k = keepmax ? max(k, ok) : min(k, ok);
}
__device__ __forceinline__ void bitonic64(unsigned& k, const int lane) {
    bitonic_step<2, 1>(k, lane);
    bitonic_step<4, 2>(k, lane); bitonic_step<4, 1>(k, lane);
    bitonic_step<8, 4>(k, lane); bitonic_step<8, 2>(k, lane); bitonic_step<8, 1>(k, lane);
    bitonic_step<16, 8>(k, lane); bitonic_step<16, 4>(k, lane); bitonic_step<16, 2>(k, lane); bitonic_step<16, 1>(k, lane);
    bitonic_step<32, 16>(k, lane); bitonic_step<32, 8>(k, lane); bitonic_step<32, 4>(k, lane); bitonic_step<32, 2>(k, lane); bitonic_step<32, 1>(k, lane);
    bitonic_step<64, 32>(k, lane); bitonic_step<64, 16>(k, lane); bitonic_step<64, 8>(k, lane); bitonic_step<64, 4>(k, lane); bitonic_step<64, 2>(k, lane); bitonic_step<64, 1>(k, lane);
}
__device__ __forceinline__ void merge32(unsigned& k, const int lane) {
    bitonic_step<64, 16>(k, lane); bitonic_step<64, 8>(k, lane); bitonic_step<64, 4>(k, lane); bitonic_step<64, 2>(k, lane); bitonic_step<64, 1>(k, lane);
}
__device__ __forceinline__ void top16_of_128(const float* s, float& tv, int& ti, const int lane) {
    unsigned ka = (okey(s[lane]) & ~0x7Fu) | (unsigned)(127 - lane), kb = (okey(s[64 + lane]) & ~0x7Fu) | (unsigned)(63 - lane);
    bitonic64(ka, lane); bitonic64(kb, lane);
    const unsigned rb = (unsigned)__shfl((int)kb, 31 - lane);
    unsigned k = (lane < 16) ? ka : ((lane < 32) ? rb : 0u);
    merge32(k, lane);
    ti = 127 - (int)(k & 0x7Fu);
    tv = s[ti];
}

__device__ __forceinline__ unsigned mirror16(unsigned v) { return (unsigned)__builtin_amdgcn_update_dpp(0, (int)v, 0x140, 0xF, 0xF, true); }
__device__ __forceinline__ void top16_pair(const float* s1, const float* s2, float& tv, int& ti, const int lane) {
    unsigned a1 = (okey(s1[lane]) & ~0x7Fu) | (unsigned)(127 - lane), b1 = (okey(s1[64 + lane]) & ~0x7Fu) | (unsigned)(63 - lane);
    unsigned a2 = (okey(s2[lane]) & ~0x7Fu) | (unsigned)(127 - lane), b2 = (okey(s2[64 + lane]) & ~0x7Fu) | (unsigned)(63 - lane);
#define PEER_S4(K, J) bitonic_step<K, J>(a1, lane); bitonic_step<K, J>(b1, lane); bitonic_step<K, J>(a2, lane); bitonic_step<K, J>(b2, lane);
    PEER_S4(2, 1) PEER_S4(4, 2) PEER_S4(4, 1) PEER_S4(8, 4) PEER_S4(8, 2) PEER_S4(8, 1) PEER_S4(64, 8) PEER_S4(64, 4) PEER_S4(64, 2) PEER_S4(64, 1)
#undef PEER_S4
    unsigned m1 = max(a1, mirror16(b1)), m2 = max(a2, mirror16(b2));
#define PEER_S2(J) bitonic_step<64, J>(m1, lane); bitonic_step<64, J>(m2, lane);
    PEER_S2(8) PEER_S2(4) PEER_S2(2) PEER_S2(1)
#undef PEER_S2
    const bool odd = (lane & 16) != 0;
    const unsigned own = odd ? m2 : m1, snd = odd ? m1 : m2;
    unsigned c = max(own, (unsigned)__shfl_xor((int)snd, 31));
    bitonic_step<64, 8>(c, lane); bitonic_step<64, 4>(c, lane); bitonic_step<64, 2>(c, lane); bitonic_step<64, 1>(c, lane);
    c = max(c, (unsigned)__shfl_xor((int)c, 47));
    bitonic_step<64, 8>(c, lane); bitonic_step<64, 4>(c, lane); bitonic_step<64, 2>(c, lane); bitonic_step<64, 1>(c, lane);
    ti = 127 - (int)(c & 0x7Fu);
    tv = (odd ? s2 : s1)[ti];
}

#ifndef DUP_PEER
#define DUP_PEER 0
#endif
constexpr int PEER_EID_OFF = 131072, PEER_GATE_OFF = 139264;
#ifndef PGB
#define PGB 8
#endif

__device__ __forceinline__ void peer_unit(const Args& a, const int unit, unsigned char* lds) {
    const bfr* QP = (const bfr*)(a.ws + WS_QP); const bfr* SUBK = (const bfr*)(a.ws + WS_SUBK);
    const unsigned char* PU4 = a.ws + WS_PU; const unsigned char* PV4 = a.ws + WS_PV;
    const bfr* HB = (const bfr*)(a.ws + WS_HB); const float* part = (const float*)(a.ws + WS_PART);
    float* S = (float*)lds; int* EID = (int*)(lds + PEER_EID_OFF); float* GATE = (float*)(lds + PEER_GATE_OFF);
    const int tid = my_tid(), lane = tid & 63, wv = tid >> 6, fr = lane & 15, fq = lane >> 4, t0 = unit * 16;
    for (int rp_ = 0; rp_ < ((DUP_PEER & 1) ? 2 : 1); ++rp_) {
    for (int hc = wv * 2; hc < wv * 2 + 2; ++hc) {
        bf16x8 A[4];
#pragma unroll
        for (int ks = 0; ks < 4; ++ks) A[ks] = *reinterpret_cast<const bf16x8*>(&QP[(size_t)(t0 + fr) * D + hc * 128 + ks * 32 + fq * 8]);
#pragma unroll 2
        for (int nt = 0; nt < 8; ++nt) {
            f32x4 acc = {0.f, 0.f, 0.f, 0.f};
#pragma unroll
            for (int ks = 0; ks < 4; ++ks) {
                const bf16x8 B = *reinterpret_cast<const bf16x8*>(&SUBK[(size_t)(hc * 128 + nt * 16 + fr) * 128 + ks * 32 + fq * 8]);
                acc = __builtin_amdgcn_mfma_f32_16x16x32_bf16(A[ks], B, acc, 0, 0, 0);
            }
#pragma unroll
            for (int j = 0; j < 4; ++j) S[((fq * 4 + j) * 16 + hc) * 128 + nt * 16 + fr] = acc[j];
        }
    }
    __syncthreads();
    for (int job = wv * 16; job < wv * 16 + 16; ++job) {
        const int tok = job >> 3, hh = job & 7;
        const float* s1 = S + (tok * 16 + hh * 2) * 128; const float* s2 = s1 + 128;
        float vv; int ii;
        top16_pair(s1, s2, vv, ii, lane);
        int ci = -1, cj = 0;
        { int base = 0;
#pragma unroll
          for (int i = 0; i < 16; ++i) { const int cnt = 16 / (i + 1); if (lane >= base && lane < base + cnt) { ci = i; cj = lane - base; } base += cnt; } }
        const float a1 = __shfl(vv, ci < 0 ? 0 : ci), b1 = __shfl(vv, 16 + cj);
        unsigned ck = (ci >= 0) ? ((okey(a1 + b1) & ~0xFFu) | (unsigned)(255 - (ci * 16 + cj))) : 0u;
        bitonic64(ck, lane);
        const int cid = 255 - (int)(ck & 0xFFu);
        const int pi = (lane < 16) ? (cid >> 4) : 0, pj = (lane < 16) ? (cid & 15) : 0;
        const float cv = __shfl(vv, pi) + __shfl(vv, 16 + pj);
        const float mx = __shfl(cv, 0);
        float e = (lane < 16) ? __expf(cv - mx) : 0.f;
        float se = e;
#pragma unroll
        for (int o = 1; o < 16; o <<= 1) se += __shfl_xor(se, o);
        const int e1 = __shfl(ii, pi), e2 = __shfl(ii, 16 + pj);
        if (lane < 16) { EID[tok * 128 + hh * 16 + lane] = e1 * 128 + e2; GATE[tok * 128 + hh * 16 + lane] = e * frcp_(se); }
    }
    __syncthreads();
    }
    for (int rp_ = 0; rp_ < ((DUP_PEER & 2) ? 2 : 1); ++rp_)
    for (int tk = wv * 2; tk < wv * 2 + 2; ++tk) {
        const int t = t0 + tk;
        int ln = lane; asm volatile("" : "+v"(ln));
        const float rstd = row_rstd(part, t);
        unsigned q1[4], q2[4]; float h1s, h2s;
        {
            float hf[32]; float am = 0.f;
#pragma unroll
            for (int q = 0; q < 8; ++q) {
                const uint2 xr = *reinterpret_cast<const uint2*>(&HB[(size_t)t * D + q * 256 + ln * 4]);
                const float4 g0 = *reinterpret_cast<const float4*>(&a.in[I_NFG][q * 256 + ln * 4]);
                hf[q * 4] = bflo(xr.x) * rstd * g0.x; hf[q * 4 + 1] = bfhi(xr.x) * rstd * g0.y; hf[q * 4 + 2] = bflo(xr.y) * rstd * g0.z; hf[q * 4 + 3] = bfhi(xr.y) * rstd * g0.w;
                am = fmaxf(am, fmaxf(fmaxf(fabsf(hf[q * 4]), fabsf(hf[q * 4 + 1])), fmaxf(fabsf(hf[q * 4 + 2]), fabsf(hf[q * 4 + 3]))));
            }
            h1s = am * (1.f / 7.f); const float i1 = h1s > 0.f ? frcp_(h1s) : 0.f;
            float qv[32]; float am2 = 0.f;
#pragma unroll
            for (int i = 0; i < 32; ++i) { qv[i] = fminf(fmaxf(__builtin_rintf(hf[i] * i1), -7.f), 7.f); hf[i] -= qv[i] * h1s; am2 = fmaxf(am2, fabsf(hf[i])); }
            q1[0] = pack8_i4(qv); q1[1] = pack8_i4(qv + 8); q1[2] = pack8_i4(qv + 16); q1[3] = pack8_i4(qv + 24);
            h2s = am2 * (1.f / 7.f); const float i2 = h2s > 0.f ? frcp_(h2s) : 0.f;
#pragma unroll
            for (int i = 0; i < 32; ++i) qv[i] = fminf(fmaxf(__builtin_rintf(hf[i] * i2), -7.f), 7.f);
            q2[0] = pack8_i4(qv); q2[1] = pack8_i4(qv + 8); q2[2] = pack8_i4(qv + 16); q2[3] = pack8_i4(qv + 24);
        }
        float coef0 = 0.f, coef1 = 0.f;
#pragma unroll 1
        for (int half = 0; half < 2; ++half) {
            float mydot = 0.f;
#define PEER_LOAD_U(W, SC, E0) _Pragma("unroll") for (int bq = 0; bq < 4; ++bq) { \
                const int eid = EID[tk * 128 + half * 64 + (E0) + bq]; const unsigned char* rowp = PU4 + (size_t)eid * PEER_ROWB; \
                SC[bq] = *reinterpret_cast<const bfr*>(rowp + 1024 + ln * 2); W[bq] = *reinterpret_cast<const uint4*>(rowp + ln * 16); } __builtin_amdgcn_sched_barrier(0);
#define PEER_DOT_U(W, SC, E0) _Pragma("unroll") for (int bq = 0; bq < 4; ++bq) { \
                int a1 = 0, a2 = 0; \
                a1 = __builtin_amdgcn_sdot8((int)W[bq].x, (int)q1[0], a1, false); a2 = __builtin_amdgcn_sdot8((int)W[bq].x, (int)q2[0], a2, false); \
                a1 = __builtin_amdgcn_sdot8((int)W[bq].y, (int)q1[1], a1, false); a2 = __builtin_amdgcn_sdot8((int)W[bq].y, (int)q2[1], a2, false); \
                a1 = __builtin_amdgcn_sdot8((int)W[bq].z, (int)q1[2], a1, false); a2 = __builtin_amdgcn_sdot8((int)W[bq].z, (int)q2[2], a2, false); \
                a1 = __builtin_amdgcn_sdot8((int)W[bq].w, (int)q1[3], a1, false); a2 = __builtin_amdgcn_sdot8((int)W[bq].w, (int)q2[3], a2, false); \
                float p = ((float)a1 * h1s + (float)a2 * h2s) * bf2f(SC[bq]); \
                p = wave_sum(p); if (lane == (E0) + bq) mydot = p; __builtin_amdgcn_sched_barrier(0); }
            {
                uint4 wA[4], wB[4]; bfr sA[4], sB[4];
                PEER_LOAD_U(wA, sA, 0)
#pragma unroll 1
                for (int e0 = 0; e0 < 56; e0 += 8) {
                    PEER_LOAD_U(wB, sB, e0 + 4)
                    PEER_DOT_U(wA, sA, e0)
                    PEER_LOAD_U(wA, sA, e0 + 8)
                    PEER_DOT_U(wB, sB, e0 + 4)
                }
                PEER_LOAD_U(wB, sB, 60)
                PEER_DOT_U(wA, sA, 56)
                PEER_DOT_U(wB, sB, 60)
            }
            const float gl = 0.5f * mydot * (1.f + erff(mydot * 0.7071067811865476f));
            const float cfv = gl * GATE[tk * 128 + half * 64 + lane];
            if (half == 0) coef0 = cfv; else coef1 = cfv;
        }
        h16x2 ov2[16];
#pragma unroll
        for (int j = 0; j < 16; ++j) ov2[j] = h16x2{(_Float16)0.f, (_Float16)0.f};
        {
#define PEER_LOAD_V(W, SC, E0) _Pragma("unroll") for (int bq = 0; bq < 4; ++bq) { \
                const int eid = __builtin_amdgcn_readfirstlane(EID[tk * 128 + (E0) + bq]); const unsigned char* rowp = PV4 + (size_t)eid * PEER_ROWB; \
                SC[bq] = *reinterpret_cast<const bfr*>(rowp + 1024 + ln * 2); W[bq] = *reinterpret_cast<const uint4*>(rowp + ln * 16); } __builtin_amdgcn_sched_barrier(0);
#define PEER_AXPY_V(W, SC, E0) _Pragma("unroll") for (int bq = 0; bq < 4; ++bq) { \
                const float cfl = __int_as_float(__builtin_amdgcn_readlane(__float_as_int(((E0) < 64) ? coef0 : coef1), ((E0) + bq) & 63)); \
                const unsigned dw[4] = {W[bq].x, W[bq].y, W[bq].z, W[bq].w}; const _Float16 ch = (_Float16)(cfl * bf2f(SC[bq])); const h16x2 c2 = {ch, ch}; \
                _Pragma("unroll") for (int d = 0; d < 4; ++d) { \
                    ov2[d * 4 + 0] = c2 * __builtin_amdgcn_cvt_scalef32_pk_f16_fp4(dw[d], 1.0f, 0) + ov2[d * 4 + 0]; \
                    ov2[d * 4 + 1] = c2 * __builtin_amdgcn_cvt_scalef32_pk_f16_fp4(dw[d], 1.0f, 1) + ov2[d * 4 + 1]; \
                    ov2[d * 4 + 2] = c2 * __builtin_amdgcn_cvt_scalef32_pk_f16_fp4(dw[d], 1.0f, 2) + ov2[d * 4 + 2]; \
                    ov2[d * 4 + 3] = c2 * __builtin_amdgcn_cvt_scalef32_pk_f16_fp4(dw[d], 1.0f, 3) + ov2[d * 4 + 3]; } \
                __builtin_amdgcn_sched_barrier(0); }
            uint4 wA[4], wB[4]; bfr sA[4], sB[4];
            PEER_LOAD_V(wA, sA, 0)
#pragma unroll 1
            for (int e0 = 0; e0 < 120; e0 += 8) {
                PEER_LOAD_V(wB, sB, e0 + 4)
                PEER_AXPY_V(wA, sA, e0)
                PEER_LOAD_V(wA, sA, e0 + 8)
                PEER_AXPY_V(wB, sB, e0 + 4)
            }
            PEER_LOAD_V(wB, sB, 124)
            PEER_AXPY_V(wA, sA, 120)
            PEER_AXPY_V(wB, sB, 124)
        }
        float ss = 0.f;
        float hv[32];
        { int l2 = lane; asm volatile("" : "+v"(l2));
#pragma unroll
          for (int q = 0; q < 8; ++q) {
              const uint2 xr = *reinterpret_cast<const uint2*>(&HB[(size_t)t * D + q * 256 + l2 * 4]);
              float4 x0; x0.x = bflo(xr.x); x0.y = bfhi(xr.x); x0.z = bflo(xr.y); x0.w = bfhi(xr.y);
              hv[q * 4 + 0] = x0.x; hv[q * 4 + 1] = x0.y; hv[q * 4 + 2] = x0.z; hv[q * 4 + 3] = x0.w;
          } }
#pragma unroll
        for (int j = 0; j < 32; ++j) { hv[j] += (DBG_NOPEER ? 0.f : (float)ov2[j >> 1][j & 1]); ss += hv[j] * hv[j]; }
        ss = wave_sum(ss);
        const float r2 = rsqrtf(ss * (1.f / D) + EPS);
#pragma unroll
        for (int q = 0; q < 8; ++q) {
            const float4 g0 = *reinterpret_cast<const float4*>(&a.in[I_NFIN][q * 256 + ln * 4]);
            float4 o0;
            o0.x = hv[q * 4 + 0] * r2 * g0.x; o0.y = hv[q * 4 + 1] * r2 * g0.y; o0.z = hv[q * 4 + 2] * r2 * g0.z; o0.w = hv[q * 4 + 3] * r2 * g0.w;
            *reinterpret_cast<float4*>(&a.out[(size_t)t * D + q * 256 + ln * 4]) = o0;
        }
    }
    __syncthreads();
}
constexpr int NPHASE = 9;
__global__ void __launch_bounds__(512, 2) mk_fwd(Args a) {
    extern __shared__ __attribute__((aligned(16))) unsigned char lds[];
    volatile LAS unsigned* barw = (volatile LAS unsigned*)((LAS unsigned char*)lds + LDS_BARW);
    unsigned* MISC = (unsigned*)(lds + LDS_MISC);
    if (threadIdx.x < 4) barw[threadIdx.x] = 0u;
    __syncthreads();
    XcdBarrier bar; bar.bar = (unsigned*)(a.ws + WS_CTL); bar.x = 0; bar.st = barw;
#if !MK_SPLIT
    bar = xcd_barrier_post((unsigned*)(a.ws + WS_CTL), barw);
#endif
    const int lo = a.ph_lo, hi = a.ph_hi;
#ifndef PH_MASK
#define PH_MASK 0x1FF
#endif
#define IN(k) (((PH_MASK >> (k)) & 1) && lo <= (k) && (k) < hi)
#ifndef DUP_RW
#define DUP_RW 0
#endif
#ifndef DUP_CHAIN
#define DUP_CHAIN 0
#endif
#ifndef DUP_MASK
#define DUP_MASK 0
#endif
#define REP(k) for (int rep_ = 0; rep_ < (((DUP_MASK >> (k)) & 1) ? 2 : 1); ++rep_)
#define SEAM(k) do { if (IN(k) && IN((k) + 1)) xcd_barrier(bar); } while (0)
    unsigned char* ws = a.ws;
    const bfr* P = (const bfr*)(ws + WS_P);

    if (IN(0)) REP(0) {
        const int tid = my_tid(), wv = tid >> 6; (void)tid; (void)wv;
        {
            const float* x = a.in[I_X]; const float* g = a.in[I_NMG]; bfr* XN = (bfr*)(ws + WS_XN);
            const int lane = tid & 63;
            for (int row = blockIdx.x * 8 + wv; row < T; row += gridDim.x * 8) {
                float4 v[8]; float ss = 0.f;
#pragma unroll
                for (int j = 0; j < 8; ++j) { v[j] = reinterpret_cast<const float4*>(x + (size_t)row * D)[j * 64 + lane]; ss += v[j].x * v[j].x + v[j].y * v[j].y + v[j].z * v[j].z + v[j].w * v[j].w; }
                ss = wave_sum(ss);
                const float rs = rsqrtf(ss * (1.f / D) + EPS);
#pragma unroll
                for (int j = 0; j < 8; ++j) {
                    const float4 gg = reinterpret_cast<const float4*>(g)[j * 64 + lane];
                    uint2 o; o.x = pack2(v[j].x * rs * gg.x, v[j].y * rs * gg.y); o.y = pack2(v[j].z * rs * gg.z, v[j].w * rs * gg.w);
                    reinterpret_cast<uint2*>(XN + (size_t)row * D)[j * 64 + lane] = o;
                }
            }
        }
        float* tl = (float*)lds;
        tr_all(a.in[I_WIN], (bfr*)(ws + WS_WTIN), D, NIN, NINP, nullptr, tl);
        tr_all(a.in[I_WBR], (bfr*)(ws + WS_WTA), RW, D, D, nullptr, tl);
        tr_all(a.in[I_WBD], (bfr*)(ws + WS_WTB), RW, D, D, nullptr, tl);
        tr_all(a.in[I_WOUT], (bfr*)(ws + WS_WTOUT), D, D, D, nullptr, tl);
        tr_all(a.in[I_WPQ], (bfr*)(ws + WS_WTPQ), D, D, D, a.in[I_NFG], tl);
        for (int it = blockIdx.x; it < 16 * 4; it += gridDim.x) {
            const int h = it >> 2, k0 = (it & 3) * 64;
            tr_tile(a.in[I_WUV] + (size_t)h * 256 * 64, (bfr*)(ws + WS_WUVT) + (size_t)h * 64 * 256, 256, 64, k0, 0, nullptr, tl);
        }
        cvt_all(a.in[I_WUK], (bfr*)(ws + WS_WUK), (size_t)16 * 256 * 64);
        cvt_all(a.in[I_SUBK], (bfr*)(ws + WS_SUBK), (size_t)16 * 128 * 128);
    }
    SEAM(0);

    if (IN(1)) REP(1) {
        const int tid = my_tid(), wv = tid >> 6; (void)tid; (void)wv;
        EpiP E{(bfr*)(ws + WS_P)};
        const int nM = T / BM, nN = NINP / BM;
        for (int tile = blockIdx.x; tile < nM * nN; tile += gridDim.x) {
            int brow, bcol; tile_rc(tile, nM, nN, brow, bcol);
            gemm_tile((const bfr*)(ws + WS_XN), (const bfr*)(ws + WS_WTIN), D, brow, bcol, (bfr*)lds, E);
        }
        {
            const int rem = (nM * nN) % (int)gridDim.x, idle = (int)gridDim.x - rem;
            if (rem == 0) cvt_i4_rows(a.in[I_PU], ws + WS_PU, blockIdx.x, gridDim.x);
            else if ((int)blockIdx.x >= rem) cvt_i4_rows(a.in[I_PU], ws + WS_PU, (int)blockIdx.x - rem, idle);
        }
    }
    SEAM(1);

    if (IN(2)) REP(2) {
        const int tid = my_tid(), wv = tid >> 6; (void)tid; (void)wv;
        rwkv_load_weights(a, blockIdx.x & 15, lds);
        {
            const int h = blockIdx.x & 15, nun = (NUNIT - (int)blockIdx.x + (int)gridDim.x - 1) / (int)gridDim.x;
            RwIn inA, inB;
            if (nun > 0) rwkv_fetch(a, (int)blockIdx.x >> 4, h, inA);
            for (int k = 0; k < nun; k += 2) {
                const int c0 = ((int)blockIdx.x + k * (int)gridDim.x) >> 4, c1 = ((int)blockIdx.x + (k + 1) * (int)gridDim.x) >> 4, c2 = ((int)blockIdx.x + (k + 2) * (int)gridDim.x) >> 4;
                rwkv_unit(a, c0, h, lds, inA, inB, (k + 1 < nun) ? c1 : -1);
                if (k + 1 < nun) rwkv_unit(a, c1, h, lds, inB, inA, (k + 2 < nun) ? c2 : -1);
            }
        }
        dsa_cnorm(a);
        dsa_qlat(a);
    }
    SEAM(2);

    if (IN(3)) REP(3) {
        const int tid = my_tid(), wv = tid >> 6; (void)tid; (void)wv;
        if (blockIdx.x < 32) {
            if (wv == 0) rwkv_chain(a, blockIdx.x >> 1, blockIdx.x & 1);
            else cvt_fp4_rows(a.in[I_PV], ws + WS_PV, (int)blockIdx.x * 7 + (wv - 1), 32 * 7);
        }
        __syncthreads();
        for (int i = tid; i < 512; i += 512) ((float*)(lds + DSA_RELB_OFF))[i] = a.in[I_RELB][i];
        __syncthreads();
        unsigned* cnt = (unsigned*)(ws + WS_CTL + CTL_CNT) + rep_ * 64;
        for (;;) {
            if (tid == 0) MISC[0] = atomicAdd(cnt, 1u);
            __syncthreads();
            const unsigned n = MISC[0];
            __syncthreads();
            if (n >= T / 8) break;
            dsa_unit(a, (T / 8 - 1) - (int)n, lds);
        }
    }
    SEAM(3);

    if (IN(4)) REP(4) {
        const int tid = my_tid(), wv = tid >> 6; (void)tid; (void)wv;
        float* Ls = (float*)lds + wv * 4352;
        for (int u = blockIdx.x * 8 + wv; u < NUNIT; u += gridDim.x * 8) rwkv_out_unit(a, u, Ls);
        dsa_oproj(a);
    }
    SEAM(4);

    if (IN(5)) REP(5) {
        const int tid = my_tid(), wv = tid >> 6; (void)tid; (void)wv;
        const int nM = T / BM, nN = D / BM;
        for (int tile = blockIdx.x; tile < nM * nN; tile += gridDim.x) {
            int brow, bcol; tile_rc(tile, nM, nN, brow, bcol);
#pragma unroll 1
            for (int pass = 0; pass < 2; ++pass) {
                EpiMix E{(bfr*)(ws + (pass ? WS_MIX : WS_TMPA)), pass ? (const bfr*)(ws + WS_TMPA) : (const bfr*)nullptr, P + (pass ? C_GB : C_GA)};
                gemm_tile((const bfr*)(ws + (pass ? WS_DO : WS_RWO)), (const bfr*)(ws + (pass ? WS_WTB : WS_WTA)), RW, brow, bcol, (bfr*)lds, E);
                asm volatile("s_waitcnt vmcnt(0)" ::: "memory");
            }
        }
    }
    SEAM(5);

    if (IN(6)) REP(6) {
        const int tid = my_tid(), wv = tid >> 6; (void)tid; (void)wv;
        const int nM = T / BM, nN = D / BM;
        for (int tile = blockIdx.x; tile < nM * nN; tile += gridDim.x) {
            int brow, bcol; tile_rc(tile, nM, nN, brow, bcol);
            EpiH E{(bfr*)(ws + WS_HB), a.in[I_X], (float*)(ws + WS_PART), bcol >> 8};
            gemm_tile((const bfr*)(ws + WS_MIX), (const bfr*)(ws + WS_WTOUT), D, brow, bcol, (bfr*)lds, E);
        }
    }
    SEAM(6);

    if (IN(7)) REP(7) {
        const int tid = my_tid(), wv = tid >> 6; (void)tid; (void)wv;
        const int nM = T / BM, nN = D / BM;
        float* rs = (float*)(lds + 135168);
        for (int tile = blockIdx.x; tile < nM * nN; tile += gridDim.x) {
            int brow, bcol; tile_rc(tile, nM, nN, brow, bcol);
            if (tid < 256) rs[tid] = row_rstd((const float*)(ws + WS_PART), brow + tid);
            __syncthreads();
            EpiQ E{(bfr*)(ws + WS_QP), rs, brow};
            gemm_tile((const bfr*)(ws + WS_HB), (const bfr*)(ws + WS_WTPQ), D, brow, bcol, (bfr*)lds, E);
        }
    }
    SEAM(7);

    if (IN(8)) REP(8) {
        const int tid = my_tid(), wv = tid >> 6; (void)tid; (void)wv;
        for (int u = blockIdx.x; u < T / 16; u += gridDim.x) peer_unit(a, u, lds);
    }
#undef IN
#undef SEAM
}

extern "C" void kernel_launch(void* const* d_in, const int* in_sizes, int n_in, void* d_out, int out_size, void* d_ws, size_t ws_size, hipStream_t stream) {
    static int grid = 0;
    if (grid == 0) {
        if (n_in != 27 || out_size != T * D || ws_size < WS_END) { fprintf(stderr, "kernel_launch: unexpected shapes (n_in %d out %d ws %zu)\n", n_in, out_size, ws_size); grid = -1; return; }
        int dev = 0, cus = 0, per_cu = 0;
        if (hipGetDevice(&dev) != hipSuccess || hipDeviceGetAttribute(&cus, hipDeviceAttributeMultiprocessorCount, dev) != hipSuccess) { grid = -1; return; }
        if (hipFuncSetAttribute((const void*)mk_fwd, hipFuncAttributeMaxDynamicSharedMemorySize, LDS_BYTES) != hipSuccess) { fprintf(stderr, "kernel_launch: hipFuncSetAttribute failed\n"); grid = -1; return; }
        if (hipOccupancyMaxActiveBlocksPerMultiprocessor(&per_cu, (const void*)mk_fwd, 512, LDS_BYTES) != hipSuccess || per_cu < 1) { fprintf(stderr, "kernel_launch: occupancy query says %d\n", per_cu); (void)hipGetLastError(); grid = -1; return; }
        grid = cus;
    }
    if (grid < 0) return;
    if (hipMemsetAsync((char*)d_ws + WS_CTL, 0, CTL_ZERO, stream) != hipSuccess) return;
    Args a{};
    for (int i = 0; i < 27; ++i) a.in[i] = (const float*)d_in[i];
    a.out = (float*)d_out; a.ws = (unsigned char*)d_ws;
#if MK_SPLIT
    for (int ph = 0; ph < NPHASE; ++ph) { a.ph_lo = ph; a.ph_hi = ph + 1; hipLaunchKernelGGL(mk_fwd, dim3(grid), dim3(512), LDS_BYTES, stream, a); }
#elif defined(PROBE_PHASE)
    a.ph_lo = 0; a.ph_hi = PROBE_PHASE + 1;
    hipLaunchKernelGGL(mk_fwd, dim3(grid), dim3(512), LDS_BYTES, stream, a);
    (void)hipMemsetAsync((char*)d_ws + WS_CTL, 0, CTL_ZERO, stream);
    a.ph_lo = PROBE_PHASE; a.ph_hi = NPHASE;
    hipLaunchKernelGGL(mk_fwd, dim3(grid), dim3(512), LDS_BYTES, stream, a);
#else
    a.ph_lo = 0; a.ph_hi = NPHASE;
    hipLaunchKernelGGL(mk_fwd, dim3(grid), dim3(512), LDS_BYTES, stream, a);
#endif
}
```

```cpp
#include <hip/hip_runtime.h>
#include <stdint.h>
#include <stdio.h>

#ifndef MK_SPLIT
#define MK_SPLIT 0
#endif

#ifndef DBG_NOPEER
#define DBG_NOPEER 0
#endif
#ifndef DBG_NODSA
#define DBG_NODSA 0
#endif
typedef unsigned short bfr;
using bf16x8 = __attribute__((ext_vector_type(8))) short;
using bf16x4 = __attribute__((ext_vector_type(4))) short;
using f32x4  = __attribute__((ext_vector_type(4))) float;
using f32x2  = __attribute__((ext_vector_type(2))) float;
using f32x16 = __attribute__((ext_vector_type(16))) float;
using u32x4  = __attribute__((ext_vector_type(4))) unsigned;
using h16x2  = __attribute__((ext_vector_type(2))) _Float16;

constexpr int T = 8192, D = 2048, NIN = 9320, NINP = 9472;
constexpr int RW = 1024, NH = 16, HD = 64;
constexpr int C_R = 0, C_K = 1024, C_V = 2048, C_ZW = 3072, C_ZA = 3136, C_ZG = 3200, C_Q = 3360, C_CKV = 4384,
              C_IQ = 4640, C_IK = 5152, C_IW = 5216, C_GA = 5224, C_GB = 7272;
constexpr int KVR = 256, NUNIT = 128 * 16;
constexpr float EPS = 1e-6f;

constexpr size_t MiB = 1u << 20;
constexpr size_t WS_CTL = 0;
constexpr size_t CTL_ZERO = 65536;
constexpr size_t CTL_CNT = 16384;
constexpr size_t CTL_ROWSS = 32768;
constexpr size_t WS_WTA = 1 * MiB, WS_WTB = 5 * MiB, WS_WTOUT = 9 * MiB, WS_WTPQ = 17 * MiB;
constexpr size_t WS_WUK = 25 * MiB, WS_WUVT = 25 * MiB + 512 * 1024, WS_SUBK = 26 * MiB;
constexpr size_t WS_X = 27 * MiB;
constexpr size_t WS_XN = WS_X, WS_WTIN = WS_X + 32 * MiB;
constexpr size_t WS_PM = WS_X, WS_WY = WS_X + 16 * MiB, WS_GM = WS_X + 32 * MiB, WS_YLOC = WS_X + 48 * MiB;
constexpr size_t WS_MIX = WS_X;
constexpr size_t WS_P = 96 * MiB;
constexpr size_t WS_H = 96 * MiB, WS_HB = 160 * MiB, WS_QP = 192 * MiB;
constexpr size_t WS_GG = 244 * MiB, WS_BON = 260 * MiB, WS_CB = 276 * MiB;
#ifdef OLAT_SEP
constexpr size_t WS_QLAT = 280 * MiB, WS_OLAT = 456 * MiB;
#else
constexpr size_t WS_QLAT = 280 * MiB, WS_OLAT = WS_QLAT;
#endif
constexpr size_t WS_KEYS = 344 * MiB;
constexpr size_t WS_PU = 490 * MiB, WS_PV = 312 * MiB;
constexpr size_t WS_PUS = WS_PU + 32 * MiB, WS_PVS = WS_PV + 32 * MiB;
constexpr size_t WS_ZT = 408 * MiB, WS_RWO = 424 * MiB, WS_DO = 440 * MiB, WS_TMPA = 456 * MiB;
constexpr size_t WS_IKC = 489 * MiB;
constexpr size_t WS_PART = 488 * MiB;
constexpr size_t WS_END = 508 * MiB;

constexpr int LDS_BYTES = 163840 - 1024;
constexpr int LDS_BARW = LDS_BYTES - 64;
constexpr int LDS_MISC = LDS_BYTES - 512;

typedef __bf16 bf16v2_t __attribute__((ext_vector_type(2)));
__device__ __forceinline__ bfr f2bf(float f) { const __bf16 r = (__bf16)f; return __builtin_bit_cast(bfr, r); }
__device__ __forceinline__ float bf2f(bfr b) { return __uint_as_float(((unsigned)b) << 16); }
__device__ __forceinline__ unsigned pack2(float a, float b) { const f32x2 v = {a, b}; const bf16v2_t r = __builtin_convertvector(v, bf16v2_t); return __builtin_bit_cast(unsigned, r); }
__device__ __forceinline__ float bflo(unsigned u) { return __uint_as_float(u << 16); }
__device__ __forceinline__ float bfhi(unsigned u) { return __uint_as_float(u & 0xFFFF0000u); }
__device__ __forceinline__ int my_tid() { int t = threadIdx.x; asm volatile("" : "+v"(t)); return t; }

template <int CTRL> __device__ __forceinline__ float dpp_f(float v) {
    return __int_as_float(__builtin_amdgcn_update_dpp(0, __float_as_int(v), CTRL, 0xF, 0xF, true));
}
#define DPP_XOR1 0xB1
#define DPP_XOR2 0x4E
__device__ __forceinline__ float sumx16(const float v) { const auto r = __builtin_amdgcn_permlane16_swap(__float_as_uint(v), __float_as_uint(v), false, false); return __uint_as_float(r[0]) + __uint_as_float(r[1]); }
__device__ __forceinline__ float sumx32(const float v) { const auto r = __builtin_amdgcn_permlane32_swap(__float_as_uint(v), __float_as_uint(v), false, false); return __uint_as_float(r[0]) + __uint_as_float(r[1]); }
__device__ __forceinline__ float maxx16(const float v) { const auto r = __builtin_amdgcn_permlane16_swap(__float_as_uint(v), __float_as_uint(v), false, false); return fmaxf(__uint_as_float(r[0]), __uint_as_float(r[1])); }
__device__ __forceinline__ float maxx32(const float v) { const auto r = __builtin_amdgcn_permlane32_swap(__float_as_uint(v), __float_as_uint(v), false, false); return fmaxf(__uint_as_float(r[0]), __uint_as_float(r[1])); }
__device__ __forceinline__ unsigned xor16_u(const unsigned v, const int lane) { const auto r = __builtin_amdgcn_permlane16_swap(v, v, false, false); return (lane & 16) ? r[0] : r[1]; }
__device__ __forceinline__ unsigned xor32_u(const unsigned v, const int lane) { const auto r = __builtin_amdgcn_permlane32_swap(v, v, false, false); return (lane & 32) ? r[0] : r[1]; }
__device__ __forceinline__ float wave_sum(float v) {
    v += dpp_f<DPP_XOR1>(v); v += dpp_f<DPP_XOR2>(v); v += dpp_f<0x141>(v); v += dpp_f<0x140>(v);
    v = sumx16(v); v = sumx32(v); return v;
}
__device__ __forceinline__ float wave_sum4(const float p0, const float p1, const float p2, const float p3, const int lane) {
    const bool b0 = (lane & 1) != 0, b1 = (lane & 2) != 0;
    const float x01 = (b0 ? p1 : p0) + dpp_f<DPP_XOR1>(b0 ? p0 : p1);
    const float x23 = (b0 ? p3 : p2) + dpp_f<DPP_XOR1>(b0 ? p2 : p3);
    float y = (b1 ? x23 : x01) + dpp_f<DPP_XOR2>(b1 ? x01 : x23);
    y += dpp_f<0x124>(y);
    y += dpp_f<0x128>(y);
    y = sumx16(y); y = sumx32(y);
    return y;
}
__device__ __forceinline__ float frcp_(float x) { return __builtin_amdgcn_rcpf(x); }
__device__ __forceinline__ float sigmoidf_(float x) { return frcp_(1.f + __expf(-x)); }

#define XB_TMO      128
#define XB_XCNT(j)  (256  + 64 * (j))
#define XB_XSUB(j)  (1280 + 64 * (j))
#define XB_XGEN(j)  (2304 + 64 * (j))
#define XB_TOP      3328
#define XB_TOPGEN   3392
#define XCD_BAR_WORDS 3456
#define XB_SPIN_CAP (1u << 20)
#define LAS __attribute__((address_space(3)))

__device__ __forceinline__ unsigned xb_ld(unsigned* p)              { return __hip_atomic_load(p, __ATOMIC_RELAXED, __HIP_MEMORY_SCOPE_AGENT); }
__device__ __forceinline__ unsigned xb_add(unsigned* p, unsigned v) { return __hip_atomic_fetch_add(p, v, __ATOMIC_RELAXED, __HIP_MEMORY_SCOPE_AGENT); }
__device__ __forceinline__ unsigned xb_xcc_id() { return (unsigned)__builtin_amdgcn_s_getreg((3 << 11) | 20) & 0xFu; }
#define XB_SPIN(cond, bar) do { unsigned _sp = 0; while (cond) { __builtin_amdgcn_s_sleep(1); \
    if ((++_sp & 255u) == 0u) { if (xb_ld(&(bar)[XB_TMO])) break; if (_sp > XB_SPIN_CAP) { atomicAdd(&(bar)[XB_TMO], 1u); break; } } } } while (0)

struct XcdBarrier { unsigned* bar; unsigned x; volatile LAS unsigned* st; };

__device__ __forceinline__ XcdBarrier xcd_barrier_post(unsigned* bar, volatile LAS unsigned* st) {
    XcdBarrier b; b.bar = bar; b.x = xb_xcc_id(); b.st = st;
    if (threadIdx.x == 0) (void)xb_add(&bar[XB_XCNT(b.x)], 1u);
    return b;
}
__device__ __forceinline__ void xcd_barrier_complete(unsigned* bar, unsigned x, unsigned& nloc, unsigned& nx) {
    const unsigned G = gridDim.x * gridDim.y * gridDim.z;
    unsigned sum, cnt, mine, sp = 0u;
    for (;;) {
        sum = 0u; cnt = 0u; mine = 0u;
#pragma unroll
        for (unsigned j = 0; j < 16; ++j) { const unsigned c = xb_ld(&bar[XB_XCNT(j)]); sum += c; cnt += (c > 0u) ? 1u : 0u; mine = (j == x) ? c : mine; }
        if (sum == G) break;
        __builtin_amdgcn_s_sleep(1);
        if ((++sp & 255u) == 0u) { if (xb_ld(&bar[XB_TMO])) break; if (sp > XB_SPIN_CAP) { atomicAdd(&bar[XB_TMO], 1u); break; } }
    }
    nloc = mine > 0u ? mine : 1u; nx = cnt > 0u ? cnt : 1u;
}
__device__ __forceinline__ void xcd_barrier(const XcdBarrier& b) {
    asm volatile("s_waitcnt vmcnt(0)" ::: "memory");
    __syncthreads();
    if (threadIdx.x == 0) {
        unsigned* bar = b.bar;
        __builtin_amdgcn_s_waitcnt(0);
        unsigned nloc = b.st[0], nx = b.st[1];
        if (nloc == 0u) { xcd_barrier_complete(bar, b.x, nloc, nx); b.st[0] = nloc; b.st[1] = nx; }
        const unsigned old = xb_add(&bar[XB_XSUB(b.x)], 1u);
        const unsigned gen = old / nloc;
        if (old + 1u == (gen + 1u) * nloc) {
            __builtin_amdgcn_fence(__ATOMIC_RELEASE, "agent");
            asm volatile("s_waitcnt vmcnt(0)" ::: "memory");
            const unsigned og = xb_add(&bar[XB_TOP], 1u);
            const unsigned tg = og / nx;
            if (og + 1u == (tg + 1u) * nx) xb_add(&bar[XB_TOPGEN], 1u);
            else XB_SPIN(xb_ld(&bar[XB_TOPGEN]) == tg, bar);
            __builtin_amdgcn_fence(__ATOMIC_ACQUIRE, "agent");
            xb_add(&bar[XB_XGEN(b.x)], 1u);
            asm volatile("s_waitcnt vmcnt(0)" ::: "memory");
        } else {
            XB_SPIN(xb_ld(&bar[XB_XGEN(b.x)]) == gen, bar);
            asm volatile("buffer_inv sc0" ::: "memory");
            asm volatile("s_waitcnt vmcnt(0)" ::: "memory");
        }
    }
    __syncthreads();
}

struct Args { const float* in[27]; float* out; unsigned char* ws; int ph_lo, ph_hi; };
enum { I_X = 0, I_NMG, I_WIN, I_SHIFT, I_W0, I_WDEC, I_A0, I_WICL, I_WGATE, I_KK, I_KA, I_RK, I_LNW, I_LNB, I_KVG, I_WUK, I_WUV,
       I_RELB, I_WBR, I_WBD, I_WOUT, I_NFG, I_WPQ, I_SUBK, I_PU, I_PV, I_NFIN };

constexpr int BM = 256, BK = 64, HALF = 128, HT = HALF * BK;
constexpr int EPI_LDW = 260;
__device__ __forceinline__ int lds_byte(int r, int c) {
    int st = (r >> 4) * 2 + (c >> 5), rr = r & 15, cc = c & 31, ob = rr * 64 + cc * 2;
    return st * 1024 + (ob ^ (((ob >> 9) & 1) << 5));
}
__device__ __forceinline__ void stage_rc(int b, int& R, int& C) {
    int st = b / 1024, sb = b % 1024, swz = sb ^ (((sb >> 9) & 1) << 5);
    R = (st >> 1) * 16 + swz / 64; C = (st & 1) * 32 + (swz % 64) / 2;
}

template <class Epi>
__device__ __forceinline__ void gemm_tile(const bfr* __restrict__ A, const bfr* __restrict__ Bt, const int K, const int brow, const int bcol,
                                          bfr* shm, Epi& epi) {
#define SA(b,h) (shm+((b)*2+(h))*HT)
#define SB(b,h) (shm+(4+(b)*2+(h))*HT)
#define STAGE_X(TT,P,BASE,br,kt) do{long _g=(long)(br)*K+(long)(kt)*BK; \
    for(int _i=0;_i<2;++_i){int _b=(TT)*16+_i*8192;int _r,_c;stage_rc(_b,_r,_c); \
      __builtin_amdgcn_global_load_lds((const unsigned*)(BASE+_g+(long)_r*K+_c), \
        (LAS unsigned*)((LAS char*)(P)+_b),16,0,0);}}while(0)
#define STAGE(P,BASE,br,kt) STAGE_X(tq,P,BASE,br,kt)
#define LDA(dst,b,h) for(int m=0;m<4;++m)for(int k=0;k<2;++k) \
    dst[m][k]=*reinterpret_cast<const bf16x8*>((char*)SA(b,h)+lds_byte(wr*64+m*16+fr,k*32+fq*8))
#define LDB(dst,b,h) for(int n=0;n<2;++n)for(int k=0;k<2;++k) \
    dst[n][k]=*reinterpret_cast<const bf16x8*>((char*)SB(b,h)+lds_byte(wc*32+n*16+fr,k*32+fq*8))
#define MMA(ai,bj,At_,Bt_) do{__builtin_amdgcn_s_setprio(1); \
    for(int m=0;m<4;++m)for(int n=0;n<2;++n)for(int k=0;k<2;++k) \
      acc[ai][bj][m][n]=__builtin_amdgcn_mfma_f32_16x16x32_bf16(At_[m][k],Bt_[n][k],acc[ai][bj][m][n],0,0,0); \
    __builtin_amdgcn_s_setprio(0);}while(0)
#define WAIT_V(n) asm volatile("s_waitcnt vmcnt(" #n ")":::"memory")
#define WAIT_L(n) asm volatile("s_waitcnt lgkmcnt(" #n ")":::"memory")
#define BAR __builtin_amdgcn_s_barrier()
#define SCHED __builtin_amdgcn_sched_barrier(0)
    const int tq = my_tid();
    int wid = tq >> 6, lane = tq & 63, wr = wid >> 2, wc = wid & 3, fr = lane & 15, fq = lane >> 4;
    f32x4 acc[2][2][4][2] = {};
    bf16x8 At[4][2], B0[2][2], B1[2][2];
    const int nt = K / BK;
    STAGE(SB(0,0),Bt,bcol,0); STAGE(SA(0,0),A,brow,0);
    STAGE(SB(0,1),Bt,bcol+HALF,0); STAGE(SA(0,1),A,brow+HALF,0);
    if(wr==1)BAR;
    WAIT_V(4); BAR;
    STAGE(SB(1,0),Bt,bcol,1); STAGE(SA(1,0),A,brow,1); STAGE(SB(1,1),Bt,bcol+HALF,1);
    WAIT_V(6); BAR;
    for(int t=0;t<nt-2;t+=2){
        LDB(B0,0,0); SCHED; LDA(At,0,0); STAGE(SA(1,1),A,brow+HALF,t+1);
        WAIT_L(8); BAR; WAIT_L(0); MMA(0,0,At,B0); BAR; SCHED;
        LDB(B1,0,1); STAGE(SB(0,0),Bt,bcol,t+2);
        BAR; WAIT_L(0); MMA(0,1,At,B1); BAR;
        LDA(At,0,1); STAGE(SA(0,0),A,brow,t+2);
        BAR; WAIT_L(0); MMA(1,0,At,B0); BAR; SCHED;
        STAGE(SB(0,1),Bt,bcol+HALF,t+2);
        WAIT_V(6); BAR; MMA(1,1,At,B1); BAR;
        LDB(B0,1,0); SCHED; LDA(At,1,0); STAGE(SA(0,1),A,brow+HALF,t+2);
        WAIT_L(8); BAR; WAIT_L(0); MMA(0,0,At,B0); BAR; SCHED;
        LDB(B1,1,1); STAGE(SB(1,0),Bt,bcol,t+3);
        BAR; WAIT_L(0); MMA(0,1,At,B1); BAR;
        LDA(At,1,1); STAGE(SA(1,0),A,brow,t+3);
        BAR; WAIT_L(0); MMA(1,0,At,B0); BAR; SCHED;
        STAGE(SB(1,1),Bt,bcol+HALF,t+3);
        WAIT_V(6); BAR; MMA(1,1,At,B1); BAR;
    }
    int tz=threadIdx.x; asm volatile("":"+v"(tz)); wid=tz>>6; lane=tz&63; wr=wid>>2; wc=wid&3; fr=lane&15; fq=lane>>4;
    { LDB(B0,0,0); WAIT_V(0); LDA(At,0,0); STAGE_X(tz,SA(1,1),A,brow+HALF,nt-1);
      BAR; WAIT_L(0); MMA(0,0,At,B0); BAR;
      LDB(B1,0,1); BAR; WAIT_L(0); MMA(0,1,At,B1); BAR;
      LDA(At,0,1); WAIT_V(4); BAR; WAIT_L(0); MMA(1,0,At,B0); MMA(1,1,At,B1); BAR; }
    { LDB(B0,1,0); LDA(At,1,0); WAIT_V(2); BAR; WAIT_L(0); MMA(0,0,At,B0); BAR;
      LDB(B1,1,1); WAIT_V(0); BAR; WAIT_L(0); MMA(0,1,At,B1); BAR;
      LDA(At,1,1); BAR; WAIT_L(0); MMA(1,0,At,B0); MMA(1,1,At,B1); BAR; }
    if(wr==0)BAR;
    {
        float* stg = (float*)shm;
#pragma unroll
        for (int ai = 0; ai < 2; ++ai) {
            typename Epi::Pre pre[8];
#pragma unroll
            for (int it = 0; it < 8; ++it) pre[it] = epi.pre(brow + ai * HALF + it * 16 + wid * 2 + (lane >> 5), bcol + (lane & 31) * 8);
            __syncthreads();
#pragma unroll
            for (int bj = 0; bj < 2; ++bj)
#pragma unroll
                for (int m = 0; m < 4; ++m)
#pragma unroll
                    for (int n = 0; n < 2; ++n)
#pragma unroll
                        for (int j = 0; j < 4; ++j) stg[(wr * 64 + m * 16 + fq * 4 + j) * EPI_LDW + bj * HALF + wc * 32 + n * 16 + fr] = acc[ai][bj][m][n][j];
            __syncthreads();
#pragma unroll
            for (int it = 0; it < 8; ++it) {
                const int r = it * 16 + wid * 2 + (lane >> 5), c = (lane & 31) * 8;
                const float4 v0 = *reinterpret_cast<const float4*>(&stg[r * EPI_LDW + c]);
                const float4 v1 = *reinterpret_cast<const float4*>(&stg[r * EPI_LDW + c + 4]);
                const float v[8] = {v0.x, v0.y, v0.z, v0.w, v1.x, v1.y, v1.z, v1.w};
                epi.vec8(brow + ai * HALF + r, bcol + c, v, pre[it]);
            }
        }
    }
    __syncthreads();
#undef SA
#undef SB
#undef STAGE_X
#undef STAGE
#undef LDA
#undef LDB
#undef MMA
}

__device__ __forceinline__ void tile_rc(int wgid, const int nM, const int nN, int& brow, int& bcol) {
    const int nwg = nM * nN;
    { int q = nwg / 8, r = nwg % 8, xcd = wgid % 8, off = wgid / 8; wgid = (xcd < r ? xcd * (q + 1) : r * (q + 1) + (xcd - r) * q) + off; }
    const int nig = 8 * nN, gid = wgid / nig, fm = gid * 8, gsz = min(nM - fm, 8);
    const int pm = fm + ((wgid % nig) % gsz), pn = (wgid % nig) / gsz;
    brow = pm * BM; bcol = pn * BM;
}

__device__ __forceinline__ uint4 pack8(const float* v) { uint4 o; o.x = pack2(v[0], v[1]); o.y = pack2(v[2], v[3]); o.z = pack2(v[4], v[5]); o.w = pack2(v[6], v[7]); return o; }
__device__ __forceinline__ void unpack8(const uint4 u, float* v) { v[0] = bflo(u.x); v[1] = bfhi(u.x); v[2] = bflo(u.y); v[3] = bfhi(u.y); v[4] = bflo(u.z); v[5] = bfhi(u.z); v[6] = bflo(u.w); v[7] = bfhi(u.w); }
struct EpiP {
    bfr* P;
    struct Pre {};
    __device__ __forceinline__ Pre pre(int, int) const { return Pre{}; }
    __device__ __forceinline__ void vec8(int row, int col, const float* v, const Pre&) { *reinterpret_cast<uint4*>(&P[(size_t)row * NINP + col]) = pack8(v); }
};
struct EpiMix {
    bfr* outp; const bfr* addp; const bfr* gate;
    struct Pre { uint4 g, t; };
    __device__ __forceinline__ Pre pre(int row, int col) const {
        Pre p; p.g = *reinterpret_cast<const uint4*>(&gate[(size_t)row * NINP + col]);
        p.t = addp ? *reinterpret_cast<const uint4*>(&addp[(size_t)row * D + col]) : make_uint4(0u, 0u, 0u, 0u);
        return p;
    }
    __device__ __forceinline__ void vec8(int row, int col, const float* v, const Pre& p) {
        float g[8], r[8];
        unpack8(p.g, g);
#pragma unroll
        for (int i = 0; i < 8; ++i) r[i] = sigmoidf_(g[i]) * v[i];
        if (addp) { float t[8]; unpack8(p.t, t);
#pragma unroll
            for (int i = 0; i < 8; ++i) r[i] += t[i]; }
        *reinterpret_cast<uint4*>(&outp[(size_t)row * D + col]) = pack8(r);
    }
};
struct EpiH {
    bfr* hb; const float* x; float* part; int slot;
    struct Pre { float4 x0, x1; };
    __device__ __forceinline__ Pre pre(int row, int col) const {
        Pre p; p.x0 = *reinterpret_cast<const float4*>(&x[(size_t)row * D + col]); p.x1 = *reinterpret_cast<const float4*>(&x[(size_t)row * D + col + 4]); return p;
    }
    __device__ __forceinline__ void vec8(int row, int col, const float* v, const Pre& p) {
        const float4 x0 = p.x0, x1 = p.x1;
        float h[8] = {x0.x + v[0], x0.y + v[1], x0.z + v[2], x0.w + v[3], x1.x + v[4], x1.y + v[5], x1.z + v[6], x1.w + v[7]};
        *reinterpret_cast<uint4*>(&hb[(size_t)row * D + col]) = pack8(h);
        float s = 0.f;
#pragma unroll
        for (int i = 0; i < 8; ++i) s += h[i] * h[i];
        s += dpp_f<DPP_XOR1>(s); s += dpp_f<DPP_XOR2>(s); s += dpp_f<0x141>(s); s += dpp_f<0x140>(s);
        s = sumx16(s);
        if ((threadIdx.x & 31) == 0) part[(size_t)row * 8 + slot] = s;
    }
};
struct EpiQ {
    bfr* qp; const float* part;
    struct Pre { float4 p0, p1; };
    __device__ __forceinline__ Pre pre(int row, int) const {
        Pre p; p.p0 = *reinterpret_cast<const float4*>(&part[(size_t)row * 8]); p.p1 = *reinterpret_cast<const float4*>(&part[(size_t)row * 8 + 4]); return p;
    }
    __device__ __forceinline__ void vec8(int row, int col, const float* v, const Pre& p) {
        const float ssum = ((((((p.p0.x + p.p0.y) + p.p0.z) + p.p0.w) + p.p1.x) + p.p1.y) + p.p1.z) + p.p1.w;
        const float sc = rsqrtf(ssum * (1.f / D) + EPS); float r[8];
#pragma unroll
        for (int i = 0; i < 8; ++i) r[i] = v[i] * sc;
        *reinterpret_cast<uint4*>(&qp[(size_t)row * D + col]) = pack8(r);
    }
};
__device__ __forceinline__ float row_rstd(const float* part, int row) {
    float s = 0.f;
#pragma unroll
    for (int i = 0; i < 8; ++i) s += part[(size_t)row * 8 + i];
    return rsqrtf(s * (1.f / D) + EPS);
}

__device__ __forceinline__ void tr_tile(const float* __restrict__ src, bfr* __restrict__ dst, int K, int N, int k0, int n0, const float* kscale, float* lds) {
    const int tid = my_tid(), n = tid & 63, kk = tid >> 6;
#pragma unroll
    for (int j = 0; j < 8; ++j) { int k = kk + 8 * j, gn = n0 + n; float v = (gn < N) ? src[(size_t)(k0 + k) * N + gn] : 0.f; if (kscale) v *= kscale[k0 + k]; lds[k * 65 + n] = v; }
    __syncthreads();
    const int nn = tid >> 3, ks = tid & 7;
    uint4 o;
    o.x = pack2(lds[(ks * 8 + 0) * 65 + nn], lds[(ks * 8 + 1) * 65 + nn]); o.y = pack2(lds[(ks * 8 + 2) * 65 + nn], lds[(ks * 8 + 3) * 65 + nn]);
    o.z = pack2(lds[(ks * 8 + 4) * 65 + nn], lds[(ks * 8 + 5) * 65 + nn]); o.w = pack2(lds[(ks * 8 + 6) * 65 + nn], lds[(ks * 8 + 7) * 65 + nn]);
    *reinterpret_cast<uint4*>(&dst[(size_t)(n0 + nn) * K + k0 + ks * 8]) = o;
    __syncthreads();
}
struct StripRegs { float v[8][4]; };
__device__ __forceinline__ void strip_load(const float* __restrict__ src, int N, int k0, int n0, StripRegs& R) {
    const int tid = my_tid(), n = tid & 63, kk = tid >> 6;
#pragma unroll
    for (int j = 0; j < 8; ++j)
#pragma unroll
        for (int q = 0; q < 4; ++q) { const int gn = n0 + q * 64 + n; R.v[j][q] = (gn < N) ? src[(size_t)(k0 + kk + 8 * j) * N + gn] : 0.f; }
}
__device__ __forceinline__ void strip_store(const StripRegs& R, bfr* __restrict__ dst, int K, int k0, int n0, const float* kscale, float* lds) {
    const int tid = my_tid(), n = tid & 63, kk = tid >> 6;
#pragma unroll
    for (int j = 0; j < 8; ++j) {
        const float sc = kscale ? kscale[k0 + kk + 8 * j] : 1.f;
#pragma unroll
        for (int q = 0; q < 4; ++q) lds[(kk + 8 * j) * 257 + q * 64 + n] = R.v[j][q] * sc;
    }
    __syncthreads();
    const int nn = tid >> 1, hf = tid & 1;
#pragma unroll
    for (int c = 0; c < 4; ++c) {
        const int kb = hf * 32 + c * 8;
        uint4 o;
        o.x = pack2(lds[(kb + 0) * 257 + nn], lds[(kb + 1) * 257 + nn]); o.y = pack2(lds[(kb + 2) * 257 + nn], lds[(kb + 3) * 257 + nn]);
        o.z = pack2(lds[(kb + 4) * 257 + nn], lds[(kb + 5) * 257 + nn]); o.w = pack2(lds[(kb + 6) * 257 + nn], lds[(kb + 7) * 257 + nn]);
        *reinterpret_cast<uint4*>(&dst[(size_t)(n0 + nn) * K + k0 + kb]) = o;
    }
    __syncthreads();
}
__device__ __forceinline__ void tr_all(const float* src, bfr* dst, int K, int N, int Npad, const float* kscale, float* lds) {
    if ((Npad & 255) == 0) {
        const int nk = K / 64, ns = Npad / 256, tot = nk * ns;
        StripRegs RA, RB;
        int it = blockIdx.x;
        if (it < tot) strip_load(src, N, (it % nk) * 64, (it / nk) * 256, RA);
        while (it < tot) {
            const int itn = it + gridDim.x, it2 = itn + gridDim.x;
            if (itn < tot) strip_load(src, N, (itn % nk) * 64, (itn / nk) * 256, RB);
            strip_store(RA, dst, K, (it % nk) * 64, (it / nk) * 256, kscale, lds);
            if (itn >= tot) break;
            if (it2 < tot) strip_load(src, N, (it2 % nk) * 64, (it2 / nk) * 256, RA);
            strip_store(RB, dst, K, (itn % nk) * 64, (itn / nk) * 256, kscale, lds);
            it = it2;
        }
        return;
    }
    const int nk = K / 64, nn = Npad / 64;
    for (int it = blockIdx.x; it < nk * nn; it += gridDim.x) tr_tile(src, dst, K, N, (it % nk) * 64, (it / nk) * 64, kscale, lds);
}
__device__ __forceinline__ void cvt_all(const float* __restrict__ src, bfr* __restrict__ dst, size_t n) {
    const size_t n4 = n / 4;
    for (size_t i = (size_t)blockIdx.x * 512 + my_tid(); i < n4; i += (size_t)gridDim.x * 512) {
        float4 v = reinterpret_cast<const float4*>(src)[i];
        uint2 o; o.x = pack2(v.x, v.y); o.y = pack2(v.z, v.w);
        reinterpret_cast<uint2*>(dst)[i] = o;
    }
}

constexpr int PEER_ROWB = 1152;
__device__ __forceinline__ void fp4_row_store(const f32x4* x, unsigned char* __restrict__ dst, const int row, const int lane) {
    float amax = 0.f;
#pragma unroll
    for (int q = 0; q < 8; ++q) amax = fmaxf(amax, fmaxf(fmaxf(fabsf(x[q][0]), fabsf(x[q][1])), fmaxf(fabsf(x[q][2]), fabsf(x[q][3]))));
    const bfr sb = f2bf(amax * (1.f / 6.f));
    const float sc = bf2f(sb), inv = sc > 0.f ? frcp_(sc) : 0.f;
    unsigned dw[4];
#pragma unroll
    for (int d = 0; d < 4; ++d) {
        unsigned p = 0;
        p = __builtin_amdgcn_cvt_scalef32_pk_fp4_f32(p, x[2 * d][0] * inv, x[2 * d][1] * inv, 1.0f, 0);
        p = __builtin_amdgcn_cvt_scalef32_pk_fp4_f32(p, x[2 * d][2] * inv, x[2 * d][3] * inv, 1.0f, 1);
        p = __builtin_amdgcn_cvt_scalef32_pk_fp4_f32(p, x[2 * d + 1][0] * inv, x[2 * d + 1][1] * inv, 1.0f, 2);
        p = __builtin_amdgcn_cvt_scalef32_pk_fp4_f32(p, x[2 * d + 1][2] * inv, x[2 * d + 1][3] * inv, 1.0f, 3);
        dw[d] = p;
    }
    uint4 o4; o4.x = dw[0]; o4.y = dw[1]; o4.z = dw[2]; o4.w = dw[3];
    *reinterpret_cast<uint4*>(dst + (size_t)row * PEER_ROWB + lane * 16) = o4;
    *reinterpret_cast<bfr*>(dst + (size_t)row * PEER_ROWB + 1024 + lane * 2) = sb;
}
__device__ __forceinline__ void cvt_fp4_rows(const float* __restrict__ src, unsigned char* __restrict__ dst, const int wrank, const int nwaves, const int row0, const int row1) {
    const int tid = my_tid(), lane = tid & 63;
    for (int base = row0 + wrank; base < row1; base += 4 * nwaves) {
        f32x4 x[4][8];
#pragma unroll
        for (int b = 0; b < 4; ++b) { const int row = base + b * nwaves;
            if (row < row1) {
#pragma unroll
                for (int q = 0; q < 8; ++q) x[b][q] = __builtin_nontemporal_load(reinterpret_cast<const f32x4*>(&src[(size_t)row * D + q * 256 + lane * 4]));
            } }
#pragma unroll
        for (int b = 0; b < 4; ++b) { const int row = base + b * nwaves; if (row < row1) fp4_row_store(x[b], dst, row, lane); }
    }
}

__device__ __forceinline__ unsigned pack8_i4(const float* v) {
    unsigned d = 0;
#pragma unroll
    for (int i = 0; i < 8; ++i) d |= ((unsigned)((int)v[i]) & 0xFu) << (4 * i);
    return d;
}
__device__ __forceinline__ void i4_row_store(const f32x4* x, unsigned char* __restrict__ dst, const int row, const int lane) {
    float v[32]; float amax = 0.f;
#pragma unroll
    for (int q = 0; q < 8; ++q) {
        v[q * 4] = x[q][0]; v[q * 4 + 1] = x[q][1]; v[q * 4 + 2] = x[q][2]; v[q * 4 + 3] = x[q][3];
        amax = fmaxf(amax, fmaxf(fmaxf(fabsf(x[q][0]), fabsf(x[q][1])), fmaxf(fabsf(x[q][2]), fabsf(x[q][3]))));
    }
    const bfr sb = f2bf(amax * (1.f / 7.f));
    const float sc = bf2f(sb), inv = sc > 0.f ? frcp_(sc) : 0.f;
#pragma unroll
    for (int i = 0; i < 32; ++i) v[i] = fminf(fmaxf(__builtin_rintf(v[i] * inv), -7.f), 7.f);
    uint4 o4; o4.x = pack8_i4(v); o4.y = pack8_i4(v + 8); o4.z = pack8_i4(v + 16); o4.w = pack8_i4(v + 24);
    *reinterpret_cast<uint4*>(dst + (size_t)row * PEER_ROWB + lane * 16) = o4;
    *reinterpret_cast<bfr*>(dst + (size_t)row * PEER_ROWB + 1024 + lane * 2) = sb;
}
__device__ __forceinline__ void cvt_i4_rows(const float* __restrict__ src, unsigned char* __restrict__ dst, const int wrank, const int nwaves, const int row0, const int row1) {
    const int tid = my_tid(), lane = tid & 63;
    for (int base = row0 + wrank; base < row1; base += 4 * nwaves) {
        f32x4 x[4][8];
#pragma unroll
        for (int b = 0; b < 4; ++b) { const int row = base + b * nwaves;
            if (row < row1) {
#pragma unroll
                for (int q = 0; q < 8; ++q) x[b][q] = __builtin_nontemporal_load(reinterpret_cast<const f32x4*>(&src[(size_t)row * D + q * 256 + lane * 4]));
            } }
#pragma unroll
        for (int b = 0; b < 4; ++b) { const int row = base + b * nwaves; if (row < row1) i4_row_store(x[b], dst, row, lane); }
    }
}
__device__ __forceinline__ int pm_index(int kp, int k) {
    const int kpt = kp >> 5, r = kp & 31, kt = k >> 5, kk = k & 31, s = kk >> 4, rem = kk & 15;
    const int j = ((rem >> 3) << 2) | (rem & 3), hf = (rem >> 2) & 1, lane = hf * 32 + r;
    return ((((kpt * 2 + kt) * 2 + s) * 64 + lane) * 8) + j;
}
__device__ __forceinline__ int acc_index(int row, int col) {
    const int rt = row >> 5, r = row & 31, ct = col >> 5, c = col & 31;
    const int g4 = r >> 3, comp = r & 3, hf = (r >> 2) & 1, lane = hf * 32 + c;
    return ((((rt * 2 + ct) * 4 + g4) * 64 + lane) * 4) + comp;
}

constexpr int RW_ACT_STRIDE = 296, RW_LD = 72, RW_SLOT = 9216, RW_WL_OFF = 110592, RW_TOT_OFF = 148480, RW_BASE_OFF = 152576, RW_PART_OFF = 156928, RW_CONST_OFF = 157952;
__device__ __forceinline__ f32x16 tile_mm_acc(f32x16 acc, const bfr* A, const int arow0, const bfr* Bt, const int brow0, const int r, const int hf) {
#pragma unroll
    for (int ks = 0; ks < 4; ++ks)
        acc = __builtin_amdgcn_mfma_f32_32x32x16_bf16(*reinterpret_cast<const bf16x8*>(&A[(arow0 + r) * RW_LD + ks * 16 + hf * 8]),
                                                     *reinterpret_cast<const bf16x8*>(&Bt[(brow0 + r) * RW_LD + ks * 16 + hf * 8]), acc, 0, 0, 0);
    return acc;
}
__device__ __forceinline__ f32x16 tile_mm(const bfr* A, const int arow0, const bfr* Bt, const int brow0, const int r, const int hf) {
    f32x16 z;
#pragma unroll
    for (int g = 0; g < 16; ++g) z[g] = 0.f;
    return tile_mm_acc(z, A, arow0, Bt, brow0, r, hf);
}
__device__ __forceinline__ void store_t(bfr* dst, const int col0, const int row0, const f32x16 acc, const int r, const int hf) {
#pragma unroll
    for (int g4 = 0; g4 < 4; ++g4) { uint2 p; p.x = pack2(acc[g4 * 4], acc[g4 * 4 + 1]); p.y = pack2(acc[g4 * 4 + 2], acc[g4 * 4 + 3]);
        *reinterpret_cast<uint2*>(&dst[(col0 + r) * RW_LD + row0 + g4 * 8 + hf * 4]) = p; }
}
#define DPP_HMIRROR 0x141
#define DPP_MIRROR  0x140

__device__ __forceinline__ void rwkv_load_weights(const Args& a, const int h, unsigned char* lds) {
    bfr* WL = (bfr*)(lds + RW_WL_OFF);
    const int tid = my_tid();
    for (int idx = tid; idx < 288 * 64; idx += 512) {
        const int m = idx >> 6, d = idx & 63;
        const float v = (m < 64) ? a.in[I_WDEC][(size_t)m * RW + h * 64 + d] : (m < 128) ? a.in[I_WICL][(size_t)(m - 64) * RW + h * 64 + d] : a.in[I_WGATE][(size_t)(m - 128) * RW + h * 64 + d];
        WL[d * RW_ACT_STRIDE + m] = f2bf(v);
    }
    float* CONST = (float*)(lds + RW_CONST_OFF);
    for (int idx = tid; idx < 288; idx += 512) CONST[idx] = a.in[I_SHIFT][C_ZW + idx];
    {
        const int k = tid >> 6, d = tid & 63, hd = h * 64 + d;
        const float v = (k == 0) ? a.in[I_SHIFT][C_R + hd] : (k == 1) ? a.in[I_SHIFT][C_K + hd] : (k == 2) ? a.in[I_SHIFT][C_V + hd] : (k == 3) ? a.in[I_W0][hd]
                      : (k == 4) ? a.in[I_A0][hd] : (k == 5) ? a.in[I_KK][hd] : (k == 6) ? a.in[I_KA][hd] : a.in[I_RK][hd];
        CONST[288 + k * 64 + d] = v;
    }
    __syncthreads();
}

struct RwIn { unsigned zc[20], zp[20]; unsigned rkv[15]; };
__device__ __forceinline__ void rwkv_fetch(const Args& a, const int c, const int h, RwIn& in) {
    const bfr* __restrict__ P = (const bfr*)(a.ws + WS_P);
    const int tid = my_tid(), lane = tid & 63, wv = tid >> 6, fr = lane & 15, fq = lane >> 4, t0 = c * 64;
    {
#pragma unroll
        for (int k = 0; k < 5; ++k) {
            const int g = min(tid + k * 512, 64 * 36 - 1);
            const int i = g / 36, cc = (g - i * 36) * 8, t = t0 + i;
            const bfr* pc = P + (size_t)t * NINP + C_ZW + cc;
            const uint4 vc = *reinterpret_cast<const uint4*>(pc);
            uint4 vp = *reinterpret_cast<const uint4*>(t > 0 ? pc - NINP : pc);
            if (t == 0) vp = make_uint4(0u, 0u, 0u, 0u);
            in.zc[k * 4] = vc.x; in.zc[k * 4 + 1] = vc.y; in.zc[k * 4 + 2] = vc.z; in.zc[k * 4 + 3] = vc.w;
            in.zp[k * 4] = vp.x; in.zp[k * 4 + 1] = vp.y; in.zp[k * 4 + 2] = vp.z; in.zp[k * 4 + 3] = vp.w;
        }
    }
}
__device__ __forceinline__ void rwkv_fetch_rkv(const Args& a, const int c, const int h, RwIn& in) {
    const bfr* __restrict__ P = (const bfr*)(a.ws + WS_P);
    const int tid = my_tid(), lane = tid & 63, wv = tid >> 6, fr = lane & 15, fq = lane >> 4, t0 = c * 64;
    const int tt = wv >> 1, dh = wv & 1;
    {
        const int hd = h * 64 + dh * 32 + fr * 2;
        const int tp = t0 + tt * 16 + fq * 4 - 1;
        const bool hp = tp >= 0;
        const size_t rp = (size_t)(hp ? tp : 0) * NINP;
        in.rkv[0] = hp ? *reinterpret_cast<const unsigned*>(&P[rp + C_R + hd]) : 0u; in.rkv[5] = hp ? *reinterpret_cast<const unsigned*>(&P[rp + C_K + hd]) : 0u;
        in.rkv[10] = hp ? *reinterpret_cast<const unsigned*>(&P[rp + C_V + hd]) : 0u;
#pragma unroll
        for (int j = 0; j < 4; ++j) { const size_t ro = (size_t)(tp + 1 + j) * NINP;
            in.rkv[j + 1] = *reinterpret_cast<const unsigned*>(&P[ro + C_R + hd]); in.rkv[5 + j + 1] = *reinterpret_cast<const unsigned*>(&P[ro + C_K + hd]);
            in.rkv[10 + j + 1] = *reinterpret_cast<const unsigned*>(&P[ro + C_V + hd]); }
    }
}

__device__ __forceinline__ void rwkv_unit(const Args& a, const int c, const int h, unsigned char* lds, const RwIn& in, RwIn& nxt, const int cnext) {
    const float* __restrict__ smix = a.in[I_SHIFT];
    const int tid = my_tid(), lane = tid & 63, wv = tid >> 6, fr = lane & 15, fq = lane >> 4, t0 = c * 64, u = c * 16 + h;
#define SLOT(k) ((bfr*)(lds + (k) * RW_SLOT))
    bfr* ACT = (bfr*)lds; const bfr* WL = (const bfr*)(lds + RW_WL_OFF);
    float* TOT = (float*)(lds + RW_TOT_OFF); float* BASE = (float*)(lds + RW_BASE_OFF); float* PART = (float*)(lds + RW_PART_OFF);
    const float* CONST = (const float*)(lds + RW_CONST_OFF);
    {
#pragma unroll
        for (int k = 0; k < 5; ++k) {
            const int g = min(tid + k * 512, 64 * 36 - 1);
            const int i = g / 36, cc = (g - i * 36) * 8;
            float cur[8], prv[8], z[8];
            unpack8(make_uint4(in.zc[k * 4], in.zc[k * 4 + 1], in.zc[k * 4 + 2], in.zc[k * 4 + 3]), cur); unpack8(make_uint4(in.zp[k * 4], in.zp[k * 4 + 1], in.zp[k * 4 + 2], in.zp[k * 4 + 3]), prv);
            const float4 m0 = *reinterpret_cast<const float4*>(&CONST[cc]), m1 = *reinterpret_cast<const float4*>(&CONST[cc + 4]);
            const float mx[8] = {m0.x, m0.y, m0.z, m0.w, m1.x, m1.y, m1.z, m1.w};
            const bool is_t = cc < 64, is_s = cc >= 128;
            const float sc = is_t ? 2.f : -1.f;
#pragma unroll
            for (int e = 0; e < 8; ++e) {
                const float zz = cur[e] + (prv[e] - cur[e]) * mx[e];
                const float rr = frcp_(1.f + __expf(sc * zz));
                z[e] = is_t ? (1.f - 2.f * rr) : (is_s ? rr : zz);
            }
            *reinterpret_cast<uint4*>(&ACT[i * RW_ACT_STRIDE + cc]) = pack8(z);
        }
    }
    const int tt = wv >> 1, dh = wv & 1;
    float zr[2][4], zk[2][4], zv[2][4];
#pragma unroll
    for (int dt = 0; dt < 2; ++dt) {
        const int d64 = dh * 32 + fr * 2 + dt;
        const float mr = CONST[288 + d64], mk = CONST[288 + 64 + d64], mv = CONST[288 + 128 + d64];
#define RKV(n) (dt ? bfhi(in.rkv[n]) : bflo(in.rkv[n]))
        float pr = RKV(0), pk = RKV(5), pv = RKV(10);
#pragma unroll
        for (int j = 0; j < 4; ++j) {
            const float cr = RKV(j + 1), ck = RKV(5 + j + 1), cv = RKV(10 + j + 1);
            zr[dt][j] = cr + (pr - cr) * mr; zk[dt][j] = ck + (pk - ck) * mk; zv[dt][j] = cv + (pv - cv) * mv;
            pr = cr; pk = ck; pv = cv;
        }
    }
    __syncthreads();
    f32x4 xw[2], xa[2], xg[2];
#pragma unroll
    for (int dt = 0; dt < 2; ++dt) {
        xw[dt] = f32x4{0.f, 0.f, 0.f, 0.f}; xa[dt] = xw[dt]; xg[dt] = xw[dt];
        const bfr* arow = ACT + (tt * 16 + fr) * RW_ACT_STRIDE + fq * 8;
        const bfr* brow = WL + (dh * 32 + fr * 2 + dt) * RW_ACT_STRIDE + fq * 8;
#pragma unroll
        for (int ks = 0; ks < 2; ++ks) {
            xw[dt] = __builtin_amdgcn_mfma_f32_16x16x32_bf16(*reinterpret_cast<const bf16x8*>(arow + ks * 32), *reinterpret_cast<const bf16x8*>(brow + ks * 32), xw[dt], 0, 0, 0);
            xa[dt] = __builtin_amdgcn_mfma_f32_16x16x32_bf16(*reinterpret_cast<const bf16x8*>(arow + 64 + ks * 32), *reinterpret_cast<const bf16x8*>(brow + 64 + ks * 32), xa[dt], 0, 0, 0);
        }
#pragma unroll
        for (int ks = 0; ks < 5; ++ks)
            xg[dt] = __builtin_amdgcn_mfma_f32_16x16x32_bf16(*reinterpret_cast<const bf16x8*>(arow + 128 + ks * 32), *reinterpret_cast<const bf16x8*>(brow + 128 + ks * 32), xg[dt], 0, 0, 0);
    }
    float lw[2][4], av[2][4], kkr[2][4], k4[2][4], n2[4], cf[4];
#pragma unroll
    for (int j = 0; j < 4; ++j) { n2[j] = 0.f; cf[j] = 0.f; }
#pragma unroll
    for (int dt = 0; dt < 2; ++dt) {
        const int d64 = dh * 32 + fr * 2 + dt;
        const float w0 = CONST[288 + 192 + d64], a0 = CONST[288 + 256 + d64], kkm = CONST[288 + 320 + d64], kam = CONST[288 + 384 + d64], rkm = CONST[288 + 448 + d64];
        float run = 0.f;
#pragma unroll
        for (int j = 0; j < 4; ++j) {
            run += -0.6065306597126334f * sigmoidf_(w0 + xw[dt][j]);
            lw[dt][j] = run;
            av[dt][j] = sigmoidf_(a0 + xa[dt][j]);
            kkr[dt][j] = zk[dt][j] * kkm;
            k4[dt][j] = zk[dt][j] * (1.f + (av[dt][j] - 1.f) * kam);
            n2[j] += kkr[dt][j] * kkr[dt][j];
            cf[j] += zr[dt][j] * k4[dt][j] * rkm;
        }
        TOT[(tt * 4 + fq) * 64 + dh * 32 + fr * 2 + dt] = run;
    }
#pragma unroll
    for (int j = 0; j < 4; ++j) {
        n2[j] += dpp_f<DPP_XOR1>(n2[j]); n2[j] += dpp_f<DPP_XOR2>(n2[j]); n2[j] += dpp_f<DPP_HMIRROR>(n2[j]); n2[j] += dpp_f<DPP_MIRROR>(n2[j]);
        cf[j] += dpp_f<DPP_XOR1>(cf[j]); cf[j] += dpp_f<DPP_XOR2>(cf[j]); cf[j] += dpp_f<DPP_HMIRROR>(cf[j]); cf[j] += dpp_f<DPP_MIRROR>(cf[j]);
        if (fr == 0) { PART[(wv * 16 + fq * 4 + j) * 2] = n2[j]; PART[(wv * 16 + fq * 4 + j) * 2 + 1] = cf[j]; }
    }
    __syncthreads();
    if (tid < 64) {
        float run = 0.f;
#pragma unroll
        for (int g = 0; g < 16; ++g) { const float tv = TOT[g * 64 + tid]; BASE[g * 64 + tid] = run; run += tv; }
        BASE[16 * 64 + tid] = run;
    }
    __syncthreads();
    {
        bfr* Gg = (bfr*)(a.ws + WS_GG); bfr* Bon = (bfr*)(a.ws + WS_BON);
        const int i0 = tt * 16 + fq * 4;
        float rn[4], cft[4];
#pragma unroll
        for (int j = 0; j < 4; ++j) {
            const float n2t = n2[j] + PART[((wv ^ 1) * 16 + fq * 4 + j) * 2]; cft[j] = cf[j] + PART[((wv ^ 1) * 16 + fq * 4 + j) * 2 + 1];
            rn[j] = __builtin_amdgcn_rsqf(fmaxf(n2t, 1e-24f));
        }
#pragma unroll
        for (int j = 0; j < 4; ++j) {
            const size_t o = (size_t)(t0 + i0 + j) * RW + h * 64 + dh * 32 + fr * 2;
            *reinterpret_cast<unsigned*>(&Gg[o]) = pack2(xg[0][j], xg[1][j]);
            *reinterpret_cast<unsigned*>(&Bon[o]) = pack2(cft[j] * zv[0][j], cft[j] * zv[1][j]);
        }
#pragma unroll
        for (int dt = 0; dt < 2; ++dt) {
            const int d = dh * 32 + fr * 2 + dt;
            const float base = BASE[(tt * 4 + fq) * 64 + d], clT = BASE[16 * 64 + d];
            float vAt[4], vBh[4], vKh[4];
#pragma unroll
            for (int j = 0; j < 4; ++j) {
                const float cl = base + lw[dt][j], clm1 = (j == 0) ? base : base + lw[dt][j - 1];
                const float gi = __expf(cl), gm1 = __expf(clm1), ig = __expf(-cl), gce = __expf(clT - cl);
                const float kk = kkr[dt][j] * rn[j], beta = kk * av[dt][j];
                vAt[j] = -kk * gm1; vBh[j] = beta * gce; vKh[j] = k4[dt][j] * gce;
                SLOT(0)[(i0 + j) * RW_LD + d] = f2bf(vAt[j]);
                SLOT(1)[(i0 + j) * RW_LD + d] = f2bf(beta * ig);
                SLOT(2)[(i0 + j) * RW_LD + d] = f2bf(k4[dt][j] * ig);
                SLOT(3)[(i0 + j) * RW_LD + d] = f2bf(zr[dt][j] * gi);
            }
            uint2 p;
            p.x = pack2(vAt[0], vAt[1]); p.y = pack2(vAt[2], vAt[3]); *reinterpret_cast<uint2*>(&SLOT(4)[d * RW_LD + i0]) = p;
            p.x = pack2(vBh[0], vBh[1]); p.y = pack2(vBh[2], vBh[3]); *reinterpret_cast<uint2*>(&SLOT(5)[d * RW_LD + i0]) = p;
            p.x = pack2(vKh[0], vKh[1]); p.y = pack2(vKh[2], vKh[3]); *reinterpret_cast<uint2*>(&SLOT(6)[d * RW_LD + i0]) = p;
            p.x = pack2(zv[dt][0], zv[dt][1]); p.y = pack2(zv[dt][2], zv[dt][3]); *reinterpret_cast<uint2*>(&SLOT(7)[d * RW_LD + i0]) = p;
        }
    }
    __syncthreads();
    if (cnext >= 0) { rwkv_fetch(a, cnext, h, nxt); rwkv_fetch_rkv(a, cnext, h, nxt); }
    const int r = lane & 31, hf = lane >> 5;
    {
        const int prod = wv >> 1, sub = wv & 1;
        const bfr* Aop = (prod & 1) ? SLOT(2) : SLOT(1);
        const bfr* Bop = (prod >= 2) ? SLOT(3) : SLOT(0);
        bfr* Ld = SLOT(8 + prod);
        const bool incl = prod >= 2;
        for (int job = 0; job < (sub ? 2 : 1); ++job) {
            const int jt = sub ? job : 0, it = sub ? 1 : 0;
            f32x16 acc = tile_mm(Aop, jt * 32, Bop, it * 32, r, hf);
#pragma unroll
            for (int g4 = 0; g4 < 4; ++g4) {
                const int i = it * 32 + r, j0 = jt * 32 + g4 * 8 + hf * 4;
                float v[4];
#pragma unroll
                for (int q = 0; q < 4; ++q) { const int j = j0 + q; v[q] = (incl ? (j <= i) : (j < i)) ? acc[g4 * 4 + q] : 0.f; }
                uint2 p; p.x = pack2(v[0], v[1]); p.y = pack2(v[2], v[3]);
                *reinterpret_cast<uint2*>(&Ld[i * RW_LD + j0]) = p;
            }
        }
        if (!sub) {
#pragma unroll
            for (int g4 = 0; g4 < 4; ++g4) *reinterpret_cast<uint2*>(&Ld[r * RW_LD + 32 + g4 * 8 + hf * 4]) = make_uint2(0u, 0u);
        }
    }
    __syncthreads();
    if (wv == 0) {
        bfr* Tl = SLOT(0); bfr* TlT = SLOT(1); const bfr* Lab = SLOT(8);
        for (int q = 0; q < 9; ++q) { *reinterpret_cast<uint4*>((unsigned char*)Tl + (q * 64 + lane) * 16) = make_uint4(0u, 0u, 0u, 0u); *reinterpret_cast<uint4*>((unsigned char*)TlT + (q * 64 + lane) * 16) = make_uint4(0u, 0u, 0u, 0u); }
        {
            const int bq = lane >> 4, cc = lane & 15;
            float x[16];
#pragma unroll
            for (int rr = 0; rr < 16; ++rr) {
                float lrow[16];
                unpack8(*reinterpret_cast<const uint4*>(&Lab[(bq * 16 + rr) * RW_LD + bq * 16]), lrow);
                unpack8(*reinterpret_cast<const uint4*>(&Lab[(bq * 16 + rr) * RW_LD + bq * 16 + 8]), lrow + 8);
                float sacc = (rr == cc) ? 1.f : 0.f;
#pragma unroll
                for (int m = 0; m < rr; ++m) sacc += lrow[m] * x[m];
                x[rr] = sacc;
            }
#pragma unroll
            for (int rr = 0; rr < 16; ++rr) Tl[(bq * 16 + rr) * RW_LD + bq * 16 + cc] = f2bf(x[rr]);
            *reinterpret_cast<uint4*>(&TlT[(bq * 16 + cc) * RW_LD + bq * 16]) = pack8(x);
            *reinterpret_cast<uint4*>(&TlT[(bq * 16 + cc) * RW_LD + bq * 16 + 8]) = pack8(x + 8);
        }
        asm volatile("s_waitcnt lgkmcnt(0)" ::: "memory");
#pragma unroll
        for (int bi = 1; bi < 4; ++bi) {
#pragma unroll
            for (int bj = 0; bj < bi; ++bj) {
                f32x4 acc = {0.f, 0.f, 0.f, 0.f};
#pragma unroll
                for (int bm = bj; bm < bi; ++bm) {
                    const bf16x4 Af = *reinterpret_cast<const bf16x4*>(&Lab[(bi * 16 + fr) * RW_LD + bm * 16 + fq * 4]);
                    const bf16x4 Bf = *reinterpret_cast<const bf16x4*>(&TlT[(bj * 16 + fr) * RW_LD + bm * 16 + fq * 4]);
                    acc = __builtin_amdgcn_mfma_f32_16x16x16bf16_1k(Af, Bf, acc, 0, 0, 0);
                }
                bf16x4 Bacc; Bacc[0] = (short)f2bf(acc[0]); Bacc[1] = (short)f2bf(acc[1]); Bacc[2] = (short)f2bf(acc[2]); Bacc[3] = (short)f2bf(acc[3]);
                const bf16x4 Ad = *reinterpret_cast<const bf16x4*>(&Tl[(bi * 16 + fr) * RW_LD + bi * 16 + fq * 4]);
                const f32x4 tb = __builtin_amdgcn_mfma_f32_16x16x16bf16_1k(Ad, Bacc, f32x4{0.f, 0.f, 0.f, 0.f}, 0, 0, 0);
#pragma unroll
                for (int q = 0; q < 4; ++q) Tl[(bi * 16 + fq * 4 + q) * RW_LD + bj * 16 + fr] = f2bf(tb[q]);
                uint2 p; p.x = pack2(tb[0], tb[1]); p.y = pack2(tb[2], tb[3]);
                *reinterpret_cast<uint2*>(&TlT[(bj * 16 + fr) * RW_LD + bi * 16 + fq * 4]) = p;
            }
            asm volatile("s_waitcnt lgkmcnt(0)" ::: "memory");
        }
    } else if (wv >= 4) {
        const int it = (wv >> 1) & 1, vt = wv & 1;
        const f32x16 acc = tile_mm(SLOT(9), it * 32, SLOT(7), vt * 32, r, hf);
        store_t(SLOT(2), vt * 32, it * 32, acc, r, hf);
    }
    __syncthreads();
    {
        const int which = wv >> 2, it = (wv >> 1) & 1, ct = wv & 1;
        const f32x16 acc = tile_mm(SLOT(0), it * 32, which ? SLOT(2) : SLOT(4), ct * 32, r, hf);
        store_t(which ? SLOT(9) : SLOT(8), ct * 32, it * 32, acc, r, hf);
    }
    __syncthreads();
    if (wv < 4) {
        {
            const int dtl = wv >> 1, itl = wv & 1;
            f32x16 acc = tile_mm(SLOT(8), dtl * 32, SLOT(10), itl * 32, r, hf);
            bfr* WY = (bfr*)(a.ws + WS_WY) + (size_t)u * 4096;
            const int i = itl * 32 + r;
#pragma unroll
            for (int g4 = 0; g4 < 4; ++g4) {
                const int d0 = dtl * 32 + g4 * 8 + hf * 4;
                const uint2 rr2 = *reinterpret_cast<const uint2*>(&SLOT(3)[i * RW_LD + d0]);
                uint2 p; p.x = pack2(acc[g4 * 4] + bflo(rr2.x), acc[g4 * 4 + 1] + bfhi(rr2.x)); p.y = pack2(acc[g4 * 4 + 2] + bflo(rr2.y), acc[g4 * 4 + 3] + bfhi(rr2.y));
                *reinterpret_cast<uint2*>(&WY[i * 64 + d0]) = p;
            }
        }
        {
            const int it = wv >> 1, vt = wv & 1;
            f32x16 acc = tile_mm(SLOT(10), it * 32, SLOT(9), vt * 32, r, hf);
            acc = tile_mm_acc(acc, SLOT(11), it * 32, SLOT(7), vt * 32, r, hf);
            bfr* YL = (bfr*)(a.ws + WS_YLOC) + (size_t)u * 4096;
#pragma unroll
            for (int g4 = 0; g4 < 4; ++g4) { uint2 p; p.x = pack2(acc[g4 * 4], acc[g4 * 4 + 1]); p.y = pack2(acc[g4 * 4 + 2], acc[g4 * 4 + 3]);
                *reinterpret_cast<uint2*>(&YL[(((it * 2 + vt) * 4 + g4) * 64 + lane) * 4]) = p; }
        }
    } else {
        {
            const int kt = (wv >> 1) & 1, kpt = wv & 1;
            f32x16 acc = tile_mm(SLOT(8), kt * 32, SLOT(5), kpt * 32, r, hf);
            if (kt == kpt) {
                const float gc = __expf(BASE[16 * 64 + kt * 32 + r]);
#pragma unroll
                for (int g = 0; g < 16; ++g) if (((g & 3) + 8 * (g >> 2) + 4 * hf) == r) acc[g] += gc;
            }
            bfr* PM = (bfr*)(a.ws + WS_PM) + (size_t)u * 4096;
#pragma unroll
            for (int sgrp = 0; sgrp < 2; ++sgrp) {
                float v8[8];
#pragma unroll
                for (int q = 0; q < 8; ++q) v8[q] = acc[sgrp * 8 + q];
                *reinterpret_cast<uint4*>(&PM[(((kpt * 2 + kt) * 2 + sgrp) * 64 + lane) * 8]) = pack8(v8);
            }
        }
        {
            const int kpt = (wv >> 1) & 1, vt = wv & 1;
            f32x16 acc = tile_mm(SLOT(5), kpt * 32, SLOT(9), vt * 32, r, hf);
            acc = tile_mm_acc(acc, SLOT(6), kpt * 32, SLOT(7), vt * 32, r, hf);
            bfr* GM = (bfr*)(a.ws + WS_GM) + (size_t)u * 4096;
#pragma unroll
            for (int g4 = 0; g4 < 4; ++g4) { uint2 p; p.x = pack2(acc[g4 * 4], acc[g4 * 4 + 1]); p.y = pack2(acc[g4 * 4 + 2], acc[g4 * 4 + 3]);
                *reinterpret_cast<uint2*>(&GM[(((kpt * 2 + vt) * 4 + g4) * 64 + lane) * 4]) = p; }
        }
    }
    __syncthreads();
#undef SLOT
}

__device__ __forceinline__ void rwkv_chain(const Args& a, const int h, const int vh) {
    const int lane = my_tid() & 63, r = lane & 31, hf = lane >> 5;
    const bfr* PMb = (const bfr*)(a.ws + WS_PM); const bfr* GMb = (const bfr*)(a.ws + WS_GM); bfr* ZTb = (bfr*)(a.ws + WS_ZT);
    f32x16 Z[2];
#pragma unroll
    for (int g = 0; g < 16; ++g) { Z[0][g] = 0.f; Z[1][g] = 0.f; }
    bf16x8 Acur[8], Anxt[8]; uint2 Ccur[8], Cnxt[8];
    {
        const bfr* pm = PMb + (size_t)h * 4096; const bfr* gm = GMb + (size_t)h * 4096;
#pragma unroll
        for (int f = 0; f < 8; ++f) Acur[f] = *reinterpret_cast<const bf16x8*>(&pm[(f * 64 + lane) * 8]);
#pragma unroll
        for (int kpt = 0; kpt < 2; ++kpt)
#pragma unroll
            for (int g4 = 0; g4 < 4; ++g4) Ccur[kpt * 4 + g4] = *reinterpret_cast<const uint2*>(&gm[(((kpt * 2 + vh) * 4 + g4) * 64 + lane) * 4]);
    }
    for (int c = 0; c < 128; ++c) {
        const int u = c * 16 + h;
        if (c + 1 < 128) {
            const bfr* pm = PMb + (size_t)(u + 16) * 4096; const bfr* gm = GMb + (size_t)(u + 16) * 4096;
#pragma unroll
            for (int f = 0; f < 8; ++f) Anxt[f] = *reinterpret_cast<const bf16x8*>(&pm[(f * 64 + lane) * 8]);
#pragma unroll
            for (int kpt = 0; kpt < 2; ++kpt)
#pragma unroll
                for (int g4 = 0; g4 < 4; ++g4) Cnxt[kpt * 4 + g4] = *reinterpret_cast<const uint2*>(&gm[(((kpt * 2 + vh) * 4 + g4) * 64 + lane) * 4]);
        }
        bfr* zt = ZTb + (size_t)u * 4096 + (size_t)(vh * 32 + r) * 64;
        bf16x8 Bf[2][2];
#pragma unroll
        for (int kt = 0; kt < 2; ++kt) {
#pragma unroll
            for (int g4 = 0; g4 < 4; ++g4) {
                uint2 o; o.x = pack2(Z[kt][g4 * 4], Z[kt][g4 * 4 + 1]); o.y = pack2(Z[kt][g4 * 4 + 2], Z[kt][g4 * 4 + 3]);
                *reinterpret_cast<uint2*>(&zt[kt * 32 + g4 * 8 + hf * 4]) = o;
                const int s = g4 >> 1, e = (g4 & 1) * 4;
                Bf[kt][s][e] = (short)(o.x & 0xFFFF); Bf[kt][s][e + 1] = (short)(o.x >> 16); Bf[kt][s][e + 2] = (short)(o.y & 0xFFFF); Bf[kt][s][e + 3] = (short)(o.y >> 16);
            }
        }
        f32x16 Zn[2];
#pragma unroll
        for (int kpt = 0; kpt < 2; ++kpt)
#pragma unroll
            for (int g4 = 0; g4 < 4; ++g4) {
                const uint2 cc = Ccur[kpt * 4 + g4];
                Zn[kpt][g4 * 4] = bflo(cc.x); Zn[kpt][g4 * 4 + 1] = bfhi(cc.x); Zn[kpt][g4 * 4 + 2] = bflo(cc.y); Zn[kpt][g4 * 4 + 3] = bfhi(cc.y);
            }
#pragma unroll
        for (int kpt = 0; kpt < 2; ++kpt)
#pragma unroll
            for (int kt = 0; kt < 2; ++kt)
#pragma unroll
                for (int s = 0; s < 2; ++s)
                    Zn[kpt] = __builtin_amdgcn_mfma_f32_32x32x16_bf16(Acur[(kpt * 2 + kt) * 2 + s], Bf[kt][s], Zn[kpt], 0, 0, 0);
        Z[0] = Zn[0]; Z[1] = Zn[1];
#pragma unroll
        for (int f = 0; f < 8; ++f) { Acur[f] = Anxt[f]; Ccur[f] = Cnxt[f]; }
    }
}

__device__ __forceinline__ void rwkv_out_unit(const Args& a, const int u, float* Ls) {
    const int lane = my_tid() & 63, r = lane & 31, hf = lane >> 5, c = u >> 4, h = u & 15, t0 = c * 64;
    const bfr* WY = (const bfr*)(a.ws + WS_WY) + (size_t)u * 4096; const bfr* YL = (const bfr*)(a.ws + WS_YLOC) + (size_t)u * 4096;
    const bfr* ZT = (const bfr*)(a.ws + WS_ZT) + (size_t)u * 4096;
    float* LNs = Ls + 8 * 4352 - (my_tid() >> 6) * (4352 - 128);
    LNs[lane] = a.in[I_LNW][h * 64 + lane]; LNs[64 + lane] = a.in[I_LNB][h * 64 + lane];
    f32x16 acc[2][2];
#pragma unroll
    for (int it = 0; it < 2; ++it)
#pragma unroll
        for (int vt = 0; vt < 2; ++vt)
#pragma unroll
            for (int g4 = 0; g4 < 4; ++g4) {
                const uint2 cc = *reinterpret_cast<const uint2*>(&YL[(((it * 2 + vt) * 4 + g4) * 64 + lane) * 4]);
                acc[it][vt][g4 * 4] = bflo(cc.x); acc[it][vt][g4 * 4 + 1] = bfhi(cc.x); acc[it][vt][g4 * 4 + 2] = bflo(cc.y); acc[it][vt][g4 * 4 + 3] = bfhi(cc.y);
            }
#pragma unroll
    for (int ks = 0; ks < 4; ++ks) {
        bf16x8 A[2], B[2];
#pragma unroll
        for (int it = 0; it < 2; ++it) A[it] = *reinterpret_cast<const bf16x8*>(&WY[(it * 32 + r) * 64 + ks * 16 + hf * 8]);
#pragma unroll
        for (int vt = 0; vt < 2; ++vt) B[vt] = *reinterpret_cast<const bf16x8*>(&ZT[(vt * 32 + r) * 64 + ks * 16 + hf * 8]);
#pragma unroll
        for (int it = 0; it < 2; ++it)
#pragma unroll
            for (int vt = 0; vt < 2; ++vt) acc[it][vt] = __builtin_amdgcn_mfma_f32_32x32x16_bf16(A[it], B[vt], acc[it][vt], 0, 0, 0);
    }
    const int rowl = lane >> 3, ch = lane & 7;
    uint4 ggr[8], bbr[8];
    {
        const bfr* Gg0 = (const bfr*)(a.ws + WS_GG); const bfr* Bon0 = (const bfr*)(a.ws + WS_BON);
#pragma unroll
        for (int it = 0; it < 8; ++it) { const size_t o0 = (size_t)(t0 + it * 8 + rowl) * RW + h * 64 + ch * 8;
            ggr[it] = *reinterpret_cast<const uint4*>(&Gg0[o0]); bbr[it] = *reinterpret_cast<const uint4*>(&Bon0[o0]); }
    }
#pragma unroll
    for (int it = 0; it < 2; ++it)
#pragma unroll
        for (int vt = 0; vt < 2; ++vt)
#pragma unroll
            for (int g = 0; g < 16; ++g) Ls[(it * 32 + (g & 3) + 8 * (g >> 2) + 4 * hf) * 68 + vt * 32 + r] = acc[it][vt][g];
    asm volatile("s_waitcnt lgkmcnt(0)" ::: "memory");
    __builtin_amdgcn_wave_barrier();
    {
        float y[64]; float s1 = 0.f, s2 = 0.f;
#pragma unroll
        for (int q = 0; q < 16; ++q) {
            const float4 x = *reinterpret_cast<const float4*>(&Ls[lane * 68 + q * 4]);
            y[q * 4] = x.x; y[q * 4 + 1] = x.y; y[q * 4 + 2] = x.z; y[q * 4 + 3] = x.w;
            s1 += (x.x + x.y) + (x.z + x.w);
        }
        const float mean = s1 * (1.f / 64.f);
#pragma unroll
        for (int v = 0; v < 64; ++v) { const float d = y[v] - mean; s2 += d * d; }
        const float rstd = rsqrtf(s2 * (1.f / 64.f) + 64e-5f);
        Ls[lane * 68 + 64] = mean; Ls[lane * 68 + 65] = rstd;
    }
    asm volatile("s_waitcnt lgkmcnt(0)" ::: "memory");
    __builtin_amdgcn_wave_barrier();
    {
        bfr* RWO = (bfr*)(a.ws + WS_RWO);
        const float4 w0 = *reinterpret_cast<const float4*>(&LNs[ch * 8]), w1 = *reinterpret_cast<const float4*>(&LNs[ch * 8 + 4]);
        const float4 b0 = *reinterpret_cast<const float4*>(&LNs[64 + ch * 8]), b1 = *reinterpret_cast<const float4*>(&LNs[64 + ch * 8 + 4]);
        const float lw[8] = {w0.x, w0.y, w0.z, w0.w, w1.x, w1.y, w1.z, w1.w}, lb[8] = {b0.x, b0.y, b0.z, b0.w, b1.x, b1.y, b1.z, b1.w};
#pragma unroll
        for (int it = 0; it < 8; ++it) {
            const int row = it * 8 + rowl;
            const float4 y0 = *reinterpret_cast<const float4*>(&Ls[row * 68 + ch * 8]), y1 = *reinterpret_cast<const float4*>(&Ls[row * 68 + ch * 8 + 4]);
            const float2 st = *reinterpret_cast<const float2*>(&Ls[row * 68 + 64]);
            const float yv[8] = {y0.x, y0.y, y0.z, y0.w, y1.x, y1.y, y1.z, y1.w};
            float gg[8], bb[8], rr[8];
            unpack8(ggr[it], gg);
            unpack8(bbr[it], bb);
#pragma unroll
            for (int e = 0; e < 8; ++e) rr[e] = ((yv[e] - st.x) * st.y * lw[e] + lb[e] + bb[e]) * gg[e];
            *reinterpret_cast<uint4*>(&RWO[(size_t)(t0 + row) * RW + h * 64 + ch * 8]) = pack8(rr);
        }
    }
    asm volatile("s_waitcnt lgkmcnt(0)" ::: "memory");
    __builtin_amdgcn_wave_barrier();
}
#ifndef DUP_DSA
#define DUP_DSA 0
#endif
constexpr float IDX_SCALE = 0.04419417382415922f;
constexpr int CT_ROW = 544;
constexpr int CT_WAVE = 18432;
constexpr int DSA_RELB_OFF = 155648;
constexpr int DSA_HIST_OFF = 131072;
constexpr int DSA_SEL_OFF = 147456;

typedef __bf16 bf16p2_t __attribute__((ext_vector_type(2)));
__device__ __forceinline__ bf16x8 fp8x8_to_bf16(const uint2 w) {
    const u32x4 r = {__builtin_bit_cast(unsigned, __builtin_amdgcn_cvt_scalef32_pk_bf16_fp8(w.x, 1.0f, false)), __builtin_bit_cast(unsigned, __builtin_amdgcn_cvt_scalef32_pk_bf16_fp8(w.x, 1.0f, true)),
                     __builtin_bit_cast(unsigned, __builtin_amdgcn_cvt_scalef32_pk_bf16_fp8(w.y, 1.0f, false)), __builtin_bit_cast(unsigned, __builtin_amdgcn_cvt_scalef32_pk_bf16_fp8(w.y, 1.0f, true))};
    return __builtin_bit_cast(bf16x8, r);
}
__device__ __forceinline__ unsigned pack4_fp8(float a0, float a1, float a2, float a3) {
    int p = 0; p = __builtin_amdgcn_cvt_pk_fp8_f32(a0, a1, p, false); p = __builtin_amdgcn_cvt_pk_fp8_f32(a2, a3, p, true); return (unsigned)p;
}
__device__ __forceinline__ int rel_bucket(int rel) {
    const int n = rel < 0 ? -rel : rel;
    const int lg = 8 + (n >= 15) + (n >= 27) + (n >= 50) + (n >= 91) + (n >= 166) + (n >= 305) + (n >= 559);
    return (n < 8 ? n : lg) + (rel > 0 ? 16 : 0);
}
__device__ __forceinline__ unsigned fkey(float f) {
    if (f == 0.f) f = 0.f;
    const unsigned u = __float_as_uint(f);
    return (u & 0x80000000u) ? ~u : (u | 0x80000000u);
}

struct CnIn { uint2 raw[4]; };
__device__ __forceinline__ void dsa_cnorm_fetch(const Args& a, CnIn& in) {
    const bfr* P = (const bfr*)(a.ws + WS_P);
    const int lane = my_tid() & 63, wv = my_tid() >> 6;
#pragma unroll
    for (int k = 0; k < 4; ++k) {
        const int t = (int)blockIdx.x * 8 + wv + k * (int)gridDim.x * 8;
        if (t < T) {
            in.raw[k] = *reinterpret_cast<const uint2*>(&P[(size_t)t * NINP + C_CKV + lane * 4]);
        }
    }
}
__device__ __forceinline__ void dsa_cnorm_finish(const Args& a, const CnIn& in) {
    const bfr* P = (const bfr*)(a.ws + WS_P); unsigned char* CB8 = a.ws + WS_CB; bfr* IKC = (bfr*)(a.ws + WS_IKC);
    const int lane = my_tid() & 63, wv = my_tid() >> 6;
    const float4 g = reinterpret_cast<const float4*>(a.in[I_KVG])[lane];
#pragma unroll
    for (int k = 0; k < 4; ++k) {
        const int t = (int)blockIdx.x * 8 + wv + k * (int)gridDim.x * 8;
        if (t < T) {
            const uint2 raw = in.raw[k];
            const float v0 = bflo(raw.x), v1 = bfhi(raw.x), v2 = bflo(raw.y), v3 = bfhi(raw.y);
            const float ss = wave_sum(v0 * v0 + v1 * v1 + v2 * v2 + v3 * v3);
            const float rs = rsqrtf(ss * (1.f / 256.f) + EPS);
            int pk = 0;
            pk = __builtin_amdgcn_cvt_pk_fp8_f32(v0 * rs * g.x, v1 * rs * g.y, pk, false);
            pk = __builtin_amdgcn_cvt_pk_fp8_f32(v2 * rs * g.z, v3 * rs * g.w, pk, true);
            *reinterpret_cast<int*>(&CB8[(size_t)t * 256 + lane * 4]) = pk;
            if (lane < 16) *reinterpret_cast<uint2*>(&IKC[(size_t)t * 64 + lane * 4]) = *reinterpret_cast<const uint2*>(&P[(size_t)t * NINP + C_IK + lane * 4]);
        }
    }
}
__device__ __forceinline__ void dsa_qlat(const Args& a) {
    const bfr* P = (const bfr*)(a.ws + WS_P); const bfr* WUK = (const bfr*)(a.ws + WS_WUK); unsigned char* QL8 = a.ws + WS_QLAT;
    const int lane = my_tid() & 63, wv = my_tid() >> 6, fr = lane & 15, fq = lane >> 4;
    for (int it = blockIdx.x * 8 + wv; it < (T / 64) * NH; it += gridDim.x * 8) {
        const int tg = it >> 4, h = it & 15, t0 = tg * 64;
        bf16x8 Bt[4][2];
#pragma unroll
        for (int tl = 0; tl < 4; ++tl)
#pragma unroll
            for (int ks = 0; ks < 2; ++ks) Bt[tl][ks] = *reinterpret_cast<const bf16x8*>(&P[(size_t)(t0 + tl * 16 + fr) * NINP + C_Q + h * 64 + ks * 32 + fq * 8]);
        bf16x8 Aw[16][2];
#pragma unroll
        for (int nt = 0; nt < 16; ++nt) {
            Aw[nt][0] = *reinterpret_cast<const bf16x8*>(&WUK[(size_t)(h * 256 + nt * 16 + fr) * 64 + fq * 8]);
            Aw[nt][1] = *reinterpret_cast<const bf16x8*>(&WUK[(size_t)(h * 256 + nt * 16 + fr) * 64 + 32 + fq * 8]);
        }
#pragma unroll
        for (int nt = 0; nt < 16; ++nt) {
#pragma unroll
            for (int tl = 0; tl < 4; ++tl) {
                f32x4 acc = {0.f, 0.f, 0.f, 0.f};
                acc = __builtin_amdgcn_mfma_f32_16x16x32_bf16(Aw[nt][0], Bt[tl][0], acc, 0, 0, 0);
                acc = __builtin_amdgcn_mfma_f32_16x16x32_bf16(Aw[nt][1], Bt[tl][1], acc, 0, 0, 0);
                *reinterpret_cast<unsigned*>(&QL8[((size_t)(t0 + tl * 16 + fr) * NH + h) * 256 + nt * 16 + fq * 4]) = pack4_fp8(acc[0], acc[1], acc[2], acc[3]);
            }
        }
    }
}
__device__ __forceinline__ void dsa_oproj(const Args& a) {
    const unsigned char* OL8 = a.ws + WS_OLAT; const bfr* WUVT = (const bfr*)(a.ws + WS_WUVT); bfr* DO = (bfr*)(a.ws + WS_DO);
    const int lane = my_tid() & 63, wv = my_tid() >> 6, fr = lane & 15, fq = lane >> 4;
    for (int it = blockIdx.x * 8 + wv; it < (T / 64) * NH; it += gridDim.x * 8) {
        const int tg = it >> 4, h = it & 15, t0 = tg * 64;
        f32x4 acc[4][4];
#pragma unroll
        for (int tl = 0; tl < 4; ++tl)
#pragma unroll
            for (int nt = 0; nt < 4; ++nt) acc[tl][nt] = f32x4{0.f, 0.f, 0.f, 0.f};
        bf16x8 A[3][4]; uint2 Br[3][4];
#define OPJ_LOAD(S, KS) { _Pragma("unroll") for (int nt = 0; nt < 4; ++nt) A[S][nt] = *reinterpret_cast<const bf16x8*>(&WUVT[(size_t)(h * 64 + nt * 16 + fr) * 256 + (KS) * 32 + fq * 8]); \
                          _Pragma("unroll") for (int tl = 0; tl < 4; ++tl) Br[S][tl] = *reinterpret_cast<const uint2*>(&OL8[((size_t)(t0 + tl * 16 + fr) * NH + h) * 256 + (KS) * 32 + fq * 8]); }
        OPJ_LOAD(0, 0) OPJ_LOAD(1, 1)
#pragma unroll
        for (int ks = 0; ks < 8; ++ks) {
            if (ks + 2 < 8) { if ((ks + 2) % 3 == 0) OPJ_LOAD(0, ks + 2) else if ((ks + 2) % 3 == 1) OPJ_LOAD(1, ks + 2) else OPJ_LOAD(2, ks + 2) }
#pragma unroll
            for (int tl = 0; tl < 4; ++tl) {
                const bf16x8 Bt = fp8x8_to_bf16(Br[ks % 3][tl]);
#pragma unroll
                for (int nt = 0; nt < 4; ++nt) acc[tl][nt] = __builtin_amdgcn_mfma_f32_16x16x32_bf16(A[ks % 3][nt], Bt, acc[tl][nt], 0, 0, 0);
            }
        }
#undef OPJ_LOAD
#pragma unroll
        for (int tl = 0; tl < 4; ++tl)
#pragma unroll
            for (int nt = 0; nt < 4; ++nt) { uint2 o; o.x = pack2(acc[tl][nt][0], acc[tl][nt][1]); o.y = pack2(acc[tl][nt][2], acc[tl][nt][3]);
                *reinterpret_cast<uint2*>(&DO[(size_t)(t0 + tl * 16 + fr) * RW + h * 64 + nt * 16 + fq * 4]) = o; }
    }
}

__device__ __forceinline__ float bin_scale(const float sumw2) { const float sg = sqrtf(32.f * sumw2); return sg > 1e-20f ? 90.f / sg : 1.f; }
__device__ __forceinline__ int score_bin(const float sc, const float bsc) { const float f = floorf(sc * bsc) + 512.f; return (int)fminf(fmaxf(f, 0.f), 1023.f); }
__device__ __forceinline__ float key_score(const unsigned k) { return __uint_as_float((k & 0x80000000u) ? (k ^ 0x80000000u) : ~k); }
__device__ __forceinline__ void hist_scan(const unsigned* hist, const int nb, const unsigned need, unsigned* res, const int lane) {
    const int per = nb >> 6;
    unsigned s = 0;
    for (int i = 0; i < per; ++i) s += hist[lane * per + i];
    unsigned S = s;
#pragma unroll
    for (int o = 1; o < 64; o <<= 1) { const unsigned tt = __shfl_down(S, o); if (lane + o < 64) S += tt; }
    const unsigned long long m = __ballot(S >= need);
    const int ls = 63 - __clzll(m);
    if (lane == ls) {
        unsigned accv = S - s; int bin = lane * per; unsigned abv = accv;
        for (int bb = lane * per + per - 1; bb >= lane * per; --bb) { const unsigned cc = hist[bb]; if (accv + cc >= need) { bin = bb; abv = accv; break; } accv += cc; }
        res[0] = (unsigned)bin; res[1] = abv;
    }
}

__device__ __forceinline__ void dsa_select4(const Args& a, const int t0, const int qs, unsigned char* lds) {
    const bfr* P = (const bfr*)(a.ws + WS_P); const bfr* IKC = (const bfr*)(a.ws + WS_IKC);
    float* SC = (float*)lds; int* SEL = (int*)(lds + DSA_SEL_OFF); unsigned* MISC = (unsigned*)(lds + LDS_MISC);
    const int tid = my_tid(), lane = tid & 63, wv = tid >> 6, r = lane & 31, hf = lane >> 5;
    const int L = 64 * (t0 / 64 + 1);
    if (L <= 256) {
        for (int i = tid; i < 4 * 256; i += 512) SEL[(qs + (i >> 8)) * 256 + (i & 255)] = (i & 255) | (rel_bucket((i & 255) - (t0 + (i >> 8))) << 16);
        if (tid < 4) MISC[16 + qs + tid] = (unsigned)L;
        __syncthreads();
        return;
    }
    for (int i = tid; i < 4096; i += 512) ((unsigned*)(lds + DSA_HIST_OFF))[i] = 0u;
    __syncthreads();
    {
        const int qq = r >> 3, hh = r & 7;
        bf16x8 B[4];
#pragma unroll
        for (int ks = 0; ks < 4; ++ks) B[ks] = *reinterpret_cast<const bf16x8*>(&P[(size_t)(t0 + qq) * NINP + C_IQ + hh * 64 + ks * 16 + hf * 8]);
        const float wgt = bf2f(P[(size_t)(t0 + qq) * NINP + C_IW + hh]) * IDX_SCALE;
        float w2 = wgt * wgt; w2 += dpp_f<DPP_XOR1>(w2); w2 += dpp_f<DPP_XOR2>(w2); w2 += dpp_f<0x141>(w2);
        const float bsc = bin_scale(w2);
        if (hh == 0 && hf == 0) ((float*)MISC)[48 + qq] = bsc;
        const int ntile = L >> 5;
        for (int rp_ = 0; rp_ < ((DUP_DSA & 1) ? 2 : 1); ++rp_) {
        bf16x8 An[4];
        if (wv < ntile) {
#pragma unroll
            for (int ks = 0; ks < 4; ++ks) An[ks] = *reinterpret_cast<const bf16x8*>(&IKC[(size_t)(wv * 32 + r) * 64 + ks * 16 + hf * 8]);
        }
        for (int kt = wv; kt < ntile; kt += 8) {
            bf16x8 Ac[4];
#pragma unroll
            for (int ks = 0; ks < 4; ++ks) Ac[ks] = An[ks];
            if (kt + 8 < ntile) {
#pragma unroll
                for (int ks = 0; ks < 4; ++ks) An[ks] = *reinterpret_cast<const bf16x8*>(&IKC[(size_t)((kt + 8) * 32 + r) * 64 + ks * 16 + hf * 8]);
            }
            f32x16 acc;
#pragma unroll
            for (int g = 0; g < 16; ++g) acc[g] = 0.f;
#pragma unroll
            for (int ks = 0; ks < 4; ++ks) acc = __builtin_amdgcn_mfma_f32_32x32x16_bf16(Ac[ks], B[ks], acc, 0, 0, 0);
            float s1[8], s2[4], s3[2];
            const bool b0 = (hh & 1) != 0, b1 = (hh & 2) != 0, b2 = (hh & 4) != 0;
#pragma unroll
            for (int p = 0; p < 8; ++p) {
                const float x0 = fmaxf(acc[2 * p], 0.f) * wgt, x1 = fmaxf(acc[2 * p + 1], 0.f) * wgt;
                s1[p] = (b0 ? x1 : x0) + dpp_f<DPP_XOR1>(b0 ? x0 : x1);
            }
#pragma unroll
            for (int p = 0; p < 4; ++p) s2[p] = (b1 ? s1[2 * p + 1] : s1[2 * p]) + dpp_f<DPP_XOR2>(b1 ? s1[2 * p] : s1[2 * p + 1]);
#pragma unroll
            for (int p = 0; p < 2; ++p) s3[p] = (b2 ? s2[2 * p + 1] : s2[2 * p]) + __shfl_xor(b2 ? s2[2 * p] : s2[2 * p + 1], 4);
#pragma unroll
            for (int p = 0; p < 2; ++p) { const int g = 8 * p + hh; const unsigned fk = fkey(s3[p]); ((unsigned*)SC)[qq * 8192 + kt * 32 + (g & 3) + 8 * (g >> 2) + 4 * hf] = fk;
                if (rp_ == 0) atomicAdd((unsigned*)(lds + DSA_HIST_OFF) + qq * 1024 + score_bin(s3[p], bsc), 1u); }
        }
        }
    }
    __syncthreads();
    const int q = wv >> 1, l128 = (wv & 1) * 64 + lane;
    const unsigned* keys = (const unsigned*)(SC + q * 8192);
    unsigned* hist = (unsigned*)(lds + DSA_HIST_OFF) + q * 1024;
    unsigned* res = MISC + 32 + q * 4;
    for (int rp_ = 0; rp_ < ((DUP_DSA & 2) ? 2 : 1); ++rp_) {
    const float bsc = ((const float*)MISC)[48 + q];
    unsigned need = 256;
    if (rp_ > 0) {
        for (int i = l128; i < 1024; i += 128) hist[i] = 0u;
        __syncthreads();
        for (int idx = l128; idx < L; idx += 128) atomicAdd(&hist[score_bin(key_score(keys[idx]), bsc)], 1u);
        __syncthreads();
    }
    if ((wv & 1) == 0) hist_scan(hist, 1024, need, res, lane);
    __syncthreads();
    const int b0 = (int)res[0]; need -= res[1];
    __syncthreads();
    unsigned* cand = hist + 256;
    if (l128 == 0) { res[2] = 0u; res[3] = 0u; }
    if (tid == 0) MISC[52] = 0u;
    __syncthreads();
    for (int idx = l128; idx < L; idx += 128) {
        const unsigned k = keys[idx];
        if (score_bin(key_score(k), bsc) == b0) { const unsigned p = atomicAdd(&res[2], 1u); if (p < 768u) cand[p] = k; }
    }
    __syncthreads();
    const unsigned ncand = res[2];
    if (l128 == 0 && ncand > 768u) MISC[52] = 1u;
    __syncthreads();
    const bool fast = MISC[52] == 0u;
    unsigned prefix = 0;
    if (fast) {
        for (unsigned i = l128; i < ncand; i += 128) {
            const unsigned me = cand[i]; unsigned cgt = 0, ceq = 0;
            for (unsigned j = 0; j < ncand; ++j) { const unsigned o = cand[j]; cgt += (o > me) ? 1u : 0u; ceq += (o == me) ? 1u : 0u; }
            if (cgt < need && need <= cgt + ceq) { res[0] = me; res[1] = cgt; }
        }
        __syncthreads();
        prefix = res[0]; need -= res[1];
        __syncthreads();
    } else {
#pragma unroll 1
        for (int pass = 0; pass < 4; ++pass) {
            const int lo_shift = 24 - 8 * pass;
            for (int i = l128; i < 256; i += 128) hist[i] = 0u;
            __syncthreads();
            for (int idx = l128; idx < L; idx += 128) {
                const unsigned k = keys[idx];
                const bool ok = (score_bin(key_score(k), bsc) == b0) && (pass == 0 || (k >> (lo_shift + 8)) == prefix);
                if (ok) atomicAdd(&hist[(k >> lo_shift) & 255u], 1u);
            }
            __syncthreads();
            if ((wv & 1) == 0) hist_scan(hist, 256, need, res, lane);
            __syncthreads();
            prefix = (prefix << 8) | res[0]; need -= res[1];
            __syncthreads();
        }
    }
    const unsigned tkey = prefix;
    if ((wv & 1) == 0) {
        const unsigned ngt = 256u - need; unsigned rg = 0, rt = 0;
        const unsigned long long lt = (1ull << lane) - 1ull;
        for (int base = 0; base < L; base += 64) {
            const unsigned k = keys[base + lane];
            const bool gt = k > tkey, tie = k == tkey;
            const unsigned long long mg = __ballot(gt), mt = __ballot(tie);
            if (gt) { const unsigned p = rg + (unsigned)__popcll(mg & lt); if (p < 256u) SEL[(qs + q) * 256 + p] = base + lane; }
            if (tie) { const unsigned p = rt + (unsigned)__popcll(mt & lt); if (p < need) SEL[(qs + q) * 256 + ngt + p] = base + lane; }
            rg += (unsigned)__popcll(mg); rt += (unsigned)__popcll(mt);
        }
        if (lane == 0) MISC[16 + qs + q] = 256u;
    }
    __syncthreads();
    for (int i = l128; i < 256; i += 128) { const int e = SEL[(qs + q) * 256 + i]; SEL[(qs + q) * 256 + i] = e | (rel_bucket(e - (t0 + q)) << 16); }
    __syncthreads();
    }
}

__device__ __forceinline__ void dsa_attend(const Args& a, const int t, const int* sel, const int nsel, unsigned char* ct, const float* relb_l) {
    const unsigned char* CB8 = a.ws + WS_CB; const unsigned char* QL8 = a.ws + WS_QLAT; unsigned char* OL8 = a.ws + WS_OLAT;
    const int lane = my_tid() & 63, fr = lane & 15, fq = lane >> 4;
    bf16x8 Bq[8];
#pragma unroll
    for (int j = 0; j < 4; ++j) {
        const uint4 w = *reinterpret_cast<const uint4*>(&QL8[((size_t)t * NH + fr) * 256 + j * 64 + fq * 16]);
        Bq[2 * j] = fp8x8_to_bf16(uint2{w.x, w.y}); Bq[2 * j + 1] = fp8x8_to_bf16(uint2{w.z, w.w});
    }
    f32x4 o[16];
#pragma unroll
    for (int mt = 0; mt < 16; ++mt) o[mt] = f32x4{0.f, 0.f, 0.f, 0.f};
    float mrun = -1e30f, lrun = 0.f;
    const unsigned tr_addr = (unsigned)(size_t)ct + (unsigned)((4 * fq + (fr >> 2)) * CT_ROW + (fr & 3) * 8);
    const int nblk = nsel >> 5;
    uint4 ArA[2][4], ArB[2][4];
#define ATT_LOAD(AR, KB) _Pragma("unroll") for (int tt = 0; tt < 2; ++tt) { \
        const int kidx = sel[(KB) * 32 + tt * 16 + fr] & 0xFFFF; \
        _Pragma("unroll") for (int j = 0; j < 4; ++j) AR[tt][j] = *reinterpret_cast<const uint4*>(&CB8[(size_t)kidx * 256 + j * 64 + fq * 16]); }
#define ATT_QK(AR) _Pragma("unroll") for (int tt = 0; tt < 2; ++tt) { \
        st[tt] = f32x4{0.f, 0.f, 0.f, 0.f}; \
        _Pragma("unroll") for (int j = 0; j < 4; ++j) { \
            const bf16x8 A0 = fp8x8_to_bf16(uint2{AR[tt][j].x, AR[tt][j].y}), A1 = fp8x8_to_bf16(uint2{AR[tt][j].z, AR[tt][j].w}); \
            st[tt] = __builtin_amdgcn_mfma_f32_16x16x32_bf16(A0, Bq[2 * j], st[tt], 0, 0, 0); \
            st[tt] = __builtin_amdgcn_mfma_f32_16x16x32_bf16(A1, Bq[2 * j + 1], st[tt], 0, 0, 0); \
            *reinterpret_cast<bf16x8*>(ct + (tt * 16 + fr) * CT_ROW + (j * 64 + fq * 16) * 2) = A0; \
            *reinterpret_cast<bf16x8*>(ct + (tt * 16 + fr) * CT_ROW + (j * 64 + fq * 16 + 8) * 2) = A1; } }
#define ATT_SMPV(KB) { \
        float lg[8]; float bmax = -1e30f; \
        _Pragma("unroll") for (int tt = 0; tt < 2; ++tt) { \
            const int4 k4 = *reinterpret_cast<const int4*>(&sel[(KB) * 32 + tt * 16 + fq * 4]); \
            const int kk4[4] = {k4.x, k4.y, k4.z, k4.w}; \
            _Pragma("unroll") for (int j = 0; j < 4; ++j) { \
                const float v = st[tt][j] * 0.125f + relb_l[(kk4[j] >> 16) * 16 + fr]; \
                lg[tt * 4 + j] = v; bmax = fmaxf(bmax, v); } } \
        bmax = maxx16(bmax); bmax = maxx32(bmax); \
        const bool resc = __any(bmax > mrun + 8.f);             \
        if (resc) {                           \
            const float mnew = fmaxf(mrun, bmax); const float alpha = __expf(mrun - mnew); mrun = mnew; lrun *= alpha; \
            asm volatile("" ::: "memory"); \
            _Pragma("unroll") for (int mt = 0; mt < 16; ++mt) { o[mt][0] *= alpha; o[mt][1] *= alpha; o[mt][2] *= alpha; o[mt][3] *= alpha; } } \
        float psum = 0.f; bf16x8 Pf; \
        _Pragma("unroll") for (int e = 0; e < 8; e += 2) { \
            const float p0 = __expf(lg[e] - mrun), p1 = __expf(lg[e + 1] - mrun); psum += p0 + p1; \
            const unsigned pk = pack2(p0, p1); Pf[e] = (short)(pk & 0xFFFF); Pf[e + 1] = (short)(pk >> 16); } \
        lrun += psum; \
        asm volatile("s_waitcnt lgkmcnt(0)" ::: "memory"); \
        __builtin_amdgcn_wave_barrier(); \
        _Pragma("unroll") for (int m4 = 0; m4 < 4; ++m4) { \
            uint2 r0[4], r1[4]; \
            asm volatile("ds_read_b64_tr_b16 %0, %8 offset:%9\n\tds_read_b64_tr_b16 %1, %8 offset:%10\n\t" \
                         "ds_read_b64_tr_b16 %2, %8 offset:%11\n\tds_read_b64_tr_b16 %3, %8 offset:%12\n\t" \
                         "ds_read_b64_tr_b16 %4, %8 offset:%13\n\tds_read_b64_tr_b16 %5, %8 offset:%14\n\t" \
                         "ds_read_b64_tr_b16 %6, %8 offset:%15\n\tds_read_b64_tr_b16 %7, %8 offset:%16\n\ts_waitcnt lgkmcnt(0)" \
                         : "=&v"(r0[0]), "=&v"(r1[0]), "=&v"(r0[1]), "=&v"(r1[1]), "=&v"(r0[2]), "=&v"(r1[2]), "=&v"(r0[3]), "=&v"(r1[3]) \
                         : "v"(tr_addr), "n"(m4 * 128), "n"(m4 * 128 + 16 * CT_ROW), "n"(m4 * 128 + 32), "n"(m4 * 128 + 32 + 16 * CT_ROW), \
                           "n"(m4 * 128 + 64), "n"(m4 * 128 + 64 + 16 * CT_ROW), "n"(m4 * 128 + 96), "n"(m4 * 128 + 96 + 16 * CT_ROW) \
                         : "memory"); \
            _Pragma("unroll") for (int i = 0; i < 4; ++i) { \
                const int mt = m4 * 4 + i; \
                const u32x4 raw = {r0[i].x, r0[i].y, r1[i].x, r1[i].y}; \
                const bf16x8 Av = __builtin_bit_cast(bf16x8, raw); \
                o[mt] = __builtin_amdgcn_mfma_f32_16x16x32_bf16(Av, Pf, o[mt], 0, 0, 0); } } \
        asm volatile("s_waitcnt lgkmcnt(0)" ::: "memory"); \
        __builtin_amdgcn_wave_barrier(); }
    f32x4 st[2];
    ATT_LOAD(ArA, 0)
    ATT_LOAD(ArB, 1)
    int kb = 0;
#pragma unroll 1
    for (; kb + 2 < nblk; kb += 2) {
        ATT_QK(ArA) ATT_LOAD(ArA, kb + 2) ATT_SMPV(kb)
        ATT_QK(ArB) ATT_LOAD(ArB, kb + 3) ATT_SMPV(kb + 1)
    }
    ATT_QK(ArA) ATT_SMPV(kb)
    ATT_QK(ArB) ATT_SMPV(kb + 1)
#undef ATT_LOAD
#undef ATT_QK
#undef ATT_SMPV
    lrun = sumx16(lrun); lrun = sumx32(lrun);
    const float inv = frcp_(lrun);
#pragma unroll
    for (int mt = 0; mt < 16; ++mt) {
        *reinterpret_cast<unsigned*>(&OL8[((size_t)t * NH + fr) * 256 + mt * 16 + fq * 4]) = pack4_fp8(o[mt][0] * inv, o[mt][1] * inv, o[mt][2] * inv, o[mt][3] * inv);
    }
}

constexpr int DSA_CCAP = 256;
__device__ __forceinline__ bool dsa_select8(const Args& a, const int t0, unsigned char* lds) {
    const bfr* P = (const bfr*)(a.ws + WS_P); const bfr* IKC = (const bfr*)(a.ws + WS_IKC);
    unsigned* KEYS = (unsigned*)(a.ws + WS_KEYS) + (size_t)blockIdx.x * (8 * 8192);
    unsigned short* BIN = (unsigned short*)lds; unsigned* H16 = (unsigned*)(lds + DSA_HIST_OFF);
    int* SEL = (int*)(lds + DSA_SEL_OFF); unsigned* MISC = (unsigned*)(lds + LDS_MISC);
    const int tid = my_tid(), lane = tid & 63, wv = tid >> 6, r = lane & 31, hf = lane >> 5;
    const int L = 64 * (t0 / 64 + 1);
    if (L <= 256) {
        for (int i = tid; i < 8 * 256; i += 512) SEL[i] = (i & 255) | (rel_bucket((i & 255) - (t0 + (i >> 8))) << 16);
        if (tid < 8) MISC[16 + tid] = (unsigned)L;
        __syncthreads();
        return true;
    }
#ifndef DUP_DSA
#define DUP_DSA 0
#endif
    for (int rp_ = 0; rp_ < ((DUP_DSA & 1) ? 2 : 1); ++rp_) {
    if (rp_) __syncthreads();
    for (int i = tid; i < 4096; i += 512) H16[i] = 0u;
    if (tid == 0) MISC[60] = 0u;
    __syncthreads();
    {
        const int qq = r >> 3, hh = r & 7;
        bf16x8 Q[2][4]; float w4[2][4][4], bs[2][2], bsq[2][4];
#pragma unroll
        for (int grp = 0; grp < 2; ++grp) {
#pragma unroll
            for (int ks = 0; ks < 4; ++ks) Q[grp][ks] = *reinterpret_cast<const bf16x8*>(&P[(size_t)(t0 + grp * 4 + qq) * NINP + C_IQ + hh * 64 + ks * 16 + hf * 8]);
#pragma unroll
            for (int q = 0; q < 4; ++q) {
                const uint4 wr = *reinterpret_cast<const uint4*>(&P[(size_t)(t0 + grp * 4 + q) * NINP + C_IW]);
                const float f0 = bflo(wr.x) * IDX_SCALE, f1 = bfhi(wr.x) * IDX_SCALE, f2 = bflo(wr.y) * IDX_SCALE, f3 = bfhi(wr.y) * IDX_SCALE;
                const float f4 = bflo(wr.z) * IDX_SCALE, f5 = bfhi(wr.z) * IDX_SCALE, f6 = bflo(wr.w) * IDX_SCALE, f7 = bfhi(wr.w) * IDX_SCALE;
                const float bq = bin_scale(f0 * f0 + f1 * f1 + f2 * f2 + f3 * f3 + f4 * f4 + f5 * f5 + f6 * f6 + f7 * f7);
                w4[grp][q][0] = hf ? f4 : f0; w4[grp][q][1] = hf ? f5 : f1; w4[grp][q][2] = hf ? f6 : f2; w4[grp][q][3] = hf ? f7 : f3;
                bsq[grp][q] = bq;
            }
            bs[grp][0] = hf ? bsq[grp][2] : bsq[grp][0]; bs[grp][1] = hf ? bsq[grp][3] : bsq[grp][1];
        }
        const int ntile = L >> 5;
        bf16x8 An[4];
        if (wv < ntile) {
#pragma unroll
            for (int ks = 0; ks < 4; ++ks) An[ks] = *reinterpret_cast<const bf16x8*>(&IKC[(size_t)(wv * 32 + r) * 64 + ks * 16 + hf * 8]);
        }
        for (int kt = wv; kt < ntile; kt += 8) {
            bf16x8 Ac[4];
#pragma unroll
            for (int ks = 0; ks < 4; ++ks) Ac[ks] = An[ks];
            if (kt + 8 < ntile) {
#pragma unroll
                for (int ks = 0; ks < 4; ++ks) An[ks] = *reinterpret_cast<const bf16x8*>(&IKC[(size_t)((kt + 8) * 32 + r) * 64 + ks * 16 + hf * 8]);
            }
#pragma unroll
            for (int grp = 0; grp < 2; ++grp) {
                f32x16 acc;
#pragma unroll
                for (int g = 0; g < 16; ++g) acc[g] = 0.f;
#pragma unroll
                for (int ks = 0; ks < 4; ++ks) acc = __builtin_amdgcn_mfma_f32_32x32x16_bf16(Q[grp][ks], Ac[ks], acc, 0, 0, 0);
                float ps[4];
#pragma unroll
                for (int q = 0; q < 4; ++q) {
                    ps[q] = fmaxf(acc[4 * q], 0.f) * w4[grp][q][0];
#pragma unroll
                    for (int j = 1; j < 4; ++j) ps[q] = fmaf(fmaxf(acc[4 * q + j], 0.f), w4[grp][q][j], ps[q]);
                }
                const auto r02 = __builtin_amdgcn_permlane32_swap(__float_as_uint(ps[0]), __float_as_uint(ps[2]), false, false);
                const auto r13 = __builtin_amdgcn_permlane32_swap(__float_as_uint(ps[1]), __float_as_uint(ps[3]), false, false);
                const float sc2[2] = {__uint_as_float(r02[0]) + __uint_as_float(r02[1]), __uint_as_float(r13[0]) + __uint_as_float(r13[1])};
#pragma unroll
                for (int p = 0; p < 2; ++p) {
                    const int q = grp * 4 + 2 * hf + p, kidx = kt * 32 + r;
                    const int bin = score_bin(sc2[p], bs[grp][p]);
                    BIN[q * 8192 + kidx] = (unsigned short)bin;
                    atomicAdd(&H16[q * 512 + (bin >> 1)], (bin & 1) ? 0x10000u : 1u);
                    __builtin_nontemporal_store(fkey(sc2[p]), &KEYS[q * 8192 + kidx]);
                }
            }
        }
    }
    }
    asm volatile("s_waitcnt vmcnt(0)" ::: "memory");
    __syncthreads();
    {
        const int q = wv;
        const unsigned short* bins = BIN + q * 8192;
        unsigned* hrow = H16 + q * 512;
        unsigned cnt[16]; unsigned sown = 0;
#pragma unroll
        for (int i = 0; i < 8; ++i) { const unsigned w = hrow[lane * 8 + i]; cnt[2 * i] = w & 0xFFFFu; cnt[2 * i + 1] = w >> 16; sown += cnt[2 * i] + cnt[2 * i + 1]; }
        unsigned S = sown;
#pragma unroll
        for (int o = 1; o < 64; o <<= 1) { const unsigned tt = __shfl_down(S, o); if (lane + o < 64) S += tt; }
        const unsigned long long mfound = __ballot(S >= 256u);
        const int ls = 63 - __clzll(mfound);
        int b0l = 0; unsigned abovel = 0;
        {
            unsigned accv = S - sown; bool done = false;
#pragma unroll
            for (int bb = 15; bb >= 0; --bb) { if (!done) { if (accv + cnt[bb] >= 256u) { b0l = lane * 16 + bb; abovel = accv; done = true; } else accv += cnt[bb]; } }
        }
        const int b0 = __shfl(b0l, ls); const unsigned ngt = __shfl((int)abovel, ls); const unsigned need = 256u - ngt;
        __builtin_amdgcn_wave_barrier();
        int* CL = (int*)hrow; unsigned* CK = hrow + DSA_CCAP;
        const unsigned long long lt = (1ull << lane) - 1ull;
        unsigned rg = 0, rc = 0;
        for (int base = 0; base < (L >> 1); base += 64) {
            const bool valid = (base + lane) < (L >> 1);
            const unsigned w = valid ? reinterpret_cast<const unsigned*>(bins)[base + lane] : 0u;
            const int ba = (int)(w & 0xFFFFu), bb = (int)(w >> 16), ia = 2 * (base + lane), ib = ia + 1;
            const bool ga = valid && ba > b0, gb = valid && bb > b0, ca = valid && ba == b0, cb = valid && bb == b0;
            const unsigned long long mga = __ballot(ga), mgb = __ballot(gb), mca = __ballot(ca), mcb = __ballot(cb);
            const unsigned pg = rg + (unsigned)__popcll(mga & lt) + (unsigned)__popcll(mgb & lt);
            const unsigned pc = rc + (unsigned)__popcll(mca & lt) + (unsigned)__popcll(mcb & lt);
            if (ga && pg < 256u) SEL[q * 256 + pg] = ia;
            if (gb && pg + (ga ? 1u : 0u) < 256u) SEL[q * 256 + pg + (ga ? 1u : 0u)] = ib;
            if (ca && pc < (unsigned)DSA_CCAP) CL[pc] = ia;
            if (cb && pc + (ca ? 1u : 0u) < (unsigned)DSA_CCAP) CL[pc + (ca ? 1u : 0u)] = ib;
            rg += (unsigned)__popcll(mga) + (unsigned)__popcll(mgb); rc += (unsigned)__popcll(mca) + (unsigned)__popcll(mcb);
        }
        const unsigned ncand = rc;
        if (ncand > (unsigned)DSA_CCAP) { if (lane == 0) MISC[60] = 1u; }
        else {
            asm volatile("s_waitcnt lgkmcnt(0)" ::: "memory");
            for (unsigned i = lane; i < ncand; i += 64) CK[i] = __hip_atomic_load(&KEYS[q * 8192 + CL[i]], __ATOMIC_RELAXED, __HIP_MEMORY_SCOPE_AGENT);
            asm volatile("s_waitcnt vmcnt(0) lgkmcnt(0)" ::: "memory");
            __builtin_amdgcn_wave_barrier();
            for (unsigned i = lane; i < ncand; i += 64) {
                const unsigned me = CK[i]; unsigned rk = 0;
                for (unsigned j = 0; j < ncand; ++j) { const unsigned o = CK[j]; rk += (o > me || (o == me && j < i)) ? 1u : 0u; }
                if (rk < need) SEL[q * 256 + ngt + rk] = CL[i];
            }
            asm volatile("s_waitcnt lgkmcnt(0)" ::: "memory");
            __builtin_amdgcn_wave_barrier();
            for (int i = lane; i < 256; i += 64) { const int e = SEL[q * 256 + i]; SEL[q * 256 + i] = e | (rel_bucket(e - (t0 + q)) << 16); }
            if (lane == 0) MISC[16 + q] = 256u;
        }
    }
    __syncthreads();
    return MISC[60] == 0u;
}

__device__ __forceinline__ void dsa_unit(const Args& a, const int unit, unsigned char* lds, unsigned* cnt, unsigned& nreg) {
    const int t0 = unit * 8, wv = my_tid() >> 6;
    if (DUP_DSA & 2) { dsa_select8(a, t0, lds); __syncthreads(); }
    if (!dsa_select8(a, t0, lds)) {
        __syncthreads();
        dsa_select4(a, t0, 0, lds);
        dsa_select4(a, t0 + 4, 4, lds);
    }
    const int* SEL = (const int*)(lds + DSA_SEL_OFF); const unsigned* MISC = (const unsigned*)(lds + LDS_MISC);
    if (my_tid() == 0) nreg = atomicAdd(cnt, 1u);
    if (DUP_DSA & 4) dsa_attend(a, t0 + wv, SEL + wv * 256, (int)MISC[16 + wv], lds + wv * CT_WAVE, (const float*)(lds + DSA_RELB_OFF));
    dsa_attend(a, t0 + wv, SEL + wv * 256, (int)MISC[16 + wv], lds + wv * CT_WAVE, (const float*)(lds + DSA_RELB_OFF));
    __syncthreads();
}
template <int J> __device__ __forceinline__ int xchg_i(int v, const int lane) {
    if (J == 1) return __builtin_amdgcn_update_dpp(0, v, 0xB1, 0xF, 0xF, true);
    else if (J == 2) return __builtin_amdgcn_update_dpp(0, v, 0x4E, 0xF, 0xF, true);
    else if (J == 4) { const int t = __builtin_amdgcn_update_dpp(0, v, 0x1B, 0xF, 0xF, true);
                       return __builtin_amdgcn_update_dpp(0, t, 0x141, 0xF, 0xF, true); }
    else if (J == 8) return __builtin_amdgcn_update_dpp(0, v, 0x128, 0xF, 0xF, true);
    else if (J == 16) return (int)xor16_u((unsigned)v, lane);
    else if (J == 32) return (int)xor32_u((unsigned)v, lane);
    else return __shfl_xor(v, J);
}
template <int J> __device__ __forceinline__ float xchg_f(float v, const int lane) { return __int_as_float(xchg_i<J>(__float_as_int(v), lane)); }

__device__ __forceinline__ unsigned okey(float f) { const unsigned u = __float_as_uint(f); return (u & 0x80000000u) ? ~u : (u | 0x80000000u); }
template <int K, int J> __device__ __forceinline__ void bitonic_step(unsigned& k, const int lane) {
    const unsigned ok = (unsigned)xchg_i<J>((int)k, lane);
    const bool desc = (K == 64) ? true : ((lane & K) == 0);
    const bool keepmax = ((lane & J) == 0) == desc;
    const unsigned sel = keepmax ? 0xFFFFFFFFu : 0u;
    asm("v_med3_u32 %0, %1, %2, %3" : "=v"(k) : "v"(k), "v"(ok), "v"(sel));
}
template <int K, int J> __device__ __forceinline__ void bitonic_step4(unsigned& a, unsigned& b, unsigned& c, unsigned& d, const int lane) {
    const unsigned oa = (unsigned)xchg_i<J>((int)a, lane), ob = (unsigned)xchg_i<J>((int)b, lane), oc = (unsigned)xchg_i<J>((int)c, lane), od = (unsigned)xchg_i<J>((int)d, lane);
    const bool desc = (K == 64) ? true : ((lane & K) == 0);
    const unsigned sel = (((lane & J) == 0) == desc) ? 0xFFFFFFFFu : 0u;
    asm volatile("v_med3_u32 %0, %4, %8, %12\n\tv_med3_u32 %1, %5, %9, %12\n\tv_med3_u32 %2, %6, %10, %12\n\tv_med3_u32 %3, %7, %11, %12"
                 : "=&v"(a), "=&v"(b), "=&v"(c), "=&v"(d) : "0"(a), "1"(b), "2"(c), "3"(d), "v"(oa), "v"(ob), "v"(oc), "v"(od), "v"(sel));
}
template <int K, int J> __device__ __forceinline__ void bitonic_step2(unsigned& a, unsigned& b, const int lane) {
    const unsigned oa = (unsigned)xchg_i<J>((int)a, lane), ob = (unsigned)xchg_i<J>((int)b, lane);
    const bool desc = (K == 64) ? true : ((lane & K) == 0);
    const unsigned sel = (((lane & J) == 0) == desc) ? 0xFFFFFFFFu : 0u;
    asm volatile("v_med3_u32 %0, %2, %4, %6\n\tv_med3_u32 %1, %3, %5, %6" : "=&v"(a), "=&v"(b) : "0"(a), "1"(b), "v"(oa), "v"(ob), "v"(sel));
}
__device__ __forceinline__ void bitonic64(unsigned& k, const int lane) {
    bitonic_step<2, 1>(k, lane);
    bitonic_step<4, 2>(k, lane); bitonic_step<4, 1>(k, lane);
    bitonic_step<8, 4>(k, lane); bitonic_step<8, 2>(k, lane); bitonic_step<8, 1>(k, lane);
    bitonic_step<16, 8>(k, lane); bitonic_step<16, 4>(k, lane); bitonic_step<16, 2>(k, lane); bitonic_step<16, 1>(k, lane);
    bitonic_step<32, 16>(k, lane); bitonic_step<32, 8>(k, lane); bitonic_step<32, 4>(k, lane); bitonic_step<32, 2>(k, lane); bitonic_step<32, 1>(k, lane);
    bitonic_step<64, 32>(k, lane); bitonic_step<64, 16>(k, lane); bitonic_step<64, 8>(k, lane); bitonic_step<64, 4>(k, lane); bitonic_step<64, 2>(k, lane); bitonic_step<64, 1>(k, lane);
}
__device__ __forceinline__ void bitonic64_2(unsigned& a, unsigned& b, const int lane) {
#define B2_(K, J) bitonic_step2<K, J>(a, b, lane);
    B2_(2, 1)
    B2_(4, 2) B2_(4, 1)
    B2_(8, 4) B2_(8, 2) B2_(8, 1)
    B2_(16, 8) B2_(16, 4) B2_(16, 2) B2_(16, 1)
    B2_(32, 16) B2_(32, 8) B2_(32, 4) B2_(32, 2) B2_(32, 1)
    B2_(64, 32) B2_(64, 16) B2_(64, 8) B2_(64, 4) B2_(64, 2) B2_(64, 1)
#undef B2_
}
__device__ __forceinline__ void merge32(unsigned& k, const int lane) {
    bitonic_step<64, 16>(k, lane); bitonic_step<64, 8>(k, lane); bitonic_step<64, 4>(k, lane); bitonic_step<64, 2>(k, lane); bitonic_step<64, 1>(k, lane);
}
__device__ __forceinline__ void top16_of_128(const float* s, float& tv, int& ti, const int lane) {
    unsigned ka = (okey(s[lane]) & ~0x7Fu) | (unsigned)(127 - lane), kb = (okey(s[64 + lane]) & ~0x7Fu) | (unsigned)(63 - lane);
    bitonic64(ka, lane); bitonic64(kb, lane);
    const unsigned rb = (unsigned)__shfl((int)kb, 31 - lane);
    unsigned k = (lane < 16) ? ka : ((lane < 32) ? rb : 0u);
    merge32(k, lane);
    ti = 127 - (int)(k & 0x7Fu);
    tv = s[ti];
}

__device__ __forceinline__ unsigned mirror16(unsigned v) { return (unsigned)__builtin_amdgcn_update_dpp(0, (int)v, 0x140, 0xF, 0xF, true); }
__device__ __forceinline__ void top16_pair(const float* s1, const float* s2, float& tv, int& ti, const int lane) {
    unsigned a1 = (okey(s1[lane]) & ~0x7Fu) | (unsigned)(127 - lane), b1 = (okey(s1[64 + lane]) & ~0x7Fu) | (unsigned)(63 - lane);
    unsigned a2 = (okey(s2[lane]) & ~0x7Fu) | (unsigned)(127 - lane), b2 = (okey(s2[64 + lane]) & ~0x7Fu) | (unsigned)(63 - lane);
#define PEER_S4(K, J) bitonic_step4<K, J>(a1, b1, a2, b2, lane);
    PEER_S4(2, 1) PEER_S4(4, 2) PEER_S4(4, 1) PEER_S4(8, 4) PEER_S4(8, 2) PEER_S4(8, 1) PEER_S4(64, 8) PEER_S4(64, 4) PEER_S4(64, 2) PEER_S4(64, 1)
#undef PEER_S4
    unsigned m1 = max(a1, mirror16(b1)), m2 = max(a2, mirror16(b2));
#define PEER_S2(J) bitonic_step2<64, J>(m1, m2, lane);
    PEER_S2(8) PEER_S2(4) PEER_S2(2) PEER_S2(1)
#undef PEER_S2
    const bool odd = (lane & 16) != 0;
    const unsigned own = odd ? m2 : m1, snd = odd ? m1 : m2;
    unsigned c = max(own, xor16_u(mirror16(snd), lane));
    bitonic_step<64, 8>(c, lane); bitonic_step<64, 4>(c, lane); bitonic_step<64, 2>(c, lane); bitonic_step<64, 1>(c, lane);
    c = max(c, xor32_u(mirror16(c), lane));
    bitonic_step<64, 8>(c, lane); bitonic_step<64, 4>(c, lane); bitonic_step<64, 2>(c, lane); bitonic_step<64, 1>(c, lane);
    ti = 127 - (int)(c & 0x7Fu);
    tv = (odd ? s2 : s1)[ti];
}

#ifndef DUP_PEER
#define DUP_PEER 0
#endif
constexpr int PEER_EID_OFF = 131072, PEER_GATE_OFF = 139264;
#ifndef PEER_SORT
#define PEER_SORT 1
#endif
#ifndef PUB
#define PUB 4
#endif
#ifndef PVB
#define PVB 4
#endif

__device__ __forceinline__ void peer_unit(const Args& a, const int t0, const int tpw, unsigned char* lds, const int mode, const int eoff, float (&cf)[4]) {
    const bfr* QP = (const bfr*)(a.ws + WS_QP); const bfr* SUBK = (const bfr*)(a.ws + WS_SUBK);
    const unsigned char* PU4 = a.ws + WS_PU; const unsigned char* PV4 = a.ws + WS_PV;
    const bfr* HB = (const bfr*)(a.ws + WS_HB); const float* part = (const float*)(a.ws + WS_PART);
    float* S = (float*)lds; int* EID = (int*)(lds + PEER_EID_OFF + eoff); float* GATE = (float*)(lds + PEER_GATE_OFF);
    const int tid = my_tid(), lane = tid & 63, wv = tid >> 6, fr = lane & 15, fq = lane >> 4;
    uint2 hA[8], hB[8];
#pragma unroll
    for (int q = 0; q < 8; ++q) { hA[q] = *reinterpret_cast<const uint2*>(&HB[(size_t)(t0 + wv * tpw) * D + q * 256 + lane * 4]);
                                  hB[q] = *reinterpret_cast<const uint2*>(&HB[(size_t)(t0 + wv * tpw + tpw - 1) * D + q * 256 + lane * 4]); }
    if (mode == 0) {
    for (int hc = wv * 2; hc < wv * 2 + 2; ++hc) {
        bf16x8 A[4];
#pragma unroll
        for (int ks = 0; ks < 4; ++ks) A[ks] = *reinterpret_cast<const bf16x8*>(&QP[(size_t)(t0 + fr) * D + hc * 128 + ks * 32 + fq * 8]);
#pragma unroll 2
        for (int nt = 0; nt < 8; ++nt) {
            f32x4 acc = {0.f, 0.f, 0.f, 0.f};
#pragma unroll
            for (int ks = 0; ks < 4; ++ks) {
                const bf16x8 B = *reinterpret_cast<const bf16x8*>(&SUBK[(size_t)(hc * 128 + nt * 16 + fr) * 128 + ks * 32 + fq * 8]);
                acc = __builtin_amdgcn_mfma_f32_16x16x32_bf16(A[ks], B, acc, 0, 0, 0);
            }
#pragma unroll
            for (int j = 0; j < 4; ++j) S[((fq * 4 + j) * 16 + hc) * 128 + nt * 16 + fr] = acc[j];
        }
    }
    __syncthreads();
    }
    float cA0 = cf[0], cA1 = cf[1], cB0 = cf[2], cB1 = cf[3];
#pragma unroll 1
    for (int st_ = (mode ? 2 * tpw : 0); st_ < (mode ? 3 * tpw : 2 * tpw); ++st_) {
    const bool early = wv < 4;
    const int kind = (tpw == 1) ? st_ : ((st_ >= 4) ? 2 : (early ? (st_ & 1) : (st_ >> 1)));
    const int ti = (tpw == 1) ? 0 : ((st_ >= 4) ? (st_ - 4) : (early ? (st_ >> 1) : (st_ & 1)));
    const int tk = wv * tpw + ti;
    if (kind == 0) {
#pragma unroll 1
    for (int hh = 0; hh < 8; ++hh) {
        const int tok = tk;
        const float* s1 = S + (tok * 16 + hh * 2) * 128; const float* s2 = s1 + 128;
        float vv; int ii;
        top16_pair(s1, s2, vv, ii, lane);
        int ci = -1, cj = 0;
        { int base = 0;
#pragma unroll
          for (int i = 0; i < 16; ++i) { const int cnt = 16 / (i + 1); if (lane >= base && lane < base + cnt) { ci = i; cj = lane - base; } base += cnt; } }
        const float a1 = __shfl(vv, ci < 0 ? 0 : ci), b1 = __shfl(vv, 16 + cj);
        unsigned ck = (ci >= 0) ? ((okey(a1 + b1) & ~0xFFu) | (unsigned)(255 - (ci * 16 + cj))) : 0u;
        bitonic64(ck, lane);
        const int cid = 255 - (int)(ck & 0xFFu);
        const int pi = (lane < 16) ? (cid >> 4) : 0, pj = (lane < 16) ? (cid & 15) : 0;
        const float cv = __shfl(vv, pi) + __shfl(vv, 16 + pj);
        const float mx = __shfl(cv, 0);
        float e = (lane < 16) ? __expf(cv - mx) : 0.f;
        float se = e;
#pragma unroll
        for (int o = 1; o < 2; ++o) { se += dpp_f<DPP_XOR1>(se); se += dpp_f<DPP_XOR2>(se); se += dpp_f<0x141>(se); se += dpp_f<0x140>(se); }
        const int e1 = __shfl(ii, pi), e2 = __shfl(ii, 16 + pj);
        if (lane < 16) { EID[tok * 128 + hh * 16 + lane] = e1 * 128 + e2; GATE[tok * 128 + hh * 16 + lane] = e * frcp_(se); }
    }
    asm volatile("s_waitcnt lgkmcnt(0)" ::: "memory");
#if PEER_SORT
    {
        unsigned ka = ((unsigned)EID[tk * 128 + lane] << 7) | (unsigned)lane, kb = ((unsigned)EID[tk * 128 + 64 + lane] << 7) | (unsigned)(64 + lane);
        bitonic64_2(ka, kb, lane);
        const unsigned kr = xor32_u(xor16_u(mirror16(kb), lane), lane);
        unsigned hi = max(ka, kr), lo = min(ka, kr);
        bitonic_step2<64, 32>(hi, lo, lane); bitonic_step2<64, 16>(hi, lo, lane); bitonic_step2<64, 8>(hi, lo, lane);
        bitonic_step2<64, 4>(hi, lo, lane); bitonic_step2<64, 2>(hi, lo, lane); bitonic_step2<64, 1>(hi, lo, lane);
        const float g0 = GATE[tk * 128 + (hi & 127u)], g1 = GATE[tk * 128 + (lo & 127u)];
        asm volatile("s_waitcnt lgkmcnt(0)" ::: "memory");
        __builtin_amdgcn_wave_barrier();
        const int p0 = ti ? 127 - lane : lane, p1 = ti ? 63 - lane : 64 + lane;
        EID[tk * 128 + p0] = (int)(hi >> 7); EID[tk * 128 + p1] = (int)(lo >> 7);
        GATE[tk * 128 + p0] = g0; GATE[tk * 128 + p1] = g1;
        asm volatile("s_waitcnt lgkmcnt(0)" ::: "memory");
    }
#endif
    } else if (kind == 1) {
    {
        const int t = t0 + tk;
        uint2 hcur[8];
#pragma unroll
        for (int q = 0; q < 8; ++q) { hcur[q].x = ti ? hB[q].x : hA[q].x; hcur[q].y = ti ? hB[q].y : hA[q].y; }
        int ln = lane; asm volatile("" : "+v"(ln));
        const unsigned lnsc = 1024u + (unsigned)ln * 2u, ln16 = (unsigned)ln * 16u;
        const float rstd = row_rstd(part, t);
        unsigned q1[4], q2[4]; float h1s, hsc;
        {
            float hf[32]; float am = 0.f;
#pragma unroll
            for (int q = 0; q < 8; ++q) {
                const uint2 xr = hcur[q];
                const float4 g0 = *reinterpret_cast<const float4*>(&a.in[I_NFG][q * 256 + ln * 4]);
                hf[q * 4] = bflo(xr.x) * rstd * g0.x; hf[q * 4 + 1] = bfhi(xr.x) * rstd * g0.y; hf[q * 4 + 2] = bflo(xr.y) * rstd * g0.z; hf[q * 4 + 3] = bfhi(xr.y) * rstd * g0.w;
                am = fmaxf(am, fmaxf(fmaxf(fabsf(hf[q * 4]), fabsf(hf[q * 4 + 1])), fmaxf(fabsf(hf[q * 4 + 2]), fabsf(hf[q * 4 + 3]))));
            }
            h1s = am * (1.f / 7.f); const float i1 = h1s > 0.f ? frcp_(h1s) : 0.f;
            float qv[32];
#pragma unroll
            for (int i = 0; i < 32; ++i) { qv[i] = fminf(fmaxf(__builtin_rintf(hf[i] * i1), -7.f), 7.f); hf[i] -= qv[i] * h1s; }
            q1[0] = pack8_i4(qv); q1[1] = pack8_i4(qv + 8); q1[2] = pack8_i4(qv + 16); q1[3] = pack8_i4(qv + 24);
            hsc = h1s * (1.f / 14.f); const float i2 = 14.f * i1;
#pragma unroll
            for (int i = 0; i < 32; ++i) qv[i] = fminf(fmaxf(__builtin_rintf(hf[i] * i2), -7.f), 7.f);
            q2[0] = pack8_i4(qv); q2[1] = pack8_i4(qv + 8); q2[2] = pack8_i4(qv + 16); q2[3] = pack8_i4(qv + 24);
        }
        float coef0 = 0.f, coef1 = 0.f;
        const bool swaph = (tpw == 2) && !early && (ti == 0);
#pragma unroll 1
        for (int hi_ = 0; hi_ < 2; ++hi_) {
            const int half = swaph ? 1 - hi_ : hi_;
            float mydot = 0.f;
#define PEER_LOAD_U(W, SC, E0) _Pragma("unroll") for (int bq = 0; bq < PUB; ++bq) { \
                const unsigned rb_ = __umul24((unsigned)EID[tk * 128 + half * 64 + (E0) + bq], (unsigned)PEER_ROWB);            \
                SC[bq] = *reinterpret_cast<const bfr*>(PU4 + (rb_ + lnsc)); W[bq] = *reinterpret_cast<const uint4*>(PU4 + (rb_ + ln16)); } __builtin_amdgcn_sched_barrier(0);
#define PEER_DOT_U(W, SC, E0) { float pp[PUB]; _Pragma("unroll") for (int bq = 0; bq < PUB; ++bq) { \
                int a1 = 0; \
                a1 = __builtin_amdgcn_sdot8((int)W[bq].x, (int)q1[0], a1, false); a1 = __builtin_amdgcn_sdot8((int)W[bq].y, (int)q1[1], a1, false); \
                a1 = __builtin_amdgcn_sdot8((int)W[bq].z, (int)q1[2], a1, false); a1 = __builtin_amdgcn_sdot8((int)W[bq].w, (int)q1[3], a1, false); \
                int a2 = __mul24(a1, 14); \
                a2 = __builtin_amdgcn_sdot8((int)W[bq].x, (int)q2[0], a2, false); a2 = __builtin_amdgcn_sdot8((int)W[bq].y, (int)q2[1], a2, false); \
                a2 = __builtin_amdgcn_sdot8((int)W[bq].z, (int)q2[2], a2, false); a2 = __builtin_amdgcn_sdot8((int)W[bq].w, (int)q2[3], a2, false); \
                pp[bq] = (float)a2 * (hsc * bf2f(SC[bq])); } \
                const float tot_ = wave_sum4(pp[0], pp[1], pp[2], pp[3], lane);            \
                if ((lane >> 2) == (((E0)) >> 2)) mydot = tot_; __builtin_amdgcn_sched_barrier(0); }
            static_assert(PUB == 4, "the batched wave reduction folds four rows");
            {
                uint4 wA[PUB], wB[PUB]; bfr sA[PUB], sB[PUB];
                PEER_LOAD_U(wA, sA, 0)
#pragma unroll 1
                for (int e0 = 0; e0 < 64 - 2 * PUB; e0 += 2 * PUB) {
                    PEER_LOAD_U(wB, sB, e0 + PUB)
                    PEER_DOT_U(wA, sA, e0)
                    PEER_LOAD_U(wA, sA, e0 + 2 * PUB)
                    PEER_DOT_U(wB, sB, e0 + PUB)
                }
                PEER_LOAD_U(wB, sB, 64 - PUB)
                PEER_DOT_U(wA, sA, 64 - 2 * PUB)
                PEER_DOT_U(wB, sB, 64 - PUB)
            }
            const float gl = 0.5f * mydot * (1.f + erff(mydot * 0.7071067811865476f));
            const float cfv = gl * GATE[tk * 128 + half * 64 + lane];
            if (half == 0) coef0 = cfv; else coef1 = cfv;
        }
        if (ti) { cB0 = coef0; cB1 = coef1; } else { cA0 = coef0; cA1 = coef1; }
    }
    } else {
    {
        const int t = t0 + tk;
        uint2 hcur[8];
#pragma unroll
        for (int q = 0; q < 8; ++q) { hcur[q].x = ti ? hB[q].x : hA[q].x; hcur[q].y = ti ? hB[q].y : hA[q].y; }
        int ln = lane; asm volatile("" : "+v"(ln));
        const unsigned lnsc = 1024u + (unsigned)ln * 2u, ln16 = (unsigned)ln * 16u;
        const float coef0 = ti ? cB0 : cA0, coef1 = ti ? cB1 : cA1;
        h16x2 ov2[16];
#pragma unroll
        for (int j = 0; j < 16; ++j) ov2[j] = h16x2{(_Float16)0.f, (_Float16)0.f};
        {
#define PEER_LOAD_V(W, SC, E0) _Pragma("unroll") for (int bq = 0; bq < PVB; ++bq) { \
                const unsigned rb_ = __umul24((unsigned)EID[tk * 128 + (E0) + bq], (unsigned)PEER_ROWB); \
                SC[bq] = *reinterpret_cast<const bfr*>(PV4 + (rb_ + lnsc)); W[bq] = *reinterpret_cast<const uint4*>(PV4 + (rb_ + ln16)); } __builtin_amdgcn_sched_barrier(0);
#define PEER_AXPY_V(W, SC, E0) _Pragma("unroll") for (int bq = 0; bq < PVB; ++bq) { \
                const float cfl = __int_as_float(__builtin_amdgcn_readlane(__float_as_int(((E0) < 64) ? coef0 : coef1), ((E0) + bq) & 63)); \
                const unsigned dw[4] = {W[bq].x, W[bq].y, W[bq].z, W[bq].w}; const _Float16 ch = (_Float16)(cfl * bf2f(SC[bq])); const h16x2 c2 = {ch, ch}; \
                _Pragma("unroll") for (int d = 0; d < 4; ++d) { \
                    ov2[d * 4 + 0] = c2 * __builtin_amdgcn_cvt_scalef32_pk_f16_fp4(dw[d], 1.0f, 0) + ov2[d * 4 + 0]; \
                    ov2[d * 4 + 1] = c2 * __builtin_amdgcn_cvt_scalef32_pk_f16_fp4(dw[d], 1.0f, 1) + ov2[d * 4 + 1]; \
                    ov2[d * 4 + 2] = c2 * __builtin_amdgcn_cvt_scalef32_pk_f16_fp4(dw[d], 1.0f, 2) + ov2[d * 4 + 2]; \
                    ov2[d * 4 + 3] = c2 * __builtin_amdgcn_cvt_scalef32_pk_f16_fp4(dw[d], 1.0f, 3) + ov2[d * 4 + 3]; } \
                __builtin_amdgcn_sched_barrier(0); }
            uint4 wA[PVB], wB[PVB]; bfr sA[PVB], sB[PVB];
            PEER_LOAD_V(wA, sA, 0)
#pragma unroll 1
            for (int e0 = 0; e0 < 128 - 2 * PVB; e0 += 2 * PVB) {
                PEER_LOAD_V(wB, sB, e0 + PVB)
                PEER_AXPY_V(wA, sA, e0)
                PEER_LOAD_V(wA, sA, e0 + 2 * PVB)
                PEER_AXPY_V(wB, sB, e0 + PVB)
            }
            PEER_LOAD_V(wB, sB, 128 - PVB)
            PEER_AXPY_V(wA, sA, 128 - 2 * PVB)
            PEER_AXPY_V(wB, sB, 128 - PVB)
        }
        float ss = 0.f;
        float hv[32];
        {
#pragma unroll
          for (int q = 0; q < 8; ++q) {
              const uint2 xr = hcur[q];
              float4 x0; x0.x = bflo(xr.x); x0.y = bfhi(xr.x); x0.z = bflo(xr.y); x0.w = bfhi(xr.y);
              hv[q * 4 + 0] = x0.x; hv[q * 4 + 1] = x0.y; hv[q * 4 + 2] = x0.z; hv[q * 4 + 3] = x0.w;
          } }
#pragma unroll
        for (int j = 0; j < 32; ++j) { hv[j] += (DBG_NOPEER ? 0.f : (float)ov2[j >> 1][j & 1]); ss += hv[j] * hv[j]; }
        ss = wave_sum(ss);
        const float r2 = rsqrtf(ss * (1.f / D) + EPS);
#pragma unroll
        for (int q = 0; q < 8; ++q) {
            const float4 g0 = *reinterpret_cast<const float4*>(&a.in[I_NFIN][q * 256 + ln * 4]);
            float4 o0;
            o0.x = hv[q * 4 + 0] * r2 * g0.x; o0.y = hv[q * 4 + 1] * r2 * g0.y; o0.z = hv[q * 4 + 2] * r2 * g0.z; o0.w = hv[q * 4 + 3] * r2 * g0.w;
            *reinterpret_cast<float4*>(&a.out[(size_t)t * D + q * 256 + ln * 4]) = o0;
        }
    }
    }
    }
    cf[0] = cA0; cf[1] = cA1; cf[2] = cB0; cf[3] = cB1;
    __syncthreads();
}
constexpr int NPHASE = 9;
__global__ void __launch_bounds__(512, 2) mk_fwd(Args a) {
    extern __shared__ __attribute__((aligned(16))) unsigned char lds[];
    volatile LAS unsigned* barw = (volatile LAS unsigned*)((LAS unsigned char*)lds + LDS_BARW);
    unsigned* MISC = (unsigned*)(lds + LDS_MISC);
    if (threadIdx.x < 4) barw[threadIdx.x] = 0u;
    __syncthreads();
    XcdBarrier bar; bar.bar = (unsigned*)(a.ws + WS_CTL); bar.x = 0; bar.st = barw;
#if !MK_SPLIT
    bar = xcd_barrier_post((unsigned*)(a.ws + WS_CTL), barw);
#endif
    const int lo = a.ph_lo, hi = a.ph_hi;
#ifndef PH_MASK
#define PH_MASK 0x1FF
#endif
#define IN(k) (((PH_MASK >> (k)) & 1) && lo <= (k) && (k) < hi)
#ifndef DUP_RW
#define DUP_RW 0
#endif
#ifndef DUP_CHAIN
#define DUP_CHAIN 0
#endif
#ifndef DUP_MASK
#define DUP_MASK 0
#endif
#define REP(k) for (int rep_ = 0; rep_ < (((DUP_MASK >> (k)) & 1) ? 2 : 1); ++rep_)
#define SEAM(k) do { if (IN(k) && IN((k) + 1)) xcd_barrier(bar); } while (0)
    unsigned char* ws = a.ws;
    const bfr* P = (const bfr*)(ws + WS_P);

    if (IN(0)) REP(0) {
        const int tid = my_tid(), wv = tid >> 6; (void)tid; (void)wv;
        {
            const float* x = a.in[I_X]; const float* g = a.in[I_NMG]; bfr* XN = (bfr*)(ws + WS_XN);
            const int lane = tid & 63;
            for (int row = blockIdx.x * 8 + wv; row < T; row += gridDim.x * 8) {
                float4 v[8]; float ss = 0.f;
#pragma unroll
                for (int j = 0; j < 8; ++j) { v[j] = reinterpret_cast<const float4*>(x + (size_t)row * D)[j * 64 + lane]; ss += v[j].x * v[j].x + v[j].y * v[j].y + v[j].z * v[j].z + v[j].w * v[j].w; }
                ss = wave_sum(ss);
                const float rs = rsqrtf(ss * (1.f / D) + EPS);
#pragma unroll
                for (int j = 0; j < 8; ++j) {
                    const float4 gg = reinterpret_cast<const float4*>(g)[j * 64 + lane];
                    uint2 o; o.x = pack2(v[j].x * rs * gg.x, v[j].y * rs * gg.y); o.y = pack2(v[j].z * rs * gg.z, v[j].w * rs * gg.w);
                    reinterpret_cast<uint2*>(XN + (size_t)row * D)[j * 64 + lane] = o;
                }
            }
        }
        float* tl = (float*)lds;
        tr_all(a.in[I_WIN], (bfr*)(ws + WS_WTIN), D, NIN, NINP, nullptr, tl);
        tr_all(a.in[I_WBR], (bfr*)(ws + WS_WTA), RW, D, D, nullptr, tl);
        tr_all(a.in[I_WBD], (bfr*)(ws + WS_WTB), RW, D, D, nullptr, tl);
        tr_all(a.in[I_WOUT], (bfr*)(ws + WS_WTOUT), D, D, D, nullptr, tl);
        tr_all(a.in[I_WPQ], (bfr*)(ws + WS_WTPQ), D, D, D, a.in[I_NFG], tl);
        for (int it = blockIdx.x; it < 16 * 4; it += gridDim.x) {
            const int h = it >> 2, k0 = (it & 3) * 64;
            tr_tile(a.in[I_WUV] + (size_t)h * 256 * 64, (bfr*)(ws + WS_WUVT) + (size_t)h * 64 * 256, 256, 64, k0, 0, nullptr, tl);
        }
        cvt_all(a.in[I_WUK], (bfr*)(ws + WS_WUK), (size_t)16 * 256 * 64);
        cvt_all(a.in[I_SUBK], (bfr*)(ws + WS_SUBK), (size_t)16 * 128 * 128);
    }
    SEAM(0);

#ifndef PEER_BLKSTAG
#define PEER_BLKSTAG 0
#endif
#ifndef PV_SPLIT
#define PV_SPLIT 0
#endif
    if (IN(1)) REP(1) {
        const int tid = my_tid(), wv = tid >> 6; (void)tid; (void)wv;
        EpiP E{(bfr*)(ws + WS_P)};
        const int nM = T / BM, nN = NINP / BM;
        for (int tile = blockIdx.x; tile < nM * nN; tile += gridDim.x) {
            int brow, bcol; tile_rc(tile, nM, nN, brow, bcol);
            gemm_tile((const bfr*)(ws + WS_XN), (const bfr*)(ws + WS_WTIN), D, brow, bcol, (bfr*)lds, E);
        }
        {
            const int rem = (nM * nN) % (int)gridDim.x, idle = (int)gridDim.x - rem;
            const int crank = (rem == 0) ? (int)blockIdx.x : (int)blockIdx.x - rem, cn = (rem == 0) ? (int)gridDim.x : idle;
            if (crank >= 0) {
                cvt_i4_rows(a.in[I_PU], ws + WS_PU, crank * 8 + wv, cn * 8, 0, 16384);
                cvt_fp4_rows(a.in[I_PV], ws + WS_PV, crank * 8 + wv, cn * 8, 0, PV_SPLIT);
            }
        }
    }
    if (IN(1) && IN(2)) { __syncthreads(); rwkv_load_weights(a, blockIdx.x & 15, lds); }
    SEAM(1);

    if (IN(2)) REP(2) {
        const int tid = my_tid(), wv = tid >> 6; (void)tid; (void)wv;
        if (!IN(1)) rwkv_load_weights(a, blockIdx.x & 15, lds);
        CnIn cn;
        {
            const int h = blockIdx.x & 15, nun = (NUNIT - (int)blockIdx.x + (int)gridDim.x - 1) / (int)gridDim.x;
            RwIn inA, inB;
            dsa_cnorm_fetch(a, cn);
            if (nun > 0) { rwkv_fetch(a, (int)blockIdx.x >> 4, h, inA); rwkv_fetch_rkv(a, (int)blockIdx.x >> 4, h, inA); }
            for (int k = 0; k < nun; k += 2) {
                const int c0 = ((int)blockIdx.x + k * (int)gridDim.x) >> 4, c1 = ((int)blockIdx.x + (k + 1) * (int)gridDim.x) >> 4, c2 = ((int)blockIdx.x + (k + 2) * (int)gridDim.x) >> 4;
                rwkv_unit(a, c0, h, lds, inA, inB, (k + 1 < nun) ? c1 : -1);
                if (k + 1 < nun) rwkv_unit(a, c1, h, lds, inB, inA, (k + 2 < nun) ? c2 : -1);
            }
        }
        dsa_cnorm_finish(a, cn);
        dsa_qlat(a);
    }
    SEAM(2);

    if (IN(3)) REP(3) {
        const int tid = my_tid(), wv = tid >> 6; (void)tid; (void)wv;
        if (blockIdx.x < 32) {
            if (wv == 0) rwkv_chain(a, blockIdx.x >> 1, blockIdx.x & 1);
            else cvt_fp4_rows(a.in[I_PV], ws + WS_PV, (int)blockIdx.x * 7 + (wv - 1), 32 * 7, PV_SPLIT, 16384);
        }
        __syncthreads();
        for (int i = tid; i < 512; i += 512) ((float*)(lds + DSA_RELB_OFF))[i] = a.in[I_RELB][i];
        __syncthreads();
        unsigned* cnt = (unsigned*)(ws + WS_CTL + CTL_CNT) + rep_ * 64;
        unsigned nreg = 0;
        if (tid == 0) nreg = atomicAdd(cnt, 1u);
        for (;;) {
            if (tid == 0) MISC[0] = nreg;
            __syncthreads();
            const unsigned n = MISC[0];
            __syncthreads();
            if (n >= T / 8) break;
            dsa_unit(a, (T / 8 - 1) - (int)n, lds, cnt, nreg);
        }
    }
    SEAM(3);

    if (IN(4)) REP(4) {
        const int tid = my_tid(), wv = tid >> 6; (void)tid; (void)wv;
        float* Ls = (float*)lds + wv * 4352;
        for (int u = blockIdx.x * 8 + wv; u < NUNIT; u += gridDim.x * 8) rwkv_out_unit(a, u, Ls);
        dsa_oproj(a);
    }
    SEAM(4);

    if (IN(5)) REP(5) {
        const int tid = my_tid(), wv = tid >> 6; (void)tid; (void)wv;
        const int nM = T / BM, nN = D / BM;
        for (int tile = blockIdx.x; tile < nM * nN; tile += gridDim.x) {
            int brow, bcol; tile_rc(tile, nM, nN, brow, bcol);
#pragma unroll 1
            for (int pass = 0; pass < 2; ++pass) {
                EpiMix E{(bfr*)(ws + (pass ? WS_MIX : WS_TMPA)), pass ? (const bfr*)(ws + WS_TMPA) : (const bfr*)nullptr, P + (pass ? C_GB : C_GA)};
                gemm_tile((const bfr*)(ws + (pass ? WS_DO : WS_RWO)), (const bfr*)(ws + (pass ? WS_WTB : WS_WTA)), RW, brow, bcol, (bfr*)lds, E);
                asm volatile("s_waitcnt vmcnt(0)" ::: "memory");
            }
        }
    }
    SEAM(5);

    if (IN(6)) REP(6) {
        const int tid = my_tid(), wv = tid >> 6; (void)tid; (void)wv;
        const int nM = T / BM, nN = D / BM;
        for (int tile = blockIdx.x; tile < nM * nN; tile += gridDim.x) {
            int brow, bcol; tile_rc(tile, nM, nN, brow, bcol);
            EpiH E{(bfr*)(ws + WS_HB), a.in[I_X], (float*)(ws + WS_PART), bcol >> 8};
            gemm_tile((const bfr*)(ws + WS_MIX), (const bfr*)(ws + WS_WTOUT), D, brow, bcol, (bfr*)lds, E);
        }
    }
    SEAM(6);

    if (IN(7)) REP(7) {
        const int tid = my_tid(), wv = tid >> 6; (void)tid; (void)wv;
        const int nM = T / BM, nN = D / BM;
        for (int tile = blockIdx.x; tile < nM * nN; tile += gridDim.x) {
            int brow, bcol; tile_rc(tile, nM, nN, brow, bcol);
            EpiQ E{(bfr*)(ws + WS_QP), (const float*)(ws + WS_PART)};
            gemm_tile((const bfr*)(ws + WS_HB), (const bfr*)(ws + WS_WTPQ), D, brow, bcol, (bfr*)lds, E);
        }
    }
    SEAM(7);

    if (IN(8)) REP(8) {
        const int tid = my_tid(), wv = tid >> 6; (void)tid; (void)wv;
        for (int tb = (int)blockIdx.x * 32; tb < T; tb += (int)gridDim.x * 32) {
            float c0[4] = {0.f, 0.f, 0.f, 0.f}, c1[4] = {0.f, 0.f, 0.f, 0.f};
#pragma unroll 1
            for (int i = 0; i < 4; ++i) {
                const int un = i & 1, mode = i >> 1;
                float cc[4];
#pragma unroll
                for (int j = 0; j < 4; ++j) cc[j] = un ? c1[j] : c0[j];
                peer_unit(a, tb + un * 16, 2, lds, mode, un * 16384, cc);
#pragma unroll
                for (int j = 0; j < 4; ++j) { if (un) c1[j] = cc[j]; else c0[j] = cc[j]; }
            }
        }
    }
#undef IN
#undef SEAM
}

extern "C" void kernel_launch(void* const* d_in, const int* in_sizes, int n_in, void* d_out, int out_size, void* d_ws, size_t ws_size, hipStream_t stream) {
    static int grid = 0;
    if (grid == 0) {
        if (n_in != 27 || out_size != T * D || ws_size < WS_END) { fprintf(stderr, "kernel_launch: unexpected shapes (n_in %d out %d ws %zu)\n", n_in, out_size, ws_size); grid = -1; return; }
        int dev = 0, cus = 0, per_cu = 0;
        if (hipGetDevice(&dev) != hipSuccess || hipDeviceGetAttribute(&cus, hipDeviceAttributeMultiprocessorCount, dev) != hipSuccess) { grid = -1; return; }
        if (hipFuncSetAttribute((const void*)mk_fwd, hipFuncAttributeMaxDynamicSharedMemorySize, LDS_BYTES) != hipSuccess) { fprintf(stderr, "kernel_launch: hipFuncSetAttribute failed\n"); grid = -1; return; }
        if (hipOccupancyMaxActiveBlocksPerMultiprocessor(&per_cu, (const void*)mk_fwd, 512, LDS_BYTES) != hipSuccess || per_cu < 1) { fprintf(stderr, "kernel_launch: occupancy query says %d\n", per_cu); (void)hipGetLastError(); grid = -1; return; }
        grid = cus;
    }
    if (grid < 0) return;
    if (hipMemsetAsync((char*)d_ws + WS_CTL, 0, CTL_ZERO, stream) != hipSuccess) return;
    Args a{};
    for (int i = 0; i < 27; ++i) a.in[i] = (const float*)d_in[i];
    a.out = (float*)d_out; a.ws = (unsigned char*)d_ws;
#if MK_SPLIT
    for (int ph = 0; ph < NPHASE; ++ph) { a.ph_lo = ph; a.ph_hi = ph + 1; hipLaunchKernelGGL(mk_fwd, dim3(grid), dim3(512), LDS_BYTES, stream, a); }
#elif defined(PROBE_PHASE)
    a.ph_lo = 0; a.ph_hi = PROBE_PHASE + 1;
    hipLaunchKernelGGL(mk_fwd, dim3(grid), dim3(512), LDS_BYTES, stream, a);
    (void)hipMemsetAsync((char*)d_ws + WS_CTL, 0, CTL_ZERO, stream);
    a.ph_lo = PROBE_PHASE; a.ph_hi = NPHASE;
    hipLaunchKernelGGL(mk_fwd, dim3(grid), dim3(512), LDS_BYTES, stream, a);
#else
    a.ph_lo = 0; a.ph_hi = NPHASE;
    hipLaunchKernelGGL(mk_fwd, dim3(grid), dim3(512), LDS_BYTES, stream, a);
#endif
}
```
